# Optimizing an MI355X kernel written in HIP

```python
import jax, jax.numpy as jnp
from jax import lax
import numpy as np

D_MODEL = 1024
BATCH = 2
SEQ = 16384
DEPTH = 4

GRID_W = 64
CTX_LEN = 256
HEAD_DIM = 128
N_Q_HEADS = D_MODEL // HEAD_DIM
N_KV_HEADS = 2
GROUP = N_Q_HEADS // N_KV_HEADS
ATTN_WIDTH = N_Q_HEADS * HEAD_DIM
KV_WIDTH = N_KV_HEADS * HEAD_DIM
POOL_WIDTH = D_MODEL // 2
POOL_WINDOWS = (2, 4, 8, 16)
N_POOL_GROUPS = 4
POOL_GROUP = POOL_WIDTH // N_POOL_GROUPS
N_IN = 2 * ATTN_WIDTH + 2 * KV_WIDTH + 2 * POOL_WIDTH + 2 * D_MODEL
Q_BLOCK = 128
ROPE_THETA = 10000.0
ROT_AXIS = HEAD_DIM // 2
N_FREQ = ROT_AXIS // 2
EPS = 1e-6
ALPHA = (2 * DEPTH) ** 0.25
BETA = (8 * DEPTH) ** -0.25

kernel_name = "hybrid_gqa_pool_parallel_deepnorm"


def rms_norm(x, g):
    xf = x.astype(jnp.float32)
    y = xf * lax.rsqrt(jnp.mean(xf * xf, axis=-1, keepdims=True) + EPS)
    return (y * g.astype(jnp.float32)).astype(x.dtype)


def layer_norm(x, g, b):
    xf = x.astype(jnp.float32)
    mu = jnp.mean(xf, axis=-1, keepdims=True)
    var = jnp.mean(jnp.square(xf - mu), axis=-1, keepdims=True)
    y = (xf - mu) * lax.rsqrt(var + EPS)
    return (y * g.astype(jnp.float32) + b.astype(jnp.float32)).astype(x.dtype)


def rope_tables(L):
    t = jnp.arange(L, dtype=jnp.int32)
    row = (t // GRID_W).astype(jnp.float32)
    col = (t % GRID_W).astype(jnp.float32)
    inv_freq = 1.0 / (ROPE_THETA ** (jnp.arange(N_FREQ, dtype=jnp.float32) / N_FREQ))
    ang = jnp.stack([row[:, None] * inv_freq[None, :], col[:, None] * inv_freq[None, :]], axis=1)
    return jnp.cos(ang), jnp.sin(ang)


def apply_rope(x, cos, sin):
    xf = x.astype(jnp.float32).reshape(x.shape[:-1] + (2, 2, N_FREQ))
    x1 = xf[..., 0, :]
    x2 = xf[..., 1, :]
    out = jnp.stack([x1 * cos - x2 * sin, x1 * sin + x2 * cos], axis=-2)
    return out.reshape(x.shape).astype(x.dtype)


def split_in(h):
    sizes = (ATTN_WIDTH, KV_WIDTH, KV_WIDTH, ATTN_WIDTH, POOL_WIDTH, POOL_WIDTH, D_MODEL, D_MODEL)
    outs = []
    o = 0
    for s in sizes:
        outs.append(h[..., o:o + s])
        o += s
    return outs


def heads(q, k, v, q_g, k_g):
    B, L = q.shape[0], q.shape[1]
    q = rms_norm(q.reshape(B, L, N_KV_HEADS, GROUP, HEAD_DIM), q_g).transpose(0, 2, 3, 1, 4)
    k = rms_norm(k.reshape(B, L, N_KV_HEADS, HEAD_DIM), k_g).transpose(0, 2, 1, 3)
    v = v.reshape(B, L, N_KV_HEADS, HEAD_DIM).transpose(0, 2, 1, 3)
    return q, k, v


def attend(q, k, v):
    s = jnp.einsum('bgrqd,bgkd->bgrqk', q * (HEAD_DIM ** -0.5), k).astype(jnp.float32)
    p = jax.nn.softmax(s, axis=-1).astype(v.dtype)
    return jnp.einsum('bgrqk,bgkd->bgrqd', p, v)


def latent_attention(q, k_all, v_all):
    B, G, R, L, hd = q.shape
    nb = L // Q_BLOCK
    qb = q.reshape(B, G, R, nb, Q_BLOCK, hd).transpose(3, 0, 1, 2, 4, 5)
    ob = lax.map(lambda qblk: attend(qblk, k_all, v_all), qb)
    return ob.transpose(1, 0, 4, 2, 3, 5).reshape(B, L, G * R * hd)


def context_attention(q, k, v):
    B, G, R, T, hd = q.shape
    return attend(q, k, v).transpose(0, 3, 1, 2, 4).reshape(B, T, G * R * hd)


def window_mean(x, w):
    B, L, C = x.shape
    a = w // 2
    b = w - a
    xf = x.astype(jnp.float32)
    xp = jnp.pad(xf, ((0, 0), (a, b), (0, 0)))
    cs = jnp.concatenate([jnp.zeros((B, 1, C), jnp.float32), jnp.cumsum(xp, axis=1)], axis=1)
    s = cs[:, w:w + L] - cs[:, :L]
    t = jnp.arange(L, dtype=jnp.int32)
    cnt = (jnp.minimum(t + b, L) - jnp.maximum(t - a, 0)).astype(jnp.float32)
    return (s / cnt[None, :, None]).astype(x.dtype)


def pool_mixer(xb, w_pool, pool_scale):
    B, L, _ = xb.shape
    parts = []
    for gi, w in enumerate(POOL_WINDOWS):
        xg = xb[..., gi * POOL_GROUP:(gi + 1) * POOL_GROUP]
        parts.append(window_mean(xg, w) - xg)
    m = jnp.stack(parts, axis=2)
    y = jnp.einsum('blgc,gcd->blgd', m, w_pool).reshape(B, L, POOL_WIDTH)
    return y * pool_scale


def merge(o_attn, z_attn, p_pool, z_pool, g_attn, g_pool, w_br_a, w_br_b, w_out):
    ya = (o_attn * jax.nn.silu(z_attn)) @ w_br_a
    yb = (p_pool * jax.nn.silu(z_pool)) @ w_br_b
    y = jax.nn.sigmoid(g_attn) * ya + jax.nn.sigmoid(g_pool) * yb
    return y @ w_out


def layer(x, cx, c, c_ctx, cos, sin, w_mod, b_mod, w_in, q_g, k_g, w_pool, pool_scale,
          w_br_a, w_br_b, w_out, ln_g, ln_b, update_ctx):
    mod = jax.nn.silu(c) @ w_mod + b_mod
    mod_c = jax.nn.silu(c_ctx) @ w_mod + b_mod
    shift, scale, gate = mod[:, None, :D_MODEL], mod[:, None, D_MODEL:2 * D_MODEL], mod[:, None, 2 * D_MODEL:]
    shift_c, scale_c, gate_c = mod_c[:D_MODEL], mod_c[D_MODEL:2 * D_MODEL], mod_c[2 * D_MODEL:]
    u = x * (1.0 + scale) + shift
    uc = cx * (1.0 + scale_c) + shift_c

    q, k, v, za, xb, zb, ga, gb = split_in(u @ w_in)
    qc_, kc_, vc_, zac, xbc, zbc, gac, gbc = split_in(uc @ w_in)

    q, k, v = heads(q, k, v, q_g, k_g)
    q = apply_rope(q, cos, sin)
    k = apply_rope(k, cos, sin)
    qc, kc, vc = heads(qc_, kc_, vc_, q_g, k_g)

    k_all = jnp.concatenate([kc, k], axis=2)
    v_all = jnp.concatenate([vc, v], axis=2)
    o_lat = latent_attention(q, k_all, v_all)
    p_lat = pool_mixer(xb, w_pool, pool_scale)
    y_lat = merge(o_lat, za, p_lat, zb, ga, gb, w_br_a, w_br_b, w_out)
    x_new = layer_norm(ALPHA * x + gate * y_lat, ln_g, ln_b)

    if update_ctx:
        o_ctx = context_attention(qc, kc, vc)
        p_ctx = pool_mixer(xbc, w_pool, pool_scale)
        y_ctx = merge(o_ctx, zac, p_ctx, zbc, gac, gbc, w_br_a, w_br_b, w_out)
        cx = layer_norm(ALPHA * cx + gate_c * y_ctx, ln_g, ln_b)
    return x_new, cx


def setup_inputs(seed: int = 0) -> dict:
    key = jax.random.key(seed)
    ks = jax.random.split(key, 18)
    f32 = jnp.float32
    n = lambda k, s: jax.random.normal(k, s, f32)
    w_in = n(ks[6], (DEPTH, D_MODEL, N_IN)) * D_MODEL ** -0.5
    v_lo = ATTN_WIDTH + KV_WIDTH
    w_in = w_in.at[:, :, v_lo:v_lo + KV_WIDTH].multiply(BETA)
    return {
        "x": n(ks[0], (BATCH, SEQ, D_MODEL)),
        "c": n(ks[1], (BATCH, D_MODEL)),
        "ctx": n(ks[2], (BATCH, CTX_LEN, D_MODEL)),
        "c_ctx": n(ks[3], (D_MODEL,)),
        "w_mod": n(ks[4], (DEPTH, D_MODEL, 3 * D_MODEL)) * 0.5 * D_MODEL ** -0.5,
        "b_mod": n(ks[5], (DEPTH, 3 * D_MODEL)) * 0.01,
        "w_in": w_in,
        "q_norm": 1.0 + 0.02 * n(ks[7], (DEPTH, HEAD_DIM)),
        "k_norm": 1.0 + 0.02 * n(ks[8], (DEPTH, HEAD_DIM)),
        "w_pool": n(ks[9], (DEPTH, N_POOL_GROUPS, POOL_GROUP, POOL_GROUP)) * POOL_GROUP ** -0.5,
        "pool_scale": 1.0 + 0.1 * n(ks[10], (DEPTH, POOL_WIDTH)),
        "w_br_a": n(ks[11], (DEPTH, ATTN_WIDTH, D_MODEL)) * BETA * ATTN_WIDTH ** -0.5,
        "w_br_b": n(ks[12], (DEPTH, POOL_WIDTH, D_MODEL)) * BETA * POOL_WIDTH ** -0.5,
        "w_out": n(ks[13], (DEPTH, D_MODEL, D_MODEL)) * BETA * D_MODEL ** -0.5,
        "ln_g": 1.0 + 0.02 * n(ks[14], (DEPTH, D_MODEL)),
        "ln_b": 0.02 * n(ks[15], (DEPTH, D_MODEL)),
    }


def reference(x, c, ctx, c_ctx, w_mod, b_mod, w_in, q_norm, k_norm, w_pool, pool_scale,
              w_br_a, w_br_b, w_out, ln_g, ln_b):
    L = x.shape[1]
    cos, sin = rope_tables(L)
    cos = cos.astype(x.dtype)
    sin = sin.astype(x.dtype)
    cx = ctx
    for l in range(DEPTH):
        x, cx = layer(x, cx, c, c_ctx, cos, sin, w_mod[l], b_mod[l], w_in[l], q_norm[l], k_norm[l],
                      w_pool[l], pool_scale[l], w_br_a[l], w_br_b[l], w_out[l], ln_g[l], ln_b[l],
                      update_ctx=(l < DEPTH - 1))
    return x
```

```cpp
#include <hip/hip_runtime.h>
#include <hip/hip_bf16.h>
#include <hip/hip_cooperative_groups.h>
#include <cstdio>
#include <cstdint>
namespace cg = cooperative_groups;

constexpr int DM = 1024, NBATCH = 2, SEQ = 16384, CTXL = 256, DEPTH = 4, HD = 128;
constexpr int TB = SEQ + CTXL;
constexpr int TROWS = NBATCH * TB;
constexpr int NIN = 5632;
constexpr float EPSV = 1e-6f;
constexpr float ALPHA_RES = 1.681792830507429f;
constexpr int NWAVES = 8, NTHREADS = 512;

constexpr size_t SZ_WIN = (size_t)NIN * DM * 2, SZ_WA = (size_t)DM * DM * 2, SZ_WB = (size_t)DM * 512 * 2, SZ_WO = SZ_WA, SZ_WP = (size_t)4 * 128 * 128 * 2;
constexpr size_t WS_WIN = 0;
constexpr size_t WS_WA = WS_WIN + DEPTH * SZ_WIN;
constexpr size_t WS_WB = WS_WA + DEPTH * SZ_WA;
constexpr size_t WS_WO = WS_WB + DEPTH * SZ_WB;
constexpr size_t WS_WP = WS_WO + DEPTH * SZ_WO;
constexpr size_t WS_MOD = WS_WP + DEPTH * SZ_WP;
constexpr size_t WS_ROPE = WS_MOD + (size_t)DEPTH * 3 * 3072 * 4;
constexpr size_t WS_CX = WS_ROPE + 2 * 256 * 32 * 4;
constexpr size_t WS_U = WS_CX + (size_t)512 * DM * 4;
constexpr size_t WS_Q = WS_U + (size_t)TROWS * DM * 2;
constexpr size_t WS_K = WS_Q + (size_t)TROWS * DM * 2;
constexpr size_t WS_V = WS_K + (size_t)TROWS * 256 * 2;
constexpr size_t WS_ZA = WS_V + (size_t)TROWS * 256 * 2;
constexpr size_t WS_XB = WS_ZA + (size_t)TROWS * DM * 2;
constexpr size_t WS_ZB = WS_XB + (size_t)TROWS * 512 * 2;
constexpr size_t WS_GA = WS_ZB + (size_t)TROWS * 512 * 2;
constexpr size_t WS_GB = WS_GA + (size_t)TROWS * DM * 2;
constexpr size_t WS_END = WS_GB + (size_t)TROWS * DM * 2;
constexpr size_t WS_BAR = WS_END, WS_END2 = WS_END + 16384;

struct Params {
    const float *x, *c, *ctx, *c_ctx, *w_mod, *b_mod, *w_in, *q_norm, *k_norm, *w_pool, *pool_scale, *w_br_a, *w_br_b, *w_out, *ln_g, *ln_b;
    float* out; unsigned char* ws;
};

namespace pg8 {
#define PG8_LAS __attribute__((address_space(3)))
typedef unsigned short bf16_t;
typedef short bf16x8 __attribute__((ext_vector_type(8)));
typedef float f32x4 __attribute__((ext_vector_type(4)));
typedef unsigned u32x4 __attribute__((ext_vector_type(4)));
constexpr int BM = 256, BK = 64, HALF = 128, HTB = HALF * BK * 2  , STAGE_BYTES = 8 * HTB, NXCD = 8, WGM = 8;

__host__ __device__ __forceinline__ int lds_byte(int r, int c) { const int st = (r >> 4) * 2 + (c >> 5), rr = r & 15, cc = c & 31, ob = rr * 64 + cc * 2; return st * 1024 + (ob ^ (((ob >> 9) & 1) << 5)); }
__host__ __device__ __forceinline__ void stage_rc(int b, int& R, int& C) { const int st = b / 1024, sb = b % 1024, swz = sb ^ (((sb >> 9) & 1) << 5); R = (st >> 1) * 16 + swz / 64; C = (st & 1) * 32 + (swz % 64) / 2; }
__host__ __device__ __forceinline__ int perm32(int rho) { const int n = rho >> 4, i = rho & 15; return 8 * (i >> 2) + 4 * n + (i & 3); }

struct Unit { int pm, pn; };
struct Gemm { const bf16_t* A; const bf16_t* Bt; int M, N, K; };

struct StaticOrder {
    int nM, nN, nwg, G, c, skip;
    __host__ __device__ void init(int M, int N, int G_, int c_) { nM = M / BM; nN = N / BM; nwg = nM * nN; G = G_; c = c_; skip = 0; }
    __host__ __device__ bool next(int i, Unit& u) const {
        const long L = (long)i * G + c; if (L >= nwg) return false;
        int wgid = (int)L; { const int q = nwg / NXCD, r = nwg % NXCD, xcd = wgid % NXCD, off = wgid / NXCD; wgid = (xcd < r ? xcd * (q + 1) : r * (q + 1) + (xcd - r) * q) + off; }
        const int nig = WGM * nN, gid = wgid / nig, fm = gid * WGM, gsz = (nM - fm) < WGM ? (nM - fm) : WGM;
        u.pm = fm + ((wgid % nig) % gsz); u.pn = (wgid % nig) / gsz; if (skip) u.pm += 1 + (u.pm >= 64 ? 1 : 0); return true;
    }
    __device__ __forceinline__ void a_ready(const Unit&) const {}
    __device__ __forceinline__ void done(const Unit&) const {}
};

typedef __bf16 bf16x2_t __attribute__((ext_vector_type(2)));
typedef float f32x2_t __attribute__((ext_vector_type(2)));
__device__ __forceinline__ unsigned cvt_pk_bf16(float lo, float hi) { const f32x2_t v = {lo, hi}; const bf16x2_t r = __builtin_convertvector(v, bf16x2_t); return __builtin_bit_cast(unsigned, r); }
typedef float f32x2 __attribute__((ext_vector_type(2)));
struct LatentOrder {
    StaticOrder S;
    __host__ __device__ void init(int N, int G_, int c_) { S.init(32768, N, G_, c_); }
    __host__ __device__ bool next(int i, Unit& u) const { if (!S.next(i, u)) return false; u.pm += 1 + (u.pm >= 64 ? 1 : 0); return true; }
    __device__ __forceinline__ void a_ready(const Unit&) const {}
    __device__ __forceinline__ void done(const Unit&) const {}
};
__device__ __forceinline__ float bf_lo(unsigned w) { return __uint_as_float(w << 16); }
__device__ __forceinline__ float bf_hi(unsigned w) { return __uint_as_float(w & 0xffff0000u); }
__device__ __forceinline__ float sigm(float x) { return __builtin_amdgcn_rcpf(1.0f + __builtin_amdgcn_exp2f(-1.4426950408889634f * x)); }
typedef unsigned u32x2 __attribute__((ext_vector_type(2)));
template <int ACT> __device__ __forceinline__ float actf(float x) { if (ACT == 1) return x * sigm(x); if (ACT == 2) return sigm(x); return x; }

struct EpiIn {
    static constexpr bool PERM = true, AFTER_DRAIN = false;
    unsigned char* ws; const float *qg, *kg;
    PG8_LAS float* part;
    template <int ACT> __device__ __forceinline__ void plain(const f32x4 (&acc)[2][2][4][2], bf16_t* base, int ldc, int colt, const Unit& u, int wr, int wc, int fr, int fq) const {
        const int row0 = u.pm * BM + wr * 64 + fr, col0 = colt + wc * 32 + 8 * fq;
#pragma unroll
        for (int ai = 0; ai < 2; ++ai)
#pragma unroll
            for (int m = 0; m < 4; ++m) { bf16_t* rowp = base + (size_t)(row0 + ai * HALF + m * 16) * ldc + col0;
#pragma unroll
                for (int bj = 0; bj < 2; ++bj) { const f32x4 v0 = acc[ai][bj][m][0], v1 = acc[ai][bj][m][1]; u32x4 w;
                    w.x = cvt_pk_bf16(actf<ACT>(v0[0]), actf<ACT>(v0[1])); w.y = cvt_pk_bf16(actf<ACT>(v0[2]), actf<ACT>(v0[3]));
                    w.z = cvt_pk_bf16(actf<ACT>(v1[0]), actf<ACT>(v1[1])); w.w = cvt_pk_bf16(actf<ACT>(v1[2]), actf<ACT>(v1[3]));
                    *(u32x4*)(rowp + bj * HALF) = w; } }
    }
    __device__ __forceinline__ void qk(const f32x4 (&acc)[2][2][4][2], const Unit& u, int wr, int wc, int fr, int fq) const {
        const bool isk = (u.pn == 4);
        const float* g = isk ? kg : qg; bf16_t* dst = (bf16_t*)(ws + (isk ? WS_K : WS_Q)); const int ldc = isk ? 256 : 1024;
        const float* cosT = (const float*)(ws + WS_ROPE); const float* sinT = cosT + 256 * 32;
        const int f0 = (wc & 1) * 16 + 4 * fq, axis = wc >> 1, e1 = axis * 64 + f0;
        const f32x4 g1 = *(const f32x4*)(g + e1), g2 = *(const f32x4*)(g + e1 + 32);
#pragma unroll
        for (int ai = 0; ai < 2; ++ai)
#pragma unroll
            for (int m = 0; m < 4; ++m)
#pragma unroll
                for (int bj = 0; bj < 2; ++bj) { const f32x4 a = acc[ai][bj][m][0], b = acc[ai][bj][m][1];
                    float s = (a[0] * a[0] + a[1] * a[1]) + (a[2] * a[2] + a[3] * a[3]) + (b[0] * b[0] + b[1] * b[1]) + (b[2] * b[2] + b[3] * b[3]);
                    s += __shfl_xor(s, 16); s += __shfl_xor(s, 32);
                    if (fq == 0) part[((ai * HALF + wr * 64 + m * 16 + fr) * 2 + bj) * 4 + wc] = s; }
        asm volatile("s_waitcnt lgkmcnt(0)" ::: "memory"); __builtin_amdgcn_s_barrier(); asm volatile("" ::: "memory");
        const int jt = u.pm % 65; const bool rope = (jt != 0);
#pragma unroll
        for (int ai = 0; ai < 2; ++ai)
#pragma unroll
            for (int m = 0; m < 4; ++m) { const int rloc = ai * HALF + wr * 64 + m * 16 + fr;
                const int pos = rope ? (axis ? (16 * m + fr) : ((jt - 1) * 4 + 2 * ai + wr)) : 0;
                f32x4 c4 = *(const f32x4*)(cosT + pos * 32 + f0), s4 = *(const f32x4*)(sinT + pos * 32 + f0);
                if (!rope) { c4 = (f32x4){1.f, 1.f, 1.f, 1.f}; s4 = (f32x4){0.f, 0.f, 0.f, 0.f}; }
#pragma unroll
                for (int bj = 0; bj < 2; ++bj) { const f32x4 p = *(const PG8_LAS f32x4*)(part + (rloc * 2 + bj) * 4);
                    const float rstd = __builtin_amdgcn_rsqf(((p[0] + p[1]) + (p[2] + p[3])) * (1.0f / 128.0f) + 1e-6f);
                    const f32x4 y1 = acc[ai][bj][m][0] * rstd * g1, y2 = acc[ai][bj][m][1] * rstd * g2;
                    f32x4 o1 = y1 * c4 - y2 * s4, o2 = y1 * s4 + y2 * c4;
                    if (!isk) { o1 = o1 * 0.12751743074602458f; o2 = o2 * 0.12751743074602458f; }
                    const int head = isk ? bj : 2 * u.pn + bj;
                    bf16_t* ptr = dst + (size_t)(u.pm * BM + rloc) * ldc + head * 128 + e1;
                    u32x2 w1, w2; w1.x = cvt_pk_bf16(o1[0], o1[1]); w1.y = cvt_pk_bf16(o1[2], o1[3]); w2.x = cvt_pk_bf16(o2[0], o2[1]); w2.y = cvt_pk_bf16(o2[2], o2[3]);
                    *(u32x2*)ptr = w1; *(u32x2*)(ptr + 32) = w2; } }
    }
    __device__ __forceinline__ void operator()(const f32x4 (&acc)[2][2][4][2], const Unit& u, int wr, int wc, int fr, int fq) const {
        const int pn = u.pn;
        if (pn < 5) { qk(acc, u, wr, wc, fr, fq); return; }
        if (pn == 5) plain<0>(acc, (bf16_t*)(ws + WS_V), 256, 0, u, wr, wc, fr, fq);
        else if (pn < 10) plain<1>(acc, (bf16_t*)(ws + WS_ZA), 1024, (pn - 6) * 256, u, wr, wc, fr, fq);
        else if (pn < 12) plain<0>(acc, (bf16_t*)(ws + WS_XB), 512, (pn - 10) * 256, u, wr, wc, fr, fq);
        else if (pn < 14) plain<1>(acc, (bf16_t*)(ws + WS_ZB), 512, (pn - 12) * 256, u, wr, wc, fr, fq);
        else if (pn < 18) plain<2>(acc, (bf16_t*)(ws + WS_GA), 1024, (pn - 14) * 256, u, wr, wc, fr, fq);
        else plain<2>(acc, (bf16_t*)(ws + WS_GB), 1024, (pn - 18) * 256, u, wr, wc, fr, fq);
    }
};
template <int MODE> struct EpiGate {
    static constexpr bool PERM = true, AFTER_DRAIN = false;
    unsigned char* ws;
    __device__ __forceinline__ void operator()(const f32x4 (&acc)[2][2][4][2], const Unit& u, int wr, int wc, int fr, int fq) const {
        bf16_t* GA = (bf16_t*)(ws + WS_GA); const bf16_t* GB = (const bf16_t*)(ws + WS_GB); bf16_t* Y = (bf16_t*)(ws + WS_ZA);
        const int row0 = u.pm * BM + wr * 64 + fr, col0 = u.pn * BM + wc * 32 + 8 * fq;
#pragma unroll
        for (int ai = 0; ai < 2; ++ai)
#pragma unroll
            for (int m = 0; m < 4; ++m) { const size_t off = (size_t)(row0 + ai * HALF + m * 16) * 1024 + col0;
#pragma unroll
                for (int bj = 0; bj < 2; ++bj) { const f32x4 v0 = acc[ai][bj][m][0], v1 = acc[ai][bj][m][1];
                    const u32x4 ga = *(const u32x4*)(GA + off + bj * HALF); u32x4 w;
                    if (MODE == 0) {
                        w.x = cvt_pk_bf16(v0[0] * bf_lo(ga.x), v0[1] * bf_hi(ga.x)); w.y = cvt_pk_bf16(v0[2] * bf_lo(ga.y), v0[3] * bf_hi(ga.y));
                        w.z = cvt_pk_bf16(v1[0] * bf_lo(ga.z), v1[1] * bf_hi(ga.z)); w.w = cvt_pk_bf16(v1[2] * bf_lo(ga.w), v1[3] * bf_hi(ga.w));
                        *(u32x4*)(GA + off + bj * HALF) = w;
                    } else {
                        const u32x4 gb = *(const u32x4*)(GB + off + bj * HALF);
                        w.x = cvt_pk_bf16(bf_lo(ga.x) + v0[0] * bf_lo(gb.x), bf_hi(ga.x) + v0[1] * bf_hi(gb.x)); w.y = cvt_pk_bf16(bf_lo(ga.y) + v0[2] * bf_lo(gb.y), bf_hi(ga.y) + v0[3] * bf_hi(gb.y));
                        w.z = cvt_pk_bf16(bf_lo(ga.z) + v1[0] * bf_lo(gb.z), bf_hi(ga.z) + v1[1] * bf_hi(gb.z)); w.w = cvt_pk_bf16(bf_lo(ga.w) + v1[2] * bf_lo(gb.w), bf_hi(ga.w) + v1[3] * bf_hi(gb.w));
                        *(u32x4*)(Y + off + bj * HALF) = w;
                    } } }
    }
};
struct EpiRes {
    static constexpr bool PERM = true, AFTER_DRAIN = false;
    const float* mod; unsigned char* ws;
    __device__ __forceinline__ void operator()(const f32x4 (&acc)[2][2][4][2], const Unit& u, int wr, int wc, int fr, int fq) const {
        const int b = u.pm / 65, jt = u.pm % 65; bf16_t* dl = (bf16_t*)(ws + WS_GA);
        const float* gate = mod + (jt ? b : 2) * 3072 + 2048;
        const int row0 = u.pm * BM + wr * 64 + fr, col0 = u.pn * BM + wc * 32 + 8 * fq;
        f32x4 gv[2][2];
#pragma unroll
        for (int bj = 0; bj < 2; ++bj)
#pragma unroll
            for (int n = 0; n < 2; ++n) gv[bj][n] = *(const f32x4*)(gate + col0 + bj * HALF + 4 * n);
#pragma unroll
        for (int ai = 0; ai < 2; ++ai)
#pragma unroll
            for (int m = 0; m < 4; ++m) { bf16_t* rowp = dl + (size_t)(row0 + ai * HALF + m * 16) * 1024 + col0;
#pragma unroll
                for (int bj = 0; bj < 2; ++bj) { const f32x4 v0 = acc[ai][bj][m][0] * gv[bj][0], v1 = acc[ai][bj][m][1] * gv[bj][1]; u32x4 w;
                    w.x = cvt_pk_bf16(v0[0], v0[1]); w.y = cvt_pk_bf16(v0[2], v0[3]); w.z = cvt_pk_bf16(v1[0], v1[1]); w.w = cvt_pk_bf16(v1[2], v1[3]);
                    *(u32x4*)(rowp + bj * HALF) = w; } }
    }
};

template <class Epi, class Sched, bool ALIGN_EPI = false, bool SP2 = false>
__device__ __forceinline__ void gemm_phase(PG8_LAS unsigned char* lds, const Gemm g, const Sched& S, const Epi& E, const int wid_in) {
    int lane = __builtin_amdgcn_mbcnt_hi(~0u, __builtin_amdgcn_mbcnt_lo(~0u, 0u)); asm volatile("" : "+v"(lane));
    const int wid = wid_in, tid = wid * 64 + lane, wr = wid >> 2, wc = wid & 3, fr = lane & 15, fq = lane >> 4;
    const int K = g.K, nt = K / BK;
    unsigned voffA[2], voffB[2];
#pragma unroll
    for (int i = 0; i < 2; ++i) { int R, C; stage_rc(tid * 16 + i * 8192, R, C); const int Rb = Epi::PERM ? ((R & ~31) + perm32(R & 31)) : R;
        voffA[i] = (unsigned)(R * K + C) * 2u; voffB[i] = (unsigned)(Rb * K + C) * 2u; }
    const size_t kstep = (size_t)(BK * 2);
    const size_t hstep = (size_t)HALF * K * 2;
    const size_t tstep = 2 * hstep;
    const unsigned ldsw = (unsigned)wid * 1024u;
    const int aoff = lds_byte(wr * 64 + fr, fq * 8), boff = lds_byte(wc * 32 + fr, fq * 8);
#define PG8_SA(b, h) (((b) * 2 + (h)) * HTB)
#define PG8_SB(b, h) ((4 + (b) * 2 + (h)) * HTB)
#define PG8_STAGE(bufoff, gbase, voff) do { _Pragma("unroll") for (int _i = 0; _i < 2; ++_i) \
        __builtin_amdgcn_global_load_lds((const unsigned*)((const char*)(gbase) + (voff)[_i]), (PG8_LAS unsigned*)(lds + (bufoff) + ldsw + _i * 8192), 16, 0, 0); } while (0)
#define PG8_LDA(dst, b, h) do { _Pragma("unroll") for (int m = 0; m < 4; ++m) _Pragma("unroll") for (int k = 0; k < 2; ++k) dst[m][k] = *(const PG8_LAS bf16x8*)(lds + PG8_SA(b, h) + aoff + m * 2048 + k * 1024); } while (0)
#define PG8_LDB(dst, b, h) do { _Pragma("unroll") for (int n = 0; n < 2; ++n) _Pragma("unroll") for (int k = 0; k < 2; ++k) dst[n][k] = *(const PG8_LAS bf16x8*)(lds + PG8_SB(b, h) + boff + n * 2048 + k * 1024); } while (0)
#define PG8_MMA(ai, bj, At, Bt) do { __builtin_amdgcn_s_setprio(1); _Pragma("unroll") for (int m = 0; m < 4; ++m) _Pragma("unroll") for (int n = 0; n < 2; ++n) _Pragma("unroll") for (int k = 0; k < 2; ++k) \
        acc[ai][bj][m][n] = __builtin_amdgcn_mfma_f32_16x16x32_bf16(Bt[n][k], At[m][k], acc[ai][bj][m][n], 0, 0, 0); __builtin_amdgcn_s_setprio(0); } while (0)
#define PG8_WAIT_V(n) asm volatile("s_waitcnt vmcnt(" #n ")" ::: "memory")
#define PG8_WAIT_L(n) asm volatile("s_waitcnt lgkmcnt(" #n ")" ::: "memory")
#define PG8_BAR __builtin_amdgcn_s_barrier()
#define PG8_SCHED __builtin_amdgcn_sched_barrier(0)
    Unit cur, nxt; int ui = 0;
    if (!S.next(0, cur)) return;
    f32x4 acc[2][2][4][2];
#pragma unroll
    for (int a = 0; a < 2; ++a)
#pragma unroll
        for (int b = 0; b < 2; ++b)
#pragma unroll
            for (int m = 0; m < 4; ++m)
#pragma unroll
                for (int n = 0; n < 2; ++n) acc[a][b][m][n] = (f32x4){0.f, 0.f, 0.f, 0.f};
    bf16x8 At[4][2], B0[2][2], B1[2][2];
    const char* cA = (const char*)g.A + (size_t)cur.pm * tstep; const char* cB = (const char*)g.Bt + (size_t)cur.pn * tstep;
    S.a_ready(cur);
    if constexpr (SP2) {
        PG8_STAGE(PG8_SB(0, 0), cB, voffB); PG8_STAGE(PG8_SB(0, 1), cB + hstep, voffB); PG8_STAGE(PG8_SA(0, 0), cA, voffA); PG8_STAGE(PG8_SA(0, 1), cA + hstep, voffA);
        if (wr == 1) PG8_BAR;
        PG8_WAIT_V(2); PG8_BAR;
        PG8_STAGE(PG8_SB(1, 0), cB + kstep, voffB); PG8_STAGE(PG8_SA(1, 0), cA + kstep, voffA); PG8_STAGE(PG8_SB(1, 1), cB + hstep + kstep, voffB);
        PG8_WAIT_V(6); PG8_BAR;
    } else {
        PG8_STAGE(PG8_SB(0, 0), cB, voffB); PG8_STAGE(PG8_SA(0, 0), cA, voffA); PG8_STAGE(PG8_SB(0, 1), cB + hstep, voffB); PG8_STAGE(PG8_SA(0, 1), cA + hstep, voffA);
        if (wr == 1) PG8_BAR;
        PG8_WAIT_V(4); PG8_BAR;
        PG8_STAGE(PG8_SB(1, 0), cB + kstep, voffB); PG8_STAGE(PG8_SA(1, 0), cA + kstep, voffA); PG8_STAGE(PG8_SB(1, 1), cB + hstep + kstep, voffB);
        PG8_WAIT_V(6); PG8_BAR;
    }
    for (;;) {
        const bool has_next = S.next(ui + 1, nxt);
        const char* nA = has_next ? (const char*)g.A + (size_t)nxt.pm * tstep : cA; const char* nB = has_next ? (const char*)g.Bt + (size_t)nxt.pn * tstep : cB;
        for (int t = 0; t < nt; t += 2) {
            const bool last = (t == nt - 2);
            const char* a1 = cA + (size_t)(t + 1) * kstep;
            const char* a2 = last ? nA : cA + (size_t)(t + 2) * kstep; const char* b2 = last ? nB : cB + (size_t)(t + 2) * kstep;
            const char* a3 = a2 + kstep; const char* b3 = b2 + kstep;
            if (last && has_next) S.a_ready(nxt);
            if constexpr (SP2) {
            PG8_LDB(B0, 0, 0); PG8_LDB(B1, 0, 1); PG8_SCHED; PG8_LDA(At, 0, 0); PG8_STAGE(PG8_SA(1, 1), a1 + hstep, voffA);
            PG8_WAIT_V(8); PG8_WAIT_L(0); PG8_BAR; PG8_MMA(0, 0, At, B0); PG8_MMA(0, 1, At, B1); PG8_BAR; PG8_SCHED;
            PG8_LDA(At, 0, 1); PG8_STAGE(PG8_SB(0, 0), b2, voffB); PG8_STAGE(PG8_SB(0, 1), b2 + hstep, voffB); PG8_STAGE(PG8_SA(0, 0), a2, voffA);
            PG8_WAIT_V(8); PG8_WAIT_L(0); PG8_BAR; PG8_MMA(1, 0, At, B0); PG8_MMA(1, 1, At, B1); PG8_BAR; PG8_SCHED;
            PG8_LDB(B0, 1, 0); PG8_LDB(B1, 1, 1); PG8_SCHED; PG8_LDA(At, 1, 0); PG8_STAGE(PG8_SA(0, 1), a2 + hstep, voffA);
            PG8_WAIT_V(8); PG8_WAIT_L(0); PG8_BAR; PG8_MMA(0, 0, At, B0); PG8_MMA(0, 1, At, B1); PG8_BAR; PG8_SCHED;
            PG8_LDA(At, 1, 1); PG8_STAGE(PG8_SB(1, 0), b3, voffB); PG8_STAGE(PG8_SB(1, 1), b3 + hstep, voffB); PG8_STAGE(PG8_SA(1, 0), a3, voffA);
            PG8_WAIT_V(8); PG8_WAIT_L(0); PG8_BAR; PG8_MMA(1, 0, At, B0); PG8_MMA(1, 1, At, B1); PG8_BAR; PG8_SCHED;
            } else {
            PG8_LDB(B0, 0, 0); PG8_SCHED; PG8_LDA(At, 0, 0); PG8_STAGE(PG8_SA(1, 1), a1 + hstep, voffA);
            PG8_WAIT_L(8); PG8_BAR; PG8_WAIT_L(0); PG8_MMA(0, 0, At, B0); PG8_BAR; PG8_SCHED;
            PG8_LDB(B1, 0, 1); PG8_STAGE(PG8_SB(0, 0), b2, voffB);
            PG8_BAR; PG8_WAIT_L(0); PG8_MMA(0, 1, At, B1); PG8_BAR;
            PG8_LDA(At, 0, 1); PG8_STAGE(PG8_SA(0, 0), a2, voffA);
            PG8_BAR; PG8_WAIT_L(0); PG8_MMA(1, 0, At, B0); PG8_BAR; PG8_SCHED;
            PG8_STAGE(PG8_SB(0, 1), b2 + hstep, voffB);
            PG8_WAIT_V(6); PG8_BAR; PG8_MMA(1, 1, At, B1); PG8_BAR;
            PG8_LDB(B0, 1, 0); PG8_SCHED; PG8_LDA(At, 1, 0); PG8_STAGE(PG8_SA(0, 1), a2 + hstep, voffA);
            PG8_WAIT_L(8); PG8_BAR; PG8_WAIT_L(0); PG8_MMA(0, 0, At, B0); PG8_BAR; PG8_SCHED;
            PG8_LDB(B1, 1, 1); PG8_STAGE(PG8_SB(1, 0), b3, voffB);
            PG8_BAR; PG8_WAIT_L(0); PG8_MMA(0, 1, At, B1); PG8_BAR;
            PG8_LDA(At, 1, 1); PG8_STAGE(PG8_SA(1, 0), a3, voffA);
            PG8_BAR; PG8_WAIT_L(0); PG8_MMA(1, 0, At, B0); PG8_BAR; PG8_SCHED;
            PG8_STAGE(PG8_SB(1, 1), b3 + hstep, voffB);
            PG8_WAIT_V(6); PG8_BAR; PG8_MMA(1, 1, At, B1); PG8_BAR;
            }
        }
        if constexpr (ALIGN_EPI) { if (wr == 0) PG8_BAR; }
        if constexpr (!Epi::AFTER_DRAIN) { int l2 = __builtin_amdgcn_mbcnt_hi(~0u, __builtin_amdgcn_mbcnt_lo(~0u, 0u)); asm volatile("" : "+v"(l2));
            E(acc, cur, wr, wc, l2 & 15, l2 >> 4); S.done(cur); }
        if (!has_next) break;
#pragma unroll
        for (int a = 0; a < 2; ++a)
#pragma unroll
            for (int b = 0; b < 2; ++b)
#pragma unroll
                for (int m = 0; m < 4; ++m)
#pragma unroll
                    for (int n = 0; n < 2; ++n) acc[a][b][m][n] = (f32x4){0.f, 0.f, 0.f, 0.f};
        cur = nxt; cA = nA; cB = nB; ++ui;
        if constexpr (ALIGN_EPI) { if (wr == 1) PG8_BAR; }
    }
    PG8_WAIT_V(0);
    if constexpr (!ALIGN_EPI) { if (wr == 0) PG8_BAR; }
    PG8_BAR;
    if constexpr (Epi::AFTER_DRAIN) { E.fused(acc, cur, wr, wc, fr, fq, lds, wid, lane); S.done(cur); }
#undef PG8_SA
#undef PG8_SB
#undef PG8_STAGE
#undef PG8_LDA
#undef PG8_LDB
#undef PG8_MMA
#undef PG8_WAIT_V
#undef PG8_WAIT_L
#undef PG8_BAR
#undef PG8_SCHED
}
}
namespace att {
using bf16 = __hip_bfloat16;
constexpr int   D = 128, NW = 8, QBLK = 32, KVBLK = 64;
constexpr float SCALE = 0.088388347648318440f;
constexpr float THR = 8.f;
constexpr int SDEPTH = 1;
constexpr int LDQ = 1024, LDK = 256, LDO = 1024;
constexpr size_t SHM_V = KVBLK * D * 2, SHM_K = KVBLK * D * 2, SHM_ATTN = 2 * SHM_V + 2 * SHM_K + NW * 64 * 4;
using bf16x8 = __attribute__((ext_vector_type(8))) short;
using s16x4  = __attribute__((ext_vector_type(4))) short;
using f32x16 = __attribute__((ext_vector_type(16))) float;
using f32x8  = __attribute__((ext_vector_type(8))) float;
using u32x4  = __attribute__((ext_vector_type(4))) unsigned;
#define KSWZ(row, colB) ((row) * 256 + ((colB) ^ (((row) & 15) << 4)))
#define SBAR() __builtin_amdgcn_sched_barrier(0)
__device__ __forceinline__ int crow(int r, int hi) { return (r & 3) + 8 * (r >> 2) + 4 * hi; }
__device__ __forceinline__ unsigned cvtpk(float lo, float hi) { return pg8::cvt_pk_bf16(lo, hi); }
template <typename TIn> struct Stage;
template <> struct Stage<bf16>  { using T = bf16x8;
  __device__ static __forceinline__ T ld8(const bf16* p) { return *reinterpret_cast<const bf16x8*>(p); }
  __device__ static __forceinline__ bf16x8 tobf(T x) { return x; } };
template <> struct Stage<float> { using T = f32x8;
  __device__ static __forceinline__ T ld8(const float* p) { return *reinterpret_cast<const f32x8*>(p); }
  __device__ static __forceinline__ bf16x8 tobf(T x) {
    u32x4 w = {cvtpk(x[0], x[1]), cvtpk(x[2], x[3]), cvtpk(x[4], x[5]), cvtpk(x[6], x[7])}; return *reinterpret_cast<bf16x8*>(&w); } };

__device__ __forceinline__ void partialSM(f32x16& p0, f32x16& p1, float& m_reg, float& mn, float& alpha) {
  constexpr float C = SCALE * 1.4426950408889634f;
  float pmax = p0[0]; for (int r = 1; r < 16; ++r) pmax = fmaxf(pmax, p0[r]); for (int r = 0; r < 16; ++r) pmax = fmaxf(pmax, p1[r]);
  { auto rr = __builtin_amdgcn_permlane32_swap(__float_as_uint(pmax), __float_as_uint(pmax), false, false);
    pmax = fmaxf(__uint_as_float(rr[0]), __uint_as_float(rr[1])); }
  if (__builtin_expect(__all(pmax - m_reg <= THR / SCALE), 1)) { mn = m_reg; alpha = 1.f; }
  else { mn = fmaxf(m_reg, pmax); alpha = __builtin_amdgcn_exp2f((m_reg - mn) * C); m_reg = mn; }
  float mnC = -mn * C;
  for (int r = 0; r < 16; ++r) p0[r] = fmaf(p0[r], C, mnC); for (int r = 0; r < 16; ++r) p1[r] = fmaf(p1[r], C, mnC);
  for (int r = 0; r < 16; ++r) p0[r] = __builtin_amdgcn_exp2f(p0[r]);
}
__device__ __forceinline__ void finishSM(f32x16& p0, f32x16& p1, float alpha, float& l_reg, bf16x8& pa0, bf16x8& pa1, bf16x8& pa2, bf16x8& pa3) {
  for (int r = 0; r < 16; ++r) p1[r] = __builtin_amdgcn_exp2f(p1[r]);
  float ps = 0; for (int r = 0; r < 16; ++r) ps += p0[r]; for (int r = 0; r < 16; ++r) ps += p1[r];
  { auto rr = __builtin_amdgcn_permlane32_swap(__float_as_uint(ps), __float_as_uint(ps), false, false);
    ps = __uint_as_float(rr[0]) + __uint_as_float(rr[1]); }
  l_reg = l_reg * alpha + ps;
#define PK4(P, BASE, OUT) do { unsigned a0 = cvtpk(P[BASE + 0], P[BASE + 1]), a1 = cvtpk(P[BASE + 2], P[BASE + 3]);   \
    unsigned b0 = cvtpk(P[BASE + 4], P[BASE + 5]), b1 = cvtpk(P[BASE + 6], P[BASE + 7]);                              \
    auto r0 = __builtin_amdgcn_permlane32_swap(a0, b0, false, false); auto r1 = __builtin_amdgcn_permlane32_swap(a1, b1, false, false); \
    u32x4 w = {r0[0], r1[0], r0[1], r1[1]}; OUT = *reinterpret_cast<bf16x8*>(&w); } while (0)
  PK4(p0, 0, pa0); PK4(p0, 8, pa1); PK4(p1, 0, pa2); PK4(p1, 8, pa3);
#undef PK4
}
__device__ __forceinline__ void partialSM2(f32x16& p0, f32x16& p1, const float negBC) {
  constexpr float C = SCALE * 1.4426950408889634f;
  for (int r = 0; r < 16; ++r) p0[r] = fmaf(p0[r], C, negBC); for (int r = 0; r < 16; ++r) p1[r] = fmaf(p1[r], C, negBC);
  for (int r = 0; r < 16; ++r) p0[r] = __builtin_amdgcn_exp2f(p0[r]);
}
__device__ __forceinline__ void finishSM2(f32x16& p0, f32x16& p1, float& l_reg, bf16x8& pa0, bf16x8& pa1, bf16x8& pa2, bf16x8& pa3) {
  for (int r = 0; r < 16; ++r) p1[r] = __builtin_amdgcn_exp2f(p1[r]);
  float ps = 0; for (int r = 0; r < 16; ++r) ps += p0[r]; for (int r = 0; r < 16; ++r) ps += p1[r];
  l_reg += ps;
#define PK4(P, BASE, OUT) do { unsigned a0 = cvtpk(P[BASE + 0], P[BASE + 1]), a1 = cvtpk(P[BASE + 2], P[BASE + 3]);   \
    unsigned b0 = cvtpk(P[BASE + 4], P[BASE + 5]), b1 = cvtpk(P[BASE + 6], P[BASE + 7]);                              \
    auto r0 = __builtin_amdgcn_permlane32_swap(a0, b0, false, false); auto r1 = __builtin_amdgcn_permlane32_swap(a1, b1, false, false); \
    u32x4 w = {r0[0], r1[0], r0[1], r1[1]}; OUT = *reinterpret_cast<bf16x8*>(&w); } while (0)
  PK4(p0, 0, pa0); PK4(p0, 8, pa1); PK4(p1, 0, pa2); PK4(p1, 8, pa3);
#undef PK4
}
__device__ __forceinline__ void qkt(f32x16& p0, f32x16& p1, const bf16* Ks, const bf16x8* qr, int r32, int hi) {
  p0 = f32x16{}; p1 = f32x16{};
  for (int d0 = 0; d0 < 8; ++d0) { int cb = (d0 * 16 + hi * 8) * 2;
    bf16x8 b0 = *reinterpret_cast<const bf16x8*>((const char*)Ks + KSWZ(r32, cb));
    bf16x8 b1 = *reinterpret_cast<const bf16x8*>((const char*)Ks + KSWZ(32 + r32, cb));
    p0 = __builtin_amdgcn_mfma_f32_32x32x16_bf16(b0, qr[d0], p0, 0, 0, 0);
    p1 = __builtin_amdgcn_mfma_f32_32x32x16_bf16(b1, qr[d0], p1, 0, 0, 0); }
}
__device__ __forceinline__ void partialSM3(f32x16& p0) { for (int r = 0; r < 16; ++r) p0[r] = __builtin_amdgcn_exp2f(p0[r]); }
__device__ __forceinline__ void qkt3(f32x16& p0, f32x16& p1, const bf16* Ks, const bf16x8* qr, int r32, int hi, const f32x16& cinit) {
  { int cb = (hi * 8) * 2;
    bf16x8 b0 = *reinterpret_cast<const bf16x8*>((const char*)Ks + KSWZ(r32, cb));
    bf16x8 b1 = *reinterpret_cast<const bf16x8*>((const char*)Ks + KSWZ(32 + r32, cb));
    p0 = __builtin_amdgcn_mfma_f32_32x32x16_bf16(b0, qr[0], cinit, 0, 0, 0);
    p1 = __builtin_amdgcn_mfma_f32_32x32x16_bf16(b1, qr[0], cinit, 0, 0, 0); }
  for (int d0 = 1; d0 < 8; ++d0) { int cb = (d0 * 16 + hi * 8) * 2;
    bf16x8 b0 = *reinterpret_cast<const bf16x8*>((const char*)Ks + KSWZ(r32, cb));
    bf16x8 b1 = *reinterpret_cast<const bf16x8*>((const char*)Ks + KSWZ(32 + r32, cb));
    p0 = __builtin_amdgcn_mfma_f32_32x32x16_bf16(b0, qr[d0], p0, 0, 0, 0);
    p1 = __builtin_amdgcn_mfma_f32_32x32x16_bf16(b1, qr[d0], p1, 0, 0, 0); }
}
__device__ __forceinline__ int v_st(int k, int c) { const int kk = (k & ~0xC) | ((k & 4) << 1) | ((k & 8) >> 1); return ((kk >> 3) * 4 + (c >> 5)) * 512 + ((kk & 7) * 32 + (c & 31)) * 2; }
__device__ __forceinline__ int v_rd_base(int lane) { return ((lane & 3) << 3) | (((lane >> 2) & 3) << 6) | (((lane >> 4) & 1) << 5) | (((lane >> 5) & 1) << 8); }
constexpr int v_rd_off(int d0, int ks, int half) { return d0 * 512 + ks * 4096 + half * 2048; }
template <int OFF> __device__ __forceinline__ s16x4 tr_read(int vb) {
  s16x4 r; asm volatile("ds_read_b64_tr_b16 %0, %1 offset:%2" : "=&v"(r) : "v"(vb), "i"(OFF) : "memory"); return r;
}
template <int D0> __device__ __forceinline__ void pv_one(f32x16& od, int vb, bf16x8 pa0, bf16x8 pa1, bf16x8 pa2, bf16x8 pa3) {
  const s16x4 l0 = tr_read<v_rd_off(D0, 0, 0)>(vb), h0 = tr_read<v_rd_off(D0, 0, 1)>(vb), l1 = tr_read<v_rd_off(D0, 1, 0)>(vb), h1 = tr_read<v_rd_off(D0, 1, 1)>(vb);
  const s16x4 l2 = tr_read<v_rd_off(D0, 2, 0)>(vb), h2 = tr_read<v_rd_off(D0, 2, 1)>(vb), l3 = tr_read<v_rd_off(D0, 3, 0)>(vb), h3 = tr_read<v_rd_off(D0, 3, 1)>(vb);
  asm volatile("s_waitcnt lgkmcnt(0)" ::: "memory"); SBAR();
#define PK(L, H) (bf16x8){L[0], L[1], L[2], L[3], H[0], H[1], H[2], H[3]}
  od = __builtin_amdgcn_mfma_f32_32x32x16_bf16(pa0, PK(l0, h0), od, 0, 0, 0);
  od = __builtin_amdgcn_mfma_f32_32x32x16_bf16(pa1, PK(l1, h1), od, 0, 0, 0);
  od = __builtin_amdgcn_mfma_f32_32x32x16_bf16(pa2, PK(l2, h2), od, 0, 0, 0);
  od = __builtin_amdgcn_mfma_f32_32x32x16_bf16(pa3, PK(l3, h3), od, 0, 0, 0);
#undef PK
}
__device__ __forceinline__ void pv_d0(f32x16* o, int vb, bf16x8 pa0, bf16x8 pa1, bf16x8 pa2, bf16x8 pa3) {
  pv_one<0>(o[0], vb, pa0, pa1, pa2, pa3); pv_one<1>(o[1], vb, pa0, pa1, pa2, pa3); pv_one<2>(o[2], vb, pa0, pa1, pa2, pa3); pv_one<3>(o[3], vb, pa0, pa1, pa2, pa3);
}
__device__ __forceinline__ void attn_dense_body(const bf16* Qb, const bf16* __restrict__ Kh, const bf16* __restrict__ Vh, const bf16* __restrict__ Zb,
                                                bf16* Ob, int seq, char* lds, const int wid_in, const float kmax) {
  using St = Stage<bf16>; using SQ = Stage<bf16>; using TQ = bf16;
  int lane = __builtin_amdgcn_mbcnt_hi(~0u, __builtin_amdgcn_mbcnt_lo(~0u, 0u)); asm volatile("" : "+v"(lane));
  const int wid = wid_in, tid = wid * 64 + lane, r32 = lane & 31, hi = lane >> 5;
  bf16* V_lds = (bf16*)lds; bf16* K_lds = (bf16*)(lds + 2 * SHM_V);
  float* ws = (float*)(lds + 2 * SHM_V + 2 * SHM_K) + wid * 64; float* li_l = ws; float* al_l = ws + 32;
  float l_reg = 0; f32x16 o[4] = {}; bf16x8 qr[8];
  const TQ* Qw = Qb + (long)(wid * QBLK + r32) * LDQ + hi * 8;
#pragma unroll
  for (int d0 = 0; d0 < 8; ++d0) qr[d0] = SQ::tobf(SQ::ld8(Qw + d0 * 16));
  float negBC;
  { float ss = 0.f;
#pragma unroll
    for (int d0 = 0; d0 < 8; ++d0)
#pragma unroll
      for (int e = 0; e < 8; ++e) { const float qv = __uint_as_float((unsigned)(unsigned short)qr[d0][e] << 16); ss = fmaf(qv, qv, ss); }
    auto rr = __builtin_amdgcn_permlane32_swap(__float_as_uint(ss), __float_as_uint(ss), false, false);
    ss = __uint_as_float(rr[0]) + __uint_as_float(rr[1]);
    negBC = -(sqrtf(ss) * kmax * (11.313708498984761f * 1.01f) + 0.07f); }
  f32x16 cinit; for (int r = 0; r < 16; ++r) cinit[r] = negBC;
  const int sr = tid >> 4, sc = (tid & 15) * 8, vst0 = v_st(sr, sc), vst1 = v_st(32 + sr, sc);
  const int vb0 = (int)(uintptr_t)V_lds + v_rd_base(lane);
  struct { typename St::T vs0, vs1, ks0, ks1; } sr_[SDEPTH];
#define SLOAD(i, k0) do { sr_[i].vs0 = St::ld8(&Vh[(long)((k0) + sr) * LDK + sc]); sr_[i].vs1 = St::ld8(&Vh[(long)((k0) + 32 + sr) * LDK + sc]); \
    sr_[i].ks0 = St::ld8(&Kh[(long)((k0) + sr) * LDK + sc]); sr_[i].ks1 = St::ld8(&Kh[(long)((k0) + 32 + sr) * LDK + sc]); } while (0)
#define SWRITE(b, i) do { *(bf16x8*)((char*)V_lds + (b) * SHM_V + vst0) = St::tobf(sr_[i].vs0);          \
    *(bf16x8*)((char*)V_lds + (b) * SHM_V + vst1) = St::tobf(sr_[i].vs1); int kc = sc * 2;               \
    *(bf16x8*)((char*)K_lds + (b) * SHM_K + KSWZ(sr, kc)) = St::tobf(sr_[i].ks0);                       \
    *(bf16x8*)((char*)K_lds + (b) * SHM_K + KSWZ(32 + sr, kc)) = St::tobf(sr_[i].ks1); } while (0)
#define SWAIT() do { if constexpr (SDEPTH == 2) asm volatile("s_waitcnt vmcnt(4)" ::: "memory"); else asm volatile("s_waitcnt vmcnt(0)" ::: "memory"); } while (0)
#define RESC(a) do { if (__any((a) < 1.f)) { if (hi == 0) al_l[r32] = (a); asm volatile("s_waitcnt lgkmcnt(0)" ::: "memory"); \
    for (int d = 0; d < 4; ++d) for (int r = 0; r < 16; ++r) o[d][r] *= al_l[crow(r, hi)]; } } while (0)
  f32x16 pA0, pA1, pB0, pB1; bf16x8 pa0, pa1, pa2, pa3; const int NT = seq / KVBLK;
  constexpr int SE = 0, SO = SDEPTH - 1;
  SLOAD(SE, 0); asm volatile("s_waitcnt vmcnt(0)" ::: "memory"); SWRITE(0, SE); __syncthreads();
  qkt3(pA0, pA1, K_lds, qr, r32, hi, cinit); partialSM3(pA0);
  SLOAD(SO, KVBLK); if constexpr (SDEPTH == 2) { if (2 < NT) SLOAD(SE, 2 * KVBLK); }
  SWAIT(); SWRITE(1, SO); __syncthreads();
  for (int j = 1; j + 1 < NT; j += 2) {
    SBAR(); qkt3(pB0, pB1, (bf16*)((char*)K_lds + SHM_K), qr, r32, hi, cinit);
    finishSM2(pA0, pA1, l_reg, pa0, pa1, pa2, pa3); SBAR();
    SLOAD(SO, (j + SDEPTH) * KVBLK); SBAR();
    pv_d0(o, vb0, pa0, pa1, pa2, pa3); partialSM3(pB0);
    __syncthreads(); SWAIT(); SWRITE(0, SE);
    __syncthreads();
    SBAR(); qkt3(pA0, pA1, K_lds, qr, r32, hi, cinit);
    finishSM2(pB0, pB1, l_reg, pa0, pa1, pa2, pa3); SBAR();
    if (SDEPTH == 1 || j + 3 < NT) SLOAD(SE, (j + 1 + SDEPTH) * KVBLK); SBAR();
    pv_d0(o, vb0 + (int)SHM_V, pa0, pa1, pa2, pa3); partialSM3(pA0);
    __syncthreads(); SWAIT(); SWRITE(1, SO);
    __syncthreads();
  }
  SBAR(); qkt3(pB0, pB1, (bf16*)((char*)K_lds + SHM_K), qr, r32, hi, cinit);
  finishSM2(pA0, pA1, l_reg, pa0, pa1, pa2, pa3); SBAR();
  pv_d0(o, vb0, pa0, pa1, pa2, pa3); partialSM3(pB0);
  __syncthreads();
  finishSM2(pB0, pB1, l_reg, pa0, pa1, pa2, pa3); SBAR();
  pv_d0(o, vb0 + (int)SHM_V, pa0, pa1, pa2, pa3);
  { auto rr = __builtin_amdgcn_permlane32_swap(__float_as_uint(l_reg), __float_as_uint(l_reg), false, false); l_reg = __uint_as_float(rr[0]) + __uint_as_float(rr[1]); }
  if (hi == 0) li_l[r32] = l_reg; asm volatile("s_waitcnt lgkmcnt(0)" ::: "memory");
  float rli[16];
#pragma unroll
  for (int r = 0; r < 16; ++r) rli[r] = __builtin_amdgcn_rcpf(li_l[crow(r, hi)]);
  { int lb = (4 * hi) * LDO + r32; asm volatile("" : "+v"(lb));
    unsigned short* Ow = (unsigned short*)Ob + (long)(wid * QBLK) * LDO + lb; const unsigned short* Zw = (const unsigned short*)Zb + (long)(wid * QBLK) * LDO + lb;
#pragma unroll
    for (int r = 0; r < 16; ++r) { const int ro = ((r & 3) + 8 * (r >> 2)) * LDO;
#pragma unroll
      for (int d0 = 0; d0 < 4; ++d0) { const float z = __uint_as_float((unsigned)Zw[ro + d0 * 32] << 16);
        Ow[ro + d0 * 32] = (unsigned short)(cvtpk(o[d0][r] * rli[r] * z, 0.f) & 0xffffu); }
      asm volatile("" ::: "memory"); } }
#undef SLOAD
#undef SWRITE
#undef SWAIT
#undef RESC
}
}

typedef unsigned short bf16_t;
typedef float f32x4 __attribute__((ext_vector_type(4)));
typedef unsigned u32x4 __attribute__((ext_vector_type(4)));
typedef unsigned u32x2v __attribute__((ext_vector_type(2)));
typedef short bf16x8v __attribute__((ext_vector_type(8)));
typedef float f32x16v __attribute__((ext_vector_type(16)));
#define LAS __attribute__((address_space(3)))
#define XB_TMO      128
#define XB_XCNT(j)  (256  + 64 * (j))
#define XB_XSUB(j)  (1280 + 64 * (j))
#define XB_XGEN(j)  (2304 + 64 * (j))
#define XB_TOP      3328
#define XB_TOPGEN   3392
#define XCD_BAR_WORDS 3456
#define XB_SPIN_CAP (1u << 18)

__device__ __forceinline__ unsigned xb_ld(unsigned* p)              { return __hip_atomic_load(p, __ATOMIC_RELAXED, __HIP_MEMORY_SCOPE_AGENT); }
__device__ __forceinline__ unsigned xb_add(unsigned* p, unsigned v) { return __hip_atomic_fetch_add(p, v, __ATOMIC_RELAXED, __HIP_MEMORY_SCOPE_AGENT); }
__device__ __forceinline__ unsigned xb_xcc_id() { return (unsigned)__builtin_amdgcn_s_getreg((3 << 11) | 20) & 0xFu; }
#define XB_SPIN(cond, bar) do { unsigned _sp = 0; while (cond) { __builtin_amdgcn_s_sleep(1); \
    if ((++_sp & 255u) == 0u) { if (xb_ld(&(bar)[XB_TMO])) break; if (_sp > XB_SPIN_CAP) { atomicAdd(&(bar)[XB_TMO], 1u); break; } } } } while (0)

struct XcdBarrier {
    unsigned* bar; unsigned x;
    volatile LAS unsigned* st;
};

__device__ __forceinline__ XcdBarrier xcd_barrier_post(unsigned* bar, volatile LAS unsigned* st, const bool leader) {
    XcdBarrier b; b.bar = bar; b.x = xb_xcc_id(); b.st = st;
    if (leader) (void)xb_add(&bar[XB_XCNT(b.x)], 1u);
    return b;
}
__device__ __forceinline__ void xcd_barrier_complete(unsigned* bar, unsigned x, unsigned& nloc, unsigned& nx) {
    const unsigned G = gridDim.x * gridDim.y * gridDim.z;
    unsigned sum, cnt, mine, sp = 0u;
    for (;;) {
        sum = 0u; cnt = 0u; mine = 0u;
#pragma unroll
        for (unsigned j = 0; j < 16; ++j) { const unsigned c = xb_ld(&bar[XB_XCNT(j)]); sum += c; cnt += (c > 0u) ? 1u : 0u; mine = (j == x) ? c : mine; }
        if (sum == G) break;
        __builtin_amdgcn_s_sleep(1);
        if ((++sp & 255u) == 0u) { if (xb_ld(&bar[XB_TMO])) break; if (sp > XB_SPIN_CAP) { atomicAdd(&bar[XB_TMO], 1u); break; } }
    }
    nloc = mine > 0u ? mine : 1u; nx = cnt > 0u ? cnt : 1u;
}

__device__ __forceinline__ void xcd_barrier(const XcdBarrier& b, const bool leader) {
    asm volatile("s_waitcnt vmcnt(0)" ::: "memory");
    __syncthreads();
    if (leader) {
        unsigned* bar = b.bar;
        __builtin_amdgcn_s_waitcnt(0);
        unsigned nloc = b.st[0], nx = b.st[1];
        if (nloc == 0u) { xcd_barrier_complete(bar, b.x, nloc, nx); b.st[0] = nloc; b.st[1] = nx; }
        const unsigned old = xb_add(&bar[XB_XSUB(b.x)], 1u);
        const unsigned gen = old / nloc;
        if (old + 1u == (gen + 1u) * nloc) {
            __builtin_amdgcn_fence(__ATOMIC_RELEASE, "agent");
            asm volatile("s_waitcnt vmcnt(0)" ::: "memory");
            const unsigned og = xb_add(&bar[XB_TOP], 1u);
            const unsigned tg = og / nx;
            if (og + 1u == (tg + 1u) * nx) xb_add(&bar[XB_TOPGEN], 1u);
            else XB_SPIN(xb_ld(&bar[XB_TOPGEN]) == tg, bar);
            __builtin_amdgcn_fence(__ATOMIC_ACQUIRE, "agent");
            xb_add(&bar[XB_XGEN(b.x)], 1u);
            asm volatile("s_waitcnt vmcnt(0)" ::: "memory");
        } else {
            XB_SPIN(xb_ld(&bar[XB_XGEN(b.x)]) == gen, bar);
            __builtin_amdgcn_fence(__ATOMIC_ACQUIRE, "agent");
            asm volatile("s_waitcnt vmcnt(0)" ::: "memory");
        }
    }
    __syncthreads();
}

constexpr int RING_BYTES = pg8::STAGE_BYTES;
constexpr int PART_OFF = RING_BYTES;
constexpr int XBST_OFF = RING_BYTES + 8192;
constexpr int LDS_BYTES = RING_BYTES + 8192 + 16;

__device__ __forceinline__ unsigned pk2(float a, float b) { return pg8::cvt_pk_bf16(a, b); }
__device__ __forceinline__ float wave_sum(float v) {
#pragma unroll
    for (int o = 1; o < 64; o <<= 1) v += __shfl_xor(v, o);
    return v;
}
__device__ __forceinline__ const float* xrow_c(const float* lat, const float* cx, int r) {
    const int b = r / TB, rr = r - b * TB;
    return rr < CTXL ? cx + ((size_t)b * CTXL + rr) * DM : lat + ((size_t)b * SEQ + (rr - CTXL)) * DM;
}
__device__ __forceinline__ int qk_src(int c) { const int h = c & ~127, cp = c & 127;
    return h + ((cp >> 6) & 1) * 64 + ((cp >> 2) & 1) * 32 + ((cp >> 5) & 1) * 16 + ((cp >> 3) & 3) * 4 + (cp & 3); }

__device__ __forceinline__ void transpose_item(const float* W, int K, int N, bf16_t* WT, LAS float* scr, int item, int lane, int nperm) {
    const int nblk = N / 32, kb = item / nblk, nb = item % nblk, k0 = 64 * kb, n0 = 32 * nb;
    const int cdst = n0 + (lane & 31), csrc = cdst < nperm ? qk_src(cdst) : cdst;
#pragma unroll 8
    for (int i = 0; i < 32; ++i) { const int kk = 2 * i + (lane >> 5); scr[kk * 33 + (lane & 31)] = W[(size_t)(k0 + kk) * N + csrc]; }
    asm volatile("s_waitcnt lgkmcnt(0)" ::: "memory");
    const int c = lane & 7;
#pragma unroll
    for (int j = 0; j < 4; ++j) { const int n = (lane >> 3) + 8 * j; const LAS float* s = scr + (8 * c) * 33 + n;
        u32x4 o; o.x = pk2(s[0 * 33], s[1 * 33]); o.y = pk2(s[2 * 33], s[3 * 33]); o.z = pk2(s[4 * 33], s[5 * 33]); o.w = pk2(s[6 * 33], s[7 * 33]);
        *(u32x4*)(WT + (size_t)(n0 + n) * K + k0 + 8 * c) = o; }
    asm volatile("s_waitcnt lgkmcnt(0)" ::: "memory");
}

template <int GI> __device__ __forceinline__ void pool_unit_t(const bf16_t* XB, bf16_t* ZB, const bf16_t* WPt, const float* pscale, int R0, int lane) {
    constexpr int g = GI, a = 1 << GI;
    const int pm = R0 >> 8, b = pm / 65, jt = pm % 65;
    const int lo = b * TB + (jt ? CTXL : 0), hiR = jt ? (b + 1) * TB : b * TB + CTXL;
    const int r32 = lane & 31, hh = lane >> 5, t = R0 + r32;
    const int s0 = max(t - a, lo), s1 = min(t + a - 1, hiR - 1); const float inv = 1.0f / (float)(s1 - s0 + 1);
    f32x16v acc0 = {}, acc1 = {}, acc2 = {}, acc3 = {};
    const bf16_t* xb = XB + g * 128 + hh * 8;
    const bf16_t* wp = WPt + (size_t)(g * 128 + r32) * 128 + hh * 8;
    float wq[2 * a]; int rq[2 * a];
#pragma unroll
    for (int q = 0; q < 2 * a; ++q) { const int rr = t - a + q; const bool ok = (rr >= lo) && (rr < hiR); wq[q] = ok ? inv : 0.f; rq[q] = ok ? rr : t; }
#pragma unroll 1
    for (int kk = 0; kk < 8; ++kk) {
        u32x4 wv[2 * a];
#pragma unroll
        for (int q = 0; q < 2 * a; ++q) wv[q] = *(const u32x4*)(xb + (size_t)rq[q] * 512 + kk * 16);
        const u32x4 w = *(const u32x4*)(xb + (size_t)t * 512 + kk * 16);
        const bf16x8v w0 = *(const bf16x8v*)(wp + kk * 16), w1 = *(const bf16x8v*)(wp + 32 * 128 + kk * 16), w2 = *(const bf16x8v*)(wp + 64 * 128 + kk * 16), w3 = *(const bf16x8v*)(wp + 96 * 128 + kk * 16);
        float s[8] = {0.f, 0.f, 0.f, 0.f, 0.f, 0.f, 0.f, 0.f};
#pragma unroll
        for (int q = 0; q < 2 * a; ++q) { const float f = wq[q]; const u32x4 v = wv[q];
            s[0] += f * pg8::bf_lo(v.x); s[1] += f * pg8::bf_hi(v.x); s[2] += f * pg8::bf_lo(v.y); s[3] += f * pg8::bf_hi(v.y); s[4] += f * pg8::bf_lo(v.z); s[5] += f * pg8::bf_hi(v.z); s[6] += f * pg8::bf_lo(v.w); s[7] += f * pg8::bf_hi(v.w); }
        u32x4 mf; mf.x = pk2(s[0] - pg8::bf_lo(w.x), s[1] - pg8::bf_hi(w.x)); mf.y = pk2(s[2] - pg8::bf_lo(w.y), s[3] - pg8::bf_hi(w.y));
        mf.z = pk2(s[4] - pg8::bf_lo(w.z), s[5] - pg8::bf_hi(w.z)); mf.w = pk2(s[6] - pg8::bf_lo(w.w), s[7] - pg8::bf_hi(w.w));
        const bf16x8v mfrag = *reinterpret_cast<bf16x8v*>(&mf);
        acc0 = __builtin_amdgcn_mfma_f32_32x32x16_bf16(w0, mfrag, acc0, 0, 0, 0); acc1 = __builtin_amdgcn_mfma_f32_32x32x16_bf16(w1, mfrag, acc1, 0, 0, 0);
        acc2 = __builtin_amdgcn_mfma_f32_32x32x16_bf16(w2, mfrag, acc2, 0, 0, 0); acc3 = __builtin_amdgcn_mfma_f32_32x32x16_bf16(w3, mfrag, acc3, 0, 0, 0);
    }
    bf16_t* zrow = ZB + (size_t)t * 512 + g * 128; const float* ps = pscale + g * 128;
#define POOL_OUT(ACC, NS) do { _Pragma("unroll") for (int q = 0; q < 4; ++q) { const int n0 = (NS) * 32 + 8 * q + 4 * hh; const u32x2v z = *(const u32x2v*)(zrow + n0); const f32x4 p4 = *(const f32x4*)(ps + n0); \
        u32x2v o; o.x = pk2(ACC[4 * q + 0] * p4[0] * pg8::bf_lo(z.x), ACC[4 * q + 1] * p4[1] * pg8::bf_hi(z.x)); o.y = pk2(ACC[4 * q + 2] * p4[2] * pg8::bf_lo(z.y), ACC[4 * q + 3] * p4[3] * pg8::bf_hi(z.y)); \
        *(u32x2v*)(zrow + n0) = o; } } while (0)
    POOL_OUT(acc0, 0); POOL_OUT(acc1, 1); POOL_OUT(acc2, 2); POOL_OUT(acc3, 3);
#undef POOL_OUT
}
__device__ __forceinline__ void pool_unit(const bf16_t* XB, bf16_t* ZB, const bf16_t* WPt, const float* pscale, int wu, int lane) {
    const int g = wu & 3, R0 = (wu >> 2) * 32;
    if (g == 0) pool_unit_t<0>(XB, ZB, WPt, pscale, R0, lane); else if (g == 1) pool_unit_t<1>(XB, ZB, WPt, pscale, R0, lane);
    else if (g == 2) pool_unit_t<2>(XB, ZB, WPt, pscale, R0, lane); else pool_unit_t<3>(XB, ZB, WPt, pscale, R0, lane);
}

__device__ __forceinline__ void wtile_mac(f32x16v& acc, const bf16_t* Wp, const bf16_t* Ap, int nsteps) {
#pragma unroll 8
    for (int kk = 0; kk < nsteps; ++kk) { const bf16x8v wf = *(const bf16x8v*)(Wp + kk * 16), af = *(const bf16x8v*)(Ap + kk * 16); acc = __builtin_amdgcn_mfma_f32_32x32x16_bf16(wf, af, acc, 0, 0, 0); }
}
__device__ __forceinline__ void ctx_merge_task(unsigned char* wsl, int l, int task, int lane) {
    const int tr = task >> 5, n0c = (task & 31) * 32, b = tr >> 3, r32 = lane & 31, hh = lane >> 5;
    const size_t token = (size_t)b * TB + (size_t)(tr & 7) * 32 + r32;
    f32x16v aa = {}, ab = {};
    wtile_mac(aa, (const bf16_t*)(wsl + WS_WA + l * SZ_WA) + (size_t)(n0c + r32) * 1024 + hh * 8, (const bf16_t*)(wsl + WS_Q) + token * 1024 + hh * 8, 64);
    wtile_mac(ab, (const bf16_t*)(wsl + WS_WB + l * SZ_WB) + (size_t)(n0c + r32) * 512 + hh * 8, (const bf16_t*)(wsl + WS_ZB) + token * 512 + hh * 8, 32);
    const bf16_t* ga = (const bf16_t*)(wsl + WS_GA) + token * 1024 + n0c; const bf16_t* gb = (const bf16_t*)(wsl + WS_GB) + token * 1024 + n0c; bf16_t* yo = (bf16_t*)(wsl + WS_ZA) + token * 1024 + n0c;
#pragma unroll
    for (int q = 0; q < 4; ++q) { const int nn = 8 * q + 4 * hh; const u32x2v a = *(const u32x2v*)(ga + nn), g2 = *(const u32x2v*)(gb + nn); u32x2v o;
        o.x = pk2(aa[4 * q + 0] * pg8::bf_lo(a.x) + ab[4 * q + 0] * pg8::bf_lo(g2.x), aa[4 * q + 1] * pg8::bf_hi(a.x) + ab[4 * q + 1] * pg8::bf_hi(g2.x));
        o.y = pk2(aa[4 * q + 2] * pg8::bf_lo(a.y) + ab[4 * q + 2] * pg8::bf_lo(g2.y), aa[4 * q + 3] * pg8::bf_hi(a.y) + ab[4 * q + 3] * pg8::bf_hi(g2.y));
        *(u32x2v*)(yo + nn) = o; }
}
__device__ __forceinline__ void ctx_out_task(unsigned char* wsl, int l, int task, int lane, const float* gate) {
    const int tr = task >> 5, n0c = (task & 31) * 32, b = tr >> 3, r32 = lane & 31, hh = lane >> 5;
    const size_t token = (size_t)b * TB + (size_t)(tr & 7) * 32 + r32;
    f32x16v acc = {};
    wtile_mac(acc, (const bf16_t*)(wsl + WS_WO + l * SZ_WO) + (size_t)(n0c + r32) * 1024 + hh * 8, (const bf16_t*)(wsl + WS_ZA) + token * 1024 + hh * 8, 64);
    bf16_t* dl = (bf16_t*)(wsl + WS_GA) + token * 1024 + n0c;
#pragma unroll
    for (int q = 0; q < 4; ++q) { const int nn = 8 * q + 4 * hh; const f32x4 gv = *(const f32x4*)(gate + n0c + nn); u32x2v o;
        o.x = pk2(acc[4 * q + 0] * gv[0], acc[4 * q + 1] * gv[1]); o.y = pk2(acc[4 * q + 2] * gv[2], acc[4 * q + 3] * gv[3]); *(u32x2v*)(dl + nn) = o; }
}
#define QUEUE_LOOP(CTRWORD, NTASK, CALL) do { unsigned* qc_ = (unsigned*)(wsl + WS_BAR) + (CTRWORD); \
    for (;;) { unsigned wq_ = 0u; if (lane == 0) wq_ = __hip_atomic_fetch_add(qc_, 1u, __ATOMIC_RELAXED, __HIP_MEMORY_SCOPE_AGENT); \
        const int task = __builtin_amdgcn_readfirstlane((int)wq_); if (task >= (NTASK)) break; CALL; } } while (0)

__device__ __forceinline__ void store_u(const f32x4 (&v)[4], const float* mod, bf16_t* urow, int lane) {
#pragma unroll
    for (int j = 0; j < 4; ++j) { const int c = 4 * lane + 256 * j; const f32x4 sh = *(const f32x4*)(mod + c), sc = *(const f32x4*)(mod + 1024 + c);
        const f32x4 u = v[j] * (sc + 1.0f) + sh; u32x2v o; o.x = pk2(u[0], u[1]); o.y = pk2(u[2], u[3]); *(u32x2v*)(urow + c) = o; }
}

__global__ void __launch_bounds__(NTHREADS, 2) mega(Params P) {
    extern __shared__ __attribute__((aligned(16))) unsigned char lds[];
    cg::grid_group grid = cg::this_grid();
    const int wave = __builtin_amdgcn_readfirstlane(threadIdx.x >> 6);
#define LANE_ID() (__builtin_amdgcn_mbcnt_hi(~0u, __builtin_amdgcn_mbcnt_lo(~0u, 0u)))
    const int G = gridDim.x, bid = blockIdx.x, gw = bid * NWAVES + wave, NGW = G * NWAVES;
#define GRID_SYNC() xcd_barrier(xbar, wave == 0 && LANE_ID() == 0)
#define CAS __attribute__((address_space(4)))
#define WSL() const CAS Params* pp = (const CAS Params*)__builtin_amdgcn_kernarg_segment_ptr(); asm volatile("" : "+s"(pp)); unsigned char* wsl = pp->ws; asm volatile("" : "+s"(wsl))
#define U ((bf16_t*)(wsl + WS_U))
#define Q ((bf16_t*)(wsl + WS_Q))
#define Kb ((bf16_t*)(wsl + WS_K))
#define Vb ((bf16_t*)(wsl + WS_V))
#define ZA ((bf16_t*)(wsl + WS_ZA))
#define XB ((bf16_t*)(wsl + WS_XB))
#define ZB ((bf16_t*)(wsl + WS_ZB))
#define MOD ((float*)(wsl + WS_MOD))
#define CX ((float*)(wsl + WS_CX))
#define DELTA ((const bf16_t*)(wsl + WS_GA))
    LAS unsigned char* l3 = (LAS unsigned char*)lds;
    const CAS Params* pp0 = (const CAS Params*)__builtin_amdgcn_kernarg_segment_ptr();
    { volatile LAS unsigned* st = (volatile LAS unsigned*)(l3 + XBST_OFF); if (wave == 0 && LANE_ID() == 0) { st[0] = 0u; st[1] = 0u; st[2] = 0u; st[3] = 0u; } }
    __syncthreads();
    XcdBarrier xbar = xcd_barrier_post((unsigned*)(pp0->ws + WS_BAR), (volatile LAS unsigned*)(l3 + XBST_OFF), wave == 0 && LANE_ID() == 0);
    grid.sync();

    constexpr int NPH = 2 + 5 * DEPTH;
#pragma unroll 1
    for (int ph = 0; ph < NPH; ++ph) {
    const int l = ph < 2 ? 0 : (ph - 2) / 5, sph = ph < 2 ? ph : 2 + (ph - 2) % 5;
    if (sph == 0) {
        WSL(); int lane = LANE_ID(); asm volatile("" : "+v"(lane)); const int tid = wave * 64 + lane; unsigned char* ws = wsl; float* cosT = (float*)(wsl + WS_ROPE); float* sinT = cosT + 256 * 32;
        LAS float* scr = (LAS float*)(l3 + wave * 16384);
        constexpr int I_IN = (DM / 64) * (NIN / 32), I_A = (DM / 64) * (DM / 32), I_B = (512 / 64) * (DM / 32), I_O = I_A, I_P = (128 / 64) * (128 / 32);
        constexpr int PER_L = I_IN + I_A + I_B + I_O + 4 * I_P;
        for (int it = gw; it < DEPTH * PER_L; it += NGW) {
            const int l = it / PER_L; int r = it - l * PER_L;
            if (r < I_IN) { transpose_item(pp->w_in + (size_t)l * DM * NIN, DM, NIN, (bf16_t*)(ws + WS_WIN + l * SZ_WIN), scr, r, lane, 1280); continue; } r -= I_IN;
            if (r < I_A) { transpose_item(pp->w_br_a + (size_t)l * DM * DM, DM, DM, (bf16_t*)(ws + WS_WA + l * SZ_WA), scr, r, lane, 0); continue; } r -= I_A;
            if (r < I_B) { transpose_item(pp->w_br_b + (size_t)l * 512 * DM, 512, DM, (bf16_t*)(ws + WS_WB + l * SZ_WB), scr, r, lane, 0); continue; } r -= I_B;
            if (r < I_O) { transpose_item(pp->w_out + (size_t)l * DM * DM, DM, DM, (bf16_t*)(ws + WS_WO + l * SZ_WO), scr, r, lane, 0); continue; } r -= I_O;
            const int g = r / I_P; r -= g * I_P;
            transpose_item(pp->w_pool + ((size_t)l * 4 + g) * 128 * 128, 128, 128, (bf16_t*)(ws + WS_WP + l * SZ_WP) + (size_t)g * 128 * 128, scr, r, lane, 0);
        }
        for (int i = bid * NTHREADS + tid; i < 256 * 32; i += G * NTHREADS) { const int pos = i >> 5, f = i & 31;
            const float invf = 1.0f / __builtin_amdgcn_exp2f(13.287712379549449f * (float)f * (1.0f / 32.0f)); const float ang = (float)pos * invf;
            double rev = (double)ang * 0.15915494309189535; rev -= floor(rev); const float fr_ = (float)rev;
            cosT[i] = __builtin_amdgcn_cosf(fr_); sinT[i] = __builtin_amdgcn_sinf(fr_); }
        __syncthreads();
        LAS float* sv = (LAS float*)l3;
        LAS float* red = sv + 3 * 1024;
        for (int i = tid; i < 3 * 1024; i += NTHREADS) { const int v = i >> 10, k = i & 1023; const float cv = v < 2 ? pp->c[v * 1024 + k] : pp->c_ctx[k]; sv[i] = cv * pg8::sigm(cv); }
        __syncthreads();
        for (int un = bid; un < DEPTH * 48; un += G) { const int l = un / 48, n = (un % 48) * 64 + lane, ks = wave;
            const float* wm = pp->w_mod + (size_t)l * DM * 3072 + (size_t)(ks * 128) * 3072 + n; float a0 = 0.f, a1 = 0.f, a2 = 0.f;
#pragma unroll 8
            for (int k = 0; k < 128; ++k) { const float w = wm[(size_t)k * 3072]; a0 += sv[ks * 128 + k] * w; a1 += sv[1024 + ks * 128 + k] * w; a2 += sv[2048 + ks * 128 + k] * w; }
            red[(ks * 3 + 0) * 64 + lane] = a0; red[(ks * 3 + 1) * 64 + lane] = a1; red[(ks * 3 + 2) * 64 + lane] = a2;
            __syncthreads();
            if (tid < 192) { const int v = tid >> 6, cl = tid & 63; float s = 0.f;
#pragma unroll
                for (int q = 0; q < 8; ++q) s += red[(q * 3 + v) * 64 + cl];
                const int nn = (un % 48) * 64 + cl; MOD[((size_t)l * 3 + v) * 3072 + nn] = s + pp->b_mod[l * 3072 + nn]; }
            __syncthreads();
        }
    } else if (sph == 1) {
    WSL(); int lane = LANE_ID(); asm volatile("" : "+v"(lane));
    for (int r = gw; r < TROWS; r += NGW) { const float* xr = xrow_c(pp->x, pp->ctx, r); const int b = r / TB, mi = (r - b * TB) < CTXL ? 2 : b;
        f32x4 v[4];
#pragma unroll
        for (int j = 0; j < 4; ++j) v[j] = *(const f32x4*)(xr + 4 * lane + 256 * j);
        store_u(v, MOD + mi * 3072, U + (size_t)r * DM, lane); }
    } else if (sph == 2) {
        {
            WSL(); pg8::Gemm g{U, (const bf16_t*)(wsl + WS_WIN + l * SZ_WIN), TROWS, NIN, DM}; pg8::StaticOrder S; S.init(TROWS, NIN, G, bid);
            pg8::EpiIn E{wsl, pp->q_norm + l * 128, pp->k_norm + l * 128, (LAS float*)(l3 + PART_OFF)};
            pg8::gemm_phase<pg8::EpiIn, pg8::StaticOrder, true, true>(l3, g, S, E, wave);
        }
    } else if (sph == 3) {
        {
            WSL(); int lane = LANE_ID(); asm volatile("" : "+v"(lane)); const bf16_t* WPt = (const bf16_t*)(wsl + WS_WP + l * SZ_WP);
            const int nunits = 1024 + (l < DEPTH - 1 ? 16 : 0);
            float kmax; { const float* kn = pp->k_norm + l * 128; kmax = fmaxf(fabsf(kn[lane]), fabsf(kn[lane + 64]));
#pragma unroll
                for (int o_ = 1; o_ < 64; o_ <<= 1) kmax = fmaxf(kmax, __shfl_xor(kmax, o_)); }
            for (int un = bid; un < nunits; un += G) {
                __syncthreads();
                int b, h, rowq, seq;
                if (un < 1024) { b = un >> 9; h = (un >> 6) & 7; rowq = b * TB + CTXL + (un & 63) * 256; seq = TB; }
                else { const int c = un - 1024; b = c >> 3; h = c & 7; rowq = b * TB; seq = CTXL; }
                const size_t qoff = (size_t)rowq * DM + h * 128, koff = (size_t)b * TB * 256 + (h >> 2) * 128;
                att::attn_dense_body((const att::bf16*)(Q + qoff), (const att::bf16*)(Kb + koff), (const att::bf16*)(Vb + koff), (const att::bf16*)(ZA + qoff), (att::bf16*)(Q + qoff), seq, (char*)lds, wave, kmax);
            }
            { unsigned* qctr = (unsigned*)(wsl + WS_BAR) + 8 + l; const int npool = (l < DEPTH - 1) ? (TROWS / 32) * 4 : (NBATCH * SEQ / 32) * 4;
              for (;;) { unsigned wq = 0u; if (lane == 0) wq = __hip_atomic_fetch_add(qctr, 1u, __ATOMIC_RELAXED, __HIP_MEMORY_SCOPE_AGENT);
                  const int wi = __builtin_amdgcn_readfirstlane((int)wq); if (wi >= npool) break;
                  int wu = wi; if (l == DEPTH - 1) { const int rc = wi >> 2, rcf = rc + (CTXL / 32) * (1 + rc / (SEQ / 32)); wu = (rcf << 2) | (wi & 3); }
                  pool_unit(XB, ZB, WPt, pp->pool_scale + l * 512, wu, lane); } }
        }
    } else if (sph == 4) {
        {
            WSL(); pg8::Gemm g{Q, (const bf16_t*)(wsl + WS_WA + l * SZ_WA), TROWS, DM, DM};
            pg8::EpiGate<0> E{wsl};
            { pg8::StaticOrder S; S.init(NBATCH * SEQ, DM, G, bid); S.skip = 1; pg8::gemm_phase<pg8::EpiGate<0>, pg8::StaticOrder, true, true>(l3, g, S, E, wave); }
        }
        {
            WSL(); pg8::Gemm g{ZB, (const bf16_t*)(wsl + WS_WB + l * SZ_WB), TROWS, DM, 512};
            pg8::EpiGate<1> E{wsl};
            { pg8::StaticOrder S; S.init(NBATCH * SEQ, DM, G, bid); S.skip = 1; pg8::gemm_phase<pg8::EpiGate<1>, pg8::StaticOrder, true, true>(l3, g, S, E, wave); }
        }
        if (l < DEPTH - 1) { WSL(); int lane = LANE_ID(); asm volatile("" : "+v"(lane)); QUEUE_LOOP(32 + l, 512, ctx_merge_task(wsl, l, task, lane)); }
    } else if (sph == 5) {
        {
            WSL(); pg8::Gemm g{ZA, (const bf16_t*)(wsl + WS_WO + l * SZ_WO), TROWS, DM, DM};
            pg8::EpiRes E{MOD + (size_t)l * 3 * 3072, wsl};
            { pg8::StaticOrder S; S.init(NBATCH * SEQ, DM, G, bid); S.skip = 1; pg8::gemm_phase<pg8::EpiRes, pg8::StaticOrder, true, true>(l3, g, S, E, wave); }
        }
        if (l < DEPTH - 1) { WSL(); int lane = LANE_ID(); asm volatile("" : "+v"(lane)); const float* gate_c = MOD + (size_t)l * 3 * 3072 + 2 * 3072 + 2048; QUEUE_LOOP(48 + l, 512, ctx_out_task(wsl, l, task, lane, gate_c)); }
    } else {
        {
            WSL(); int lane = LANE_ID(); asm volatile("" : "+v"(lane)); const float* modl = MOD + (size_t)l * 3 * 3072; const float* lg = pp->ln_g + l * DM; const float* lb = pp->ln_b + l * DM; const bool last = (l == DEPTH - 1);
            const float* xlat = l == 0 ? pp->x : pp->out; const float* xctx = l == 0 ? pp->ctx : CX;
            auto ln_row = [&](const int r, const f32x4 (&vin)[4]) {
                const int b = r / TB, rr = r - b * TB; const bool isctx = rr < CTXL; f32x4 v[4]; float s = 0.f;
#pragma unroll
                for (int j = 0; j < 4; ++j) { v[j] = vin[j]; s += (v[j][0] + v[j][1]) + (v[j][2] + v[j][3]); }
                const float mean = wave_sum(s) * (1.0f / DM); float s2 = 0.f;
#pragma unroll
                for (int j = 0; j < 4; ++j) { v[j] = v[j] - mean; s2 += (v[j][0] * v[j][0] + v[j][1] * v[j][1]) + (v[j][2] * v[j][2] + v[j][3] * v[j][3]); }
                const float rstd = 1.0f / sqrtf(wave_sum(s2) * (1.0f / DM) + EPSV);
                float* xo = isctx ? CX + ((size_t)b * CTXL + rr) * DM : pp->out + ((size_t)b * SEQ + (rr - CTXL)) * DM;
#pragma unroll
                for (int j = 0; j < 4; ++j) { const int c = 4 * lane + 256 * j; v[j] = v[j] * rstd * *(const f32x4*)(lg + c) + *(const f32x4*)(lb + c); *(f32x4*)(xo + c) = v[j]; }
                if (!last) store_u(v, modl + 3 * 3072 + (isctx ? 2 : b) * 3072, U + (size_t)r * DM, lane);
            };
            const int nrows = last ? NBATCH * SEQ : TROWS;
            for (int i0 = gw; i0 < nrows; i0 += 2 * NGW) {
                const int i1 = i0 + NGW; const bool has1 = i1 < nrows;
                const int r0 = last ? i0 + CTXL * (1 + i0 / SEQ) : i0, r1 = has1 ? (last ? i1 + CTXL * (1 + i1 / SEQ) : i1) : r0;
                f32x4 va[4], vb[4]; const float* xa = xrow_c(xlat, xctx, r0); const float* xb_ = xrow_c(xlat, xctx, r1);
                const bf16_t* da = DELTA + (size_t)r0 * DM; const bf16_t* db = DELTA + (size_t)r1 * DM;
#pragma unroll
                for (int j = 0; j < 4; ++j) { const int c = 4 * lane + 256 * j; const f32x4 x0 = *(const f32x4*)(xa + c), x1 = *(const f32x4*)(xb_ + c);
                    const u32x2v d0 = *(const u32x2v*)(da + c), d1 = *(const u32x2v*)(db + c);
                    va[j] = x0 * ALPHA_RES + (f32x4){pg8::bf_lo(d0.x), pg8::bf_hi(d0.x), pg8::bf_lo(d0.y), pg8::bf_hi(d0.y)};
                    vb[j] = x1 * ALPHA_RES + (f32x4){pg8::bf_lo(d1.x), pg8::bf_hi(d1.x), pg8::bf_lo(d1.y), pg8::bf_hi(d1.y)}; }
                ln_row(r0, va); if (has1) ln_row(r1, vb);
            }
        }
    }
    if (ph + 1 < NPH) GRID_SYNC();
    }
}

extern "C" void kernel_launch(void* const* d_in, const int* in_sizes, int n_in, void* d_out, int out_size, void* d_ws, size_t ws_size, hipStream_t stream) {
    static int grid_blocks = 0;
    if (grid_blocks == 0) {
        if (n_in != 16 || ws_size < WS_END2 || out_size != NBATCH * SEQ * DM) { fprintf(stderr, "kernel_launch: unexpected shapes: n_in %d out %d ws %zu (need %zu)\n", n_in, out_size, ws_size, (size_t)WS_END2); grid_blocks = -1; return; }
        int dev = 0, cus = 0, per_cu = 0;
        hipGetDevice(&dev); hipDeviceGetAttribute(&cus, hipDeviceAttributeMultiprocessorCount, dev);
        if (hipFuncSetAttribute((const void*)mega, hipFuncAttributeMaxDynamicSharedMemorySize, LDS_BYTES) != hipSuccess) { fprintf(stderr, "kernel_launch: hipFuncSetAttribute failed\n"); grid_blocks = -1; return; }
        if (hipOccupancyMaxActiveBlocksPerMultiprocessor(&per_cu, (const void*)mega, NTHREADS, LDS_BYTES) != hipSuccess || per_cu < 1) { fprintf(stderr, "kernel_launch: occupancy query gave %d\n", per_cu); per_cu = 1; }
        (void)hipGetLastError();
        grid_blocks = cus * per_cu;
    }
    if (grid_blocks < 0) return;
    Params p{};
    p.x = (const float*)d_in[0]; p.c = (const float*)d_in[1]; p.ctx = (const float*)d_in[2]; p.c_ctx = (const float*)d_in[3]; p.w_mod = (const float*)d_in[4]; p.b_mod = (const float*)d_in[5];
    p.w_in = (const float*)d_in[6]; p.q_norm = (const float*)d_in[7]; p.k_norm = (const float*)d_in[8]; p.w_pool = (const float*)d_in[9]; p.pool_scale = (const float*)d_in[10];
    p.w_br_a = (const float*)d_in[11]; p.w_br_b = (const float*)d_in[12]; p.w_out = (const float*)d_in[13]; p.ln_g = (const float*)d_in[14]; p.ln_b = (const float*)d_in[15];
    p.out = (float*)d_out; p.ws = (unsigned char*)d_ws;
    void* args[] = {&p};
    if (hipMemsetAsync((char*)d_ws + WS_BAR, 0, XCD_BAR_WORDS * 4, stream) != hipSuccess) { fprintf(stderr, "kernel_launch: memset of the barrier word failed\n"); return; }
    hipError_t e = hipLaunchCooperativeKernel((const void*)mega, dim3(grid_blocks), dim3(NTHREADS), args, LDS_BYTES, stream);
    if (e != hipSuccess) fprintf(stderr, "kernel_launch: cooperative launch failed: %s (grid %d)\n", hipGetErrorString(e), grid_blocks);
}
```

```cpp
#include <hip/hip_runtime.h>
#include <hip/hip_bf16.h>
#include <hip/hip_cooperative_groups.h>
#include <cstdio>
#include <cstdint>
namespace cg = cooperative_groups;

constexpr int DM = 1024, NBATCH = 2, SEQ = 16384, CTXL = 256, DEPTH = 4, HD = 128;
constexpr int TB = SEQ + CTXL;
constexpr int TROWS = NBATCH * TB;
constexpr int NIN = 5632;
constexpr float EPSV = 1e-6f;
constexpr float ALPHA_RES = 1.681792830507429f;
constexpr int NWAVES = 8, NTHREADS = 512;

constexpr size_t SZ_WIN = (size_t)NIN * DM * 2, SZ_WA = (size_t)DM * DM * 2, SZ_WB = (size_t)DM * 512 * 2, SZ_WO = SZ_WA, SZ_WP = (size_t)4 * 128 * 128 * 2;
constexpr size_t WS_WIN = 0;
constexpr size_t WS_WA = WS_WIN + DEPTH * SZ_WIN;
constexpr size_t WS_WB = WS_WA + DEPTH * SZ_WA;
constexpr size_t WS_WO = WS_WB + DEPTH * SZ_WB;
constexpr size_t WS_WP = WS_WO + DEPTH * SZ_WO;
constexpr size_t WS_MOD = WS_WP + DEPTH * SZ_WP;
constexpr size_t WS_ROPE = WS_MOD + (size_t)DEPTH * 3 * 3072 * 4;
constexpr size_t WS_CX = WS_ROPE + 2 * 256 * 32 * 4;
constexpr size_t WS_U = WS_CX + (size_t)512 * DM * 4;
constexpr size_t WS_Q = WS_U + (size_t)TROWS * DM * 2;
constexpr size_t WS_K = WS_Q + (size_t)TROWS * DM * 2;
constexpr size_t WS_V = WS_K + (size_t)TROWS * 256 * 2;
constexpr size_t WS_ZA = WS_V + (size_t)TROWS * 256 * 2;
constexpr size_t WS_XB = WS_ZA + (size_t)TROWS * DM * 2;
constexpr size_t WS_ZB = WS_XB + (size_t)TROWS * 512 * 2;
constexpr size_t WS_GA = WS_ZB + (size_t)TROWS * 512 * 2;
constexpr size_t WS_GB = WS_GA + (size_t)TROWS * DM * 2;
constexpr size_t WS_END = WS_GB + (size_t)TROWS * DM * 2;
constexpr size_t WS_BAR = WS_END, WS_END2 = WS_END + 16384;

struct Params {
    const float *x, *c, *ctx, *c_ctx, *w_mod, *b_mod, *w_in, *q_norm, *k_norm, *w_pool, *pool_scale, *w_br_a, *w_br_b, *w_out, *ln_g, *ln_b;
    float* out; unsigned char* ws;
};

namespace pg8 {
#define PG8_LAS __attribute__((address_space(3)))
typedef unsigned short bf16_t;
typedef short bf16x8 __attribute__((ext_vector_type(8)));
typedef float f32x4 __attribute__((ext_vector_type(4)));
typedef unsigned u32x4 __attribute__((ext_vector_type(4)));
constexpr int BM = 256, BK = 64, HALF = 128, HTB = HALF * BK * 2  , STAGE_BYTES = 8 * HTB, NXCD = 8, WGM = 8;

__host__ __device__ __forceinline__ int lds_byte(int r, int c) { const int st = (r >> 4) * 2 + (c >> 5), rr = r & 15, cc = c & 31, ob = rr * 64 + cc * 2; return st * 1024 + (ob ^ (((ob >> 9) & 1) << 5)); }
__host__ __device__ __forceinline__ void stage_rc(int b, int& R, int& C) { const int st = b / 1024, sb = b % 1024, swz = sb ^ (((sb >> 9) & 1) << 5); R = (st >> 1) * 16 + swz / 64; C = (st & 1) * 32 + (swz % 64) / 2; }
__host__ __device__ __forceinline__ int perm32(int rho) { const int n = rho >> 4, i = rho & 15; return 8 * (i >> 2) + 4 * n + (i & 3); }

struct Unit { int pm, pn; };
struct Gemm { const bf16_t* A; const bf16_t* Bt; int M, N, K; };

struct StaticOrder {
    int nM, nN, nwg, G, c, skip;
    __host__ __device__ void init(int M, int N, int G_, int c_) { nM = M / BM; nN = N / BM; nwg = nM * nN; G = G_; c = c_; skip = 0; }
    __host__ __device__ bool next(int i, Unit& u) const {
        const long L = (long)i * G + c; if (L >= nwg) return false;
        int wgid = (int)L; { const int q = nwg / NXCD, r = nwg % NXCD, xcd = wgid % NXCD, off = wgid / NXCD; wgid = (xcd < r ? xcd * (q + 1) : r * (q + 1) + (xcd - r) * q) + off; }
        const int nig = WGM * nN, gid = wgid / nig, fm = gid * WGM, gsz = (nM - fm) < WGM ? (nM - fm) : WGM;
        u.pm = fm + ((wgid % nig) % gsz); u.pn = (wgid % nig) / gsz; if (skip) u.pm += 1 + (u.pm >= 64 ? 1 : 0); return true;
    }
    __device__ __forceinline__ void a_ready(const Unit&) const {}
    __device__ __forceinline__ void done(const Unit&) const {}
};

typedef __bf16 bf16x2_t __attribute__((ext_vector_type(2)));
typedef float f32x2_t __attribute__((ext_vector_type(2)));
__device__ __forceinline__ unsigned cvt_pk_bf16(float lo, float hi) { const f32x2_t v = {lo, hi}; const bf16x2_t r = __builtin_convertvector(v, bf16x2_t); return __builtin_bit_cast(unsigned, r); }
typedef float f32x2 __attribute__((ext_vector_type(2)));
struct LatentOrder {
    StaticOrder S;
    __host__ __device__ void init(int N, int G_, int c_) { S.init(32768, N, G_, c_); }
    __host__ __device__ bool next(int i, Unit& u) const { if (!S.next(i, u)) return false; u.pm += 1 + (u.pm >= 64 ? 1 : 0); return true; }
    __device__ __forceinline__ void a_ready(const Unit&) const {}
    __device__ __forceinline__ void done(const Unit&) const {}
};
__device__ __forceinline__ float bf_lo(unsigned w) { return __uint_as_float(w << 16); }
__device__ __forceinline__ float bf_hi(unsigned w) { return __uint_as_float(w & 0xffff0000u); }
__device__ __forceinline__ float sigm(float x) { return __builtin_amdgcn_rcpf(1.0f + __builtin_amdgcn_exp2f(-1.4426950408889634f * x)); }
typedef unsigned u32x2 __attribute__((ext_vector_type(2)));
template <int ACT> __device__ __forceinline__ float actf(float x) { if (ACT == 1) return x * sigm(x); if (ACT == 2) return sigm(x); return x; }

struct EpiIn {
    static constexpr bool PERM = true, AFTER_DRAIN = false;
    unsigned char* ws; const float *qg, *kg;
    PG8_LAS float* part;
    template <int ACT> __device__ __forceinline__ void plain(const f32x4 (&acc)[2][2][4][2], bf16_t* base, int ldc, int colt, const Unit& u, int wr, int wc, int fr, int fq) const {
        const int row0 = u.pm * BM + wr * 64 + fr, col0 = colt + wc * 32 + 8 * fq;
#pragma unroll
        for (int ai = 0; ai < 2; ++ai)
#pragma unroll
            for (int m = 0; m < 4; ++m) { bf16_t* rowp = base + (size_t)(row0 + ai * HALF + m * 16) * ldc + col0;
#pragma unroll
                for (int bj = 0; bj < 2; ++bj) { const f32x4 v0 = acc[ai][bj][m][0], v1 = acc[ai][bj][m][1]; u32x4 w;
                    w.x = cvt_pk_bf16(actf<ACT>(v0[0]), actf<ACT>(v0[1])); w.y = cvt_pk_bf16(actf<ACT>(v0[2]), actf<ACT>(v0[3]));
                    w.z = cvt_pk_bf16(actf<ACT>(v1[0]), actf<ACT>(v1[1])); w.w = cvt_pk_bf16(actf<ACT>(v1[2]), actf<ACT>(v1[3]));
                    *(u32x4*)(rowp + bj * HALF) = w; } }
    }
    __device__ __forceinline__ void qk(const f32x4 (&acc)[2][2][4][2], const Unit& u, int wr, int wc, int fr, int fq) const {
        const bool isk = (u.pn == 4);
        const float* g = isk ? kg : qg; bf16_t* dst = (bf16_t*)(ws + (isk ? WS_K : WS_Q)); const int ldc = isk ? 256 : 1024;
        const float* cosT = (const float*)(ws + WS_ROPE); const float* sinT = cosT + 256 * 32;
        const int f0 = (wc & 1) * 16 + 4 * fq, axis = wc >> 1, e1 = axis * 64 + f0;
        const f32x4 g1 = *(const f32x4*)(g + e1), g2 = *(const f32x4*)(g + e1 + 32);
#pragma unroll
        for (int ai = 0; ai < 2; ++ai)
#pragma unroll
            for (int m = 0; m < 4; ++m)
#pragma unroll
                for (int bj = 0; bj < 2; ++bj) { const f32x4 a = acc[ai][bj][m][0], b = acc[ai][bj][m][1];
                    float s = (a[0] * a[0] + a[1] * a[1]) + (a[2] * a[2] + a[3] * a[3]) + (b[0] * b[0] + b[1] * b[1]) + (b[2] * b[2] + b[3] * b[3]);
                    s += __shfl_xor(s, 16); s += __shfl_xor(s, 32);
                    if (fq == 0) part[((ai * HALF + wr * 64 + m * 16 + fr) * 2 + bj) * 4 + wc] = s; }
        asm volatile("s_waitcnt lgkmcnt(0)" ::: "memory"); __builtin_amdgcn_s_barrier(); asm volatile("" ::: "memory");
        const int jt = u.pm % 65; const bool rope = (jt != 0);
#pragma unroll
        for (int ai = 0; ai < 2; ++ai)
#pragma unroll
            for (int m = 0; m < 4; ++m) { const int rloc = ai * HALF + wr * 64 + m * 16 + fr;
                const int pos = rope ? (axis ? (16 * m + fr) : ((jt - 1) * 4 + 2 * ai + wr)) : 0;
                f32x4 c4 = *(const f32x4*)(cosT + pos * 32 + f0), s4 = *(const f32x4*)(sinT + pos * 32 + f0);
                if (!rope) { c4 = (f32x4){1.f, 1.f, 1.f, 1.f}; s4 = (f32x4){0.f, 0.f, 0.f, 0.f}; }
#pragma unroll
                for (int bj = 0; bj < 2; ++bj) { const f32x4 p = *(const PG8_LAS f32x4*)(part + (rloc * 2 + bj) * 4);
                    const float rstd = __builtin_amdgcn_rsqf(((p[0] + p[1]) + (p[2] + p[3])) * (1.0f / 128.0f) + 1e-6f);
                    const f32x4 y1 = acc[ai][bj][m][0] * rstd * g1, y2 = acc[ai][bj][m][1] * rstd * g2;
                    f32x4 o1 = y1 * c4 - y2 * s4, o2 = y1 * s4 + y2 * c4;
                    if (!isk) { o1 = o1 * 0.12751743074602458f; o2 = o2 * 0.12751743074602458f; }
                    const int head = isk ? bj : 2 * u.pn + bj;
                    bf16_t* ptr = dst + (size_t)(u.pm * BM + rloc) * ldc + head * 128 + e1;
                    u32x2 w1, w2; w1.x = cvt_pk_bf16(o1[0], o1[1]); w1.y = cvt_pk_bf16(o1[2], o1[3]); w2.x = cvt_pk_bf16(o2[0], o2[1]); w2.y = cvt_pk_bf16(o2[2], o2[3]);
                    *(u32x2*)ptr = w1; *(u32x2*)(ptr + 32) = w2; } }
    }
    __device__ __forceinline__ void operator()(const f32x4 (&acc)[2][2][4][2], const Unit& u, int wr, int wc, int fr, int fq) const {
        const int pn = u.pn;
        if (pn < 5) { qk(acc, u, wr, wc, fr, fq); return; }
        if (pn == 5) plain<0>(acc, (bf16_t*)(ws + WS_V), 256, 0, u, wr, wc, fr, fq);
        else if (pn < 10) plain<1>(acc, (bf16_t*)(ws + WS_ZA), 1024, (pn - 6) * 256, u, wr, wc, fr, fq);
        else if (pn < 12) plain<0>(acc, (bf16_t*)(ws + WS_XB), 512, (pn - 10) * 256, u, wr, wc, fr, fq);
        else if (pn < 14) plain<1>(acc, (bf16_t*)(ws + WS_ZB), 512, (pn - 12) * 256, u, wr, wc, fr, fq);
        else if (pn < 18) plain<2>(acc, (bf16_t*)(ws + WS_GA), 1024, (pn - 14) * 256, u, wr, wc, fr, fq);
        else plain<2>(acc, (bf16_t*)(ws + WS_GB), 1024, (pn - 18) * 256, u, wr, wc, fr, fq);
    }
};
template <int MODE> struct EpiGate {
    static constexpr bool PERM = true, AFTER_DRAIN = false;
    unsigned char* ws;
    __device__ __forceinline__ void operator()(const f32x4 (&acc)[2][2][4][2], const Unit& u, int wr, int wc, int fr, int fq) const {
        bf16_t* GA = (bf16_t*)(ws + WS_GA); const bf16_t* GB = (const bf16_t*)(ws + WS_GB); bf16_t* Y = (bf16_t*)(ws + WS_ZA);
        const int row0 = u.pm * BM + wr * 64 + fr, col0 = u.pn * BM + wc * 32 + 8 * fq;
#pragma unroll
        for (int ai = 0; ai < 2; ++ai)
#pragma unroll
            for (int m = 0; m < 4; ++m) { const size_t off = (size_t)(row0 + ai * HALF + m * 16) * 1024 + col0;
#pragma unroll
                for (int bj = 0; bj < 2; ++bj) { const f32x4 v0 = acc[ai][bj][m][0], v1 = acc[ai][bj][m][1];
                    const u32x4 ga = *(const u32x4*)(GA + off + bj * HALF); u32x4 w;
                    if (MODE == 0) {
                        w.x = cvt_pk_bf16(v0[0] * bf_lo(ga.x), v0[1] * bf_hi(ga.x)); w.y = cvt_pk_bf16(v0[2] * bf_lo(ga.y), v0[3] * bf_hi(ga.y));
                        w.z = cvt_pk_bf16(v1[0] * bf_lo(ga.z), v1[1] * bf_hi(ga.z)); w.w = cvt_pk_bf16(v1[2] * bf_lo(ga.w), v1[3] * bf_hi(ga.w));
                        *(u32x4*)(GA + off + bj * HALF) = w;
                    } else {
                        const u32x4 gb = *(const u32x4*)(GB + off + bj * HALF);
                        w.x = cvt_pk_bf16(bf_lo(ga.x) + v0[0] * bf_lo(gb.x), bf_hi(ga.x) + v0[1] * bf_hi(gb.x)); w.y = cvt_pk_bf16(bf_lo(ga.y) + v0[2] * bf_lo(gb.y), bf_hi(ga.y) + v0[3] * bf_hi(gb.y));
                        w.z = cvt_pk_bf16(bf_lo(ga.z) + v1[0] * bf_lo(gb.z), bf_hi(ga.z) + v1[1] * bf_hi(gb.z)); w.w = cvt_pk_bf16(bf_lo(ga.w) + v1[2] * bf_lo(gb.w), bf_hi(ga.w) + v1[3] * bf_hi(gb.w));
                        *(u32x4*)(Y + off + bj * HALF) = w;
                    } } }
    }
};
struct EpiRes {
    static constexpr bool PERM = true, AFTER_DRAIN = false;
    const float* mod; unsigned char* ws;
    __device__ __forceinline__ void operator()(const f32x4 (&acc)[2][2][4][2], const Unit& u, int wr, int wc, int fr, int fq) const {
        const int b = u.pm / 65, jt = u.pm % 65; bf16_t* dl = (bf16_t*)(ws + WS_GA);
        const float* gate = mod + (jt ? b : 2) * 3072 + 2048;
        const int row0 = u.pm * BM + wr * 64 + fr, col0 = u.pn * BM + wc * 32 + 8 * fq;
        f32x4 gv[2][2];
#pragma unroll
        for (int bj = 0; bj < 2; ++bj)
#pragma unroll
            for (int n = 0; n < 2; ++n) gv[bj][n] = *(const f32x4*)(gate + col0 + bj * HALF + 4 * n);
#pragma unroll
        for (int ai = 0; ai < 2; ++ai)
#pragma unroll
            for (int m = 0; m < 4; ++m) { bf16_t* rowp = dl + (size_t)(row0 + ai * HALF + m * 16) * 1024 + col0;
#pragma unroll
                for (int bj = 0; bj < 2; ++bj) { const f32x4 v0 = acc[ai][bj][m][0] * gv[bj][0], v1 = acc[ai][bj][m][1] * gv[bj][1]; u32x4 w;
                    w.x = cvt_pk_bf16(v0[0], v0[1]); w.y = cvt_pk_bf16(v0[2], v0[3]); w.z = cvt_pk_bf16(v1[0], v1[1]); w.w = cvt_pk_bf16(v1[2], v1[3]);
                    *(u32x4*)(rowp + bj * HALF) = w; } }
    }
};

template <class Epi, class Sched, bool ALIGN_EPI = false, bool SP2 = false>
__device__ __forceinline__ void gemm_phase(PG8_LAS unsigned char* lds, const Gemm g, const Sched& S, const Epi& E, const int wid_in) {
    int lane = __builtin_amdgcn_mbcnt_hi(~0u, __builtin_amdgcn_mbcnt_lo(~0u, 0u)); asm volatile("" : "+v"(lane));
    const int wid = wid_in, tid = wid * 64 + lane, wr = wid >> 2, wc = wid & 3, fr = lane & 15, fq = lane >> 4;
    const int K = g.K, nt = K / BK;
    unsigned voffA[2], voffB[2];
#pragma unroll
    for (int i = 0; i < 2; ++i) { int R, C; stage_rc(tid * 16 + i * 8192, R, C); const int Rb = Epi::PERM ? ((R & ~31) + perm32(R & 31)) : R;
        voffA[i] = (unsigned)(R * K + C) * 2u; voffB[i] = (unsigned)(Rb * K + C) * 2u; }
    const size_t kstep = (size_t)(BK * 2);
    const size_t hstep = (size_t)HALF * K * 2;
    const size_t tstep = 2 * hstep;
    const unsigned ldsw = (unsigned)wid * 1024u;
    const int aoff = lds_byte(wr * 64 + fr, fq * 8), boff = lds_byte(wc * 32 + fr, fq * 8);
#define PG8_SA(b, h) (((b) * 2 + (h)) * HTB)
#define PG8_SB(b, h) ((4 + (b) * 2 + (h)) * HTB)
#define PG8_STAGE(bufoff, gbase, voff) do { _Pragma("unroll") for (int _i = 0; _i < 2; ++_i) \
        __builtin_amdgcn_global_load_lds((const unsigned*)((const char*)(gbase) + (voff)[_i]), (PG8_LAS unsigned*)(lds + (bufoff) + ldsw + _i * 8192), 16, 0, 0); } while (0)
#define PG8_LDA(dst, b, h) do { _Pragma("unroll") for (int m = 0; m < 4; ++m) _Pragma("unroll") for (int k = 0; k < 2; ++k) dst[m][k] = *(const PG8_LAS bf16x8*)(lds + PG8_SA(b, h) + aoff + m * 2048 + k * 1024); } while (0)
#define PG8_LDB(dst, b, h) do { _Pragma("unroll") for (int n = 0; n < 2; ++n) _Pragma("unroll") for (int k = 0; k < 2; ++k) dst[n][k] = *(const PG8_LAS bf16x8*)(lds + PG8_SB(b, h) + boff + n * 2048 + k * 1024); } while (0)
#define PG8_MMA(ai, bj, At, Bt) do { __builtin_amdgcn_s_setprio(1); _Pragma("unroll") for (int m = 0; m < 4; ++m) _Pragma("unroll") for (int n = 0; n < 2; ++n) _Pragma("unroll") for (int k = 0; k < 2; ++k) \
        acc[ai][bj][m][n] = __builtin_amdgcn_mfma_f32_16x16x32_bf16(Bt[n][k], At[m][k], acc[ai][bj][m][n], 0, 0, 0); __builtin_amdgcn_s_setprio(0); } while (0)
#define PG8_WAIT_V(n) asm volatile("s_waitcnt vmcnt(" #n ")" ::: "memory")
#define PG8_WAIT_L(n) asm volatile("s_waitcnt lgkmcnt(" #n ")" ::: "memory")
#define PG8_BAR __builtin_amdgcn_s_barrier()
#define PG8_SCHED __builtin_amdgcn_sched_barrier(0)
    Unit cur, nxt; int ui = 0;
    if (!S.next(0, cur)) return;
    f32x4 acc[2][2][4][2];
#pragma unroll
    for (int a = 0; a < 2; ++a)
#pragma unroll
        for (int b = 0; b < 2; ++b)
#pragma unroll
            for (int m = 0; m < 4; ++m)
#pragma unroll
                for (int n = 0; n < 2; ++n) acc[a][b][m][n] = (f32x4){0.f, 0.f, 0.f, 0.f};
    bf16x8 At[4][2], B0[2][2], B1[2][2];
    const char* cA = (const char*)g.A + (size_t)cur.pm * tstep; const char* cB = (const char*)g.Bt + (size_t)cur.pn * tstep;
    S.a_ready(cur);
    if constexpr (SP2) {
        PG8_STAGE(PG8_SB(0, 0), cB, voffB); PG8_STAGE(PG8_SB(0, 1), cB + hstep, voffB); PG8_STAGE(PG8_SA(0, 0), cA, voffA); PG8_STAGE(PG8_SA(0, 1), cA + hstep, voffA);
        if (wr == 1) PG8_BAR;
        PG8_WAIT_V(2); PG8_BAR;
        PG8_STAGE(PG8_SB(1, 0), cB + kstep, voffB); PG8_STAGE(PG8_SA(1, 0), cA + kstep, voffA); PG8_STAGE(PG8_SB(1, 1), cB + hstep + kstep, voffB);
        PG8_WAIT_V(6); PG8_BAR;
    } else {
        PG8_STAGE(PG8_SB(0, 0), cB, voffB); PG8_STAGE(PG8_SA(0, 0), cA, voffA); PG8_STAGE(PG8_SB(0, 1), cB + hstep, voffB); PG8_STAGE(PG8_SA(0, 1), cA + hstep, voffA);
        if (wr == 1) PG8_BAR;
        PG8_WAIT_V(4); PG8_BAR;
        PG8_STAGE(PG8_SB(1, 0), cB + kstep, voffB); PG8_STAGE(PG8_SA(1, 0), cA + kstep, voffA); PG8_STAGE(PG8_SB(1, 1), cB + hstep + kstep, voffB);
        PG8_WAIT_V(6); PG8_BAR;
    }
    for (;;) {
        const bool has_next = S.next(ui + 1, nxt);
        const char* nA = has_next ? (const char*)g.A + (size_t)nxt.pm * tstep : cA; const char* nB = has_next ? (const char*)g.Bt + (size_t)nxt.pn * tstep : cB;
        for (int t = 0; t < nt; t += 2) {
            const bool last = (t == nt - 2);
            const char* a1 = cA + (size_t)(t + 1) * kstep;
            const char* a2 = last ? nA : cA + (size_t)(t + 2) * kstep; const char* b2 = last ? nB : cB + (size_t)(t + 2) * kstep;
            const char* a3 = a2 + kstep; const char* b3 = b2 + kstep;
            if (last && has_next) S.a_ready(nxt);
            if constexpr (SP2) {
            PG8_LDB(B0, 0, 0); PG8_LDB(B1, 0, 1); PG8_SCHED; PG8_LDA(At, 0, 0); PG8_STAGE(PG8_SA(1, 1), a1 + hstep, voffA);
            PG8_WAIT_V(8); PG8_WAIT_L(0); PG8_BAR; PG8_MMA(0, 0, At, B0); PG8_MMA(0, 1, At, B1); PG8_BAR; PG8_SCHED;
            PG8_LDA(At, 0, 1); PG8_STAGE(PG8_SB(0, 0), b2, voffB); PG8_STAGE(PG8_SB(0, 1), b2 + hstep, voffB); PG8_STAGE(PG8_SA(0, 0), a2, voffA);
            PG8_WAIT_V(8); PG8_WAIT_L(0); PG8_BAR; PG8_MMA(1, 0, At, B0); PG8_MMA(1, 1, At, B1); PG8_BAR; PG8_SCHED;
            PG8_LDB(B0, 1, 0); PG8_LDB(B1, 1, 1); PG8_SCHED; PG8_LDA(At, 1, 0); PG8_STAGE(PG8_SA(0, 1), a2 + hstep, voffA);
            PG8_WAIT_V(8); PG8_WAIT_L(0); PG8_BAR; PG8_MMA(0, 0, At, B0); PG8_MMA(0, 1, At, B1); PG8_BAR; PG8_SCHED;
            PG8_LDA(At, 1, 1); PG8_STAGE(PG8_SB(1, 0), b3, voffB); PG8_STAGE(PG8_SB(1, 1), b3 + hstep, voffB); PG8_STAGE(PG8_SA(1, 0), a3, voffA);
            PG8_WAIT_V(8); PG8_WAIT_L(0); PG8_BAR; PG8_MMA(1, 0, At, B0); PG8_MMA(1, 1, At, B1); PG8_BAR; PG8_SCHED;
            } else {
            PG8_LDB(B0, 0, 0); PG8_SCHED; PG8_LDA(At, 0, 0); PG8_STAGE(PG8_SA(1, 1), a1 + hstep, voffA);
            PG8_WAIT_L(8); PG8_BAR; PG8_WAIT_L(0); PG8_MMA(0, 0, At, B0); PG8_BAR; PG8_SCHED;
            PG8_LDB(B1, 0, 1); PG8_STAGE(PG8_SB(0, 0), b2, voffB);
            PG8_BAR; PG8_WAIT_L(0); PG8_MMA(0, 1, At, B1); PG8_BAR;
            PG8_LDA(At, 0, 1); PG8_STAGE(PG8_SA(0, 0), a2, voffA);
            PG8_BAR; PG8_WAIT_L(0); PG8_MMA(1, 0, At, B0); PG8_BAR; PG8_SCHED;
            PG8_STAGE(PG8_SB(0, 1), b2 + hstep, voffB);
            PG8_WAIT_V(6); PG8_BAR; PG8_MMA(1, 1, At, B1); PG8_BAR;
            PG8_LDB(B0, 1, 0); PG8_SCHED; PG8_LDA(At, 1, 0); PG8_STAGE(PG8_SA(0, 1), a2 + hstep, voffA);
            PG8_WAIT_L(8); PG8_BAR; PG8_WAIT_L(0); PG8_MMA(0, 0, At, B0); PG8_BAR; PG8_SCHED;
            PG8_LDB(B1, 1, 1); PG8_STAGE(PG8_SB(1, 0), b3, voffB);
            PG8_BAR; PG8_WAIT_L(0); PG8_MMA(0, 1, At, B1); PG8_BAR;
            PG8_LDA(At, 1, 1); PG8_STAGE(PG8_SA(1, 0), a3, voffA);
            PG8_BAR; PG8_WAIT_L(0); PG8_MMA(1, 0, At, B0); PG8_BAR; PG8_SCHED;
            PG8_STAGE(PG8_SB(1, 1), b3 + hstep, voffB);
            PG8_WAIT_V(6); PG8_BAR; PG8_MMA(1, 1, At, B1); PG8_BAR;
            }
        }
        if constexpr (ALIGN_EPI) { if (wr == 0) PG8_BAR; }
        if constexpr (!Epi::AFTER_DRAIN) { int l2 = __builtin_amdgcn_mbcnt_hi(~0u, __builtin_amdgcn_mbcnt_lo(~0u, 0u)); asm volatile("" : "+v"(l2));
            E(acc, cur, wr, wc, l2 & 15, l2 >> 4); S.done(cur); }
        if (!has_next) break;
#pragma unroll
        for (int a = 0; a < 2; ++a)
#pragma unroll
            for (int b = 0; b < 2; ++b)
#pragma unroll
                for (int m = 0; m < 4; ++m)
#pragma unroll
                    for (int n = 0; n < 2; ++n) acc[a][b][m][n] = (f32x4){0.f, 0.f, 0.f, 0.f};
        cur = nxt; cA = nA; cB = nB; ++ui;
        if constexpr (ALIGN_EPI) { if (wr == 1) PG8_BAR; }
    }
    PG8_WAIT_V(0);
    if constexpr (!ALIGN_EPI) { if (wr == 0) PG8_BAR; }
    PG8_BAR;
    if constexpr (Epi::AFTER_DRAIN) { E.fused(acc, cur, wr, wc, fr, fq, lds, wid, lane); S.done(cur); }
#undef PG8_SA
#undef PG8_SB
#undef PG8_STAGE
#undef PG8_LDA
#undef PG8_LDB
#undef PG8_MMA
#undef PG8_WAIT_V
#undef PG8_WAIT_L
#undef PG8_BAR
#undef PG8_SCHED
}
}
namespace att {
using bf16 = __hip_bfloat16;
constexpr int   D = 128, NW = 8, QBLK = 32, KVBLK = 64;
constexpr float SCALE = 0.088388347648318440f;
constexpr float THR = 8.f;
constexpr int SDEPTH = 1;
constexpr int LDQ = 1024, LDK = 256, LDO = 1024;
constexpr size_t SHM_V = KVBLK * D * 2, SHM_K = KVBLK * D * 2, SHM_ATTN = 2 * SHM_V + 2 * SHM_K + NW * 64 * 4;
using bf16x8 = __attribute__((ext_vector_type(8))) short;
using s16x4  = __attribute__((ext_vector_type(4))) short;
using f32x16 = __attribute__((ext_vector_type(16))) float;
using f32x8  = __attribute__((ext_vector_type(8))) float;
using u32x4  = __attribute__((ext_vector_type(4))) unsigned;
#define KSWZ(row, colB) ((row) * 256 + ((colB) ^ (((row) & 15) << 4)))
#define SBAR() __builtin_amdgcn_sched_barrier(0)
__device__ __forceinline__ int crow(int r, int hi) { return (r & 3) + 8 * (r >> 2) + 4 * hi; }
__device__ __forceinline__ unsigned cvtpk(float lo, float hi) { return pg8::cvt_pk_bf16(lo, hi); }
template <typename TIn> struct Stage;
template <> struct Stage<bf16>  { using T = bf16x8;
  __device__ static __forceinline__ T ld8(const bf16* p) { return *reinterpret_cast<const bf16x8*>(p); }
  __device__ static __forceinline__ bf16x8 tobf(T x) { return x; } };
template <> struct Stage<float> { using T = f32x8;
  __device__ static __forceinline__ T ld8(const float* p) { return *reinterpret_cast<const f32x8*>(p); }
  __device__ static __forceinline__ bf16x8 tobf(T x) {
    u32x4 w = {cvtpk(x[0], x[1]), cvtpk(x[2], x[3]), cvtpk(x[4], x[5]), cvtpk(x[6], x[7])}; return *reinterpret_cast<bf16x8*>(&w); } };

__device__ __forceinline__ void partialSM(f32x16& p0, f32x16& p1, float& m_reg, float& mn, float& alpha) {
  constexpr float C = SCALE * 1.4426950408889634f;
  float pmax = p0[0]; for (int r = 1; r < 16; ++r) pmax = fmaxf(pmax, p0[r]); for (int r = 0; r < 16; ++r) pmax = fmaxf(pmax, p1[r]);
  { auto rr = __builtin_amdgcn_permlane32_swap(__float_as_uint(pmax), __float_as_uint(pmax), false, false);
    pmax = fmaxf(__uint_as_float(rr[0]), __uint_as_float(rr[1])); }
  if (__builtin_expect(__all(pmax - m_reg <= THR / SCALE), 1)) { mn = m_reg; alpha = 1.f; }
  else { mn = fmaxf(m_reg, pmax); alpha = __builtin_amdgcn_exp2f((m_reg - mn) * C); m_reg = mn; }
  float mnC = -mn * C;
  for (int r = 0; r < 16; ++r) p0[r] = fmaf(p0[r], C, mnC); for (int r = 0; r < 16; ++r) p1[r] = fmaf(p1[r], C, mnC);
  for (int r = 0; r < 16; ++r) p0[r] = __builtin_amdgcn_exp2f(p0[r]);
}
__device__ __forceinline__ void finishSM(f32x16& p0, f32x16& p1, float alpha, float& l_reg, bf16x8& pa0, bf16x8& pa1, bf16x8& pa2, bf16x8& pa3) {
  for (int r = 0; r < 16; ++r) p1[r] = __builtin_amdgcn_exp2f(p1[r]);
  float ps = 0; for (int r = 0; r < 16; ++r) ps += p0[r]; for (int r = 0; r < 16; ++r) ps += p1[r];
  { auto rr = __builtin_amdgcn_permlane32_swap(__float_as_uint(ps), __float_as_uint(ps), false, false);
    ps = __uint_as_float(rr[0]) + __uint_as_float(rr[1]); }
  l_reg = l_reg * alpha + ps;
#define PK4(P, BASE, OUT) do { unsigned a0 = cvtpk(P[BASE + 0], P[BASE + 1]), a1 = cvtpk(P[BASE + 2], P[BASE + 3]);   \
    unsigned b0 = cvtpk(P[BASE + 4], P[BASE + 5]), b1 = cvtpk(P[BASE + 6], P[BASE + 7]);                              \
    auto r0 = __builtin_amdgcn_permlane32_swap(a0, b0, false, false); auto r1 = __builtin_amdgcn_permlane32_swap(a1, b1, false, false); \
    u32x4 w = {r0[0], r1[0], r0[1], r1[1]}; OUT = *reinterpret_cast<bf16x8*>(&w); } while (0)
  PK4(p0, 0, pa0); PK4(p0, 8, pa1); PK4(p1, 0, pa2); PK4(p1, 8, pa3);
#undef PK4
}
__device__ __forceinline__ void partialSM2(f32x16& p0, f32x16& p1, const float negBC) {
  constexpr float C = SCALE * 1.4426950408889634f;
  for (int r = 0; r < 16; ++r) p0[r] = fmaf(p0[r], C, negBC); for (int r = 0; r < 16; ++r) p1[r] = fmaf(p1[r], C, negBC);
  for (int r = 0; r < 16; ++r) p0[r] = __builtin_amdgcn_exp2f(p0[r]);
}
__device__ __forceinline__ void finishSM2(f32x16& p0, f32x16& p1, float& l_reg, bf16x8& pa0, bf16x8& pa1, bf16x8& pa2, bf16x8& pa3) {
  for (int r = 0; r < 16; ++r) p1[r] = __builtin_amdgcn_exp2f(p1[r]);
  float ps = 0; for (int r = 0; r < 16; ++r) ps += p0[r]; for (int r = 0; r < 16; ++r) ps += p1[r];
  l_reg += ps;
#define PK4(P, BASE, OUT) do { unsigned a0 = cvtpk(P[BASE + 0], P[BASE + 1]), a1 = cvtpk(P[BASE + 2], P[BASE + 3]);   \
    unsigned b0 = cvtpk(P[BASE + 4], P[BASE + 5]), b1 = cvtpk(P[BASE + 6], P[BASE + 7]);                              \
    auto r0 = __builtin_amdgcn_permlane32_swap(a0, b0, false, false); auto r1 = __builtin_amdgcn_permlane32_swap(a1, b1, false, false); \
    u32x4 w = {r0[0], r1[0], r0[1], r1[1]}; OUT = *reinterpret_cast<bf16x8*>(&w); } while (0)
  PK4(p0, 0, pa0); PK4(p0, 8, pa1); PK4(p1, 0, pa2); PK4(p1, 8, pa3);
#undef PK4
}
__device__ __forceinline__ void qkt(f32x16& p0, f32x16& p1, const bf16* Ks, const bf16x8* qr, int r32, int hi) {
  p0 = f32x16{}; p1 = f32x16{};
  for (int d0 = 0; d0 < 8; ++d0) { int cb = (d0 * 16 + hi * 8) * 2;
    bf16x8 b0 = *reinterpret_cast<const bf16x8*>((const char*)Ks + KSWZ(r32, cb));
    bf16x8 b1 = *reinterpret_cast<const bf16x8*>((const char*)Ks + KSWZ(32 + r32, cb));
    p0 = __builtin_amdgcn_mfma_f32_32x32x16_bf16(b0, qr[d0], p0, 0, 0, 0);
    p1 = __builtin_amdgcn_mfma_f32_32x32x16_bf16(b1, qr[d0], p1, 0, 0, 0); }
}
__device__ __forceinline__ void partialSM3(f32x16& p0) { for (int r = 0; r < 16; ++r) p0[r] = __builtin_amdgcn_exp2f(p0[r]); }
__device__ __forceinline__ void qkt3(f32x16& p0, f32x16& p1, const bf16* Ks, const bf16x8* qr, int r32, int hi, const f32x16& cinit) {
  { int cb = (hi * 8) * 2;
    bf16x8 b0 = *reinterpret_cast<const bf16x8*>((const char*)Ks + KSWZ(r32, cb));
    bf16x8 b1 = *reinterpret_cast<const bf16x8*>((const char*)Ks + KSWZ(32 + r32, cb));
    p0 = __builtin_amdgcn_mfma_f32_32x32x16_bf16(b0, qr[0], cinit, 0, 0, 0);
    p1 = __builtin_amdgcn_mfma_f32_32x32x16_bf16(b1, qr[0], cinit, 0, 0, 0); }
  for (int d0 = 1; d0 < 8; ++d0) { int cb = (d0 * 16 + hi * 8) * 2;
    bf16x8 b0 = *reinterpret_cast<const bf16x8*>((const char*)Ks + KSWZ(r32, cb));
    bf16x8 b1 = *reinterpret_cast<const bf16x8*>((const char*)Ks + KSWZ(32 + r32, cb));
    p0 = __builtin_amdgcn_mfma_f32_32x32x16_bf16(b0, qr[d0], p0, 0, 0, 0);
    p1 = __builtin_amdgcn_mfma_f32_32x32x16_bf16(b1, qr[d0], p1, 0, 0, 0); }
}
__device__ __forceinline__ int v_st(int k, int c) { const int kk = (k & ~0xC) | ((k & 4) << 1) | ((k & 8) >> 1); return ((kk >> 3) * 4 + (c >> 5)) * 512 + ((kk & 7) * 32 + (c & 31)) * 2; }
__device__ __forceinline__ int v_rd_base(int lane) { return ((lane & 3) << 3) | (((lane >> 2) & 3) << 6) | (((lane >> 4) & 1) << 5) | (((lane >> 5) & 1) << 8); }
constexpr int v_rd_off(int d0, int ks, int half) { return d0 * 512 + ks * 4096 + half * 2048; }
template <int OFF> __device__ __forceinline__ s16x4 tr_read(int vb) {
  s16x4 r; asm volatile("ds_read_b64_tr_b16 %0, %1 offset:%2" : "=&v"(r) : "v"(vb), "i"(OFF) : "memory"); return r;
}
template <int D0> __device__ __forceinline__ void pv_one(f32x16& od, int vb, bf16x8 pa0, bf16x8 pa1, bf16x8 pa2, bf16x8 pa3) {
  const s16x4 l0 = tr_read<v_rd_off(D0, 0, 0)>(vb), h0 = tr_read<v_rd_off(D0, 0, 1)>(vb), l1 = tr_read<v_rd_off(D0, 1, 0)>(vb), h1 = tr_read<v_rd_off(D0, 1, 1)>(vb);
  const s16x4 l2 = tr_read<v_rd_off(D0, 2, 0)>(vb), h2 = tr_read<v_rd_off(D0, 2, 1)>(vb), l3 = tr_read<v_rd_off(D0, 3, 0)>(vb), h3 = tr_read<v_rd_off(D0, 3, 1)>(vb);
  asm volatile("s_waitcnt lgkmcnt(0)" ::: "memory"); SBAR();
#define PK(L, H) (bf16x8){L[0], L[1], L[2], L[3], H[0], H[1], H[2], H[3]}
  od = __builtin_amdgcn_mfma_f32_32x32x16_bf16(pa0, PK(l0, h0), od, 0, 0, 0);
  od = __builtin_amdgcn_mfma_f32_32x32x16_bf16(pa1, PK(l1, h1), od, 0, 0, 0);
  od = __builtin_amdgcn_mfma_f32_32x32x16_bf16(pa2, PK(l2, h2), od, 0, 0, 0);
  od = __builtin_amdgcn_mfma_f32_32x32x16_bf16(pa3, PK(l3, h3), od, 0, 0, 0);
#undef PK
}
__device__ __forceinline__ void pv_d0(f32x16* o, int vb, bf16x8 pa0, bf16x8 pa1, bf16x8 pa2, bf16x8 pa3) {
  pv_one<0>(o[0], vb, pa0, pa1, pa2, pa3); pv_one<1>(o[1], vb, pa0, pa1, pa2, pa3); pv_one<2>(o[2], vb, pa0, pa1, pa2, pa3); pv_one<3>(o[3], vb, pa0, pa1, pa2, pa3);
}
__device__ __forceinline__ void attn_dense_body(const bf16* Qb, const bf16* __restrict__ Kh, const bf16* __restrict__ Vh, const bf16* __restrict__ Zb,
                                                bf16* Ob, int seq, char* lds, const int wid_in, const float kmax) {
  using St = Stage<bf16>; using SQ = Stage<bf16>; using TQ = bf16;
  int lane = __builtin_amdgcn_mbcnt_hi(~0u, __builtin_amdgcn_mbcnt_lo(~0u, 0u)); asm volatile("" : "+v"(lane));
  const int wid = wid_in, tid = wid * 64 + lane, r32 = lane & 31, hi = lane >> 5;
  bf16* V_lds = (bf16*)lds; bf16* K_lds = (bf16*)(lds + 2 * SHM_V);
  float* ws = (float*)(lds + 2 * SHM_V + 2 * SHM_K) + wid * 64; float* li_l = ws; float* al_l = ws + 32;
  float l_reg = 0; f32x16 o[4] = {}; bf16x8 qr[8];
  const TQ* Qw = Qb + (long)(wid * QBLK + r32) * LDQ + hi * 8;
#pragma unroll
  for (int d0 = 0; d0 < 8; ++d0) qr[d0] = SQ::tobf(SQ::ld8(Qw + d0 * 16));
  float negBC;
  { float ss = 0.f;
#pragma unroll
    for (int d0 = 0; d0 < 8; ++d0)
#pragma unroll
      for (int e = 0; e < 8; ++e) { const float qv = __uint_as_float((unsigned)(unsigned short)qr[d0][e] << 16); ss = fmaf(qv, qv, ss); }
    auto rr = __builtin_amdgcn_permlane32_swap(__float_as_uint(ss), __float_as_uint(ss), false, false);
    ss = __uint_as_float(rr[0]) + __uint_as_float(rr[1]);
    negBC = -(sqrtf(ss) * kmax * (11.313708498984761f * 1.01f) + 0.07f); }
  f32x16 cinit; for (int r = 0; r < 16; ++r) cinit[r] = negBC;
  const int sr = tid >> 4, sc = (tid & 15) * 8, vst0 = v_st(sr, sc), vst1 = v_st(32 + sr, sc);
  const int vb0 = (int)(uintptr_t)V_lds + v_rd_base(lane);
  struct { typename St::T vs0, vs1, ks0, ks1; } sr_[SDEPTH];
#define SLOAD(i, k0) do { sr_[i].vs0 = St::ld8(&Vh[(long)((k0) + sr) * LDK + sc]); sr_[i].vs1 = St::ld8(&Vh[(long)((k0) + 32 + sr) * LDK + sc]); \
    sr_[i].ks0 = St::ld8(&Kh[(long)((k0) + sr) * LDK + sc]); sr_[i].ks1 = St::ld8(&Kh[(long)((k0) + 32 + sr) * LDK + sc]); } while (0)
#define SWRITE(b, i) do { *(bf16x8*)((char*)V_lds + (b) * SHM_V + vst0) = St::tobf(sr_[i].vs0);          \
    *(bf16x8*)((char*)V_lds + (b) * SHM_V + vst1) = St::tobf(sr_[i].vs1); int kc = sc * 2;               \
    *(bf16x8*)((char*)K_lds + (b) * SHM_K + KSWZ(sr, kc)) = St::tobf(sr_[i].ks0);                       \
    *(bf16x8*)((char*)K_lds + (b) * SHM_K + KSWZ(32 + sr, kc)) = St::tobf(sr_[i].ks1); } while (0)
#define SWAIT() do { if constexpr (SDEPTH == 2) asm volatile("s_waitcnt vmcnt(4)" ::: "memory"); else asm volatile("s_waitcnt vmcnt(0)" ::: "memory"); } while (0)
#define RESC(a) do { if (__any((a) < 1.f)) { if (hi == 0) al_l[r32] = (a); asm volatile("s_waitcnt lgkmcnt(0)" ::: "memory"); \
    for (int d = 0; d < 4; ++d) for (int r = 0; r < 16; ++r) o[d][r] *= al_l[crow(r, hi)]; } } while (0)
  f32x16 pA0, pA1, pB0, pB1; bf16x8 pa0, pa1, pa2, pa3; const int NT = seq / KVBLK;
  constexpr int SE = 0, SO = SDEPTH - 1;
  SLOAD(SE, 0); asm volatile("s_waitcnt vmcnt(0)" ::: "memory"); SWRITE(0, SE); __syncthreads();
  qkt3(pA0, pA1, K_lds, qr, r32, hi, cinit); partialSM3(pA0);
  SLOAD(SO, KVBLK); if constexpr (SDEPTH == 2) { if (2 < NT) SLOAD(SE, 2 * KVBLK); }
  SWAIT(); SWRITE(1, SO); __syncthreads();
  for (int j = 1; j + 1 < NT; j += 2) {
    SBAR(); qkt3(pB0, pB1, (bf16*)((char*)K_lds + SHM_K), qr, r32, hi, cinit);
    finishSM2(pA0, pA1, l_reg, pa0, pa1, pa2, pa3); SBAR();
    SLOAD(SO, (j + SDEPTH) * KVBLK); SBAR();
    pv_d0(o, vb0, pa0, pa1, pa2, pa3); partialSM3(pB0);
    __syncthreads(); SWAIT(); SWRITE(0, SE);
    __syncthreads();
    SBAR(); qkt3(pA0, pA1, K_lds, qr, r32, hi, cinit);
    finishSM2(pB0, pB1, l_reg, pa0, pa1, pa2, pa3); SBAR();
    if (SDEPTH == 1 || j + 3 < NT) SLOAD(SE, (j + 1 + SDEPTH) * KVBLK); SBAR();
    pv_d0(o, vb0 + (int)SHM_V, pa0, pa1, pa2, pa3); partialSM3(pA0);
    __syncthreads(); SWAIT(); SWRITE(1, SO);
    __syncthreads();
  }
  SBAR(); qkt3(pB0, pB1, (bf16*)((char*)K_lds + SHM_K), qr, r32, hi, cinit);
  finishSM2(pA0, pA1, l_reg, pa0, pa1, pa2, pa3); SBAR();
  pv_d0(o, vb0, pa0, pa1, pa2, pa3); partialSM3(pB0);
  __syncthreads();
  finishSM2(pB0, pB1, l_reg, pa0, pa1, pa2, pa3); SBAR();
  pv_d0(o, vb0 + (int)SHM_V, pa0, pa1, pa2, pa3);
  { auto rr = __builtin_amdgcn_permlane32_swap(__float_as_uint(l_reg), __float_as_uint(l_reg), false, false); l_reg = __uint_as_float(rr[0]) + __uint_as_float(rr[1]); }
  if (hi == 0) li_l[r32] = l_reg; asm volatile("s_waitcnt lgkmcnt(0)" ::: "memory");
  float rli[16];
#pragma unroll
  for (int r = 0; r < 16; ++r) rli[r] = __builtin_amdgcn_rcpf(li_l[crow(r, hi)]);
  { int lb = (4 * hi) * LDO + r32; asm volatile("" : "+v"(lb));
    unsigned short* Ow = (unsigned short*)Ob + (long)(wid * QBLK) * LDO + lb; const unsigned short* Zw = (const unsigned short*)Zb + (long)(wid * QBLK) * LDO + lb;
#pragma unroll
    for (int r = 0; r < 16; ++r) { const int ro = ((r & 3) + 8 * (r >> 2)) * LDO;
#pragma unroll
      for (int d0 = 0; d0 < 4; ++d0) { const float z = __uint_as_float((unsigned)Zw[ro + d0 * 32] << 16);
        Ow[ro + d0 * 32] = (unsigned short)(cvtpk(o[d0][r] * rli[r] * z, 0.f) & 0xffffu); }
      asm volatile("" ::: "memory"); } }
#undef SLOAD
#undef SWRITE
#undef SWAIT
#undef RESC
}
}

typedef unsigned short bf16_t;
typedef float f32x4 __attribute__((ext_vector_type(4)));
typedef unsigned u32x4 __attribute__((ext_vector_type(4)));
typedef unsigned u32x2v __attribute__((ext_vector_type(2)));
typedef short bf16x8v __attribute__((ext_vector_type(8)));
typedef float f32x16v __attribute__((ext_vector_type(16)));
#define LAS __attribute__((address_space(3)))
#define XB_TMO      128
#define XB_XCNT(j)  (256  + 64 * (j))
#define XB_XSUB(j)  (1280 + 64 * (j))
#define XB_XGEN(j)  (2304 + 64 * (j))
#define XB_TOP      3328
#define XB_TOPGEN   3392
#define XCD_BAR_WORDS 3456
#define XB_SPIN_CAP (1u << 18)

__device__ __forceinline__ unsigned xb_ld(unsigned* p)              { return __hip_atomic_load(p, __ATOMIC_RELAXED, __HIP_MEMORY_SCOPE_AGENT); }
__device__ __forceinline__ unsigned xb_add(unsigned* p, unsigned v) { return __hip_atomic_fetch_add(p, v, __ATOMIC_RELAXED, __HIP_MEMORY_SCOPE_AGENT); }
__device__ __forceinline__ unsigned xb_xcc_id() { return (unsigned)__builtin_amdgcn_s_getreg((3 << 11) | 20) & 0xFu; }
#define XB_SPIN(cond, bar) do { unsigned _sp = 0; while (cond) { __builtin_amdgcn_s_sleep(1); \
    if ((++_sp & 255u) == 0u) { if (xb_ld(&(bar)[XB_TMO])) break; if (_sp > XB_SPIN_CAP) { atomicAdd(&(bar)[XB_TMO], 1u); break; } } } } while (0)

struct XcdBarrier {
    unsigned* bar; unsigned x;
    volatile LAS unsigned* st;
};

__device__ __forceinline__ XcdBarrier xcd_barrier_post(unsigned* bar, volatile LAS unsigned* st, const bool leader) {
    XcdBarrier b; b.bar = bar; b.x = xb_xcc_id(); b.st = st;
    if (leader) (void)xb_add(&bar[XB_XCNT(b.x)], 1u);
    return b;
}
__device__ __forceinline__ void xcd_barrier_complete(unsigned* bar, unsigned x, unsigned& nloc, unsigned& nx) {
    const unsigned G = gridDim.x * gridDim.y * gridDim.z;
    unsigned sum, cnt, mine, sp = 0u;
    for (;;) {
        sum = 0u; cnt = 0u; mine = 0u;
#pragma unroll
        for (unsigned j = 0; j < 16; ++j) { const unsigned c = xb_ld(&bar[XB_XCNT(j)]); sum += c; cnt += (c > 0u) ? 1u : 0u; mine = (j == x) ? c : mine; }
        if (sum == G) break;
        __builtin_amdgcn_s_sleep(1);
        if ((++sp & 255u) == 0u) { if (xb_ld(&bar[XB_TMO])) break; if (sp > XB_SPIN_CAP) { atomicAdd(&bar[XB_TMO], 1u); break; } }
    }
    nloc = mine > 0u ? mine : 1u; nx = cnt > 0u ? cnt : 1u;
}

__device__ __forceinline__ void xcd_barrier(const XcdBarrier& b, const bool leader) {
    asm volatile("s_waitcnt vmcnt(0)" ::: "memory");
    __syncthreads();
    if (leader) {
        unsigned* bar = b.bar;
        __builtin_amdgcn_s_waitcnt(0);
        unsigned nloc = b.st[0], nx = b.st[1];
        if (nloc == 0u) { xcd_barrier_complete(bar, b.x, nloc, nx); b.st[0] = nloc; b.st[1] = nx; }
        const unsigned old = xb_add(&bar[XB_XSUB(b.x)], 1u);
        const unsigned gen = old / nloc;
        if (old + 1u == (gen + 1u) * nloc) {
            __builtin_amdgcn_fence(__ATOMIC_RELEASE, "agent");
            asm volatile("s_waitcnt vmcnt(0)" ::: "memory");
            const unsigned og = xb_add(&bar[XB_TOP], 1u);
            const unsigned tg = og / nx;
            if (og + 1u == (tg + 1u) * nx) xb_add(&bar[XB_TOPGEN], 1u);
            else XB_SPIN(xb_ld(&bar[XB_TOPGEN]) == tg, bar);
            __builtin_amdgcn_fence(__ATOMIC_ACQUIRE, "agent");
            xb_add(&bar[XB_XGEN(b.x)], 1u);
            asm volatile("s_waitcnt vmcnt(0)" ::: "memory");
        } else {
            XB_SPIN(xb_ld(&bar[XB_XGEN(b.x)]) == gen, bar);
            __builtin_amdgcn_fence(__ATOMIC_ACQUIRE, "agent");
            asm volatile("s_waitcnt vmcnt(0)" ::: "memory");
        }
    }
    __syncthreads();
}

constexpr int RING_BYTES = pg8::STAGE_BYTES;
constexpr int PART_OFF = RING_BYTES;
constexpr int XBST_OFF = RING_BYTES + 8192;
constexpr int LDS_BYTES = RING_BYTES + 8192 + 16;

__device__ __forceinline__ unsigned pk2(float a, float b) { return pg8::cvt_pk_bf16(a, b); }
__device__ __forceinline__ float wave_sum(float v) {
#pragma unroll
    for (int o = 1; o < 64; o <<= 1) v += __shfl_xor(v, o);
    return v;
}
__device__ __forceinline__ const float* xrow_c(const float* lat, const float* cx, int r) {
    const int b = r / TB, rr = r - b * TB;
    return rr < CTXL ? cx + ((size_t)b * CTXL + rr) * DM : lat + ((size_t)b * SEQ + (rr - CTXL)) * DM;
}
__device__ __forceinline__ int qk_src(int c) { const int h = c & ~127, cp = c & 127;
    return h + ((cp >> 6) & 1) * 64 + ((cp >> 2) & 1) * 32 + ((cp >> 5) & 1) * 16 + ((cp >> 3) & 3) * 4 + (cp & 3); }

__device__ __forceinline__ void transpose_item(const float* W, int K, int N, bf16_t* WT, LAS float* scr, int item, int lane, int nperm) {
    const int nblk = N / 32, kb = item / nblk, nb = item % nblk, k0 = 64 * kb, n0 = 32 * nb;
    const int cdst = n0 + (lane & 31), csrc = cdst < nperm ? qk_src(cdst) : cdst;
#pragma unroll 8
    for (int i = 0; i < 32; ++i) { const int kk = 2 * i + (lane >> 5); scr[kk * 33 + (lane & 31)] = W[(size_t)(k0 + kk) * N + csrc]; }
    asm volatile("s_waitcnt lgkmcnt(0)" ::: "memory");
    const int c = lane & 7;
#pragma unroll
    for (int j = 0; j < 4; ++j) { const int n = (lane >> 3) + 8 * j; const LAS float* s = scr + (8 * c) * 33 + n;
        u32x4 o; o.x = pk2(s[0 * 33], s[1 * 33]); o.y = pk2(s[2 * 33], s[3 * 33]); o.z = pk2(s[4 * 33], s[5 * 33]); o.w = pk2(s[6 * 33], s[7 * 33]);
        *(u32x4*)(WT + (size_t)(n0 + n) * K + k0 + 8 * c) = o; }
    asm volatile("s_waitcnt lgkmcnt(0)" ::: "memory");
}

template <int GI> __device__ __forceinline__ void pool_unit_t(const bf16_t* XB, bf16_t* ZB, const bf16_t* WPt, const float* pscale, int R0, int lane) {
    constexpr int g = GI, a = 1 << GI;
    const int pm = R0 >> 8, b = pm / 65, jt = pm % 65;
    const int lo = b * TB + (jt ? CTXL : 0), hiR = jt ? (b + 1) * TB : b * TB + CTXL;
    const int r32 = lane & 31, hh = lane >> 5, t = R0 + r32;
    const int s0 = max(t - a, lo), s1 = min(t + a - 1, hiR - 1); const float inv = 1.0f / (float)(s1 - s0 + 1);
    f32x16v acc0 = {}, acc1 = {}, acc2 = {}, acc3 = {};
    const bf16_t* xb = XB + g * 128 + hh * 8;
    const bf16_t* wp = WPt + (size_t)(g * 128 + r32) * 128 + hh * 8;
    float wq[2 * a]; int rq[2 * a];
#pragma unroll
    for (int q = 0; q < 2 * a; ++q) { const int rr = t - a + q; const bool ok = (rr >= lo) && (rr < hiR); wq[q] = ok ? inv : 0.f; rq[q] = ok ? rr : t; }
#pragma unroll 1
    for (int kk = 0; kk < 8; ++kk) {
        u32x4 wv[2 * a];
#pragma unroll
        for (int q = 0; q < 2 * a; ++q) wv[q] = *(const u32x4*)(xb + (size_t)rq[q] * 512 + kk * 16);
        const u32x4 w = *(const u32x4*)(xb + (size_t)t * 512 + kk * 16);
        const bf16x8v w0 = *(const bf16x8v*)(wp + kk * 16), w1 = *(const bf16x8v*)(wp + 32 * 128 + kk * 16), w2 = *(const bf16x8v*)(wp + 64 * 128 + kk * 16), w3 = *(const bf16x8v*)(wp + 96 * 128 + kk * 16);
        float s[8] = {0.f, 0.f, 0.f, 0.f, 0.f, 0.f, 0.f, 0.f};
#pragma unroll
        for (int q = 0; q < 2 * a; ++q) { const float f = wq[q]; const u32x4 v = wv[q];
            s[0] += f * pg8::bf_lo(v.x); s[1] += f * pg8::bf_hi(v.x); s[2] += f * pg8::bf_lo(v.y); s[3] += f * pg8::bf_hi(v.y); s[4] += f * pg8::bf_lo(v.z); s[5] += f * pg8::bf_hi(v.z); s[6] += f * pg8::bf_lo(v.w); s[7] += f * pg8::bf_hi(v.w); }
        u32x4 mf; mf.x = pk2(s[0] - pg8::bf_lo(w.x), s[1] - pg8::bf_hi(w.x)); mf.y = pk2(s[2] - pg8::bf_lo(w.y), s[3] - pg8::bf_hi(w.y));
        mf.z = pk2(s[4] - pg8::bf_lo(w.z), s[5] - pg8::bf_hi(w.z)); mf.w = pk2(s[6] - pg8::bf_lo(w.w), s[7] - pg8::bf_hi(w.w));
        const bf16x8v mfrag = *reinterpret_cast<bf16x8v*>(&mf);
        acc0 = __builtin_amdgcn_mfma_f32_32x32x16_bf16(w0, mfrag, acc0, 0, 0, 0); acc1 = __builtin_amdgcn_mfma_f32_32x32x16_bf16(w1, mfrag, acc1, 0, 0, 0);
        acc2 = __builtin_amdgcn_mfma_f32_32x32x16_bf16(w2, mfrag, acc2, 0, 0, 0); acc3 = __builtin_amdgcn_mfma_f32_32x32x16_bf16(w3, mfrag, acc3, 0, 0, 0);
    }
    bf16_t* zrow = ZB + (size_t)t * 512 + g * 128; const float* ps = pscale + g * 128;
#define POOL_OUT(ACC, NS) do { _Pragma("unroll") for (int q = 0; q < 4; ++q) { const int n0 = (NS) * 32 + 8 * q + 4 * hh; const u32x2v z = *(const u32x2v*)(zrow + n0); const f32x4 p4 = *(const f32x4*)(ps + n0); \
        u32x2v o; o.x = pk2(ACC[4 * q + 0] * p4[0] * pg8::bf_lo(z.x), ACC[4 * q + 1] * p4[1] * pg8::bf_hi(z.x)); o.y = pk2(ACC[4 * q + 2] * p4[2] * pg8::bf_lo(z.y), ACC[4 * q + 3] * p4[3] * pg8::bf_hi(z.y)); \
        *(u32x2v*)(zrow + n0) = o; } } while (0)
    POOL_OUT(acc0, 0); POOL_OUT(acc1, 1); POOL_OUT(acc2, 2); POOL_OUT(acc3, 3);
#undef POOL_OUT
}
__device__ __forceinline__ void pool_unit(const bf16_t* XB, bf16_t* ZB, const bf16_t* WPt, const float* pscale, int wu, int lane) {
    const int g = wu & 3, R0 = (wu >> 2) * 32;
    if (g == 0) pool_unit_t<0>(XB, ZB, WPt, pscale, R0, lane); else if (g == 1) pool_unit_t<1>(XB, ZB, WPt, pscale, R0, lane);
    else if (g == 2) pool_unit_t<2>(XB, ZB, WPt, pscale, R0, lane); else pool_unit_t<3>(XB, ZB, WPt, pscale, R0, lane);
}

__device__ __forceinline__ void wtile16_mac(f32x4& acc, const bf16_t* Wp, const bf16_t* Ap, int nsteps) {
#pragma unroll 8
    for (int kk = 0; kk < nsteps; ++kk) { const bf16x8v wf = *(const bf16x8v*)(Wp + kk * 32), af = *(const bf16x8v*)(Ap + kk * 32); acc = __builtin_amdgcn_mfma_f32_16x16x32_bf16(wf, af, acc, 0, 0, 0); }
}
__device__ __forceinline__ void ctx_merge_task(unsigned char* wsl, int l, int task, int lane) {
    const int tr = task >> 6, n0c = (task & 63) * 16, b = tr >> 4, r16 = lane & 15, fq = lane >> 4;
    const size_t token = (size_t)b * TB + (size_t)(tr & 15) * 16 + r16;
    f32x4 aa = {0.f, 0.f, 0.f, 0.f}, ab = {0.f, 0.f, 0.f, 0.f};
    wtile16_mac(aa, (const bf16_t*)(wsl + WS_WA + l * SZ_WA) + (size_t)(n0c + r16) * 1024 + fq * 8, (const bf16_t*)(wsl + WS_Q) + token * 1024 + fq * 8, 32);
    wtile16_mac(ab, (const bf16_t*)(wsl + WS_WB + l * SZ_WB) + (size_t)(n0c + r16) * 512 + fq * 8, (const bf16_t*)(wsl + WS_ZB) + token * 512 + fq * 8, 16);
    const size_t off = token * 1024 + n0c + 4 * fq;
    const u32x2v a = *(const u32x2v*)((const bf16_t*)(wsl + WS_GA) + off), g2 = *(const u32x2v*)((const bf16_t*)(wsl + WS_GB) + off); u32x2v o;
    o.x = pk2(aa[0] * pg8::bf_lo(a.x) + ab[0] * pg8::bf_lo(g2.x), aa[1] * pg8::bf_hi(a.x) + ab[1] * pg8::bf_hi(g2.x));
    o.y = pk2(aa[2] * pg8::bf_lo(a.y) + ab[2] * pg8::bf_lo(g2.y), aa[3] * pg8::bf_hi(a.y) + ab[3] * pg8::bf_hi(g2.y));
    *(u32x2v*)((bf16_t*)(wsl + WS_ZA) + off) = o;
}
__device__ __forceinline__ void ctx_out_task(unsigned char* wsl, int l, int task, int lane, const float* gate) {
    const int tr = task >> 6, n0c = (task & 63) * 16, b = tr >> 4, r16 = lane & 15, fq = lane >> 4;
    const size_t token = (size_t)b * TB + (size_t)(tr & 15) * 16 + r16;
    f32x4 acc = {0.f, 0.f, 0.f, 0.f};
    wtile16_mac(acc, (const bf16_t*)(wsl + WS_WO + l * SZ_WO) + (size_t)(n0c + r16) * 1024 + fq * 8, (const bf16_t*)(wsl + WS_ZA) + token * 1024 + fq * 8, 32);
    const f32x4 gv = *(const f32x4*)(gate + n0c + 4 * fq); u32x2v o;
    o.x = pk2(acc[0] * gv[0], acc[1] * gv[1]); o.y = pk2(acc[2] * gv[2], acc[3] * gv[3]);
    *(u32x2v*)((bf16_t*)(wsl + WS_GA) + token * 1024 + n0c + 4 * fq) = o;
}
#define QUEUE_LOOP(CTRWORD, NTASK, CALL) do { unsigned* qc_ = (unsigned*)(wsl + WS_BAR) + (CTRWORD); \
    for (;;) { unsigned wq_ = 0u; if (lane == 0) wq_ = __hip_atomic_fetch_add(qc_, 1u, __ATOMIC_RELAXED, __HIP_MEMORY_SCOPE_AGENT); \
        const int task = __builtin_amdgcn_readfirstlane((int)wq_); if (task >= (NTASK)) break; CALL; } } while (0)

__device__ __forceinline__ void store_u(const f32x4 (&v)[4], const float* mod, bf16_t* urow, int lane) {
#pragma unroll
    for (int j = 0; j < 4; ++j) { const int c = 4 * lane + 256 * j; const f32x4 sh = *(const f32x4*)(mod + c), sc = *(const f32x4*)(mod + 1024 + c);
        const f32x4 u = v[j] * (sc + 1.0f) + sh; u32x2v o; o.x = pk2(u[0], u[1]); o.y = pk2(u[2], u[3]); *(u32x2v*)(urow + c) = o; }
}

__global__ void __launch_bounds__(NTHREADS, 2) mega(Params P) {
    extern __shared__ __attribute__((aligned(16))) unsigned char lds[];
    cg::grid_group grid = cg::this_grid();
    const int wave = __builtin_amdgcn_readfirstlane(threadIdx.x >> 6);
#define LANE_ID() (__builtin_amdgcn_mbcnt_hi(~0u, __builtin_amdgcn_mbcnt_lo(~0u, 0u)))
    const int G = gridDim.x, bid = blockIdx.x, gw = bid * NWAVES + wave, NGW = G * NWAVES;
#define GRID_SYNC() xcd_barrier(xbar, wave == 0 && LANE_ID() == 0)
#define CAS __attribute__((address_space(4)))
#define WSL() const CAS Params* pp = (const CAS Params*)__builtin_amdgcn_kernarg_segment_ptr(); asm volatile("" : "+s"(pp)); unsigned char* wsl = pp->ws; asm volatile("" : "+s"(wsl))
#define U ((bf16_t*)(wsl + WS_U))
#define Q ((bf16_t*)(wsl + WS_Q))
#define Kb ((bf16_t*)(wsl + WS_K))
#define Vb ((bf16_t*)(wsl + WS_V))
#define ZA ((bf16_t*)(wsl + WS_ZA))
#define XB ((bf16_t*)(wsl + WS_XB))
#define ZB ((bf16_t*)(wsl + WS_ZB))
#define MOD ((float*)(wsl + WS_MOD))
#define CX ((float*)(wsl + WS_CX))
#define DELTA ((const bf16_t*)(wsl + WS_GA))
    LAS unsigned char* l3 = (LAS unsigned char*)lds;
    const CAS Params* pp0 = (const CAS Params*)__builtin_amdgcn_kernarg_segment_ptr();
    { volatile LAS unsigned* st = (volatile LAS unsigned*)(l3 + XBST_OFF); if (wave == 0 && LANE_ID() == 0) { st[0] = 0u; st[1] = 0u; st[2] = 0u; st[3] = 0u; } }
    __syncthreads();
    XcdBarrier xbar = xcd_barrier_post((unsigned*)(pp0->ws + WS_BAR), (volatile LAS unsigned*)(l3 + XBST_OFF), wave == 0 && LANE_ID() == 0);
    grid.sync();

    constexpr int NPH = 2 + 5 * DEPTH;
#pragma unroll 1
    for (int ph = 0; ph < NPH; ++ph) {
    const int l = ph < 2 ? 0 : (ph - 2) / 5, sph = ph < 2 ? ph : 2 + (ph - 2) % 5;
    if (sph == 0) {
        WSL(); int lane = LANE_ID(); asm volatile("" : "+v"(lane)); const int tid = wave * 64 + lane; unsigned char* ws = wsl; float* cosT = (float*)(wsl + WS_ROPE); float* sinT = cosT + 256 * 32;
        LAS float* scr = (LAS float*)(l3 + wave * 16384);
        constexpr int I_IN = (DM / 64) * (NIN / 32), I_A = (DM / 64) * (DM / 32), I_B = (512 / 64) * (DM / 32), I_O = I_A, I_P = (128 / 64) * (128 / 32);
        constexpr int PER_L = I_IN + I_A + I_B + I_O + 4 * I_P;
        for (int it = gw; it < DEPTH * PER_L; it += NGW) {
            const int l = it / PER_L; int r = it - l * PER_L;
            if (r < I_IN) { transpose_item(pp->w_in + (size_t)l * DM * NIN, DM, NIN, (bf16_t*)(ws + WS_WIN + l * SZ_WIN), scr, r, lane, 1280); continue; } r -= I_IN;
            if (r < I_A) { transpose_item(pp->w_br_a + (size_t)l * DM * DM, DM, DM, (bf16_t*)(ws + WS_WA + l * SZ_WA), scr, r, lane, 0); continue; } r -= I_A;
            if (r < I_B) { transpose_item(pp->w_br_b + (size_t)l * 512 * DM, 512, DM, (bf16_t*)(ws + WS_WB + l * SZ_WB), scr, r, lane, 0); continue; } r -= I_B;
            if (r < I_O) { transpose_item(pp->w_out + (size_t)l * DM * DM, DM, DM, (bf16_t*)(ws + WS_WO + l * SZ_WO), scr, r, lane, 0); continue; } r -= I_O;
            const int g = r / I_P; r -= g * I_P;
            transpose_item(pp->w_pool + ((size_t)l * 4 + g) * 128 * 128, 128, 128, (bf16_t*)(ws + WS_WP + l * SZ_WP) + (size_t)g * 128 * 128, scr, r, lane, 0);
        }
        for (int i = bid * NTHREADS + tid; i < 256 * 32; i += G * NTHREADS) { const int pos = i >> 5, f = i & 31;
            const float invf = 1.0f / __builtin_amdgcn_exp2f(13.287712379549449f * (float)f * (1.0f / 32.0f)); const float ang = (float)pos * invf;
            double rev = (double)ang * 0.15915494309189535; rev -= floor(rev); const float fr_ = (float)rev;
            cosT[i] = __builtin_amdgcn_cosf(fr_); sinT[i] = __builtin_amdgcn_sinf(fr_); }
        __syncthreads();
        LAS float* sv = (LAS float*)l3;
        LAS float* red = sv + 3 * 1024;
        for (int i = tid; i < 3 * 1024; i += NTHREADS) { const int v = i >> 10, k = i & 1023; const float cv = v < 2 ? pp->c[v * 1024 + k] : pp->c_ctx[k]; sv[i] = cv * pg8::sigm(cv); }
        __syncthreads();
        for (int un = bid; un < DEPTH * 48; un += G) { const int l = un / 48, n = (un % 48) * 64 + lane, ks = wave;
            const float* wm = pp->w_mod + (size_t)l * DM * 3072 + (size_t)(ks * 128) * 3072 + n; float a0 = 0.f, a1 = 0.f, a2 = 0.f;
#pragma unroll 8
            for (int k = 0; k < 128; ++k) { const float w = wm[(size_t)k * 3072]; a0 += sv[ks * 128 + k] * w; a1 += sv[1024 + ks * 128 + k] * w; a2 += sv[2048 + ks * 128 + k] * w; }
            red[(ks * 3 + 0) * 64 + lane] = a0; red[(ks * 3 + 1) * 64 + lane] = a1; red[(ks * 3 + 2) * 64 + lane] = a2;
            __syncthreads();
            if (tid < 192) { const int v = tid >> 6, cl = tid & 63; float s = 0.f;
#pragma unroll
                for (int q = 0; q < 8; ++q) s += red[(q * 3 + v) * 64 + cl];
                const int nn = (un % 48) * 64 + cl; MOD[((size_t)l * 3 + v) * 3072 + nn] = s + pp->b_mod[l * 3072 + nn]; }
            __syncthreads();
        }
    } else if (sph == 1) {
    WSL(); int lane = LANE_ID(); asm volatile("" : "+v"(lane));
    for (int r = gw; r < TROWS; r += NGW) { const float* xr = xrow_c(pp->x, pp->ctx, r); const int b = r / TB, mi = (r - b * TB) < CTXL ? 2 : b;
        f32x4 v[4];
#pragma unroll
        for (int j = 0; j < 4; ++j) v[j] = *(const f32x4*)(xr + 4 * lane + 256 * j);
        store_u(v, MOD + mi * 3072, U + (size_t)r * DM, lane); }
    } else if (sph == 2) {
        {
            WSL(); pg8::Gemm g{U, (const bf16_t*)(wsl + WS_WIN + l * SZ_WIN), TROWS, NIN, DM}; pg8::StaticOrder S; S.init(TROWS, NIN, G, bid);
            pg8::EpiIn E{wsl, pp->q_norm + l * 128, pp->k_norm + l * 128, (LAS float*)(l3 + PART_OFF)};
            pg8::gemm_phase<pg8::EpiIn, pg8::StaticOrder, true, true>(l3, g, S, E, wave);
        }
    } else if (sph == 3) {
        {
            WSL(); int lane = LANE_ID(); asm volatile("" : "+v"(lane)); const bf16_t* WPt = (const bf16_t*)(wsl + WS_WP + l * SZ_WP);
            const int nunits = 1024 + (l < DEPTH - 1 ? 16 : 0);
            float kmax; { const float* kn = pp->k_norm + l * 128; kmax = fmaxf(fabsf(kn[lane]), fabsf(kn[lane + 64]));
#pragma unroll
                for (int o_ = 1; o_ < 64; o_ <<= 1) kmax = fmaxf(kmax, __shfl_xor(kmax, o_)); }
            for (int un = bid; un < nunits; un += G) {
                __syncthreads();
                int b, h, rowq, seq;
                if (un < 1024) { b = un >> 9; h = (un >> 6) & 7; rowq = b * TB + CTXL + (un & 63) * 256; seq = TB; }
                else { const int c = un - 1024; b = c >> 3; h = c & 7; rowq = b * TB; seq = CTXL; }
                const size_t qoff = (size_t)rowq * DM + h * 128, koff = (size_t)b * TB * 256 + (h >> 2) * 128;
                att::attn_dense_body((const att::bf16*)(Q + qoff), (const att::bf16*)(Kb + koff), (const att::bf16*)(Vb + koff), (const att::bf16*)(ZA + qoff), (att::bf16*)(Q + qoff), seq, (char*)lds, wave, kmax);
            }
            { unsigned* qctr = (unsigned*)(wsl + WS_BAR) + 8 + l; const int npool = (l < DEPTH - 1) ? (TROWS / 32) * 4 : (NBATCH * SEQ / 32) * 4;
              for (;;) { unsigned wq = 0u; if (lane == 0) wq = __hip_atomic_fetch_add(qctr, 1u, __ATOMIC_RELAXED, __HIP_MEMORY_SCOPE_AGENT);
                  const int wi = __builtin_amdgcn_readfirstlane((int)wq); if (wi >= npool) break;
                  int wu = wi; if (l == DEPTH - 1) { const int rc = wi >> 2, rcf = rc + (CTXL / 32) * (1 + rc / (SEQ / 32)); wu = (rcf << 2) | (wi & 3); }
                  pool_unit(XB, ZB, WPt, pp->pool_scale + l * 512, wu, lane); } }
        }
    } else if (sph == 4) {
        {
            WSL(); pg8::Gemm g{Q, (const bf16_t*)(wsl + WS_WA + l * SZ_WA), TROWS, DM, DM};
            pg8::EpiGate<0> E{wsl};
            { pg8::StaticOrder S; S.init(NBATCH * SEQ, DM, G, bid); S.skip = 1; pg8::gemm_phase<pg8::EpiGate<0>, pg8::StaticOrder, true, true>(l3, g, S, E, wave); }
        }
        {
            WSL(); pg8::Gemm g{ZB, (const bf16_t*)(wsl + WS_WB + l * SZ_WB), TROWS, DM, 512};
            pg8::EpiGate<1> E{wsl};
            { pg8::StaticOrder S; S.init(NBATCH * SEQ, DM, G, bid); S.skip = 1; pg8::gemm_phase<pg8::EpiGate<1>, pg8::StaticOrder, true, true>(l3, g, S, E, wave); }
        }
        if (l < DEPTH - 1) { WSL(); int lane = LANE_ID(); asm volatile("" : "+v"(lane)); for (int task = gw; task < 2048; task += NGW) ctx_merge_task(wsl, l, task, lane); }
    } else if (sph == 5) {
        {
            WSL(); pg8::Gemm g{ZA, (const bf16_t*)(wsl + WS_WO + l * SZ_WO), TROWS, DM, DM};
            pg8::EpiRes E{MOD + (size_t)l * 3 * 3072, wsl};
            { pg8::StaticOrder S; S.init(NBATCH * SEQ, DM, G, bid); S.skip = 1; pg8::gemm_phase<pg8::EpiRes, pg8::StaticOrder, true, true>(l3, g, S, E, wave); }
        }
        if (l < DEPTH - 1) { WSL(); int lane = LANE_ID(); asm volatile("" : "+v"(lane)); const float* gate_c = MOD + (size_t)l * 3 * 3072 + 2 * 3072 + 2048; for (int task = gw; task < 2048; task += NGW) ctx_out_task(wsl, l, task, lane, gate_c); }
    } else {
        {
            WSL(); int lane = LANE_ID(); asm volatile("" : "+v"(lane)); const float* modl = MOD + (size_t)l * 3 * 3072; const float* lg = pp->ln_g + l * DM; const float* lb = pp->ln_b + l * DM; const bool last = (l == DEPTH - 1);
            const float* xlat = l == 0 ? pp->x : pp->out; const float* xctx = l == 0 ? pp->ctx : CX;
            auto ln_row = [&](const int r, const f32x4 (&vin)[4]) {
                const int b = r / TB, rr = r - b * TB; const bool isctx = rr < CTXL; f32x4 v[4]; float s = 0.f;
#pragma unroll
                for (int j = 0; j < 4; ++j) { v[j] = vin[j]; s += (v[j][0] + v[j][1]) + (v[j][2] + v[j][3]); }
                const float mean = wave_sum(s) * (1.0f / DM); float s2 = 0.f;
#pragma unroll
                for (int j = 0; j < 4; ++j) { v[j] = v[j] - mean; s2 += (v[j][0] * v[j][0] + v[j][1] * v[j][1]) + (v[j][2] * v[j][2] + v[j][3] * v[j][3]); }
                const float rstd = 1.0f / sqrtf(wave_sum(s2) * (1.0f / DM) + EPSV);
                float* xo = isctx ? CX + ((size_t)b * CTXL + rr) * DM : pp->out + ((size_t)b * SEQ + (rr - CTXL)) * DM;
#pragma unroll
                for (int j = 0; j < 4; ++j) { const int c = 4 * lane + 256 * j; v[j] = v[j] * rstd * *(const f32x4*)(lg + c) + *(const f32x4*)(lb + c); *(f32x4*)(xo + c) = v[j]; }
                if (!last) store_u(v, modl + 3 * 3072 + (isctx ? 2 : b) * 3072, U + (size_t)r * DM, lane);
            };
            const int nrows = last ? NBATCH * SEQ : TROWS;
            for (int i0 = gw; i0 < nrows; i0 += 2 * NGW) {
                const int i1 = i0 + NGW; const bool has1 = i1 < nrows;
                const int r0 = last ? i0 + CTXL * (1 + i0 / SEQ) : i0, r1 = has1 ? (last ? i1 + CTXL * (1 + i1 / SEQ) : i1) : r0;
                f32x4 va[4], vb[4]; const float* xa = xrow_c(xlat, xctx, r0); const float* xb_ = xrow_c(xlat, xctx, r1);
                const bf16_t* da = DELTA + (size_t)r0 * DM; const bf16_t* db = DELTA + (size_t)r1 * DM;
#pragma unroll
                for (int j = 0; j < 4; ++j) { const int c = 4 * lane + 256 * j; const f32x4 x0 = *(const f32x4*)(xa + c), x1 = *(const f32x4*)(xb_ + c);
                    const u32x2v d0 = *(const u32x2v*)(da + c), d1 = *(const u32x2v*)(db + c);
                    va[j] = x0 * ALPHA_RES + (f32x4){pg8::bf_lo(d0.x), pg8::bf_hi(d0.x), pg8::bf_lo(d0.y), pg8::bf_hi(d0.y)};
                    vb[j] = x1 * ALPHA_RES + (f32x4){pg8::bf_lo(d1.x), pg8::bf_hi(d1.x), pg8::bf_lo(d1.y), pg8::bf_hi(d1.y)}; }
                ln_row(r0, va); if (has1) ln_row(r1, vb);
            }
        }
    }
    if (ph + 1 < NPH) GRID_SYNC();
    }
}

extern "C" void kernel_launch(void* const* d_in, const int* in_sizes, int n_in, void* d_out, int out_size, void* d_ws, size_t ws_size, hipStream_t stream) {
    static int grid_blocks = 0;
    if (grid_blocks == 0) {
        if (n_in != 16 || ws_size < WS_END2 || out_size != NBATCH * SEQ * DM) { fprintf(stderr, "kernel_launch: unexpected shapes: n_in %d out %d ws %zu (need %zu)\n", n_in, out_size, ws_size, (size_t)WS_END2); grid_blocks = -1; return; }
        int dev = 0, cus = 0, per_cu = 0;
        hipGetDevice(&dev); hipDeviceGetAttribute(&cus, hipDeviceAttributeMultiprocessorCount, dev);
        if (hipFuncSetAttribute((const void*)mega, hipFuncAttributeMaxDynamicSharedMemorySize, LDS_BYTES) != hipSuccess) { fprintf(stderr, "kernel_launch: hipFuncSetAttribute failed\n"); grid_blocks = -1; return; }
        if (hipOccupancyMaxActiveBlocksPerMultiprocessor(&per_cu, (const void*)mega, NTHREADS, LDS_BYTES) != hipSuccess || per_cu < 1) { fprintf(stderr, "kernel_launch: occupancy query gave %d\n", per_cu); per_cu = 1; }
        (void)hipGetLastError();
        grid_blocks = cus * per_cu;
    }
    if (grid_blocks < 0) return;
    Params p{};
    p.x = (const float*)d_in[0]; p.c = (const float*)d_in[1]; p.ctx = (const float*)d_in[2]; p.c_ctx = (const float*)d_in[3]; p.w_mod = (const float*)d_in[4]; p.b_mod = (const float*)d_in[5];
    p.w_in = (const float*)d_in[6]; p.q_norm = (const float*)d_in[7]; p.k_norm = (const float*)d_in[8]; p.w_pool = (const float*)d_in[9]; p.pool_scale = (const float*)d_in[10];
    p.w_br_a = (const float*)d_in[11]; p.w_br_b = (const float*)d_in[12]; p.w_out = (const float*)d_in[13]; p.ln_g = (const float*)d_in[14]; p.ln_b = (const float*)d_in[15];
    p.out = (float*)d_out; p.ws = (unsigned char*)d_ws;
    void* args[] = {&p};
    if (hipMemsetAsync((char*)d_ws + WS_BAR, 0, XCD_BAR_WORDS * 4, stream) != hipSuccess) { fprintf(stderr, "kernel_launch: memset of the barrier word failed\n"); return; }
    hipError_t e = hipLaunchCooperativeKernel((const void*)mega, dim3(grid_blocks), dim3(NTHREADS), args, LDS_BYTES, stream);
    if (e != hipSuccess) fprintf(stderr, "kernel_launch: cooperative launch failed: %s (grid %d)\n", hipGetErrorString(e), grid_blocks);
}
```

```cpp
#include <hip/hip_runtime.h>
#include <hip/hip_bf16.h>
#include <hip/hip_cooperative_groups.h>
#include <cstdio>
#include <cstdint>
namespace cg = cooperative_groups;

constexpr int DM = 1024, NBATCH = 2, SEQ = 16384, CTXL = 256, DEPTH = 4, HD = 128;
constexpr int TB = SEQ + CTXL;
constexpr int TROWS = NBATCH * TB;
constexpr int NIN = 5632;
constexpr float EPSV = 1e-6f;
constexpr float ALPHA_RES = 1.681792830507429f;
constexpr int NWAVES = 8, NTHREADS = 512;

constexpr size_t SZ_WIN = (size_t)NIN * DM * 2, SZ_WA = (size_t)DM * DM * 2, SZ_WB = (size_t)DM * 512 * 2, SZ_WO = SZ_WA, SZ_WP = (size_t)4 * 128 * 128 * 2;
constexpr size_t WS_WIN = 0;
constexpr size_t WS_WA = WS_WIN + DEPTH * SZ_WIN;
constexpr size_t WS_WB = WS_WA + DEPTH * SZ_WA;
constexpr size_t WS_WO = WS_WB + DEPTH * SZ_WB;
constexpr size_t WS_WP = WS_WO + DEPTH * SZ_WO;
constexpr size_t WS_MOD = WS_WP + DEPTH * SZ_WP;
constexpr size_t WS_ROPE = WS_MOD + (size_t)DEPTH * 3 * 3072 * 4;
constexpr size_t WS_CX = WS_ROPE + 2 * 256 * 32 * 4;
constexpr size_t WS_U = WS_CX + (size_t)512 * DM * 4;
constexpr size_t WS_Q = WS_U + (size_t)TROWS * DM * 2;
constexpr size_t WS_K = WS_Q + (size_t)TROWS * DM * 2;
constexpr size_t WS_V = WS_K + (size_t)TROWS * 256 * 2;
constexpr size_t WS_ZA = WS_V + (size_t)TROWS * 256 * 2;
constexpr size_t WS_XB = WS_ZA + (size_t)TROWS * DM * 2;
constexpr size_t WS_ZB = WS_XB + (size_t)TROWS * 512 * 2;
constexpr size_t WS_GA = WS_ZB + (size_t)TROWS * 512 * 2;
constexpr size_t WS_GB = WS_GA + (size_t)TROWS * DM * 2;
constexpr size_t WS_END = WS_GB + (size_t)TROWS * DM * 2;
constexpr size_t WS_BAR = WS_END, WS_END2 = WS_END + 16384;

struct Params {
    const float *x, *c, *ctx, *c_ctx, *w_mod, *b_mod, *w_in, *q_norm, *k_norm, *w_pool, *pool_scale, *w_br_a, *w_br_b, *w_out, *ln_g, *ln_b;
    float* out; unsigned char* ws;
};

namespace pg8 {
#define PG8_LAS __attribute__((address_space(3)))
typedef unsigned short bf16_t;
typedef short bf16x8 __attribute__((ext_vector_type(8)));
typedef float f32x4 __attribute__((ext_vector_type(4)));
typedef unsigned u32x4 __attribute__((ext_vector_type(4)));
constexpr int BM = 256, BK = 64, HALF = 128, HTB = HALF * BK * 2  , STAGE_BYTES = 8 * HTB, NXCD = 8, WGM = 8;

__host__ __device__ __forceinline__ int lds_byte(int r, int c) { const int st = (r >> 4) * 2 + (c >> 5), rr = r & 15, cc = c & 31, ob = rr * 64 + cc * 2; return st * 1024 + (ob ^ (((ob >> 9) & 1) << 5)); }
__host__ __device__ __forceinline__ void stage_rc(int b, int& R, int& C) { const int st = b / 1024, sb = b % 1024, swz = sb ^ (((sb >> 9) & 1) << 5); R = (st >> 1) * 16 + swz / 64; C = (st & 1) * 32 + (swz % 64) / 2; }
__host__ __device__ __forceinline__ int perm32(int rho) { const int n = rho >> 4, i = rho & 15; return 8 * (i >> 2) + 4 * n + (i & 3); }

struct Unit { int pm, pn; };
struct Gemm { const bf16_t* A; const bf16_t* Bt; int M, N, K; };

struct StaticOrder {
    int nM, nN, nwg, G, c, skip;
    __host__ __device__ void init(int M, int N, int G_, int c_) { nM = M / BM; nN = N / BM; nwg = nM * nN; G = G_; c = c_; skip = 0; }
    __host__ __device__ bool next(int i, Unit& u) const {
        const long L = (long)i * G + c; if (L >= nwg) return false;
        int wgid = (int)L; { const int q = nwg / NXCD, r = nwg % NXCD, xcd = wgid % NXCD, off = wgid / NXCD; wgid = (xcd < r ? xcd * (q + 1) : r * (q + 1) + (xcd - r) * q) + off; }
        const int nig = WGM * nN, gid = wgid / nig, fm = gid * WGM, gsz = (nM - fm) < WGM ? (nM - fm) : WGM;
        u.pm = fm + ((wgid % nig) % gsz); u.pn = (wgid % nig) / gsz; if (skip) u.pm += 1 + (u.pm >= 64 ? 1 : 0); return true;
    }
    __device__ __forceinline__ void a_ready(const Unit&) const {}
    __device__ __forceinline__ void done(const Unit&) const {}
};

typedef __bf16 bf16x2_t __attribute__((ext_vector_type(2)));
typedef float f32x2_t __attribute__((ext_vector_type(2)));
__device__ __forceinline__ unsigned cvt_pk_bf16(float lo, float hi) { const f32x2_t v = {lo, hi}; const bf16x2_t r = __builtin_convertvector(v, bf16x2_t); return __builtin_bit_cast(unsigned, r); }
typedef float f32x2 __attribute__((ext_vector_type(2)));
struct LatentOrder {
    StaticOrder S;
    __host__ __device__ void init(int N, int G_, int c_) { S.init(32768, N, G_, c_); }
    __host__ __device__ bool next(int i, Unit& u) const { if (!S.next(i, u)) return false; u.pm += 1 + (u.pm >= 64 ? 1 : 0); return true; }
    __device__ __forceinline__ void a_ready(const Unit&) const {}
    __device__ __forceinline__ void done(const Unit&) const {}
};
__device__ __forceinline__ float bf_lo(unsigned w) { return __uint_as_float(w << 16); }
__device__ __forceinline__ float bf_hi(unsigned w) { return __uint_as_float(w & 0xffff0000u); }
__device__ __forceinline__ float sigm(float x) { return __builtin_amdgcn_rcpf(1.0f + __builtin_amdgcn_exp2f(-1.4426950408889634f * x)); }
typedef unsigned u32x2 __attribute__((ext_vector_type(2)));
template <int ACT> __device__ __forceinline__ float actf(float x) { if (ACT == 1) return x * sigm(x); if (ACT == 2) return sigm(x); return x; }

struct EpiIn {
    static constexpr bool PERM = true, AFTER_DRAIN = false;
    unsigned char* ws; const float *qg, *kg;
    PG8_LAS float* part;
    template <int ACT> __device__ __forceinline__ void plain(const f32x4 (&acc)[2][2][4][2], bf16_t* base, int ldc, int colt, const Unit& u, int wr, int wc, int fr, int fq) const {
        const int row0 = u.pm * BM + wr * 64 + fr, col0 = colt + wc * 32 + 8 * fq;
#pragma unroll
        for (int ai = 0; ai < 2; ++ai)
#pragma unroll
            for (int m = 0; m < 4; ++m) { bf16_t* rowp = base + (size_t)(row0 + ai * HALF + m * 16) * ldc + col0;
#pragma unroll
                for (int bj = 0; bj < 2; ++bj) { const f32x4 v0 = acc[ai][bj][m][0], v1 = acc[ai][bj][m][1]; u32x4 w;
                    w.x = cvt_pk_bf16(actf<ACT>(v0[0]), actf<ACT>(v0[1])); w.y = cvt_pk_bf16(actf<ACT>(v0[2]), actf<ACT>(v0[3]));
                    w.z = cvt_pk_bf16(actf<ACT>(v1[0]), actf<ACT>(v1[1])); w.w = cvt_pk_bf16(actf<ACT>(v1[2]), actf<ACT>(v1[3]));
                    *(u32x4*)(rowp + bj * HALF) = w; } }
    }
    __device__ __forceinline__ void qk(const f32x4 (&acc)[2][2][4][2], const Unit& u, int wr, int wc, int fr, int fq) const {
        const bool isk = (u.pn == 4);
        const float* g = isk ? kg : qg; bf16_t* dst = (bf16_t*)(ws + (isk ? WS_K : WS_Q)); const int ldc = isk ? 256 : 1024;
        const float* cosT = (const float*)(ws + WS_ROPE); const float* sinT = cosT + 256 * 32;
        const int f0 = (wc & 1) * 16 + 4 * fq, axis = wc >> 1, e1 = axis * 64 + f0;
        const f32x4 g1 = *(const f32x4*)(g + e1), g2 = *(const f32x4*)(g + e1 + 32);
#pragma unroll
        for (int ai = 0; ai < 2; ++ai)
#pragma unroll
            for (int m = 0; m < 4; ++m)
#pragma unroll
                for (int bj = 0; bj < 2; ++bj) { const f32x4 a = acc[ai][bj][m][0], b = acc[ai][bj][m][1];
                    float s = (a[0] * a[0] + a[1] * a[1]) + (a[2] * a[2] + a[3] * a[3]) + (b[0] * b[0] + b[1] * b[1]) + (b[2] * b[2] + b[3] * b[3]);
                    s += __shfl_xor(s, 16); s += __shfl_xor(s, 32);
                    if (fq == 0) part[((ai * HALF + wr * 64 + m * 16 + fr) * 2 + bj) * 4 + wc] = s; }
        asm volatile("s_waitcnt lgkmcnt(0)" ::: "memory"); __builtin_amdgcn_s_barrier(); asm volatile("" ::: "memory");
        const int jt = u.pm % 65; const bool rope = (jt != 0);
#pragma unroll
        for (int ai = 0; ai < 2; ++ai)
#pragma unroll
            for (int m = 0; m < 4; ++m) { const int rloc = ai * HALF + wr * 64 + m * 16 + fr;
                const int pos = rope ? (axis ? (16 * m + fr) : ((jt - 1) * 4 + 2 * ai + wr)) : 0;
                f32x4 c4 = *(const f32x4*)(cosT + pos * 32 + f0), s4 = *(const f32x4*)(sinT + pos * 32 + f0);
                if (!rope) { c4 = (f32x4){1.f, 1.f, 1.f, 1.f}; s4 = (f32x4){0.f, 0.f, 0.f, 0.f}; }
#pragma unroll
                for (int bj = 0; bj < 2; ++bj) { const f32x4 p = *(const PG8_LAS f32x4*)(part + (rloc * 2 + bj) * 4);
                    const float rstd = __builtin_amdgcn_rsqf(((p[0] + p[1]) + (p[2] + p[3])) * (1.0f / 128.0f) + 1e-6f);
                    const f32x4 y1 = acc[ai][bj][m][0] * rstd * g1, y2 = acc[ai][bj][m][1] * rstd * g2;
                    f32x4 o1 = y1 * c4 - y2 * s4, o2 = y1 * s4 + y2 * c4;
                    if (!isk) { o1 = o1 * 0.12751743074602458f; o2 = o2 * 0.12751743074602458f; }
                    const int head = isk ? bj : 2 * u.pn + bj;
                    bf16_t* ptr = dst + (size_t)(u.pm * BM + rloc) * ldc + head * 128 + e1;
                    u32x2 w1, w2; w1.x = cvt_pk_bf16(o1[0], o1[1]); w1.y = cvt_pk_bf16(o1[2], o1[3]); w2.x = cvt_pk_bf16(o2[0], o2[1]); w2.y = cvt_pk_bf16(o2[2], o2[3]);
                    *(u32x2*)ptr = w1; *(u32x2*)(ptr + 32) = w2; } }
    }
    __device__ __forceinline__ void operator()(const f32x4 (&acc)[2][2][4][2], const Unit& u, int wr, int wc, int fr, int fq) const {
        const int pn = u.pn;
        if (pn < 5) { qk(acc, u, wr, wc, fr, fq); return; }
        if (pn == 5) plain<0>(acc, (bf16_t*)(ws + WS_V), 256, 0, u, wr, wc, fr, fq);
        else if (pn < 10) plain<1>(acc, (bf16_t*)(ws + WS_ZA), 1024, (pn - 6) * 256, u, wr, wc, fr, fq);
        else if (pn < 12) plain<0>(acc, (bf16_t*)(ws + WS_XB), 512, (pn - 10) * 256, u, wr, wc, fr, fq);
        else if (pn < 14) plain<1>(acc, (bf16_t*)(ws + WS_ZB), 512, (pn - 12) * 256, u, wr, wc, fr, fq);
        else if (pn < 18) plain<2>(acc, (bf16_t*)(ws + WS_GA), 1024, (pn - 14) * 256, u, wr, wc, fr, fq);
        else plain<2>(acc, (bf16_t*)(ws + WS_GB), 1024, (pn - 18) * 256, u, wr, wc, fr, fq);
    }
};
template <int MODE> struct EpiGate {
    static constexpr bool PERM = true, AFTER_DRAIN = false;
    unsigned char* ws;
    __device__ __forceinline__ void operator()(const f32x4 (&acc)[2][2][4][2], const Unit& u, int wr, int wc, int fr, int fq) const {
        bf16_t* GA = (bf16_t*)(ws + WS_GA); const bf16_t* GB = (const bf16_t*)(ws + WS_GB); bf16_t* Y = (bf16_t*)(ws + WS_ZA);
        const int row0 = u.pm * BM + wr * 64 + fr, col0 = u.pn * BM + wc * 32 + 8 * fq;
#pragma unroll
        for (int ai = 0; ai < 2; ++ai)
#pragma unroll
            for (int m = 0; m < 4; ++m) { const size_t off = (size_t)(row0 + ai * HALF + m * 16) * 1024 + col0;
#pragma unroll
                for (int bj = 0; bj < 2; ++bj) { const f32x4 v0 = acc[ai][bj][m][0], v1 = acc[ai][bj][m][1];
                    const u32x4 ga = *(const u32x4*)(GA + off + bj * HALF); u32x4 w;
                    if (MODE == 0) {
                        w.x = cvt_pk_bf16(v0[0] * bf_lo(ga.x), v0[1] * bf_hi(ga.x)); w.y = cvt_pk_bf16(v0[2] * bf_lo(ga.y), v0[3] * bf_hi(ga.y));
                        w.z = cvt_pk_bf16(v1[0] * bf_lo(ga.z), v1[1] * bf_hi(ga.z)); w.w = cvt_pk_bf16(v1[2] * bf_lo(ga.w), v1[3] * bf_hi(ga.w));
                        *(u32x4*)(GA + off + bj * HALF) = w;
                    } else {
                        const u32x4 gb = *(const u32x4*)(GB + off + bj * HALF);
                        w.x = cvt_pk_bf16(bf_lo(ga.x) + v0[0] * bf_lo(gb.x), bf_hi(ga.x) + v0[1] * bf_hi(gb.x)); w.y = cvt_pk_bf16(bf_lo(ga.y) + v0[2] * bf_lo(gb.y), bf_hi(ga.y) + v0[3] * bf_hi(gb.y));
                        w.z = cvt_pk_bf16(bf_lo(ga.z) + v1[0] * bf_lo(gb.z), bf_hi(ga.z) + v1[1] * bf_hi(gb.z)); w.w = cvt_pk_bf16(bf_lo(ga.w) + v1[2] * bf_lo(gb.w), bf_hi(ga.w) + v1[3] * bf_hi(gb.w));
                        *(u32x4*)(Y + off + bj * HALF) = w;
                    } } }
    }
};
struct EpiRes {
    static constexpr bool PERM = true, AFTER_DRAIN = false;
    const float* mod; unsigned char* ws;
    __device__ __forceinline__ void operator()(const f32x4 (&acc)[2][2][4][2], const Unit& u, int wr, int wc, int fr, int fq) const {
        const int b = u.pm / 65, jt = u.pm % 65; bf16_t* dl = (bf16_t*)(ws + WS_GA);
        const float* gate = mod + (jt ? b : 2) * 3072 + 2048;
        const int row0 = u.pm * BM + wr * 64 + fr, col0 = u.pn * BM + wc * 32 + 8 * fq;
        f32x4 gv[2][2];
#pragma unroll
        for (int bj = 0; bj < 2; ++bj)
#pragma unroll
            for (int n = 0; n < 2; ++n) gv[bj][n] = *(const f32x4*)(gate + col0 + bj * HALF + 4 * n);
#pragma unroll
        for (int ai = 0; ai < 2; ++ai)
#pragma unroll
            for (int m = 0; m < 4; ++m) { bf16_t* rowp = dl + (size_t)(row0 + ai * HALF + m * 16) * 1024 + col0;
#pragma unroll
                for (int bj = 0; bj < 2; ++bj) { const f32x4 v0 = acc[ai][bj][m][0] * gv[bj][0], v1 = acc[ai][bj][m][1] * gv[bj][1]; u32x4 w;
                    w.x = cvt_pk_bf16(v0[0], v0[1]); w.y = cvt_pk_bf16(v0[2], v0[3]); w.z = cvt_pk_bf16(v1[0], v1[1]); w.w = cvt_pk_bf16(v1[2], v1[3]);
                    *(u32x4*)(rowp + bj * HALF) = w; } }
    }
};

template <class Epi, class Sched, bool ALIGN_EPI = false, bool SP2 = false>
__device__ __forceinline__ void gemm_phase(PG8_LAS unsigned char* lds, const Gemm g, const Sched& S, const Epi& E, const int wid_in) {
    int lane = __builtin_amdgcn_mbcnt_hi(~0u, __builtin_amdgcn_mbcnt_lo(~0u, 0u)); asm volatile("" : "+v"(lane));
    const int wid = wid_in, tid = wid * 64 + lane, wr = wid >> 2, wc = wid & 3, fr = lane & 15, fq = lane >> 4;
    const int K = g.K, nt = K / BK;
    unsigned voffA[2], voffB[2];
#pragma unroll
    for (int i = 0; i < 2; ++i) { int R, C; stage_rc(tid * 16 + i * 8192, R, C); const int Rb = Epi::PERM ? ((R & ~31) + perm32(R & 31)) : R;
        voffA[i] = (unsigned)(R * K + C) * 2u; voffB[i] = (unsigned)(Rb * K + C) * 2u; }
    const size_t kstep = (size_t)(BK * 2);
    const size_t hstep = (size_t)HALF * K * 2;
    const size_t tstep = 2 * hstep;
    const unsigned ldsw = (unsigned)wid * 1024u;
    const int aoff = lds_byte(wr * 64 + fr, fq * 8), boff = lds_byte(wc * 32 + fr, fq * 8);
#define PG8_SA(b, h) (((b) * 2 + (h)) * HTB)
#define PG8_SB(b, h) ((4 + (b) * 2 + (h)) * HTB)
#define PG8_STAGE(bufoff, gbase, voff) do { _Pragma("unroll") for (int _i = 0; _i < 2; ++_i) \
        __builtin_amdgcn_global_load_lds((const unsigned*)((const char*)(gbase) + (voff)[_i]), (PG8_LAS unsigned*)(lds + (bufoff) + ldsw + _i * 8192), 16, 0, 0); } while (0)
#define PG8_LDA(dst, b, h) do { _Pragma("unroll") for (int m = 0; m < 4; ++m) _Pragma("unroll") for (int k = 0; k < 2; ++k) dst[m][k] = *(const PG8_LAS bf16x8*)(lds + PG8_SA(b, h) + aoff + m * 2048 + k * 1024); } while (0)
#define PG8_LDB(dst, b, h) do { _Pragma("unroll") for (int n = 0; n < 2; ++n) _Pragma("unroll") for (int k = 0; k < 2; ++k) dst[n][k] = *(const PG8_LAS bf16x8*)(lds + PG8_SB(b, h) + boff + n * 2048 + k * 1024); } while (0)
#define PG8_MMA(ai, bj, At, Bt) do { __builtin_amdgcn_s_setprio(1); _Pragma("unroll") for (int m = 0; m < 4; ++m) _Pragma("unroll") for (int n = 0; n < 2; ++n) _Pragma("unroll") for (int k = 0; k < 2; ++k) \
        acc[ai][bj][m][n] = __builtin_amdgcn_mfma_f32_16x16x32_bf16(Bt[n][k], At[m][k], acc[ai][bj][m][n], 0, 0, 0); __builtin_amdgcn_s_setprio(0); } while (0)
#define PG8_WAIT_V(n) asm volatile("s_waitcnt vmcnt(" #n ")" ::: "memory")
#define PG8_WAIT_L(n) asm volatile("s_waitcnt lgkmcnt(" #n ")" ::: "memory")
#define PG8_BAR __builtin_amdgcn_s_barrier()
#define PG8_SCHED __builtin_amdgcn_sched_barrier(0)
    Unit cur, nxt; int ui = 0;
    if (!S.next(0, cur)) return;
    f32x4 acc[2][2][4][2];
#pragma unroll
    for (int a = 0; a < 2; ++a)
#pragma unroll
        for (int b = 0; b < 2; ++b)
#pragma unroll
            for (int m = 0; m < 4; ++m)
#pragma unroll
                for (int n = 0; n < 2; ++n) acc[a][b][m][n] = (f32x4){0.f, 0.f, 0.f, 0.f};
    bf16x8 At[4][2], B0[2][2], B1[2][2];
    const char* cA = (const char*)g.A + (size_t)cur.pm * tstep; const char* cB = (const char*)g.Bt + (size_t)cur.pn * tstep;
    S.a_ready(cur);
    if constexpr (SP2) {
        PG8_STAGE(PG8_SB(0, 0), cB, voffB); PG8_STAGE(PG8_SB(0, 1), cB + hstep, voffB); PG8_STAGE(PG8_SA(0, 0), cA, voffA); PG8_STAGE(PG8_SA(0, 1), cA + hstep, voffA);
        if (wr == 1) PG8_BAR;
        PG8_WAIT_V(2); PG8_BAR;
        PG8_STAGE(PG8_SB(1, 0), cB + kstep, voffB); PG8_STAGE(PG8_SA(1, 0), cA + kstep, voffA); PG8_STAGE(PG8_SB(1, 1), cB + hstep + kstep, voffB);
        PG8_WAIT_V(6); PG8_BAR;
    } else {
        PG8_STAGE(PG8_SB(0, 0), cB, voffB); PG8_STAGE(PG8_SA(0, 0), cA, voffA); PG8_STAGE(PG8_SB(0, 1), cB + hstep, voffB); PG8_STAGE(PG8_SA(0, 1), cA + hstep, voffA);
        if (wr == 1) PG8_BAR;
        PG8_WAIT_V(4); PG8_BAR;
        PG8_STAGE(PG8_SB(1, 0), cB + kstep, voffB); PG8_STAGE(PG8_SA(1, 0), cA + kstep, voffA); PG8_STAGE(PG8_SB(1, 1), cB + hstep + kstep, voffB);
        PG8_WAIT_V(6); PG8_BAR;
    }
    for (;;) {
        const bool has_next = S.next(ui + 1, nxt);
        const char* nA = has_next ? (const char*)g.A + (size_t)nxt.pm * tstep : cA; const char* nB = has_next ? (const char*)g.Bt + (size_t)nxt.pn * tstep : cB;
        for (int t = 0; t < nt; t += 2) {
            const bool last = (t == nt - 2);
            const char* a1 = cA + (size_t)(t + 1) * kstep;
            const char* a2 = last ? nA : cA + (size_t)(t + 2) * kstep; const char* b2 = last ? nB : cB + (size_t)(t + 2) * kstep;
            const char* a3 = a2 + kstep; const char* b3 = b2 + kstep;
            if (last && has_next) S.a_ready(nxt);
            if constexpr (SP2) {
            PG8_LDB(B0, 0, 0); PG8_LDB(B1, 0, 1); PG8_SCHED; PG8_LDA(At, 0, 0); PG8_STAGE(PG8_SA(1, 1), a1 + hstep, voffA);
            PG8_WAIT_V(8); PG8_WAIT_L(0); PG8_BAR; PG8_MMA(0, 0, At, B0); PG8_MMA(0, 1, At, B1); PG8_BAR; PG8_SCHED;
            PG8_LDA(At, 0, 1); PG8_STAGE(PG8_SB(0, 0), b2, voffB); PG8_STAGE(PG8_SB(0, 1), b2 + hstep, voffB); PG8_STAGE(PG8_SA(0, 0), a2, voffA);
            PG8_WAIT_V(8); PG8_WAIT_L(0); PG8_BAR; PG8_MMA(1, 0, At, B0); PG8_MMA(1, 1, At, B1); PG8_BAR; PG8_SCHED;
            PG8_LDB(B0, 1, 0); PG8_LDB(B1, 1, 1); PG8_SCHED; PG8_LDA(At, 1, 0); PG8_STAGE(PG8_SA(0, 1), a2 + hstep, voffA);
            PG8_WAIT_V(8); PG8_WAIT_L(0); PG8_BAR; PG8_MMA(0, 0, At, B0); PG8_MMA(0, 1, At, B1); PG8_BAR; PG8_SCHED;
            PG8_LDA(At, 1, 1); PG8_STAGE(PG8_SB(1, 0), b3, voffB); PG8_STAGE(PG8_SB(1, 1), b3 + hstep, voffB); PG8_STAGE(PG8_SA(1, 0), a3, voffA);
            PG8_WAIT_V(8); PG8_WAIT_L(0); PG8_BAR; PG8_MMA(1, 0, At, B0); PG8_MMA(1, 1, At, B1); PG8_BAR; PG8_SCHED;
            } else {
            PG8_LDB(B0, 0, 0); PG8_SCHED; PG8_LDA(At, 0, 0); PG8_STAGE(PG8_SA(1, 1), a1 + hstep, voffA);
            PG8_WAIT_L(8); PG8_BAR; PG8_WAIT_L(0); PG8_MMA(0, 0, At, B0); PG8_BAR; PG8_SCHED;
            PG8_LDB(B1, 0, 1); PG8_STAGE(PG8_SB(0, 0), b2, voffB);
            PG8_BAR; PG8_WAIT_L(0); PG8_MMA(0, 1, At, B1); PG8_BAR;
            PG8_LDA(At, 0, 1); PG8_STAGE(PG8_SA(0, 0), a2, voffA);
            PG8_BAR; PG8_WAIT_L(0); PG8_MMA(1, 0, At, B0); PG8_BAR; PG8_SCHED;
            PG8_STAGE(PG8_SB(0, 1), b2 + hstep, voffB);
            PG8_WAIT_V(6); PG8_BAR; PG8_MMA(1, 1, At, B1); PG8_BAR;
            PG8_LDB(B0, 1, 0); PG8_SCHED; PG8_LDA(At, 1, 0); PG8_STAGE(PG8_SA(0, 1), a2 + hstep, voffA);
            PG8_WAIT_L(8); PG8_BAR; PG8_WAIT_L(0); PG8_MMA(0, 0, At, B0); PG8_BAR; PG8_SCHED;
            PG8_LDB(B1, 1, 1); PG8_STAGE(PG8_SB(1, 0), b3, voffB);
            PG8_BAR; PG8_WAIT_L(0); PG8_MMA(0, 1, At, B1); PG8_BAR;
            PG8_LDA(At, 1, 1); PG8_STAGE(PG8_SA(1, 0), a3, voffA);
            PG8_BAR; PG8_WAIT_L(0); PG8_MMA(1, 0, At, B0); PG8_BAR; PG8_SCHED;
            PG8_STAGE(PG8_SB(1, 1), b3 + hstep, voffB);
            PG8_WAIT_V(6); PG8_BAR; PG8_MMA(1, 1, At, B1); PG8_BAR;
            }
        }
        if constexpr (ALIGN_EPI) { if (wr == 0) PG8_BAR; }
        if constexpr (!Epi::AFTER_DRAIN) { int l2 = __builtin_amdgcn_mbcnt_hi(~0u, __builtin_amdgcn_mbcnt_lo(~0u, 0u)); asm volatile("" : "+v"(l2));
            E(acc, cur, wr, wc, l2 & 15, l2 >> 4); S.done(cur); }
        if (!has_next) break;
#pragma unroll
        for (int a = 0; a < 2; ++a)
#pragma unroll
            for (int b = 0; b < 2; ++b)
#pragma unroll
                for (int m = 0; m < 4; ++m)
#pragma unroll
                    for (int n = 0; n < 2; ++n) acc[a][b][m][n] = (f32x4){0.f, 0.f, 0.f, 0.f};
        cur = nxt; cA = nA; cB = nB; ++ui;
        if constexpr (ALIGN_EPI) { if (wr == 1) PG8_BAR; }
    }
    PG8_WAIT_V(0);
    if constexpr (!ALIGN_EPI) { if (wr == 0) PG8_BAR; }
    PG8_BAR;
    if constexpr (Epi::AFTER_DRAIN) { E.fused(acc, cur, wr, wc, fr, fq, lds, wid, lane); S.done(cur); }
#undef PG8_SA
#undef PG8_SB
#undef PG8_STAGE
#undef PG8_LDA
#undef PG8_LDB
#undef PG8_MMA
#undef PG8_WAIT_V
#undef PG8_WAIT_L
#undef PG8_BAR
#undef PG8_SCHED
}
}
namespace att {
using bf16 = __hip_bfloat16;
constexpr int   D = 128, NW = 8, QBLK = 32, KVBLK = 64;
constexpr float SCALE = 0.088388347648318440f;
constexpr float THR = 8.f;
constexpr int SDEPTH = 1;
constexpr int LDQ = 1024, LDK = 256, LDO = 1024;
constexpr size_t SHM_V = KVBLK * D * 2, SHM_K = KVBLK * D * 2, SHM_ATTN = 2 * SHM_V + 2 * SHM_K + NW * 64 * 4;
using bf16x8 = __attribute__((ext_vector_type(8))) short;
using s16x4  = __attribute__((ext_vector_type(4))) short;
using f32x16 = __attribute__((ext_vector_type(16))) float;
using f32x8  = __attribute__((ext_vector_type(8))) float;
using u32x4  = __attribute__((ext_vector_type(4))) unsigned;
#define KSWZ(row, colB) ((row) * 256 + ((colB) ^ (((row) & 15) << 4)))
#define SBAR() __builtin_amdgcn_sched_barrier(0)
__device__ __forceinline__ int crow(int r, int hi) { return (r & 3) + 8 * (r >> 2) + 4 * hi; }
__device__ __forceinline__ unsigned cvtpk(float lo, float hi) { return pg8::cvt_pk_bf16(lo, hi); }
template <typename TIn> struct Stage;
template <> struct Stage<bf16>  { using T = bf16x8;
  __device__ static __forceinline__ T ld8(const bf16* p) { return *reinterpret_cast<const bf16x8*>(p); }
  __device__ static __forceinline__ bf16x8 tobf(T x) { return x; } };
template <> struct Stage<float> { using T = f32x8;
  __device__ static __forceinline__ T ld8(const float* p) { return *reinterpret_cast<const f32x8*>(p); }
  __device__ static __forceinline__ bf16x8 tobf(T x) {
    u32x4 w = {cvtpk(x[0], x[1]), cvtpk(x[2], x[3]), cvtpk(x[4], x[5]), cvtpk(x[6], x[7])}; return *reinterpret_cast<bf16x8*>(&w); } };

__device__ __forceinline__ void partialSM(f32x16& p0, f32x16& p1, float& m_reg, float& mn, float& alpha) {
  constexpr float C = SCALE * 1.4426950408889634f;
  float pmax = p0[0]; for (int r = 1; r < 16; ++r) pmax = fmaxf(pmax, p0[r]); for (int r = 0; r < 16; ++r) pmax = fmaxf(pmax, p1[r]);
  { auto rr = __builtin_amdgcn_permlane32_swap(__float_as_uint(pmax), __float_as_uint(pmax), false, false);
    pmax = fmaxf(__uint_as_float(rr[0]), __uint_as_float(rr[1])); }
  if (__builtin_expect(__all(pmax - m_reg <= THR / SCALE), 1)) { mn = m_reg; alpha = 1.f; }
  else { mn = fmaxf(m_reg, pmax); alpha = __builtin_amdgcn_exp2f((m_reg - mn) * C); m_reg = mn; }
  float mnC = -mn * C;
  for (int r = 0; r < 16; ++r) p0[r] = fmaf(p0[r], C, mnC); for (int r = 0; r < 16; ++r) p1[r] = fmaf(p1[r], C, mnC);
  for (int r = 0; r < 16; ++r) p0[r] = __builtin_amdgcn_exp2f(p0[r]);
}
__device__ __forceinline__ void finishSM(f32x16& p0, f32x16& p1, float alpha, float& l_reg, bf16x8& pa0, bf16x8& pa1, bf16x8& pa2, bf16x8& pa3) {
  for (int r = 0; r < 16; ++r) p1[r] = __builtin_amdgcn_exp2f(p1[r]);
  float ps = 0; for (int r = 0; r < 16; ++r) ps += p0[r]; for (int r = 0; r < 16; ++r) ps += p1[r];
  { auto rr = __builtin_amdgcn_permlane32_swap(__float_as_uint(ps), __float_as_uint(ps), false, false);
    ps = __uint_as_float(rr[0]) + __uint_as_float(rr[1]); }
  l_reg = l_reg * alpha + ps;
#define PK4(P, BASE, OUT) do { unsigned a0 = cvtpk(P[BASE + 0], P[BASE + 1]), a1 = cvtpk(P[BASE + 2], P[BASE + 3]);   \
    unsigned b0 = cvtpk(P[BASE + 4], P[BASE + 5]), b1 = cvtpk(P[BASE + 6], P[BASE + 7]);                              \
    auto r0 = __builtin_amdgcn_permlane32_swap(a0, b0, false, false); auto r1 = __builtin_amdgcn_permlane32_swap(a1, b1, false, false); \
    u32x4 w = {r0[0], r1[0], r0[1], r1[1]}; OUT = *reinterpret_cast<bf16x8*>(&w); } while (0)
  PK4(p0, 0, pa0); PK4(p0, 8, pa1); PK4(p1, 0, pa2); PK4(p1, 8, pa3);
#undef PK4
}
__device__ __forceinline__ void partialSM2(f32x16& p0, f32x16& p1, const float negBC) {
  constexpr float C = SCALE * 1.4426950408889634f;
  for (int r = 0; r < 16; ++r) p0[r] = fmaf(p0[r], C, negBC); for (int r = 0; r < 16; ++r) p1[r] = fmaf(p1[r], C, negBC);
  for (int r = 0; r < 16; ++r) p0[r] = __builtin_amdgcn_exp2f(p0[r]);
}
__device__ __forceinline__ void finishSM2(f32x16& p0, f32x16& p1, float& l_reg, bf16x8& pa0, bf16x8& pa1, bf16x8& pa2, bf16x8& pa3) {
  for (int r = 0; r < 16; ++r) p1[r] = __builtin_amdgcn_exp2f(p1[r]);
  float ps = 0; for (int r = 0; r < 16; ++r) ps += p0[r]; for (int r = 0; r < 16; ++r) ps += p1[r];
  l_reg += ps;
#define PK4(P, BASE, OUT) do { unsigned a0 = cvtpk(P[BASE + 0], P[BASE + 1]), a1 = cvtpk(P[BASE + 2], P[BASE + 3]);   \
    unsigned b0 = cvtpk(P[BASE + 4], P[BASE + 5]), b1 = cvtpk(P[BASE + 6], P[BASE + 7]);                              \
    auto r0 = __builtin_amdgcn_permlane32_swap(a0, b0, false, false); auto r1 = __builtin_amdgcn_permlane32_swap(a1, b1, false, false); \
    u32x4 w = {r0[0], r1[0], r0[1], r1[1]}; OUT = *reinterpret_cast<bf16x8*>(&w); } while (0)
  PK4(p0, 0, pa0); PK4(p0, 8, pa1); PK4(p1, 0, pa2); PK4(p1, 8, pa3);
#undef PK4
}
__device__ __forceinline__ void qkt(f32x16& p0, f32x16& p1, const bf16* Ks, const bf16x8* qr, int r32, int hi) {
  p0 = f32x16{}; p1 = f32x16{};
  for (int d0 = 0; d0 < 8; ++d0) { int cb = (d0 * 16 + hi * 8) * 2;
    bf16x8 b0 = *reinterpret_cast<const bf16x8*>((const char*)Ks + KSWZ(r32, cb));
    bf16x8 b1 = *reinterpret_cast<const bf16x8*>((const char*)Ks + KSWZ(32 + r32, cb));
    p0 = __builtin_amdgcn_mfma_f32_32x32x16_bf16(b0, qr[d0], p0, 0, 0, 0);
    p1 = __builtin_amdgcn_mfma_f32_32x32x16_bf16(b1, qr[d0], p1, 0, 0, 0); }
}
__device__ __forceinline__ void partialSM3(f32x16& p0) { for (int r = 0; r < 16; ++r) p0[r] = __builtin_amdgcn_exp2f(p0[r]); }
__device__ __forceinline__ void qkt3(f32x16& p0, f32x16& p1, const bf16* Ks, const bf16x8* qr, int r32, int hi, const f32x16& cinit) {
  { int cb = (hi * 8) * 2;
    bf16x8 b0 = *reinterpret_cast<const bf16x8*>((const char*)Ks + KSWZ(r32, cb));
    bf16x8 b1 = *reinterpret_cast<const bf16x8*>((const char*)Ks + KSWZ(32 + r32, cb));
    p0 = __builtin_amdgcn_mfma_f32_32x32x16_bf16(b0, qr[0], cinit, 0, 0, 0);
    p1 = __builtin_amdgcn_mfma_f32_32x32x16_bf16(b1, qr[0], cinit, 0, 0, 0); }
  for (int d0 = 1; d0 < 8; ++d0) { int cb = (d0 * 16 + hi * 8) * 2;
    bf16x8 b0 = *reinterpret_cast<const bf16x8*>((const char*)Ks + KSWZ(r32, cb));
    bf16x8 b1 = *reinterpret_cast<const bf16x8*>((const char*)Ks + KSWZ(32 + r32, cb));
    p0 = __builtin_amdgcn_mfma_f32_32x32x16_bf16(b0, qr[d0], p0, 0, 0, 0);
    p1 = __builtin_amdgcn_mfma_f32_32x32x16_bf16(b1, qr[d0], p1, 0, 0, 0); }
}
__device__ __forceinline__ int v_st(int k, int c) { const int kk = (k & ~0xC) | ((k & 4) << 1) | ((k & 8) >> 1); return ((kk >> 3) * 4 + (c >> 5)) * 512 + ((kk & 7) * 32 + (c & 31)) * 2; }
__device__ __forceinline__ int v_rd_base(int lane) { return ((lane & 3) << 3) | (((lane >> 2) & 3) << 6) | (((lane >> 4) & 1) << 5) | (((lane >> 5) & 1) << 8); }
constexpr int v_rd_off(int d0, int ks, int half) { return d0 * 512 + ks * 4096 + half * 2048; }
template <int OFF> __device__ __forceinline__ s16x4 tr_read(int vb) {
  s16x4 r; asm volatile("ds_read_b64_tr_b16 %0, %1 offset:%2" : "=&v"(r) : "v"(vb), "i"(OFF) : "memory"); return r;
}
template <int D0> __device__ __forceinline__ void pv_one(f32x16& od, int vb, bf16x8 pa0, bf16x8 pa1, bf16x8 pa2, bf16x8 pa3) {
  const s16x4 l0 = tr_read<v_rd_off(D0, 0, 0)>(vb), h0 = tr_read<v_rd_off(D0, 0, 1)>(vb), l1 = tr_read<v_rd_off(D0, 1, 0)>(vb), h1 = tr_read<v_rd_off(D0, 1, 1)>(vb);
  const s16x4 l2 = tr_read<v_rd_off(D0, 2, 0)>(vb), h2 = tr_read<v_rd_off(D0, 2, 1)>(vb), l3 = tr_read<v_rd_off(D0, 3, 0)>(vb), h3 = tr_read<v_rd_off(D0, 3, 1)>(vb);
  asm volatile("s_waitcnt lgkmcnt(0)" ::: "memory"); SBAR();
#define PK(L, H) (bf16x8){L[0], L[1], L[2], L[3], H[0], H[1], H[2], H[3]}
  od = __builtin_amdgcn_mfma_f32_32x32x16_bf16(pa0, PK(l0, h0), od, 0, 0, 0);
  od = __builtin_amdgcn_mfma_f32_32x32x16_bf16(pa1, PK(l1, h1), od, 0, 0, 0);
  od = __builtin_amdgcn_mfma_f32_32x32x16_bf16(pa2, PK(l2, h2), od, 0, 0, 0);
  od = __builtin_amdgcn_mfma_f32_32x32x16_bf16(pa3, PK(l3, h3), od, 0, 0, 0);
#undef PK
}
__device__ __forceinline__ void pv_d0(f32x16* o, int vb, bf16x8 pa0, bf16x8 pa1, bf16x8 pa2, bf16x8 pa3) {
  pv_one<0>(o[0], vb, pa0, pa1, pa2, pa3); pv_one<1>(o[1], vb, pa0, pa1, pa2, pa3); pv_one<2>(o[2], vb, pa0, pa1, pa2, pa3); pv_one<3>(o[3], vb, pa0, pa1, pa2, pa3);
}

__device__ __forceinline__ void finishSM4(f32x16& p0, f32x16& p1, float& l_reg, bf16x8& pa0, bf16x8& pa1, bf16x8& pa2, bf16x8& pa3) {
  for (int r = 0; r < 16; ++r) p1[r] = __builtin_amdgcn_exp2f(p1[r]);
  float ps = 0; for (int r = 0; r < 16; ++r) ps += p0[r]; for (int r = 0; r < 16; ++r) ps += p1[r];
  l_reg += ps;
#define PK8(P, BASE, OUT) do { u32x4 w = {cvtpk(P[BASE + 0], P[BASE + 1]), cvtpk(P[BASE + 2], P[BASE + 3]), cvtpk(P[BASE + 4], P[BASE + 5]), cvtpk(P[BASE + 6], P[BASE + 7])}; OUT = *reinterpret_cast<bf16x8*>(&w); } while (0)
  PK8(p0, 0, pa0); PK8(p0, 8, pa1); PK8(p1, 0, pa2); PK8(p1, 8, pa3);
#undef PK8
}
__device__ __forceinline__ int v_rd_base2(int lane) { return ((lane & 3) << 3) | (((lane >> 2) & 3) << 6) | (((lane >> 4) & 1) << 5) | (((lane >> 5) & 1) << 11); }
constexpr int v_rd_off2(int d0, int ks, int part) { return d0 * 512 + ks * 4096 + part * 256; }
template <int D0> __device__ __forceinline__ void pv_one2(f32x16& od, int vb, bf16x8 pa0, bf16x8 pa1, bf16x8 pa2, bf16x8 pa3) {
  const s16x4 l0 = tr_read<v_rd_off2(D0, 0, 0)>(vb), h0 = tr_read<v_rd_off2(D0, 0, 1)>(vb), l1 = tr_read<v_rd_off2(D0, 1, 0)>(vb), h1 = tr_read<v_rd_off2(D0, 1, 1)>(vb);
  const s16x4 l2 = tr_read<v_rd_off2(D0, 2, 0)>(vb), h2 = tr_read<v_rd_off2(D0, 2, 1)>(vb), l3 = tr_read<v_rd_off2(D0, 3, 0)>(vb), h3 = tr_read<v_rd_off2(D0, 3, 1)>(vb);
  asm volatile("s_waitcnt lgkmcnt(0)" ::: "memory"); SBAR();
#define PK(L, H) (bf16x8){L[0], L[1], L[2], L[3], H[0], H[1], H[2], H[3]}
  od = __builtin_amdgcn_mfma_f32_32x32x16_bf16(PK(l0, h0), pa0, od, 0, 0, 0);
  od = __builtin_amdgcn_mfma_f32_32x32x16_bf16(PK(l1, h1), pa1, od, 0, 0, 0);
  od = __builtin_amdgcn_mfma_f32_32x32x16_bf16(PK(l2, h2), pa2, od, 0, 0, 0);
  od = __builtin_amdgcn_mfma_f32_32x32x16_bf16(PK(l3, h3), pa3, od, 0, 0, 0);
#undef PK
}
__device__ __forceinline__ void pv_d02(f32x16* o, int vb, bf16x8 pa0, bf16x8 pa1, bf16x8 pa2, bf16x8 pa3) {
  pv_one2<0>(o[0], vb, pa0, pa1, pa2, pa3); pv_one2<1>(o[1], vb, pa0, pa1, pa2, pa3); pv_one2<2>(o[2], vb, pa0, pa1, pa2, pa3); pv_one2<3>(o[3], vb, pa0, pa1, pa2, pa3);
}
__device__ __forceinline__ void attn_dense_body(const bf16* Qb, const bf16* __restrict__ Kh, const bf16* __restrict__ Vh, const bf16* __restrict__ Zb,
                                                bf16* Ob, int seq, char* lds, const int wid_in, const float kmax) {
  using St = Stage<bf16>; using SQ = Stage<bf16>; using TQ = bf16;
  int lane = __builtin_amdgcn_mbcnt_hi(~0u, __builtin_amdgcn_mbcnt_lo(~0u, 0u)); asm volatile("" : "+v"(lane));
  const int wid = wid_in, tid = wid * 64 + lane, r32 = lane & 31, hi = lane >> 5;
  bf16* V_lds = (bf16*)lds; bf16* K_lds = (bf16*)(lds + 2 * SHM_V);
  float* ws = (float*)(lds + 2 * SHM_V + 2 * SHM_K) + wid * 64; float* li_l = ws; float* al_l = ws + 32;
  float l_reg = 0; f32x16 o[4] = {}; bf16x8 qr[8];
  const TQ* Qw = Qb + (long)(wid * QBLK + r32) * LDQ + hi * 8;
#pragma unroll
  for (int d0 = 0; d0 < 8; ++d0) qr[d0] = SQ::tobf(SQ::ld8(Qw + d0 * 16));
  float negBC;
  { float ss = 0.f;
#pragma unroll
    for (int d0 = 0; d0 < 8; ++d0)
#pragma unroll
      for (int e = 0; e < 8; ++e) { const float qv = __uint_as_float((unsigned)(unsigned short)qr[d0][e] << 16); ss = fmaf(qv, qv, ss); }
    auto rr = __builtin_amdgcn_permlane32_swap(__float_as_uint(ss), __float_as_uint(ss), false, false);
    ss = __uint_as_float(rr[0]) + __uint_as_float(rr[1]);
    negBC = -(sqrtf(ss) * kmax * (11.313708498984761f * 1.01f) + 0.07f); }
  f32x16 cinit; for (int r = 0; r < 16; ++r) cinit[r] = negBC;
  const int sr = tid >> 4, sc = (tid & 15) * 8, vst0 = v_st(sr, sc), vst1 = v_st(32 + sr, sc);
  const int vb0 = (int)(uintptr_t)V_lds + v_rd_base2(lane);
  struct { typename St::T vs0, vs1, ks0, ks1; } sr_[SDEPTH];
#define SLOAD(i, k0) do { sr_[i].vs0 = St::ld8(&Vh[(long)((k0) + sr) * LDK + sc]); sr_[i].vs1 = St::ld8(&Vh[(long)((k0) + 32 + sr) * LDK + sc]); \
    sr_[i].ks0 = St::ld8(&Kh[(long)((k0) + sr) * LDK + sc]); sr_[i].ks1 = St::ld8(&Kh[(long)((k0) + 32 + sr) * LDK + sc]); } while (0)
#define SWRITE(b, i) do { *(bf16x8*)((char*)V_lds + (b) * SHM_V + vst0) = St::tobf(sr_[i].vs0);          \
    *(bf16x8*)((char*)V_lds + (b) * SHM_V + vst1) = St::tobf(sr_[i].vs1); int kc = sc * 2;               \
    *(bf16x8*)((char*)K_lds + (b) * SHM_K + KSWZ(sr, kc)) = St::tobf(sr_[i].ks0);                       \
    *(bf16x8*)((char*)K_lds + (b) * SHM_K + KSWZ(32 + sr, kc)) = St::tobf(sr_[i].ks1); } while (0)
#define SWAIT() do { if constexpr (SDEPTH == 2) asm volatile("s_waitcnt vmcnt(4)" ::: "memory"); else asm volatile("s_waitcnt vmcnt(0)" ::: "memory"); } while (0)
#define RESC(a) do { if (__any((a) < 1.f)) { if (hi == 0) al_l[r32] = (a); asm volatile("s_waitcnt lgkmcnt(0)" ::: "memory"); \
    for (int d = 0; d < 4; ++d) for (int r = 0; r < 16; ++r) o[d][r] *= al_l[crow(r, hi)]; } } while (0)
  f32x16 pA0, pA1, pB0, pB1; bf16x8 pa0, pa1, pa2, pa3; const int NT = seq / KVBLK;
  constexpr int SE = 0, SO = SDEPTH - 1;
  SLOAD(SE, 0); asm volatile("s_waitcnt vmcnt(0)" ::: "memory"); SWRITE(0, SE); __syncthreads();
  qkt3(pA0, pA1, K_lds, qr, r32, hi, cinit); partialSM3(pA0);
  SLOAD(SO, KVBLK); if constexpr (SDEPTH == 2) { if (2 < NT) SLOAD(SE, 2 * KVBLK); }
  SWAIT(); SWRITE(1, SO); __syncthreads();
  for (int j = 1; j + 1 < NT; j += 2) {
    SBAR(); qkt3(pB0, pB1, (bf16*)((char*)K_lds + SHM_K), qr, r32, hi, cinit);
    finishSM4(pA0, pA1, l_reg, pa0, pa1, pa2, pa3); SBAR();
    SLOAD(SO, (j + SDEPTH) * KVBLK); SBAR();
    pv_d02(o, vb0, pa0, pa1, pa2, pa3); partialSM3(pB0);
    __syncthreads(); SWAIT(); SWRITE(0, SE);
    __syncthreads();
    SBAR(); qkt3(pA0, pA1, K_lds, qr, r32, hi, cinit);
    finishSM4(pB0, pB1, l_reg, pa0, pa1, pa2, pa3); SBAR();
    if (SDEPTH == 1 || j + 3 < NT) SLOAD(SE, (j + 1 + SDEPTH) * KVBLK); SBAR();
    pv_d02(o, vb0 + (int)SHM_V, pa0, pa1, pa2, pa3); partialSM3(pA0);
    __syncthreads(); SWAIT(); SWRITE(1, SO);
    __syncthreads();
  }
  SBAR(); qkt3(pB0, pB1, (bf16*)((char*)K_lds + SHM_K), qr, r32, hi, cinit);
  finishSM4(pA0, pA1, l_reg, pa0, pa1, pa2, pa3); SBAR();
  pv_d02(o, vb0, pa0, pa1, pa2, pa3); partialSM3(pB0);
  __syncthreads();
  finishSM4(pB0, pB1, l_reg, pa0, pa1, pa2, pa3); SBAR();
  pv_d02(o, vb0 + (int)SHM_V, pa0, pa1, pa2, pa3);
  { auto rr = __builtin_amdgcn_permlane32_swap(__float_as_uint(l_reg), __float_as_uint(l_reg), false, false); l_reg = __uint_as_float(rr[0]) + __uint_as_float(rr[1]); }
  const float rl = __builtin_amdgcn_rcpf(l_reg);
  { int lb = (wid * QBLK + r32) * LDO + 4 * hi; asm volatile("" : "+v"(lb));
    unsigned short* Ow = (unsigned short*)Ob + lb; const unsigned short* Zw = (const unsigned short*)Zb + lb;
#pragma unroll
    for (int d0 = 0; d0 < 4; ++d0)
#pragma unroll
      for (int g = 0; g < 4; ++g) { const int co = d0 * 32 + 8 * g; const unsigned long long zz = *(const unsigned long long*)(Zw + co);
        const float z0 = __uint_as_float((unsigned)(zz << 16)), z1 = __uint_as_float((unsigned)zz & 0xffff0000u), z2 = __uint_as_float((unsigned)(zz >> 32) << 16), z3 = __uint_as_float((unsigned)(zz >> 32) & 0xffff0000u);
        const unsigned w0 = cvtpk(o[d0][4 * g + 0] * rl * z0, o[d0][4 * g + 1] * rl * z1), w1 = cvtpk(o[d0][4 * g + 2] * rl * z2, o[d0][4 * g + 3] * rl * z3);
        *(unsigned long long*)(Ow + co) = (unsigned long long)w0 | ((unsigned long long)w1 << 32); } }
#undef SLOAD
#undef SWRITE
#undef SWAIT
#undef RESC
}
}

typedef unsigned short bf16_t;
typedef float f32x4 __attribute__((ext_vector_type(4)));
typedef unsigned u32x4 __attribute__((ext_vector_type(4)));
typedef unsigned u32x2v __attribute__((ext_vector_type(2)));
typedef short bf16x8v __attribute__((ext_vector_type(8)));
typedef float f32x16v __attribute__((ext_vector_type(16)));
#define LAS __attribute__((address_space(3)))
#define XB_TMO      128
#define XB_XCNT(j)  (256  + 64 * (j))
#define XB_XSUB(j)  (1280 + 64 * (j))
#define XB_XGEN(j)  (2304 + 64 * (j))
#define XB_TOP      3328
#define XB_TOPGEN   3392
#define XCD_BAR_WORDS 3456
#define XB_SPIN_CAP (1u << 18)

__device__ __forceinline__ unsigned xb_ld(unsigned* p)              { return __hip_atomic_load(p, __ATOMIC_RELAXED, __HIP_MEMORY_SCOPE_AGENT); }
__device__ __forceinline__ unsigned xb_add(unsigned* p, unsigned v) { return __hip_atomic_fetch_add(p, v, __ATOMIC_RELAXED, __HIP_MEMORY_SCOPE_AGENT); }
__device__ __forceinline__ unsigned xb_xcc_id() { return (unsigned)__builtin_amdgcn_s_getreg((3 << 11) | 20) & 0xFu; }
#define XB_SPIN(cond, bar) do { unsigned _sp = 0; while (cond) { __builtin_amdgcn_s_sleep(1); \
    if ((++_sp & 255u) == 0u) { if (xb_ld(&(bar)[XB_TMO])) break; if (_sp > XB_SPIN_CAP) { atomicAdd(&(bar)[XB_TMO], 1u); break; } } } } while (0)

struct XcdBarrier {
    unsigned* bar; unsigned x;
    volatile LAS unsigned* st;
};

__device__ __forceinline__ XcdBarrier xcd_barrier_post(unsigned* bar, volatile LAS unsigned* st, const bool leader) {
    XcdBarrier b; b.bar = bar; b.x = xb_xcc_id(); b.st = st;
    if (leader) (void)xb_add(&bar[XB_XCNT(b.x)], 1u);
    return b;
}
__device__ __forceinline__ void xcd_barrier_complete(unsigned* bar, unsigned x, unsigned& nloc, unsigned& nx) {
    const unsigned G = gridDim.x * gridDim.y * gridDim.z;
    unsigned sum, cnt, mine, sp = 0u;
    for (;;) {
        sum = 0u; cnt = 0u; mine = 0u;
#pragma unroll
        for (unsigned j = 0; j < 16; ++j) { const unsigned c = xb_ld(&bar[XB_XCNT(j)]); sum += c; cnt += (c > 0u) ? 1u : 0u; mine = (j == x) ? c : mine; }
        if (sum == G) break;
        __builtin_amdgcn_s_sleep(1);
        if ((++sp & 255u) == 0u) { if (xb_ld(&bar[XB_TMO])) break; if (sp > XB_SPIN_CAP) { atomicAdd(&bar[XB_TMO], 1u); break; } }
    }
    nloc = mine > 0u ? mine : 1u; nx = cnt > 0u ? cnt : 1u;
}

__device__ __forceinline__ void xcd_barrier(const XcdBarrier& b, const bool leader) {
    asm volatile("s_waitcnt vmcnt(0)" ::: "memory");
    __syncthreads();
    if (leader) {
        unsigned* bar = b.bar;
        __builtin_amdgcn_s_waitcnt(0);
        unsigned nloc = b.st[0], nx = b.st[1];
        if (nloc == 0u) { xcd_barrier_complete(bar, b.x, nloc, nx); b.st[0] = nloc; b.st[1] = nx; }
        const unsigned old = xb_add(&bar[XB_XSUB(b.x)], 1u);
        const unsigned gen = old / nloc;
        if (old + 1u == (gen + 1u) * nloc) {
            __builtin_amdgcn_fence(__ATOMIC_RELEASE, "agent");
            asm volatile("s_waitcnt vmcnt(0)" ::: "memory");
            const unsigned og = xb_add(&bar[XB_TOP], 1u);
            const unsigned tg = og / nx;
            if (og + 1u == (tg + 1u) * nx) xb_add(&bar[XB_TOPGEN], 1u);
            else XB_SPIN(xb_ld(&bar[XB_TOPGEN]) == tg, bar);
            __builtin_amdgcn_fence(__ATOMIC_ACQUIRE, "agent");
            xb_add(&bar[XB_XGEN(b.x)], 1u);
            asm volatile("s_waitcnt vmcnt(0)" ::: "memory");
        } else {
            XB_SPIN(xb_ld(&bar[XB_XGEN(b.x)]) == gen, bar);
            __builtin_amdgcn_fence(__ATOMIC_ACQUIRE, "agent");
            asm volatile("s_waitcnt vmcnt(0)" ::: "memory");
        }
    }
    __syncthreads();
}

constexpr int RING_BYTES = pg8::STAGE_BYTES;
constexpr int PART_OFF = RING_BYTES;
constexpr int XBST_OFF = RING_BYTES + 8192;
constexpr int LDS_BYTES = RING_BYTES + 8192 + 16;

__device__ __forceinline__ unsigned pk2(float a, float b) { return pg8::cvt_pk_bf16(a, b); }
__device__ __forceinline__ float wave_sum(float v) {
#pragma unroll
    for (int o = 1; o < 64; o <<= 1) v += __shfl_xor(v, o);
    return v;
}
__device__ __forceinline__ const float* xrow_c(const float* lat, const float* cx, int r) {
    const int b = r / TB, rr = r - b * TB;
    return rr < CTXL ? cx + ((size_t)b * CTXL + rr) * DM : lat + ((size_t)b * SEQ + (rr - CTXL)) * DM;
}
__device__ __forceinline__ int qk_src(int c) { const int h = c & ~127, cp = c & 127;
    return h + ((cp >> 6) & 1) * 64 + ((cp >> 2) & 1) * 32 + ((cp >> 5) & 1) * 16 + ((cp >> 3) & 3) * 4 + (cp & 3); }

__device__ __forceinline__ void transpose_item(const float* W, int K, int N, bf16_t* WT, LAS float* scr, int item, int lane, int nperm) {
    const int nblk = N / 32, kb = item / nblk, nb = item % nblk, k0 = 64 * kb, n0 = 32 * nb;
    const int cdst = n0 + (lane & 31), csrc = cdst < nperm ? qk_src(cdst) : cdst;
#pragma unroll 8
    for (int i = 0; i < 32; ++i) { const int kk = 2 * i + (lane >> 5); scr[kk * 33 + (lane & 31)] = W[(size_t)(k0 + kk) * N + csrc]; }
    asm volatile("s_waitcnt lgkmcnt(0)" ::: "memory");
    const int c = lane & 7;
#pragma unroll
    for (int j = 0; j < 4; ++j) { const int n = (lane >> 3) + 8 * j; const LAS float* s = scr + (8 * c) * 33 + n;
        u32x4 o; o.x = pk2(s[0 * 33], s[1 * 33]); o.y = pk2(s[2 * 33], s[3 * 33]); o.z = pk2(s[4 * 33], s[5 * 33]); o.w = pk2(s[6 * 33], s[7 * 33]);
        *(u32x4*)(WT + (size_t)(n0 + n) * K + k0 + 8 * c) = o; }
    asm volatile("s_waitcnt lgkmcnt(0)" ::: "memory");
}

template <int GI> __device__ __forceinline__ void pool_unit_t(const bf16_t* XB, bf16_t* ZB, const bf16_t* WPt, const float* pscale, int R0, int lane) {
    constexpr int g = GI, a = 1 << GI;
    const int pm = R0 >> 8, b = pm / 65, jt = pm % 65;
    const int lo = b * TB + (jt ? CTXL : 0), hiR = jt ? (b + 1) * TB : b * TB + CTXL;
    const int r32 = lane & 31, hh = lane >> 5, t = R0 + r32;
    const int s0 = max(t - a, lo), s1 = min(t + a - 1, hiR - 1); const float inv = 1.0f / (float)(s1 - s0 + 1);
    f32x16v acc0 = {}, acc1 = {}, acc2 = {}, acc3 = {};
    const bf16_t* xb = XB + g * 128 + hh * 8;
    const bf16_t* wp = WPt + (size_t)(g * 128 + r32) * 128 + hh * 8;
    float wq[2 * a]; int rq[2 * a];
#pragma unroll
    for (int q = 0; q < 2 * a; ++q) { const int rr = t - a + q; const bool ok = (rr >= lo) && (rr < hiR); wq[q] = ok ? inv : 0.f; rq[q] = ok ? rr : t; }
#pragma unroll 1
    for (int kk = 0; kk < 8; ++kk) {
        u32x4 wv[2 * a];
#pragma unroll
        for (int q = 0; q < 2 * a; ++q) wv[q] = *(const u32x4*)(xb + (size_t)rq[q] * 512 + kk * 16);
        const u32x4 w = *(const u32x4*)(xb + (size_t)t * 512 + kk * 16);
        const bf16x8v w0 = *(const bf16x8v*)(wp + kk * 16), w1 = *(const bf16x8v*)(wp + 32 * 128 + kk * 16), w2 = *(const bf16x8v*)(wp + 64 * 128 + kk * 16), w3 = *(const bf16x8v*)(wp + 96 * 128 + kk * 16);
        float s[8] = {0.f, 0.f, 0.f, 0.f, 0.f, 0.f, 0.f, 0.f};
#pragma unroll
        for (int q = 0; q < 2 * a; ++q) { const float f = wq[q]; const u32x4 v = wv[q];
            s[0] += f * pg8::bf_lo(v.x); s[1] += f * pg8::bf_hi(v.x); s[2] += f * pg8::bf_lo(v.y); s[3] += f * pg8::bf_hi(v.y); s[4] += f * pg8::bf_lo(v.z); s[5] += f * pg8::bf_hi(v.z); s[6] += f * pg8::bf_lo(v.w); s[7] += f * pg8::bf_hi(v.w); }
        u32x4 mf; mf.x = pk2(s[0] - pg8::bf_lo(w.x), s[1] - pg8::bf_hi(w.x)); mf.y = pk2(s[2] - pg8::bf_lo(w.y), s[3] - pg8::bf_hi(w.y));
        mf.z = pk2(s[4] - pg8::bf_lo(w.z), s[5] - pg8::bf_hi(w.z)); mf.w = pk2(s[6] - pg8::bf_lo(w.w), s[7] - pg8::bf_hi(w.w));
        const bf16x8v mfrag = *reinterpret_cast<bf16x8v*>(&mf);
        acc0 = __builtin_amdgcn_mfma_f32_32x32x16_bf16(w0, mfrag, acc0, 0, 0, 0); acc1 = __builtin_amdgcn_mfma_f32_32x32x16_bf16(w1, mfrag, acc1, 0, 0, 0);
        acc2 = __builtin_amdgcn_mfma_f32_32x32x16_bf16(w2, mfrag, acc2, 0, 0, 0); acc3 = __builtin_amdgcn_mfma_f32_32x32x16_bf16(w3, mfrag, acc3, 0, 0, 0);
    }
    bf16_t* zrow = ZB + (size_t)t * 512 + g * 128; const float* ps = pscale + g * 128;
#define POOL_OUT(ACC, NS) do { _Pragma("unroll") for (int q = 0; q < 4; ++q) { const int n0 = (NS) * 32 + 8 * q + 4 * hh; const u32x2v z = *(const u32x2v*)(zrow + n0); const f32x4 p4 = *(const f32x4*)(ps + n0); \
        u32x2v o; o.x = pk2(ACC[4 * q + 0] * p4[0] * pg8::bf_lo(z.x), ACC[4 * q + 1] * p4[1] * pg8::bf_hi(z.x)); o.y = pk2(ACC[4 * q + 2] * p4[2] * pg8::bf_lo(z.y), ACC[4 * q + 3] * p4[3] * pg8::bf_hi(z.y)); \
        *(u32x2v*)(zrow + n0) = o; } } while (0)
    POOL_OUT(acc0, 0); POOL_OUT(acc1, 1); POOL_OUT(acc2, 2); POOL_OUT(acc3, 3);
#undef POOL_OUT
}
__device__ __forceinline__ void pool_unit(const bf16_t* XB, bf16_t* ZB, const bf16_t* WPt, const float* pscale, int wu, int lane) {
    const int g = wu & 3, R0 = (wu >> 2) * 32;
    if (g == 0) pool_unit_t<0>(XB, ZB, WPt, pscale, R0, lane); else if (g == 1) pool_unit_t<1>(XB, ZB, WPt, pscale, R0, lane);
    else if (g == 2) pool_unit_t<2>(XB, ZB, WPt, pscale, R0, lane); else pool_unit_t<3>(XB, ZB, WPt, pscale, R0, lane);
}

__device__ __forceinline__ void store_u(const f32x4 (&v)[4], const float* mod, bf16_t* urow, int lane) {
#pragma unroll
    for (int j = 0; j < 4; ++j) { const int c = 4 * lane + 256 * j; const f32x4 sh = *(const f32x4*)(mod + c), sc = *(const f32x4*)(mod + 1024 + c);
        const f32x4 u = v[j] * (sc + 1.0f) + sh; u32x2v o; o.x = pk2(u[0], u[1]); o.y = pk2(u[2], u[3]); *(u32x2v*)(urow + c) = o; }
}

__global__ void __launch_bounds__(NTHREADS, 2) mega(Params P) {
    extern __shared__ __attribute__((aligned(16))) unsigned char lds[];
    cg::grid_group grid = cg::this_grid();
    const int wave = __builtin_amdgcn_readfirstlane(threadIdx.x >> 6);
#define LANE_ID() (__builtin_amdgcn_mbcnt_hi(~0u, __builtin_amdgcn_mbcnt_lo(~0u, 0u)))
    const int G = gridDim.x, bid = blockIdx.x, gw = bid * NWAVES + wave, NGW = G * NWAVES;
#define GRID_SYNC() xcd_barrier(xbar, wave == 0 && LANE_ID() == 0)
#define CAS __attribute__((address_space(4)))
#define WSL() const CAS Params* pp = (const CAS Params*)__builtin_amdgcn_kernarg_segment_ptr(); asm volatile("" : "+s"(pp)); unsigned char* wsl = pp->ws; asm volatile("" : "+s"(wsl))
#define U ((bf16_t*)(wsl + WS_U))
#define Q ((bf16_t*)(wsl + WS_Q))
#define Kb ((bf16_t*)(wsl + WS_K))
#define Vb ((bf16_t*)(wsl + WS_V))
#define ZA ((bf16_t*)(wsl + WS_ZA))
#define XB ((bf16_t*)(wsl + WS_XB))
#define ZB ((bf16_t*)(wsl + WS_ZB))
#define MOD ((float*)(wsl + WS_MOD))
#define CX ((float*)(wsl + WS_CX))
#define DELTA ((const bf16_t*)(wsl + WS_GA))
    LAS unsigned char* l3 = (LAS unsigned char*)lds;
    const CAS Params* pp0 = (const CAS Params*)__builtin_amdgcn_kernarg_segment_ptr();
    { volatile LAS unsigned* st = (volatile LAS unsigned*)(l3 + XBST_OFF); if (wave == 0 && LANE_ID() == 0) { st[0] = 0u; st[1] = 0u; st[2] = 0u; st[3] = 0u; } }
    __syncthreads();
    XcdBarrier xbar = xcd_barrier_post((unsigned*)(pp0->ws + WS_BAR), (volatile LAS unsigned*)(l3 + XBST_OFF), wave == 0 && LANE_ID() == 0);
    grid.sync();

    constexpr int NPH = 2 + 5 * DEPTH;
#pragma unroll 1
    for (int ph = 0; ph < NPH; ++ph) {
    const int l = ph < 2 ? 0 : (ph - 2) / 5, sph = ph < 2 ? ph : 2 + (ph - 2) % 5;
    if (sph == 0) {
        WSL(); int lane = LANE_ID(); asm volatile("" : "+v"(lane)); const int tid = wave * 64 + lane; unsigned char* ws = wsl; float* cosT = (float*)(wsl + WS_ROPE); float* sinT = cosT + 256 * 32;
        LAS float* scr = (LAS float*)(l3 + wave * 16384);
        constexpr int I_IN = (DM / 64) * (NIN / 32), I_A = (DM / 64) * (DM / 32), I_B = (512 / 64) * (DM / 32), I_O = I_A, I_P = (128 / 64) * (128 / 32);
        constexpr int PER_L = I_IN + I_A + I_B + I_O + 4 * I_P;
        for (int it = gw; it < DEPTH * PER_L; it += NGW) {
            const int l = it / PER_L; int r = it - l * PER_L;
            if (r < I_IN) { transpose_item(pp->w_in + (size_t)l * DM * NIN, DM, NIN, (bf16_t*)(ws + WS_WIN + l * SZ_WIN), scr, r, lane, 1280); continue; } r -= I_IN;
            if (r < I_A) { transpose_item(pp->w_br_a + (size_t)l * DM * DM, DM, DM, (bf16_t*)(ws + WS_WA + l * SZ_WA), scr, r, lane, 0); continue; } r -= I_A;
            if (r < I_B) { transpose_item(pp->w_br_b + (size_t)l * 512 * DM, 512, DM, (bf16_t*)(ws + WS_WB + l * SZ_WB), scr, r, lane, 0); continue; } r -= I_B;
            if (r < I_O) { transpose_item(pp->w_out + (size_t)l * DM * DM, DM, DM, (bf16_t*)(ws + WS_WO + l * SZ_WO), scr, r, lane, 0); continue; } r -= I_O;
            const int g = r / I_P; r -= g * I_P;
            transpose_item(pp->w_pool + ((size_t)l * 4 + g) * 128 * 128, 128, 128, (bf16_t*)(ws + WS_WP + l * SZ_WP) + (size_t)g * 128 * 128, scr, r, lane, 0);
        }
        for (int i = bid * NTHREADS + tid; i < 256 * 32; i += G * NTHREADS) { const int pos = i >> 5, f = i & 31;
            const float invf = 1.0f / __builtin_amdgcn_exp2f(13.287712379549449f * (float)f * (1.0f / 32.0f)); const float ang = (float)pos * invf;
            double rev = (double)ang * 0.15915494309189535; rev -= floor(rev); const float fr_ = (float)rev;
            cosT[i] = __builtin_amdgcn_cosf(fr_); sinT[i] = __builtin_amdgcn_sinf(fr_); }
        __syncthreads();
        LAS float* sv = (LAS float*)l3;
        LAS float* red = sv + 3 * 1024;
        for (int i = tid; i < 3 * 1024; i += NTHREADS) { const int v = i >> 10, k = i & 1023; const float cv = v < 2 ? pp->c[v * 1024 + k] : pp->c_ctx[k]; sv[i] = cv * pg8::sigm(cv); }
        __syncthreads();
        for (int un = bid; un < DEPTH * 48; un += G) { const int l = un / 48, n = (un % 48) * 64 + lane, ks = wave;
            const float* wm = pp->w_mod + (size_t)l * DM * 3072 + (size_t)(ks * 128) * 3072 + n; float a0 = 0.f, a1 = 0.f, a2 = 0.f;
#pragma unroll 8
            for (int k = 0; k < 128; ++k) { const float w = wm[(size_t)k * 3072]; a0 += sv[ks * 128 + k] * w; a1 += sv[1024 + ks * 128 + k] * w; a2 += sv[2048 + ks * 128 + k] * w; }
            red[(ks * 3 + 0) * 64 + lane] = a0; red[(ks * 3 + 1) * 64 + lane] = a1; red[(ks * 3 + 2) * 64 + lane] = a2;
            __syncthreads();
            if (tid < 192) { const int v = tid >> 6, cl = tid & 63; float s = 0.f;
#pragma unroll
                for (int q = 0; q < 8; ++q) s += red[(q * 3 + v) * 64 + cl];
                const int nn = (un % 48) * 64 + cl; MOD[((size_t)l * 3 + v) * 3072 + nn] = s + pp->b_mod[l * 3072 + nn]; }
            __syncthreads();
        }
    } else if (sph == 1) {
    WSL(); int lane = LANE_ID(); asm volatile("" : "+v"(lane));
    for (int r = gw; r < TROWS; r += NGW) { const float* xr = xrow_c(pp->x, pp->ctx, r); const int b = r / TB, mi = (r - b * TB) < CTXL ? 2 : b;
        f32x4 v[4];
#pragma unroll
        for (int j = 0; j < 4; ++j) v[j] = *(const f32x4*)(xr + 4 * lane + 256 * j);
        store_u(v, MOD + mi * 3072, U + (size_t)r * DM, lane); }
    } else if (sph == 2) {
        {
            WSL(); pg8::Gemm g{U, (const bf16_t*)(wsl + WS_WIN + l * SZ_WIN), TROWS, NIN, DM}; pg8::StaticOrder S; S.init(TROWS, NIN, G, bid);
            pg8::EpiIn E{wsl, pp->q_norm + l * 128, pp->k_norm + l * 128, (LAS float*)(l3 + PART_OFF)};
            pg8::gemm_phase<pg8::EpiIn, pg8::StaticOrder, true, true>(l3, g, S, E, wave);
        }
    } else if (sph == 3) {
        {
            WSL(); int lane = LANE_ID(); asm volatile("" : "+v"(lane)); const bf16_t* WPt = (const bf16_t*)(wsl + WS_WP + l * SZ_WP);
            const int nunits = 1024 + (l < DEPTH - 1 ? 16 : 0);
            float kmax; { const float* kn = pp->k_norm + l * 128; kmax = fmaxf(fabsf(kn[lane]), fabsf(kn[lane + 64]));
#pragma unroll
                for (int o_ = 1; o_ < 64; o_ <<= 1) kmax = fmaxf(kmax, __shfl_xor(kmax, o_)); }
            for (int un = bid; un < nunits; un += G) {
                __syncthreads();
                int b, h, rowq, seq;
                if (un < 1024) { b = un >> 9; h = (un >> 6) & 7; rowq = b * TB + CTXL + (un & 63) * 256; seq = TB; }
                else { const int c = un - 1024; b = c >> 3; h = c & 7; rowq = b * TB; seq = CTXL; }
                const size_t qoff = (size_t)rowq * DM + h * 128, koff = (size_t)b * TB * 256 + (h >> 2) * 128;
                att::attn_dense_body((const att::bf16*)(Q + qoff), (const att::bf16*)(Kb + koff), (const att::bf16*)(Vb + koff), (const att::bf16*)(ZA + qoff), (att::bf16*)(Q + qoff), seq, (char*)lds, wave, kmax);
            }
            { unsigned* qctr = (unsigned*)(wsl + WS_BAR) + 8 + l; const int npool = (l < DEPTH - 1) ? (TROWS / 32) * 4 : (NBATCH * SEQ / 32) * 4;
              for (;;) { unsigned wq = 0u; if (lane == 0) wq = __hip_atomic_fetch_add(qctr, 1u, __ATOMIC_RELAXED, __HIP_MEMORY_SCOPE_AGENT);
                  const int wi = __builtin_amdgcn_readfirstlane((int)wq); if (wi >= npool) break;
                  int wu = wi; if (l == DEPTH - 1) { const int rc = wi >> 2, rcf = rc + (CTXL / 32) * (1 + rc / (SEQ / 32)); wu = (rcf << 2) | (wi & 3); }
                  pool_unit(XB, ZB, WPt, pp->pool_scale + l * 512, wu, lane); } }
        }
    } else if (sph == 4) {
        {
            WSL(); pg8::Gemm g{Q, (const bf16_t*)(wsl + WS_WA + l * SZ_WA), TROWS, DM, DM};
            pg8::EpiGate<0> E{wsl};
            { pg8::StaticOrder S; S.init(l == DEPTH - 1 ? NBATCH * SEQ : TROWS, DM, G, bid); S.skip = (l == DEPTH - 1); pg8::gemm_phase<pg8::EpiGate<0>, pg8::StaticOrder, true, true>(l3, g, S, E, wave); }
        }
        {
            WSL(); pg8::Gemm g{ZB, (const bf16_t*)(wsl + WS_WB + l * SZ_WB), TROWS, DM, 512};
            pg8::EpiGate<1> E{wsl};
            { pg8::StaticOrder S; S.init(l == DEPTH - 1 ? NBATCH * SEQ : TROWS, DM, G, bid); S.skip = (l == DEPTH - 1); pg8::gemm_phase<pg8::EpiGate<1>, pg8::StaticOrder, true, true>(l3, g, S, E, wave); }
        }
    } else if (sph == 5) {
        {
            WSL(); pg8::Gemm g{ZA, (const bf16_t*)(wsl + WS_WO + l * SZ_WO), TROWS, DM, DM};
            pg8::EpiRes E{MOD + (size_t)l * 3 * 3072, wsl};
            { pg8::StaticOrder S; S.init(l == DEPTH - 1 ? NBATCH * SEQ : TROWS, DM, G, bid); S.skip = (l == DEPTH - 1); pg8::gemm_phase<pg8::EpiRes, pg8::StaticOrder, true, true>(l3, g, S, E, wave); }
        }
    } else {
        {
            WSL(); int lane = LANE_ID(); asm volatile("" : "+v"(lane)); const float* modl = MOD + (size_t)l * 3 * 3072; const float* lg = pp->ln_g + l * DM; const float* lb = pp->ln_b + l * DM; const bool last = (l == DEPTH - 1);
            const float* xlat = l == 0 ? pp->x : pp->out; const float* xctx = l == 0 ? pp->ctx : CX;
            auto ln_row = [&](const int r, const f32x4 (&vin)[4]) {
                const int b = r / TB, rr = r - b * TB; const bool isctx = rr < CTXL; f32x4 v[4]; float s = 0.f;
#pragma unroll
                for (int j = 0; j < 4; ++j) { v[j] = vin[j]; s += (v[j][0] + v[j][1]) + (v[j][2] + v[j][3]); }
                const float mean = wave_sum(s) * (1.0f / DM); float s2 = 0.f;
#pragma unroll
                for (int j = 0; j < 4; ++j) { v[j] = v[j] - mean; s2 += (v[j][0] * v[j][0] + v[j][1] * v[j][1]) + (v[j][2] * v[j][2] + v[j][3] * v[j][3]); }
                const float rstd = 1.0f / sqrtf(wave_sum(s2) * (1.0f / DM) + EPSV);
                float* xo = isctx ? CX + ((size_t)b * CTXL + rr) * DM : pp->out + ((size_t)b * SEQ + (rr - CTXL)) * DM;
#pragma unroll
                for (int j = 0; j < 4; ++j) { const int c = 4 * lane + 256 * j; v[j] = v[j] * rstd * *(const f32x4*)(lg + c) + *(const f32x4*)(lb + c); *(f32x4*)(xo + c) = v[j]; }
                if (!last) store_u(v, modl + 3 * 3072 + (isctx ? 2 : b) * 3072, U + (size_t)r * DM, lane);
            };
            const int nrows = last ? NBATCH * SEQ : TROWS;
            for (int i0 = gw; i0 < nrows; i0 += 2 * NGW) {
                const int i1 = i0 + NGW; const bool has1 = i1 < nrows;
                const int r0 = last ? i0 + CTXL * (1 + i0 / SEQ) : i0, r1 = has1 ? (last ? i1 + CTXL * (1 + i1 / SEQ) : i1) : r0;
                f32x4 va[4], vb[4]; const float* xa = xrow_c(xlat, xctx, r0); const float* xb_ = xrow_c(xlat, xctx, r1);
                const bf16_t* da = DELTA + (size_t)r0 * DM; const bf16_t* db = DELTA + (size_t)r1 * DM;
#pragma unroll
                for (int j = 0; j < 4; ++j) { const int c = 4 * lane + 256 * j; const f32x4 x0 = *(const f32x4*)(xa + c), x1 = *(const f32x4*)(xb_ + c);
                    const u32x2v d0 = *(const u32x2v*)(da + c), d1 = *(const u32x2v*)(db + c);
                    va[j] = x0 * ALPHA_RES + (f32x4){pg8::bf_lo(d0.x), pg8::bf_hi(d0.x), pg8::bf_lo(d0.y), pg8::bf_hi(d0.y)};
                    vb[j] = x1 * ALPHA_RES + (f32x4){pg8::bf_lo(d1.x), pg8::bf_hi(d1.x), pg8::bf_lo(d1.y), pg8::bf_hi(d1.y)}; }
                ln_row(r0, va); if (has1) ln_row(r1, vb);
            }
        }
    }
    if (ph + 1 < NPH) GRID_SYNC();
    }
}

extern "C" void kernel_launch(void* const* d_in, const int* in_sizes, int n_in, void* d_out, int out_size, void* d_ws, size_t ws_size, hipStream_t stream) {
    static int grid_blocks = 0;
    if (grid_blocks == 0) {
        if (n_in != 16 || ws_size < WS_END2 || out_size != NBATCH * SEQ * DM) { fprintf(stderr, "kernel_launch: unexpected shapes: n_in %d out %d ws %zu (need %zu)\n", n_in, out_size, ws_size, (size_t)WS_END2); grid_blocks = -1; return; }
        int dev = 0, cus = 0, per_cu = 0;
        hipGetDevice(&dev); hipDeviceGetAttribute(&cus, hipDeviceAttributeMultiprocessorCount, dev);
        if (hipFuncSetAttribute((const void*)mega, hipFuncAttributeMaxDynamicSharedMemorySize, LDS_BYTES) != hipSuccess) { fprintf(stderr, "kernel_launch: hipFuncSetAttribute failed\n"); grid_blocks = -1; return; }
        if (hipOccupancyMaxActiveBlocksPerMultiprocessor(&per_cu, (const void*)mega, NTHREADS, LDS_BYTES) != hipSuccess || per_cu < 1) { fprintf(stderr, "kernel_launch: occupancy query gave %d\n", per_cu); per_cu = 1; }
        (void)hipGetLastError();
        grid_blocks = cus * per_cu;
    }
    if (grid_blocks < 0) return;
    Params p{};
    p.x = (const float*)d_in[0]; p.c = (const float*)d_in[1]; p.ctx = (const float*)d_in[2]; p.c_ctx = (const float*)d_in[3]; p.w_mod = (const float*)d_in[4]; p.b_mod = (const float*)d_in[5];
    p.w_in = (const float*)d_in[6]; p.q_norm = (const float*)d_in[7]; p.k_norm = (const float*)d_in[8]; p.w_pool = (const float*)d_in[9]; p.pool_scale = (const float*)d_in[10];
    p.w_br_a = (const float*)d_in[11]; p.w_br_b = (const float*)d_in[12]; p.w_out = (const float*)d_in[13]; p.ln_g = (const float*)d_in[14]; p.ln_b = (const float*)d_in[15];
    p.out = (float*)d_out; p.ws = (unsigned char*)d_ws;
    void* args[] = {&p};
    if (hipMemsetAsync((char*)d_ws + WS_BAR, 0, XCD_BAR_WORDS * 4, stream) != hipSuccess) { fprintf(stderr, "kernel_launch: memset of the barrier word failed\n"); return; }
    hipError_t e = hipLaunchCooperativeKernel((const void*)mega, dim3(grid_blocks), dim3(NTHREADS), args, LDS_BYTES, stream);
    if (e != hipSuccess) fprintf(stderr, "kernel_launch: cooperative launch failed: %s (grid %d)\n", hipGetErrorString(e), grid_blocks);
}
```

```cpp
#include <hip/hip_runtime.h>
#include <hip/hip_bf16.h>
#include <hip/hip_cooperative_groups.h>
#include <cstdio>
#include <cstdint>
namespace cg = cooperative_groups;

constexpr int DM = 1024, NBATCH = 2, SEQ = 16384, CTXL = 256, DEPTH = 4, HD = 128;
constexpr int TB = SEQ + CTXL;
constexpr int TROWS = NBATCH * TB;
constexpr int NIN = 5632;
constexpr float EPSV = 1e-6f;
constexpr float ALPHA_RES = 1.681792830507429f;
constexpr int NWAVES = 8, NTHREADS = 512;

constexpr size_t SZ_WIN = (size_t)NIN * DM * 2, SZ_WA = (size_t)DM * DM * 2, SZ_WB = (size_t)DM * 512 * 2, SZ_WO = SZ_WA, SZ_WP = (size_t)4 * 128 * 128 * 2;
constexpr size_t WS_WIN = 0;
constexpr size_t WS_WA = WS_WIN + DEPTH * SZ_WIN;
constexpr size_t WS_WB = WS_WA + DEPTH * SZ_WA;
constexpr size_t WS_WO = WS_WB + DEPTH * SZ_WB;
constexpr size_t WS_WP = WS_WO + DEPTH * SZ_WO;
constexpr size_t WS_MOD = WS_WP + DEPTH * SZ_WP;
constexpr size_t WS_ROPE = WS_MOD + (size_t)DEPTH * 3 * 3072 * 4;
constexpr size_t WS_CX = WS_ROPE + 2 * 256 * 32 * 4;
constexpr size_t WS_U = WS_CX + (size_t)512 * DM * 4;
constexpr size_t WS_Q = WS_U + (size_t)TROWS * DM * 2;
constexpr size_t WS_K = WS_Q + (size_t)TROWS * DM * 2;
constexpr size_t WS_V = WS_K + (size_t)TROWS * 256 * 2;
constexpr size_t WS_ZA = WS_V + (size_t)TROWS * 256 * 2;
constexpr size_t WS_XB = WS_ZA + (size_t)TROWS * DM * 2;
constexpr size_t WS_ZB = WS_XB + (size_t)TROWS * 512 * 2;
constexpr size_t WS_GA = WS_ZB + (size_t)TROWS * 512 * 2;
constexpr size_t WS_GB = WS_GA + (size_t)TROWS * DM * 2;
constexpr size_t WS_END = WS_GB + (size_t)TROWS * DM * 2;
constexpr size_t WS_BAR = WS_END, WS_END2 = WS_END + 16384;

struct Params {
    const float *x, *c, *ctx, *c_ctx, *w_mod, *b_mod, *w_in, *q_norm, *k_norm, *w_pool, *pool_scale, *w_br_a, *w_br_b, *w_out, *ln_g, *ln_b;
    float* out; unsigned char* ws;
};

namespace pg8 {
#define PG8_LAS __attribute__((address_space(3)))
typedef unsigned short bf16_t;
typedef short bf16x8 __attribute__((ext_vector_type(8)));
typedef float f32x4 __attribute__((ext_vector_type(4)));
typedef unsigned u32x4 __attribute__((ext_vector_type(4)));
constexpr int BM = 256, BK = 64, HALF = 128, HTB = HALF * BK * 2  , STAGE_BYTES = 8 * HTB, NXCD = 8, WGM = 8;

__host__ __device__ __forceinline__ int lds_byte(int r, int c) { const int st = (r >> 4) * 2 + (c >> 5), rr = r & 15, cc = c & 31, ob = rr * 64 + cc * 2; return st * 1024 + (ob ^ (((ob >> 9) & 1) << 5)); }
__host__ __device__ __forceinline__ void stage_rc(int b, int& R, int& C) { const int st = b / 1024, sb = b % 1024, swz = sb ^ (((sb >> 9) & 1) << 5); R = (st >> 1) * 16 + swz / 64; C = (st & 1) * 32 + (swz % 64) / 2; }
__host__ __device__ __forceinline__ int perm32(int rho) { const int n = rho >> 4, i = rho & 15; return 8 * (i >> 2) + 4 * n + (i & 3); }

struct Unit { int pm, pn; };
struct Gemm { const bf16_t* A; const bf16_t* Bt; int M, N, K; };

struct StaticOrder {
    int nM, nN, nwg, G, c, skip;
    __host__ __device__ void init(int M, int N, int G_, int c_) { nM = M / BM; nN = N / BM; nwg = nM * nN; G = G_; c = c_; skip = 0; }
    __host__ __device__ bool next(int i, Unit& u) const {
        const long L = (long)i * G + c; if (L >= nwg) return false;
        int wgid = (int)L; { const int q = nwg / NXCD, r = nwg % NXCD, xcd = wgid % NXCD, off = wgid / NXCD; wgid = (xcd < r ? xcd * (q + 1) : r * (q + 1) + (xcd - r) * q) + off; }
        const int nig = WGM * nN, gid = wgid / nig, fm = gid * WGM, gsz = (nM - fm) < WGM ? (nM - fm) : WGM;
        u.pm = fm + ((wgid % nig) % gsz); u.pn = (wgid % nig) / gsz; if (skip) u.pm += 1 + (u.pm >= 64 ? 1 : 0); return true;
    }
    __device__ __forceinline__ void a_ready(const Unit&) const {}
    __device__ __forceinline__ void done(const Unit&) const {}
};

typedef __bf16 bf16x2_t __attribute__((ext_vector_type(2)));
typedef float f32x2_t __attribute__((ext_vector_type(2)));
__device__ __forceinline__ unsigned cvt_pk_bf16(float lo, float hi) { const f32x2_t v = {lo, hi}; const bf16x2_t r = __builtin_convertvector(v, bf16x2_t); return __builtin_bit_cast(unsigned, r); }
typedef float f32x2 __attribute__((ext_vector_type(2)));
struct LatentOrder {
    StaticOrder S;
    __host__ __device__ void init(int N, int G_, int c_) { S.init(32768, N, G_, c_); }
    __host__ __device__ bool next(int i, Unit& u) const { if (!S.next(i, u)) return false; u.pm += 1 + (u.pm >= 64 ? 1 : 0); return true; }
    __device__ __forceinline__ void a_ready(const Unit&) const {}
    __device__ __forceinline__ void done(const Unit&) const {}
};
__device__ __forceinline__ float bf_lo(unsigned w) { return __uint_as_float(w << 16); }
__device__ __forceinline__ float bf_hi(unsigned w) { return __uint_as_float(w & 0xffff0000u); }
__device__ __forceinline__ float sigm(float x) { return __builtin_amdgcn_rcpf(1.0f + __builtin_amdgcn_exp2f(-1.4426950408889634f * x)); }
typedef unsigned u32x2 __attribute__((ext_vector_type(2)));
template <int ACT> __device__ __forceinline__ float actf(float x) { if (ACT == 1) return x * sigm(x); if (ACT == 2) return sigm(x); return x; }

struct EpiIn {
    static constexpr bool PERM = true, AFTER_DRAIN = false;
    unsigned char* ws; const float *qg, *kg;
    PG8_LAS float* part;
    template <int ACT> __device__ __forceinline__ void plain(const f32x4 (&acc)[2][2][4][2], bf16_t* base, int ldc, int colt, const Unit& u, int wr, int wc, int fr, int fq) const {
        const int row0 = u.pm * BM + wr * 64 + fr, col0 = colt + wc * 32 + 8 * fq;
#pragma unroll
        for (int ai = 0; ai < 2; ++ai)
#pragma unroll
            for (int m = 0; m < 4; ++m) { bf16_t* rowp = base + (size_t)(row0 + ai * HALF + m * 16) * ldc + col0;
#pragma unroll
                for (int bj = 0; bj < 2; ++bj) { const f32x4 v0 = acc[ai][bj][m][0], v1 = acc[ai][bj][m][1]; u32x4 w;
                    w.x = cvt_pk_bf16(actf<ACT>(v0[0]), actf<ACT>(v0[1])); w.y = cvt_pk_bf16(actf<ACT>(v0[2]), actf<ACT>(v0[3]));
                    w.z = cvt_pk_bf16(actf<ACT>(v1[0]), actf<ACT>(v1[1])); w.w = cvt_pk_bf16(actf<ACT>(v1[2]), actf<ACT>(v1[3]));
                    *(u32x4*)(rowp + bj * HALF) = w; } }
    }
    __device__ __forceinline__ void qk(const f32x4 (&acc)[2][2][4][2], const Unit& u, int wr, int wc, int fr, int fq) const {
        const bool isk = (u.pn == 4);
        const float* g = isk ? kg : qg; bf16_t* dst = (bf16_t*)(ws + (isk ? WS_K : WS_Q)); const int ldc = isk ? 256 : 1024;
        const float* cosT = (const float*)(ws + WS_ROPE); const float* sinT = cosT + 256 * 32;
        const int f0 = (wc & 1) * 16 + 4 * fq, axis = wc >> 1, e1 = axis * 64 + f0;
        const f32x4 g1 = *(const f32x4*)(g + e1), g2 = *(const f32x4*)(g + e1 + 32);
#pragma unroll
        for (int ai = 0; ai < 2; ++ai)
#pragma unroll
            for (int m = 0; m < 4; ++m)
#pragma unroll
                for (int bj = 0; bj < 2; ++bj) { const f32x4 a = acc[ai][bj][m][0], b = acc[ai][bj][m][1];
                    float s = (a[0] * a[0] + a[1] * a[1]) + (a[2] * a[2] + a[3] * a[3]) + (b[0] * b[0] + b[1] * b[1]) + (b[2] * b[2] + b[3] * b[3]);
                    s += __shfl_xor(s, 16); s += __shfl_xor(s, 32);
                    if (fq == 0) part[((ai * HALF + wr * 64 + m * 16 + fr) * 2 + bj) * 4 + wc] = s; }
        asm volatile("s_waitcnt lgkmcnt(0)" ::: "memory"); __builtin_amdgcn_s_barrier(); asm volatile("" ::: "memory");
        const int jt = u.pm % 65; const bool rope = (jt != 0);
#pragma unroll
        for (int ai = 0; ai < 2; ++ai)
#pragma unroll
            for (int m = 0; m < 4; ++m) { const int rloc = ai * HALF + wr * 64 + m * 16 + fr;
                const int pos = rope ? (axis ? (16 * m + fr) : ((jt - 1) * 4 + 2 * ai + wr)) : 0;
                f32x4 c4 = *(const f32x4*)(cosT + pos * 32 + f0), s4 = *(const f32x4*)(sinT + pos * 32 + f0);
                if (!rope) { c4 = (f32x4){1.f, 1.f, 1.f, 1.f}; s4 = (f32x4){0.f, 0.f, 0.f, 0.f}; }
#pragma unroll
                for (int bj = 0; bj < 2; ++bj) { const f32x4 p = *(const PG8_LAS f32x4*)(part + (rloc * 2 + bj) * 4);
                    const float rstd = __builtin_amdgcn_rsqf(((p[0] + p[1]) + (p[2] + p[3])) * (1.0f / 128.0f) + 1e-6f);
                    const f32x4 y1 = acc[ai][bj][m][0] * rstd * g1, y2 = acc[ai][bj][m][1] * rstd * g2;
                    f32x4 o1 = y1 * c4 - y2 * s4, o2 = y1 * s4 + y2 * c4;
                    if (!isk) { o1 = o1 * 0.12751743074602458f; o2 = o2 * 0.12751743074602458f; }
                    const int head = isk ? bj : 2 * u.pn + bj;
                    bf16_t* ptr = dst + (size_t)(u.pm * BM + rloc) * ldc + head * 128 + e1;
                    u32x2 w1, w2; w1.x = cvt_pk_bf16(o1[0], o1[1]); w1.y = cvt_pk_bf16(o1[2], o1[3]); w2.x = cvt_pk_bf16(o2[0], o2[1]); w2.y = cvt_pk_bf16(o2[2], o2[3]);
                    *(u32x2*)ptr = w1; *(u32x2*)(ptr + 32) = w2; } }
    }
    __device__ __forceinline__ void operator()(const f32x4 (&acc)[2][2][4][2], const Unit& u, int wr, int wc, int fr, int fq) const {
        const int pn = u.pn;
        if (pn < 5) { qk(acc, u, wr, wc, fr, fq); return; }
        if (pn == 5) plain<0>(acc, (bf16_t*)(ws + WS_V), 256, 0, u, wr, wc, fr, fq);
        else if (pn < 10) plain<1>(acc, (bf16_t*)(ws + WS_ZA), 1024, (pn - 6) * 256, u, wr, wc, fr, fq);
        else if (pn < 12) plain<0>(acc, (bf16_t*)(ws + WS_XB), 512, (pn - 10) * 256, u, wr, wc, fr, fq);
        else if (pn < 14) plain<1>(acc, (bf16_t*)(ws + WS_ZB), 512, (pn - 12) * 256, u, wr, wc, fr, fq);
        else if (pn < 18) plain<2>(acc, (bf16_t*)(ws + WS_GA), 1024, (pn - 14) * 256, u, wr, wc, fr, fq);
        else plain<2>(acc, (bf16_t*)(ws + WS_GB), 1024, (pn - 18) * 256, u, wr, wc, fr, fq);
    }
};
template <int MODE> struct EpiGate {
    static constexpr bool PERM = true, AFTER_DRAIN = false;
    unsigned char* ws;
    __device__ __forceinline__ void operator()(const f32x4 (&acc)[2][2][4][2], const Unit& u, int wr, int wc, int fr, int fq) const {
        bf16_t* GA = (bf16_t*)(ws + WS_GA); const bf16_t* GB = (const bf16_t*)(ws + WS_GB); bf16_t* Y = (bf16_t*)(ws + WS_ZA);
        const int row0 = u.pm * BM + wr * 64 + fr, col0 = u.pn * BM + wc * 32 + 8 * fq;
#pragma unroll
        for (int ai = 0; ai < 2; ++ai)
#pragma unroll
            for (int m = 0; m < 4; ++m) { const size_t off = (size_t)(row0 + ai * HALF + m * 16) * 1024 + col0;
#pragma unroll
                for (int bj = 0; bj < 2; ++bj) { const f32x4 v0 = acc[ai][bj][m][0], v1 = acc[ai][bj][m][1];
                    const u32x4 ga = *(const u32x4*)(GA + off + bj * HALF); u32x4 w;
                    if (MODE == 0) {
                        w.x = cvt_pk_bf16(v0[0] * bf_lo(ga.x), v0[1] * bf_hi(ga.x)); w.y = cvt_pk_bf16(v0[2] * bf_lo(ga.y), v0[3] * bf_hi(ga.y));
                        w.z = cvt_pk_bf16(v1[0] * bf_lo(ga.z), v1[1] * bf_hi(ga.z)); w.w = cvt_pk_bf16(v1[2] * bf_lo(ga.w), v1[3] * bf_hi(ga.w));
                        *(u32x4*)(GA + off + bj * HALF) = w;
                    } else {
                        const u32x4 gb = *(const u32x4*)(GB + off + bj * HALF);
                        w.x = cvt_pk_bf16(bf_lo(ga.x) + v0[0] * bf_lo(gb.x), bf_hi(ga.x) + v0[1] * bf_hi(gb.x)); w.y = cvt_pk_bf16(bf_lo(ga.y) + v0[2] * bf_lo(gb.y), bf_hi(ga.y) + v0[3] * bf_hi(gb.y));
                        w.z = cvt_pk_bf16(bf_lo(ga.z) + v1[0] * bf_lo(gb.z), bf_hi(ga.z) + v1[1] * bf_hi(gb.z)); w.w = cvt_pk_bf16(bf_lo(ga.w) + v1[2] * bf_lo(gb.w), bf_hi(ga.w) + v1[3] * bf_hi(gb.w));
                        *(u32x4*)(Y + off + bj * HALF) = w;
                    } } }
    }
};
struct EpiRes {
    static constexpr bool PERM = true, AFTER_DRAIN = false;
    const float* mod; unsigned char* ws;
    __device__ __forceinline__ void operator()(const f32x4 (&acc)[2][2][4][2], const Unit& u, int wr, int wc, int fr, int fq) const {
        const int b = u.pm / 65, jt = u.pm % 65; bf16_t* dl = (bf16_t*)(ws + WS_GA);
        const float* gate = mod + (jt ? b : 2) * 3072 + 2048;
        const int row0 = u.pm * BM + wr * 64 + fr, col0 = u.pn * BM + wc * 32 + 8 * fq;
        f32x4 gv[2][2];
#pragma unroll
        for (int bj = 0; bj < 2; ++bj)
#pragma unroll
            for (int n = 0; n < 2; ++n) gv[bj][n] = *(const f32x4*)(gate + col0 + bj * HALF + 4 * n);
#pragma unroll
        for (int ai = 0; ai < 2; ++ai)
#pragma unroll
            for (int m = 0; m < 4; ++m) { bf16_t* rowp = dl + (size_t)(row0 + ai * HALF + m * 16) * 1024 + col0;
#pragma unroll
                for (int bj = 0; bj < 2; ++bj) { const f32x4 v0 = acc[ai][bj][m][0] * gv[bj][0], v1 = acc[ai][bj][m][1] * gv[bj][1]; u32x4 w;
                    w.x = cvt_pk_bf16(v0[0], v0[1]); w.y = cvt_pk_bf16(v0[2], v0[3]); w.z = cvt_pk_bf16(v1[0], v1[1]); w.w = cvt_pk_bf16(v1[2], v1[3]);
                    *(u32x4*)(rowp + bj * HALF) = w; } }
    }
};

template <class Epi, class Sched, bool ALIGN_EPI = false, bool SP2 = false>
__device__ __forceinline__ void gemm_phase(PG8_LAS unsigned char* lds, const Gemm g, const Sched& S, const Epi& E, const int wid_in) {
    int lane = __builtin_amdgcn_mbcnt_hi(~0u, __builtin_amdgcn_mbcnt_lo(~0u, 0u)); asm volatile("" : "+v"(lane));
    const int wid = wid_in, tid = wid * 64 + lane, wr = wid >> 2, wc = wid & 3, fr = lane & 15, fq = lane >> 4;
    const int K = g.K, nt = K / BK;
    unsigned voffA[2], voffB[2];
#pragma unroll
    for (int i = 0; i < 2; ++i) { int R, C; stage_rc(tid * 16 + i * 8192, R, C); const int Rb = Epi::PERM ? ((R & ~31) + perm32(R & 31)) : R;
        voffA[i] = (unsigned)(R * K + C) * 2u; voffB[i] = (unsigned)(Rb * K + C) * 2u; }
    const size_t kstep = (size_t)(BK * 2);
    const size_t hstep = (size_t)HALF * K * 2;
    const size_t tstep = 2 * hstep;
    const unsigned ldsw = (unsigned)wid * 1024u;
    const int aoff = lds_byte(wr * 64 + fr, fq * 8), boff = lds_byte(wc * 32 + fr, fq * 8);
#define PG8_SA(b, h) (((b) * 2 + (h)) * HTB)
#define PG8_SB(b, h) ((4 + (b) * 2 + (h)) * HTB)
#define PG8_STAGE(bufoff, gbase, voff) do { _Pragma("unroll") for (int _i = 0; _i < 2; ++_i) \
        __builtin_amdgcn_global_load_lds((const unsigned*)((const char*)(gbase) + (voff)[_i]), (PG8_LAS unsigned*)(lds + (bufoff) + ldsw + _i * 8192), 16, 0, 0); } while (0)
#define PG8_LDA(dst, b, h) do { _Pragma("unroll") for (int m = 0; m < 4; ++m) _Pragma("unroll") for (int k = 0; k < 2; ++k) dst[m][k] = *(const PG8_LAS bf16x8*)(lds + PG8_SA(b, h) + aoff + m * 2048 + k * 1024); } while (0)
#define PG8_LDB(dst, b, h) do { _Pragma("unroll") for (int n = 0; n < 2; ++n) _Pragma("unroll") for (int k = 0; k < 2; ++k) dst[n][k] = *(const PG8_LAS bf16x8*)(lds + PG8_SB(b, h) + boff + n * 2048 + k * 1024); } while (0)
#define PG8_MMA(ai, bj, At, Bt) do { __builtin_amdgcn_s_setprio(1); _Pragma("unroll") for (int m = 0; m < 4; ++m) _Pragma("unroll") for (int n = 0; n < 2; ++n) _Pragma("unroll") for (int k = 0; k < 2; ++k) \
        acc[ai][bj][m][n] = __builtin_amdgcn_mfma_f32_16x16x32_bf16(Bt[n][k], At[m][k], acc[ai][bj][m][n], 0, 0, 0); __builtin_amdgcn_s_setprio(0); } while (0)
#define PG8_WAIT_V(n) asm volatile("s_waitcnt vmcnt(" #n ")" ::: "memory")
#define PG8_WAIT_L(n) asm volatile("s_waitcnt lgkmcnt(" #n ")" ::: "memory")
#define PG8_BAR __builtin_amdgcn_s_barrier()
#define PG8_SCHED __builtin_amdgcn_sched_barrier(0)
    Unit cur, nxt; int ui = 0;
    if (!S.next(0, cur)) return;
    f32x4 acc[2][2][4][2];
#pragma unroll
    for (int a = 0; a < 2; ++a)
#pragma unroll
        for (int b = 0; b < 2; ++b)
#pragma unroll
            for (int m = 0; m < 4; ++m)
#pragma unroll
                for (int n = 0; n < 2; ++n) acc[a][b][m][n] = (f32x4){0.f, 0.f, 0.f, 0.f};
    bf16x8 At[4][2], B0[2][2], B1[2][2];
    const char* cA = (const char*)g.A + (size_t)cur.pm * tstep; const char* cB = (const char*)g.Bt + (size_t)cur.pn * tstep;
    S.a_ready(cur);
    if constexpr (SP2) {
        PG8_STAGE(PG8_SB(0, 0), cB, voffB); PG8_STAGE(PG8_SB(0, 1), cB + hstep, voffB); PG8_STAGE(PG8_SA(0, 0), cA, voffA); PG8_STAGE(PG8_SA(0, 1), cA + hstep, voffA);
        if (wr == 1) PG8_BAR;
        PG8_WAIT_V(2); PG8_BAR;
        PG8_STAGE(PG8_SB(1, 0), cB + kstep, voffB); PG8_STAGE(PG8_SA(1, 0), cA + kstep, voffA); PG8_STAGE(PG8_SB(1, 1), cB + hstep + kstep, voffB);
        PG8_WAIT_V(6); PG8_BAR;
    } else {
        PG8_STAGE(PG8_SB(0, 0), cB, voffB); PG8_STAGE(PG8_SA(0, 0), cA, voffA); PG8_STAGE(PG8_SB(0, 1), cB + hstep, voffB); PG8_STAGE(PG8_SA(0, 1), cA + hstep, voffA);
        if (wr == 1) PG8_BAR;
        PG8_WAIT_V(4); PG8_BAR;
        PG8_STAGE(PG8_SB(1, 0), cB + kstep, voffB); PG8_STAGE(PG8_SA(1, 0), cA + kstep, voffA); PG8_STAGE(PG8_SB(1, 1), cB + hstep + kstep, voffB);
        PG8_WAIT_V(6); PG8_BAR;
    }
    for (;;) {
        const bool has_next = S.next(ui + 1, nxt);
        const char* nA = has_next ? (const char*)g.A + (size_t)nxt.pm * tstep : cA; const char* nB = has_next ? (const char*)g.Bt + (size_t)nxt.pn * tstep : cB;
        for (int t = 0; t < nt; t += 2) {
            const bool last = (t == nt - 2);
            const char* a1 = cA + (size_t)(t + 1) * kstep;
            const char* a2 = last ? nA : cA + (size_t)(t + 2) * kstep; const char* b2 = last ? nB : cB + (size_t)(t + 2) * kstep;
            const char* a3 = a2 + kstep; const char* b3 = b2 + kstep;
            if (last && has_next) S.a_ready(nxt);
            if constexpr (SP2) {
            PG8_LDB(B0, 0, 0); PG8_LDB(B1, 0, 1); PG8_SCHED; PG8_LDA(At, 0, 0); PG8_STAGE(PG8_SA(1, 1), a1 + hstep, voffA);
            PG8_WAIT_V(8); PG8_WAIT_L(0); PG8_BAR; PG8_MMA(0, 0, At, B0); PG8_MMA(0, 1, At, B1); PG8_BAR; PG8_SCHED;
            PG8_LDA(At, 0, 1); PG8_STAGE(PG8_SB(0, 0), b2, voffB); PG8_STAGE(PG8_SB(0, 1), b2 + hstep, voffB); PG8_STAGE(PG8_SA(0, 0), a2, voffA);
            PG8_WAIT_V(8); PG8_WAIT_L(0); PG8_BAR; PG8_MMA(1, 0, At, B0); PG8_MMA(1, 1, At, B1); PG8_BAR; PG8_SCHED;
            PG8_LDB(B0, 1, 0); PG8_LDB(B1, 1, 1); PG8_SCHED; PG8_LDA(At, 1, 0); PG8_STAGE(PG8_SA(0, 1), a2 + hstep, voffA);
            PG8_WAIT_V(8); PG8_WAIT_L(0); PG8_BAR; PG8_MMA(0, 0, At, B0); PG8_MMA(0, 1, At, B1); PG8_BAR; PG8_SCHED;
            PG8_LDA(At, 1, 1); PG8_STAGE(PG8_SB(1, 0), b3, voffB); PG8_STAGE(PG8_SB(1, 1), b3 + hstep, voffB); PG8_STAGE(PG8_SA(1, 0), a3, voffA);
            PG8_WAIT_V(8); PG8_WAIT_L(0); PG8_BAR; PG8_MMA(1, 0, At, B0); PG8_MMA(1, 1, At, B1); PG8_BAR; PG8_SCHED;
            } else {
            PG8_LDB(B0, 0, 0); PG8_SCHED; PG8_LDA(At, 0, 0); PG8_STAGE(PG8_SA(1, 1), a1 + hstep, voffA);
            PG8_WAIT_L(8); PG8_BAR; PG8_WAIT_L(0); PG8_MMA(0, 0, At, B0); PG8_BAR; PG8_SCHED;
            PG8_LDB(B1, 0, 1); PG8_STAGE(PG8_SB(0, 0), b2, voffB);
            PG8_BAR; PG8_WAIT_L(0); PG8_MMA(0, 1, At, B1); PG8_BAR;
            PG8_LDA(At, 0, 1); PG8_STAGE(PG8_SA(0, 0), a2, voffA);
            PG8_BAR; PG8_WAIT_L(0); PG8_MMA(1, 0, At, B0); PG8_BAR; PG8_SCHED;
            PG8_STAGE(PG8_SB(0, 1), b2 + hstep, voffB);
            PG8_WAIT_V(6); PG8_BAR; PG8_MMA(1, 1, At, B1); PG8_BAR;
            PG8_LDB(B0, 1, 0); PG8_SCHED; PG8_LDA(At, 1, 0); PG8_STAGE(PG8_SA(0, 1), a2 + hstep, voffA);
            PG8_WAIT_L(8); PG8_BAR; PG8_WAIT_L(0); PG8_MMA(0, 0, At, B0); PG8_BAR; PG8_SCHED;
            PG8_LDB(B1, 1, 1); PG8_STAGE(PG8_SB(1, 0), b3, voffB);
            PG8_BAR; PG8_WAIT_L(0); PG8_MMA(0, 1, At, B1); PG8_BAR;
            PG8_LDA(At, 1, 1); PG8_STAGE(PG8_SA(1, 0), a3, voffA);
            PG8_BAR; PG8_WAIT_L(0); PG8_MMA(1, 0, At, B0); PG8_BAR; PG8_SCHED;
            PG8_STAGE(PG8_SB(1, 1), b3 + hstep, voffB);
            PG8_WAIT_V(6); PG8_BAR; PG8_MMA(1, 1, At, B1); PG8_BAR;
            }
        }
        if constexpr (ALIGN_EPI) { if (wr == 0) PG8_BAR; }
        if constexpr (!Epi::AFTER_DRAIN) { int l2 = __builtin_amdgcn_mbcnt_hi(~0u, __builtin_amdgcn_mbcnt_lo(~0u, 0u)); asm volatile("" : "+v"(l2));
            E(acc, cur, wr, wc, l2 & 15, l2 >> 4); S.done(cur); }
        if (!has_next) break;
#pragma unroll
        for (int a = 0; a < 2; ++a)
#pragma unroll
            for (int b = 0; b < 2; ++b)
#pragma unroll
                for (int m = 0; m < 4; ++m)
#pragma unroll
                    for (int n = 0; n < 2; ++n) acc[a][b][m][n] = (f32x4){0.f, 0.f, 0.f, 0.f};
        cur = nxt; cA = nA; cB = nB; ++ui;
        if constexpr (ALIGN_EPI) { if (wr == 1) PG8_BAR; }
    }
    PG8_WAIT_V(0);
    if constexpr (!ALIGN_EPI) { if (wr == 0) PG8_BAR; }
    PG8_BAR;
    if constexpr (Epi::AFTER_DRAIN) { E.fused(acc, cur, wr, wc, fr, fq, lds, wid, lane); S.done(cur); }
#undef PG8_SA
#undef PG8_SB
#undef PG8_STAGE
#undef PG8_LDA
#undef PG8_LDB
#undef PG8_MMA
#undef PG8_WAIT_V
#undef PG8_WAIT_L
#undef PG8_BAR
#undef PG8_SCHED
}
}
namespace att {
using bf16 = __hip_bfloat16;
constexpr int   D = 128, NW = 8, QBLK = 32, KVBLK = 64;
constexpr float SCALE = 0.088388347648318440f;
constexpr float THR = 8.f;
constexpr int SDEPTH = 1;
constexpr int LDQ = 1024, LDK = 256, LDO = 1024;
constexpr size_t SHM_V = KVBLK * D * 2, SHM_K = KVBLK * D * 2, SHM_ATTN = 3 * SHM_V + 3 * SHM_K + NW * 64 * 4;
using bf16x8 = __attribute__((ext_vector_type(8))) short;
using s16x4  = __attribute__((ext_vector_type(4))) short;
using f32x16 = __attribute__((ext_vector_type(16))) float;
using f32x8  = __attribute__((ext_vector_type(8))) float;
using u32x4  = __attribute__((ext_vector_type(4))) unsigned;
#define KSWZ(row, colB) ((row) * 256 + ((colB) ^ (((row) & 15) << 4)))
#define SBAR() __builtin_amdgcn_sched_barrier(0)
__device__ __forceinline__ int crow(int r, int hi) { return (r & 3) + 8 * (r >> 2) + 4 * hi; }
__device__ __forceinline__ unsigned cvtpk(float lo, float hi) { return pg8::cvt_pk_bf16(lo, hi); }
template <typename TIn> struct Stage;
template <> struct Stage<bf16>  { using T = bf16x8;
  __device__ static __forceinline__ T ld8(const bf16* p) { return *reinterpret_cast<const bf16x8*>(p); }
  __device__ static __forceinline__ bf16x8 tobf(T x) { return x; } };
template <> struct Stage<float> { using T = f32x8;
  __device__ static __forceinline__ T ld8(const float* p) { return *reinterpret_cast<const f32x8*>(p); }
  __device__ static __forceinline__ bf16x8 tobf(T x) {
    u32x4 w = {cvtpk(x[0], x[1]), cvtpk(x[2], x[3]), cvtpk(x[4], x[5]), cvtpk(x[6], x[7])}; return *reinterpret_cast<bf16x8*>(&w); } };

__device__ __forceinline__ void partialSM(f32x16& p0, f32x16& p1, float& m_reg, float& mn, float& alpha) {
  constexpr float C = SCALE * 1.4426950408889634f;
  float pmax = p0[0]; for (int r = 1; r < 16; ++r) pmax = fmaxf(pmax, p0[r]); for (int r = 0; r < 16; ++r) pmax = fmaxf(pmax, p1[r]);
  { auto rr = __builtin_amdgcn_permlane32_swap(__float_as_uint(pmax), __float_as_uint(pmax), false, false);
    pmax = fmaxf(__uint_as_float(rr[0]), __uint_as_float(rr[1])); }
  if (__builtin_expect(__all(pmax - m_reg <= THR / SCALE), 1)) { mn = m_reg; alpha = 1.f; }
  else { mn = fmaxf(m_reg, pmax); alpha = __builtin_amdgcn_exp2f((m_reg - mn) * C); m_reg = mn; }
  float mnC = -mn * C;
  for (int r = 0; r < 16; ++r) p0[r] = fmaf(p0[r], C, mnC); for (int r = 0; r < 16; ++r) p1[r] = fmaf(p1[r], C, mnC);
  for (int r = 0; r < 16; ++r) p0[r] = __builtin_amdgcn_exp2f(p0[r]);
}
__device__ __forceinline__ void finishSM(f32x16& p0, f32x16& p1, float alpha, float& l_reg, bf16x8& pa0, bf16x8& pa1, bf16x8& pa2, bf16x8& pa3) {
  for (int r = 0; r < 16; ++r) p1[r] = __builtin_amdgcn_exp2f(p1[r]);
  float ps = 0; for (int r = 0; r < 16; ++r) ps += p0[r]; for (int r = 0; r < 16; ++r) ps += p1[r];
  { auto rr = __builtin_amdgcn_permlane32_swap(__float_as_uint(ps), __float_as_uint(ps), false, false);
    ps = __uint_as_float(rr[0]) + __uint_as_float(rr[1]); }
  l_reg = l_reg * alpha + ps;
#define PK4(P, BASE, OUT) do { unsigned a0 = cvtpk(P[BASE + 0], P[BASE + 1]), a1 = cvtpk(P[BASE + 2], P[BASE + 3]);   \
    unsigned b0 = cvtpk(P[BASE + 4], P[BASE + 5]), b1 = cvtpk(P[BASE + 6], P[BASE + 7]);                              \
    auto r0 = __builtin_amdgcn_permlane32_swap(a0, b0, false, false); auto r1 = __builtin_amdgcn_permlane32_swap(a1, b1, false, false); \
    u32x4 w = {r0[0], r1[0], r0[1], r1[1]}; OUT = *reinterpret_cast<bf16x8*>(&w); } while (0)
  PK4(p0, 0, pa0); PK4(p0, 8, pa1); PK4(p1, 0, pa2); PK4(p1, 8, pa3);
#undef PK4
}
__device__ __forceinline__ void partialSM2(f32x16& p0, f32x16& p1, const float negBC) {
  constexpr float C = SCALE * 1.4426950408889634f;
  for (int r = 0; r < 16; ++r) p0[r] = fmaf(p0[r], C, negBC); for (int r = 0; r < 16; ++r) p1[r] = fmaf(p1[r], C, negBC);
  for (int r = 0; r < 16; ++r) p0[r] = __builtin_amdgcn_exp2f(p0[r]);
}
__device__ __forceinline__ void finishSM2(f32x16& p0, f32x16& p1, float& l_reg, bf16x8& pa0, bf16x8& pa1, bf16x8& pa2, bf16x8& pa3) {
  for (int r = 0; r < 16; ++r) p1[r] = __builtin_amdgcn_exp2f(p1[r]);
  float ps = 0; for (int r = 0; r < 16; ++r) ps += p0[r]; for (int r = 0; r < 16; ++r) ps += p1[r];
  l_reg += ps;
#define PK4(P, BASE, OUT) do { unsigned a0 = cvtpk(P[BASE + 0], P[BASE + 1]), a1 = cvtpk(P[BASE + 2], P[BASE + 3]);   \
    unsigned b0 = cvtpk(P[BASE + 4], P[BASE + 5]), b1 = cvtpk(P[BASE + 6], P[BASE + 7]);                              \
    auto r0 = __builtin_amdgcn_permlane32_swap(a0, b0, false, false); auto r1 = __builtin_amdgcn_permlane32_swap(a1, b1, false, false); \
    u32x4 w = {r0[0], r1[0], r0[1], r1[1]}; OUT = *reinterpret_cast<bf16x8*>(&w); } while (0)
  PK4(p0, 0, pa0); PK4(p0, 8, pa1); PK4(p1, 0, pa2); PK4(p1, 8, pa3);
#undef PK4
}
__device__ __forceinline__ void qkt(f32x16& p0, f32x16& p1, const bf16* Ks, const bf16x8* qr, int r32, int hi) {
  p0 = f32x16{}; p1 = f32x16{};
  for (int d0 = 0; d0 < 8; ++d0) { int cb = (d0 * 16 + hi * 8) * 2;
    bf16x8 b0 = *reinterpret_cast<const bf16x8*>((const char*)Ks + KSWZ(r32, cb));
    bf16x8 b1 = *reinterpret_cast<const bf16x8*>((const char*)Ks + KSWZ(32 + r32, cb));
    p0 = __builtin_amdgcn_mfma_f32_32x32x16_bf16(b0, qr[d0], p0, 0, 0, 0);
    p1 = __builtin_amdgcn_mfma_f32_32x32x16_bf16(b1, qr[d0], p1, 0, 0, 0); }
}
__device__ __forceinline__ void partialSM3(f32x16& p0) { for (int r = 0; r < 16; ++r) p0[r] = __builtin_amdgcn_exp2f(p0[r]); }
__device__ __forceinline__ void qkt3(f32x16& p0, f32x16& p1, const bf16* Ks, const bf16x8* qr, int r32, int hi, const f32x16& cinit) {
  { int cb = (hi * 8) * 2;
    bf16x8 b0 = *reinterpret_cast<const bf16x8*>((const char*)Ks + KSWZ(r32, cb));
    bf16x8 b1 = *reinterpret_cast<const bf16x8*>((const char*)Ks + KSWZ(32 + r32, cb));
    p0 = __builtin_amdgcn_mfma_f32_32x32x16_bf16(b0, qr[0], cinit, 0, 0, 0);
    p1 = __builtin_amdgcn_mfma_f32_32x32x16_bf16(b1, qr[0], cinit, 0, 0, 0); }
  for (int d0 = 1; d0 < 8; ++d0) { int cb = (d0 * 16 + hi * 8) * 2;
    bf16x8 b0 = *reinterpret_cast<const bf16x8*>((const char*)Ks + KSWZ(r32, cb));
    bf16x8 b1 = *reinterpret_cast<const bf16x8*>((const char*)Ks + KSWZ(32 + r32, cb));
    p0 = __builtin_amdgcn_mfma_f32_32x32x16_bf16(b0, qr[d0], p0, 0, 0, 0);
    p1 = __builtin_amdgcn_mfma_f32_32x32x16_bf16(b1, qr[d0], p1, 0, 0, 0); }
}
__device__ __forceinline__ int v_st(int k, int c) { const int kk = (k & ~0xC) | ((k & 4) << 1) | ((k & 8) >> 1); return ((kk >> 3) * 4 + (c >> 5)) * 512 + ((kk & 7) * 32 + (c & 31)) * 2; }
__device__ __forceinline__ int v_rd_base(int lane) { return ((lane & 3) << 3) | (((lane >> 2) & 3) << 6) | (((lane >> 4) & 1) << 5) | (((lane >> 5) & 1) << 8); }
constexpr int v_rd_off(int d0, int ks, int half) { return d0 * 512 + ks * 4096 + half * 2048; }
template <int OFF> __device__ __forceinline__ s16x4 tr_read(int vb) {
  s16x4 r; asm volatile("ds_read_b64_tr_b16 %0, %1 offset:%2" : "=&v"(r) : "v"(vb), "i"(OFF) : "memory"); return r;
}
template <int D0> __device__ __forceinline__ void pv_one(f32x16& od, int vb, bf16x8 pa0, bf16x8 pa1, bf16x8 pa2, bf16x8 pa3) {
  const s16x4 l0 = tr_read<v_rd_off(D0, 0, 0)>(vb), h0 = tr_read<v_rd_off(D0, 0, 1)>(vb), l1 = tr_read<v_rd_off(D0, 1, 0)>(vb), h1 = tr_read<v_rd_off(D0, 1, 1)>(vb);
  const s16x4 l2 = tr_read<v_rd_off(D0, 2, 0)>(vb), h2 = tr_read<v_rd_off(D0, 2, 1)>(vb), l3 = tr_read<v_rd_off(D0, 3, 0)>(vb), h3 = tr_read<v_rd_off(D0, 3, 1)>(vb);
  asm volatile("s_waitcnt lgkmcnt(0)" ::: "memory"); SBAR();
#define PK(L, H) (bf16x8){L[0], L[1], L[2], L[3], H[0], H[1], H[2], H[3]}
  od = __builtin_amdgcn_mfma_f32_32x32x16_bf16(pa0, PK(l0, h0), od, 0, 0, 0);
  od = __builtin_amdgcn_mfma_f32_32x32x16_bf16(pa1, PK(l1, h1), od, 0, 0, 0);
  od = __builtin_amdgcn_mfma_f32_32x32x16_bf16(pa2, PK(l2, h2), od, 0, 0, 0);
  od = __builtin_amdgcn_mfma_f32_32x32x16_bf16(pa3, PK(l3, h3), od, 0, 0, 0);
#undef PK
}
__device__ __forceinline__ void pv_d0(f32x16* o, int vb, bf16x8 pa0, bf16x8 pa1, bf16x8 pa2, bf16x8 pa3) {
  pv_one<0>(o[0], vb, pa0, pa1, pa2, pa3); pv_one<1>(o[1], vb, pa0, pa1, pa2, pa3); pv_one<2>(o[2], vb, pa0, pa1, pa2, pa3); pv_one<3>(o[3], vb, pa0, pa1, pa2, pa3);
}

__device__ __forceinline__ void finishSM4(f32x16& p0, f32x16& p1, float& l_reg, bf16x8& pa0, bf16x8& pa1, bf16x8& pa2, bf16x8& pa3) {
  for (int r = 0; r < 16; ++r) p1[r] = __builtin_amdgcn_exp2f(p1[r]);
  float ps = 0; for (int r = 0; r < 16; ++r) ps += p0[r]; for (int r = 0; r < 16; ++r) ps += p1[r];
  l_reg += ps;
#define PK8(P, BASE, OUT) do { u32x4 w = {cvtpk(P[BASE + 0], P[BASE + 1]), cvtpk(P[BASE + 2], P[BASE + 3]), cvtpk(P[BASE + 4], P[BASE + 5]), cvtpk(P[BASE + 6], P[BASE + 7])}; OUT = *reinterpret_cast<bf16x8*>(&w); } while (0)
  PK8(p0, 0, pa0); PK8(p0, 8, pa1); PK8(p1, 0, pa2); PK8(p1, 8, pa3);
#undef PK8
}
__device__ __forceinline__ int v_rd_base2(int lane) { return ((lane & 3) << 3) | (((lane >> 2) & 3) << 6) | (((lane >> 4) & 1) << 5) | (((lane >> 5) & 1) << 11); }
constexpr int v_rd_off2(int d0, int ks, int part) { return d0 * 512 + ks * 4096 + part * 256; }
template <int D0> __device__ __forceinline__ void pv_one2(f32x16& od, int vb, bf16x8 pa0, bf16x8 pa1, bf16x8 pa2, bf16x8 pa3) {
  const s16x4 l0 = tr_read<v_rd_off2(D0, 0, 0)>(vb), h0 = tr_read<v_rd_off2(D0, 0, 1)>(vb), l1 = tr_read<v_rd_off2(D0, 1, 0)>(vb), h1 = tr_read<v_rd_off2(D0, 1, 1)>(vb);
  const s16x4 l2 = tr_read<v_rd_off2(D0, 2, 0)>(vb), h2 = tr_read<v_rd_off2(D0, 2, 1)>(vb), l3 = tr_read<v_rd_off2(D0, 3, 0)>(vb), h3 = tr_read<v_rd_off2(D0, 3, 1)>(vb);
  asm volatile("s_waitcnt lgkmcnt(0)" ::: "memory"); SBAR();
#define PK(L, H) (bf16x8){L[0], L[1], L[2], L[3], H[0], H[1], H[2], H[3]}
  od = __builtin_amdgcn_mfma_f32_32x32x16_bf16(PK(l0, h0), pa0, od, 0, 0, 0);
  od = __builtin_amdgcn_mfma_f32_32x32x16_bf16(PK(l1, h1), pa1, od, 0, 0, 0);
  od = __builtin_amdgcn_mfma_f32_32x32x16_bf16(PK(l2, h2), pa2, od, 0, 0, 0);
  od = __builtin_amdgcn_mfma_f32_32x32x16_bf16(PK(l3, h3), pa3, od, 0, 0, 0);
#undef PK
}
__device__ __forceinline__ void pv_d02(f32x16* o, int vb, bf16x8 pa0, bf16x8 pa1, bf16x8 pa2, bf16x8 pa3) {
  pv_one2<0>(o[0], vb, pa0, pa1, pa2, pa3); pv_one2<1>(o[1], vb, pa0, pa1, pa2, pa3); pv_one2<2>(o[2], vb, pa0, pa1, pa2, pa3); pv_one2<3>(o[3], vb, pa0, pa1, pa2, pa3);
}
__device__ __forceinline__ void attn_dense_body(const bf16* Qb, const bf16* __restrict__ Kh, const bf16* __restrict__ Vh, const bf16* __restrict__ Zb,
                                                bf16* Ob, int seq, char* lds, const int wid_in, const float kmax, __attribute__((address_space(3))) unsigned char* lds3) {
  using St = Stage<bf16>; using SQ = Stage<bf16>; using TQ = bf16;
  int lane = __builtin_amdgcn_mbcnt_hi(~0u, __builtin_amdgcn_mbcnt_lo(~0u, 0u)); asm volatile("" : "+v"(lane));
  const int wid = wid_in, tid = wid * 64 + lane, r32 = lane & 31, hi = lane >> 5;
  bf16* V_lds = (bf16*)lds; bf16* K_lds = (bf16*)(lds + 3 * SHM_V);
  float l_reg = 0; f32x16 o[4] = {}; bf16x8 qr[8];
  const TQ* Qw = Qb + (long)(wid * QBLK + r32) * LDQ + hi * 8;
#pragma unroll
  for (int d0 = 0; d0 < 8; ++d0) qr[d0] = SQ::tobf(SQ::ld8(Qw + d0 * 16));
  float negBC;
  { float ss = 0.f;
#pragma unroll
    for (int d0 = 0; d0 < 8; ++d0)
#pragma unroll
      for (int e = 0; e < 8; ++e) { const float qv = __uint_as_float((unsigned)(unsigned short)qr[d0][e] << 16); ss = fmaf(qv, qv, ss); }
    auto rr = __builtin_amdgcn_permlane32_swap(__float_as_uint(ss), __float_as_uint(ss), false, false);
    ss = __uint_as_float(rr[0]) + __uint_as_float(rr[1]);
    negBC = -(sqrtf(ss) * kmax * (11.313708498984761f * 1.01f) + 0.07f); }
  f32x16 cinit; for (int r = 0; r < 16; ++r) cinit[r] = negBC;
  const int vb0 = (int)(uintptr_t)V_lds + v_rd_base2(lane);
  int koff0, koff1, voff0, voff1;
  { const int rk0 = 8 * wid + (lane >> 4), rk1 = rk0 + 4; koff0 = rk0 * (LDK * 2) + (((lane & 15) ^ (rk0 & 15)) << 4); koff1 = rk1 * (LDK * 2) + (((lane & 15) ^ (rk1 & 15)) << 4);
    const int st0 = 4 * wid + (lane >> 5), st1 = st0 + 2, q8 = (lane & 31) >> 2;
    const int kk0 = ((st0 >> 2) << 3) | q8, kk1 = ((st1 >> 2) << 3) | q8;
    const int ky0 = (kk0 & ~0xC) | ((kk0 & 4) << 1) | ((kk0 & 8) >> 1), ky1 = (kk1 & ~0xC) | ((kk1 & 4) << 1) | ((kk1 & 8) >> 1);
    voff0 = ky0 * (LDK * 2) + ((st0 & 3) * 32 + (lane & 3) * 8) * 2; voff1 = ky1 * (LDK * 2) + ((st1 & 3) * 32 + (lane & 3) * 8) * 2; }
#define SDMA(s, k0) do { const char* kg_ = (const char*)(Kh + (long)(k0) * LDK); const char* vg_ = (const char*)(Vh + (long)(k0) * LDK); \
    __attribute__((address_space(3))) unsigned char* kd_ = lds3 + 3 * (int)SHM_V + (s) * (int)SHM_K + wid * 2048; __attribute__((address_space(3))) unsigned char* vd_ = lds3 + (s) * (int)SHM_V + wid * 2048; \
    __builtin_amdgcn_global_load_lds((const unsigned*)(kg_ + koff0), (__attribute__((address_space(3))) unsigned*)kd_, 16, 0, 0); \
    __builtin_amdgcn_global_load_lds((const unsigned*)(kg_ + koff1), (__attribute__((address_space(3))) unsigned*)(kd_ + 1024), 16, 0, 0); \
    __builtin_amdgcn_global_load_lds((const unsigned*)(vg_ + voff0), (__attribute__((address_space(3))) unsigned*)vd_, 16, 0, 0); \
    __builtin_amdgcn_global_load_lds((const unsigned*)(vg_ + voff1), (__attribute__((address_space(3))) unsigned*)(vd_ + 1024), 16, 0, 0); } while (0)
#define DWAIT() asm volatile("s_waitcnt vmcnt(0)" ::: "memory")
  f32x16 pA0, pA1, pB0, pB1; bf16x8 pa0, pa1, pa2, pa3; const int NT = seq / KVBLK;
  SDMA(0, 0); DWAIT(); __syncthreads();
  SDMA(1, KVBLK);
  qkt3(pA0, pA1, K_lds, qr, r32, hi, cinit); partialSM3(pA0);
  DWAIT(); __syncthreads();
  int sP = 0, sC = 1, sN = 2;
#define KSLOT(s) ((bf16*)((char*)K_lds + (s) * (int)SHM_K))
#define ROT() do { const int t_ = sP; sP = sC; sC = sN; sN = t_; } while (0)
  for (int j = 1; j + 1 < NT; j += 2) {
    SDMA(sN, (j + 1) * KVBLK);
    SBAR(); qkt3(pB0, pB1, KSLOT(sC), qr, r32, hi, cinit);
    finishSM4(pA0, pA1, l_reg, pa0, pa1, pa2, pa3); SBAR();
    pv_d02(o, vb0 + sP * (int)SHM_V, pa0, pa1, pa2, pa3); partialSM3(pB0);
    DWAIT(); __syncthreads(); ROT();
    SDMA(sN, (j + 2) * KVBLK);
    SBAR(); qkt3(pA0, pA1, KSLOT(sC), qr, r32, hi, cinit);
    finishSM4(pB0, pB1, l_reg, pa0, pa1, pa2, pa3); SBAR();
    pv_d02(o, vb0 + sP * (int)SHM_V, pa0, pa1, pa2, pa3); partialSM3(pA0);
    DWAIT(); __syncthreads(); ROT();
  }
  SBAR(); qkt3(pB0, pB1, KSLOT(sC), qr, r32, hi, cinit);
  finishSM4(pA0, pA1, l_reg, pa0, pa1, pa2, pa3); SBAR();
  pv_d02(o, vb0 + sP * (int)SHM_V, pa0, pa1, pa2, pa3); partialSM3(pB0);
  finishSM4(pB0, pB1, l_reg, pa0, pa1, pa2, pa3); SBAR();
  pv_d02(o, vb0 + sC * (int)SHM_V, pa0, pa1, pa2, pa3);
#undef KSLOT
#undef ROT
#undef SDMA
#undef DWAIT
  { auto rr = __builtin_amdgcn_permlane32_swap(__float_as_uint(l_reg), __float_as_uint(l_reg), false, false); l_reg = __uint_as_float(rr[0]) + __uint_as_float(rr[1]); }
  const float rl = __builtin_amdgcn_rcpf(l_reg);
  { int lb = (wid * QBLK + r32) * LDO + 4 * hi; asm volatile("" : "+v"(lb));
    unsigned short* Ow = (unsigned short*)Ob + lb; const unsigned short* Zw = (const unsigned short*)Zb + lb;
#pragma unroll
    for (int d0 = 0; d0 < 4; ++d0)
#pragma unroll
      for (int g = 0; g < 4; ++g) { const int co = d0 * 32 + 8 * g; const unsigned long long zz = *(const unsigned long long*)(Zw + co);
        const float z0 = __uint_as_float((unsigned)(zz << 16)), z1 = __uint_as_float((unsigned)zz & 0xffff0000u), z2 = __uint_as_float((unsigned)(zz >> 32) << 16), z3 = __uint_as_float((unsigned)(zz >> 32) & 0xffff0000u);
        const unsigned w0 = cvtpk(o[d0][4 * g + 0] * rl * z0, o[d0][4 * g + 1] * rl * z1), w1 = cvtpk(o[d0][4 * g + 2] * rl * z2, o[d0][4 * g + 3] * rl * z3);
        *(unsigned long long*)(Ow + co) = (unsigned long long)w0 | ((unsigned long long)w1 << 32); } }
}
}

typedef unsigned short bf16_t;
typedef float f32x4 __attribute__((ext_vector_type(4)));
typedef unsigned u32x4 __attribute__((ext_vector_type(4)));
typedef unsigned u32x2v __attribute__((ext_vector_type(2)));
typedef short bf16x8v __attribute__((ext_vector_type(8)));
typedef float f32x16v __attribute__((ext_vector_type(16)));
#define LAS __attribute__((address_space(3)))
#define XB_TMO      128
#define XB_XCNT(j)  (256  + 64 * (j))
#define XB_XSUB(j)  (1280 + 64 * (j))
#define XB_XGEN(j)  (2304 + 64 * (j))
#define XB_TOP      3328
#define XB_TOPGEN   3392
#define XCD_BAR_WORDS 3456
#define XB_SPIN_CAP (1u << 18)

__device__ __forceinline__ unsigned xb_ld(unsigned* p)              { return __hip_atomic_load(p, __ATOMIC_RELAXED, __HIP_MEMORY_SCOPE_AGENT); }
__device__ __forceinline__ unsigned xb_add(unsigned* p, unsigned v) { return __hip_atomic_fetch_add(p, v, __ATOMIC_RELAXED, __HIP_MEMORY_SCOPE_AGENT); }
__device__ __forceinline__ unsigned xb_xcc_id() { return (unsigned)__builtin_amdgcn_s_getreg((3 << 11) | 20) & 0xFu; }
#define XB_SPIN(cond, bar) do { unsigned _sp = 0; while (cond) { __builtin_amdgcn_s_sleep(1); \
    if ((++_sp & 255u) == 0u) { if (xb_ld(&(bar)[XB_TMO])) break; if (_sp > XB_SPIN_CAP) { atomicAdd(&(bar)[XB_TMO], 1u); break; } } } } while (0)

struct XcdBarrier {
    unsigned* bar; unsigned x;
    volatile LAS unsigned* st;
};

__device__ __forceinline__ XcdBarrier xcd_barrier_post(unsigned* bar, volatile LAS unsigned* st, const bool leader) {
    XcdBarrier b; b.bar = bar; b.x = xb_xcc_id(); b.st = st;
    if (leader) (void)xb_add(&bar[XB_XCNT(b.x)], 1u);
    return b;
}
__device__ __forceinline__ void xcd_barrier_complete(unsigned* bar, unsigned x, unsigned& nloc, unsigned& nx) {
    const unsigned G = gridDim.x * gridDim.y * gridDim.z;
    unsigned sum, cnt, mine, sp = 0u;
    for (;;) {
        sum = 0u; cnt = 0u; mine = 0u;
#pragma unroll
        for (unsigned j = 0; j < 16; ++j) { const unsigned c = xb_ld(&bar[XB_XCNT(j)]); sum += c; cnt += (c > 0u) ? 1u : 0u; mine = (j == x) ? c : mine; }
        if (sum == G) break;
        __builtin_amdgcn_s_sleep(1);
        if ((++sp & 255u) == 0u) { if (xb_ld(&bar[XB_TMO])) break; if (sp > XB_SPIN_CAP) { atomicAdd(&bar[XB_TMO], 1u); break; } }
    }
    nloc = mine > 0u ? mine : 1u; nx = cnt > 0u ? cnt : 1u;
}

__device__ __forceinline__ void xcd_barrier(const XcdBarrier& b, const bool leader) {
    asm volatile("s_waitcnt vmcnt(0)" ::: "memory");
    __syncthreads();
    if (leader) {
        unsigned* bar = b.bar;
        __builtin_amdgcn_s_waitcnt(0);
        unsigned nloc = b.st[0], nx = b.st[1];
        if (nloc == 0u) { xcd_barrier_complete(bar, b.x, nloc, nx); b.st[0] = nloc; b.st[1] = nx; }
        const unsigned old = xb_add(&bar[XB_XSUB(b.x)], 1u);
        const unsigned gen = old / nloc;
        if (old + 1u == (gen + 1u) * nloc) {
            __builtin_amdgcn_fence(__ATOMIC_RELEASE, "agent");
            asm volatile("s_waitcnt vmcnt(0)" ::: "memory");
            const unsigned og = xb_add(&bar[XB_TOP], 1u);
            const unsigned tg = og / nx;
            if (og + 1u == (tg + 1u) * nx) xb_add(&bar[XB_TOPGEN], 1u);
            else XB_SPIN(xb_ld(&bar[XB_TOPGEN]) == tg, bar);
            __builtin_amdgcn_fence(__ATOMIC_ACQUIRE, "agent");
            xb_add(&bar[XB_XGEN(b.x)], 1u);
            asm volatile("s_waitcnt vmcnt(0)" ::: "memory");
        } else {
            XB_SPIN(xb_ld(&bar[XB_XGEN(b.x)]) == gen, bar);
            __builtin_amdgcn_fence(__ATOMIC_ACQUIRE, "agent");
            asm volatile("s_waitcnt vmcnt(0)" ::: "memory");
        }
    }
    __syncthreads();
}

constexpr int RING_BYTES = pg8::STAGE_BYTES;
constexpr int PART_OFF = RING_BYTES;
constexpr int XBST_OFF = RING_BYTES + 8192;
constexpr int LDS_BYTES = RING_BYTES + 8192 + 16;

__device__ __forceinline__ unsigned pk2(float a, float b) { return pg8::cvt_pk_bf16(a, b); }
__device__ __forceinline__ float wave_sum(float v) {
#pragma unroll
    for (int o = 1; o < 64; o <<= 1) v += __shfl_xor(v, o);
    return v;
}
__device__ __forceinline__ const float* xrow_c(const float* lat, const float* cx, int r) {
    const int b = r / TB, rr = r - b * TB;
    return rr < CTXL ? cx + ((size_t)b * CTXL + rr) * DM : lat + ((size_t)b * SEQ + (rr - CTXL)) * DM;
}
__device__ __forceinline__ int qk_src(int c) { const int h = c & ~127, cp = c & 127;
    return h + ((cp >> 6) & 1) * 64 + ((cp >> 2) & 1) * 32 + ((cp >> 5) & 1) * 16 + ((cp >> 3) & 3) * 4 + (cp & 3); }

__device__ __forceinline__ void transpose_item(const float* W, int K, int N, bf16_t* WT, LAS float* scr, int item, int lane, int nperm) {
    const int nblk = N / 32, kb = item / nblk, nb = item % nblk, k0 = 64 * kb, n0 = 32 * nb;
    const int cdst = n0 + (lane & 31), csrc = cdst < nperm ? qk_src(cdst) : cdst;
#pragma unroll 8
    for (int i = 0; i < 32; ++i) { const int kk = 2 * i + (lane >> 5); scr[kk * 33 + (lane & 31)] = W[(size_t)(k0 + kk) * N + csrc]; }
    asm volatile("s_waitcnt lgkmcnt(0)" ::: "memory");
    const int c = lane & 7;
#pragma unroll
    for (int j = 0; j < 4; ++j) { const int n = (lane >> 3) + 8 * j; const LAS float* s = scr + (8 * c) * 33 + n;
        u32x4 o; o.x = pk2(s[0 * 33], s[1 * 33]); o.y = pk2(s[2 * 33], s[3 * 33]); o.z = pk2(s[4 * 33], s[5 * 33]); o.w = pk2(s[6 * 33], s[7 * 33]);
        *(u32x4*)(WT + (size_t)(n0 + n) * K + k0 + 8 * c) = o; }
    asm volatile("s_waitcnt lgkmcnt(0)" ::: "memory");
}

template <int GI> __device__ __forceinline__ void pool_unit_t(const bf16_t* XB, bf16_t* ZB, const bf16_t* WPt, const float* pscale, int R0, int lane) {
    constexpr int g = GI, a = 1 << GI;
    const int pm = R0 >> 8, b = pm / 65, jt = pm % 65;
    const int lo = b * TB + (jt ? CTXL : 0), hiR = jt ? (b + 1) * TB : b * TB + CTXL;
    const int r32 = lane & 31, hh = lane >> 5, t = R0 + r32;
    const int s0 = max(t - a, lo), s1 = min(t + a - 1, hiR - 1); const float inv = 1.0f / (float)(s1 - s0 + 1);
    f32x16v acc0 = {}, acc1 = {}, acc2 = {}, acc3 = {};
    const bf16_t* xb = XB + g * 128 + hh * 8;
    const bf16_t* wp = WPt + (size_t)(g * 128 + r32) * 128 + hh * 8;
    float wq[2 * a]; int rq[2 * a];
#pragma unroll
    for (int q = 0; q < 2 * a; ++q) { const int rr = t - a + q; const bool ok = (rr >= lo) && (rr < hiR); wq[q] = ok ? inv : 0.f; rq[q] = ok ? rr : t; }
#pragma unroll 1
    for (int kk = 0; kk < 8; ++kk) {
        u32x4 wv[2 * a];
#pragma unroll
        for (int q = 0; q < 2 * a; ++q) wv[q] = *(const u32x4*)(xb + (size_t)rq[q] * 512 + kk * 16);
        const u32x4 w = *(const u32x4*)(xb + (size_t)t * 512 + kk * 16);
        const bf16x8v w0 = *(const bf16x8v*)(wp + kk * 16), w1 = *(const bf16x8v*)(wp + 32 * 128 + kk * 16), w2 = *(const bf16x8v*)(wp + 64 * 128 + kk * 16), w3 = *(const bf16x8v*)(wp + 96 * 128 + kk * 16);
        float s[8] = {0.f, 0.f, 0.f, 0.f, 0.f, 0.f, 0.f, 0.f};
#pragma unroll
        for (int q = 0; q < 2 * a; ++q) { const float f = wq[q]; const u32x4 v = wv[q];
            s[0] += f * pg8::bf_lo(v.x); s[1] += f * pg8::bf_hi(v.x); s[2] += f * pg8::bf_lo(v.y); s[3] += f * pg8::bf_hi(v.y); s[4] += f * pg8::bf_lo(v.z); s[5] += f * pg8::bf_hi(v.z); s[6] += f * pg8::bf_lo(v.w); s[7] += f * pg8::bf_hi(v.w); }
        u32x4 mf; mf.x = pk2(s[0] - pg8::bf_lo(w.x), s[1] - pg8::bf_hi(w.x)); mf.y = pk2(s[2] - pg8::bf_lo(w.y), s[3] - pg8::bf_hi(w.y));
        mf.z = pk2(s[4] - pg8::bf_lo(w.z), s[5] - pg8::bf_hi(w.z)); mf.w = pk2(s[6] - pg8::bf_lo(w.w), s[7] - pg8::bf_hi(w.w));
        const bf16x8v mfrag = *reinterpret_cast<bf16x8v*>(&mf);
        acc0 = __builtin_amdgcn_mfma_f32_32x32x16_bf16(w0, mfrag, acc0, 0, 0, 0); acc1 = __builtin_amdgcn_mfma_f32_32x32x16_bf16(w1, mfrag, acc1, 0, 0, 0);
        acc2 = __builtin_amdgcn_mfma_f32_32x32x16_bf16(w2, mfrag, acc2, 0, 0, 0); acc3 = __builtin_amdgcn_mfma_f32_32x32x16_bf16(w3, mfrag, acc3, 0, 0, 0);
    }
    bf16_t* zrow = ZB + (size_t)t * 512 + g * 128; const float* ps = pscale + g * 128;
#define POOL_OUT(ACC, NS) do { _Pragma("unroll") for (int q = 0; q < 4; ++q) { const int n0 = (NS) * 32 + 8 * q + 4 * hh; const u32x2v z = *(const u32x2v*)(zrow + n0); const f32x4 p4 = *(const f32x4*)(ps + n0); \
        u32x2v o; o.x = pk2(ACC[4 * q + 0] * p4[0] * pg8::bf_lo(z.x), ACC[4 * q + 1] * p4[1] * pg8::bf_hi(z.x)); o.y = pk2(ACC[4 * q + 2] * p4[2] * pg8::bf_lo(z.y), ACC[4 * q + 3] * p4[3] * pg8::bf_hi(z.y)); \
        *(u32x2v*)(zrow + n0) = o; } } while (0)
    POOL_OUT(acc0, 0); POOL_OUT(acc1, 1); POOL_OUT(acc2, 2); POOL_OUT(acc3, 3);
#undef POOL_OUT
}
__device__ __forceinline__ void pool_unit(const bf16_t* XB, bf16_t* ZB, const bf16_t* WPt, const float* pscale, int wu, int lane) {
    const int g = wu & 3, R0 = (wu >> 2) * 32;
    if (g == 0) pool_unit_t<0>(XB, ZB, WPt, pscale, R0, lane); else if (g == 1) pool_unit_t<1>(XB, ZB, WPt, pscale, R0, lane);
    else if (g == 2) pool_unit_t<2>(XB, ZB, WPt, pscale, R0, lane); else pool_unit_t<3>(XB, ZB, WPt, pscale, R0, lane);
}

__device__ __forceinline__ void store_u(const f32x4 (&v)[4], const float* mod, bf16_t* urow, int lane) {
#pragma unroll
    for (int j = 0; j < 4; ++j) { const int c = 4 * lane + 256 * j; const f32x4 sh = *(const f32x4*)(mod + c), sc = *(const f32x4*)(mod + 1024 + c);
        const f32x4 u = v[j] * (sc + 1.0f) + sh; u32x2v o; o.x = pk2(u[0], u[1]); o.y = pk2(u[2], u[3]); *(u32x2v*)(urow + c) = o; }
}

__global__ void __launch_bounds__(NTHREADS, 2) mega(Params P) {
    extern __shared__ __attribute__((aligned(16))) unsigned char lds[];
    cg::grid_group grid = cg::this_grid();
    const int wave = __builtin_amdgcn_readfirstlane(threadIdx.x >> 6);
#define LANE_ID() (__builtin_amdgcn_mbcnt_hi(~0u, __builtin_amdgcn_mbcnt_lo(~0u, 0u)))
    const int G = gridDim.x, bid = blockIdx.x, gw = bid * NWAVES + wave, NGW = G * NWAVES;
#define GRID_SYNC() xcd_barrier(xbar, wave == 0 && LANE_ID() == 0)
#define CAS __attribute__((address_space(4)))
#define WSL() const CAS Params* pp = (const CAS Params*)__builtin_amdgcn_kernarg_segment_ptr(); asm volatile("" : "+s"(pp)); unsigned char* wsl = pp->ws; asm volatile("" : "+s"(wsl))
#define U ((bf16_t*)(wsl + WS_U))
#define Q ((bf16_t*)(wsl + WS_Q))
#define Kb ((bf16_t*)(wsl + WS_K))
#define Vb ((bf16_t*)(wsl + WS_V))
#define ZA ((bf16_t*)(wsl + WS_ZA))
#define XB ((bf16_t*)(wsl + WS_XB))
#define ZB ((bf16_t*)(wsl + WS_ZB))
#define MOD ((float*)(wsl + WS_MOD))
#define CX ((float*)(wsl + WS_CX))
#define DELTA ((const bf16_t*)(wsl + WS_GA))
    LAS unsigned char* l3 = (LAS unsigned char*)lds;
    const CAS Params* pp0 = (const CAS Params*)__builtin_amdgcn_kernarg_segment_ptr();
    { volatile LAS unsigned* st = (volatile LAS unsigned*)(l3 + XBST_OFF); if (wave == 0 && LANE_ID() == 0) { st[0] = 0u; st[1] = 0u; st[2] = 0u; st[3] = 0u; } }
    __syncthreads();
    XcdBarrier xbar = xcd_barrier_post((unsigned*)(pp0->ws + WS_BAR), (volatile LAS unsigned*)(l3 + XBST_OFF), wave == 0 && LANE_ID() == 0);
    grid.sync();

    constexpr int NPH = 2 + 5 * DEPTH;
#pragma unroll 1
    for (int ph = 0; ph < NPH; ++ph) {
    const int l = ph < 2 ? 0 : (ph - 2) / 5, sph = ph < 2 ? ph : 2 + (ph - 2) % 5;
    if (sph == 0) {
        WSL(); int lane = LANE_ID(); asm volatile("" : "+v"(lane)); const int tid = wave * 64 + lane; unsigned char* ws = wsl; float* cosT = (float*)(wsl + WS_ROPE); float* sinT = cosT + 256 * 32;
        LAS float* scr = (LAS float*)(l3 + wave * 16384);
        constexpr int I_IN = (DM / 64) * (NIN / 32), I_A = (DM / 64) * (DM / 32), I_B = (512 / 64) * (DM / 32), I_O = I_A, I_P = (128 / 64) * (128 / 32);
        constexpr int PER_L = I_IN + I_A + I_B + I_O + 4 * I_P;
        for (int it = gw; it < DEPTH * PER_L; it += NGW) {
            const int l = it / PER_L; int r = it - l * PER_L;
            if (r < I_IN) { transpose_item(pp->w_in + (size_t)l * DM * NIN, DM, NIN, (bf16_t*)(ws + WS_WIN + l * SZ_WIN), scr, r, lane, 1280); continue; } r -= I_IN;
            if (r < I_A) { transpose_item(pp->w_br_a + (size_t)l * DM * DM, DM, DM, (bf16_t*)(ws + WS_WA + l * SZ_WA), scr, r, lane, 0); continue; } r -= I_A;
            if (r < I_B) { transpose_item(pp->w_br_b + (size_t)l * 512 * DM, 512, DM, (bf16_t*)(ws + WS_WB + l * SZ_WB), scr, r, lane, 0); continue; } r -= I_B;
            if (r < I_O) { transpose_item(pp->w_out + (size_t)l * DM * DM, DM, DM, (bf16_t*)(ws + WS_WO + l * SZ_WO), scr, r, lane, 0); continue; } r -= I_O;
            const int g = r / I_P; r -= g * I_P;
            transpose_item(pp->w_pool + ((size_t)l * 4 + g) * 128 * 128, 128, 128, (bf16_t*)(ws + WS_WP + l * SZ_WP) + (size_t)g * 128 * 128, scr, r, lane, 0);
        }
        for (int i = bid * NTHREADS + tid; i < 256 * 32; i += G * NTHREADS) { const int pos = i >> 5, f = i & 31;
            const float invf = 1.0f / __builtin_amdgcn_exp2f(13.287712379549449f * (float)f * (1.0f / 32.0f)); const float ang = (float)pos * invf;
            double rev = (double)ang * 0.15915494309189535; rev -= floor(rev); const float fr_ = (float)rev;
            cosT[i] = __builtin_amdgcn_cosf(fr_); sinT[i] = __builtin_amdgcn_sinf(fr_); }
        __syncthreads();
        LAS float* sv = (LAS float*)l3;
        LAS float* red = sv + 3 * 1024;
        for (int i = tid; i < 3 * 1024; i += NTHREADS) { const int v = i >> 10, k = i & 1023; const float cv = v < 2 ? pp->c[v * 1024 + k] : pp->c_ctx[k]; sv[i] = cv * pg8::sigm(cv); }
        __syncthreads();
        for (int un = bid; un < DEPTH * 48; un += G) { const int l = un / 48, n = (un % 48) * 64 + lane, ks = wave;
            const float* wm = pp->w_mod + (size_t)l * DM * 3072 + (size_t)(ks * 128) * 3072 + n; float a0 = 0.f, a1 = 0.f, a2 = 0.f;
#pragma unroll 8
            for (int k = 0; k < 128; ++k) { const float w = wm[(size_t)k * 3072]; a0 += sv[ks * 128 + k] * w; a1 += sv[1024 + ks * 128 + k] * w; a2 += sv[2048 + ks * 128 + k] * w; }
            red[(ks * 3 + 0) * 64 + lane] = a0; red[(ks * 3 + 1) * 64 + lane] = a1; red[(ks * 3 + 2) * 64 + lane] = a2;
            __syncthreads();
            if (tid < 192) { const int v = tid >> 6, cl = tid & 63; float s = 0.f;
#pragma unroll
                for (int q = 0; q < 8; ++q) s += red[(q * 3 + v) * 64 + cl];
                const int nn = (un % 48) * 64 + cl; MOD[((size_t)l * 3 + v) * 3072 + nn] = s + pp->b_mod[l * 3072 + nn]; }
            __syncthreads();
        }
    } else if (sph == 1) {
    WSL(); int lane = LANE_ID(); asm volatile("" : "+v"(lane));
    for (int r = gw; r < TROWS; r += NGW) { const float* xr = xrow_c(pp->x, pp->ctx, r); const int b = r / TB, mi = (r - b * TB) < CTXL ? 2 : b;
        f32x4 v[4];
#pragma unroll
        for (int j = 0; j < 4; ++j) v[j] = *(const f32x4*)(xr + 4 * lane + 256 * j);
        store_u(v, MOD + mi * 3072, U + (size_t)r * DM, lane); }
    } else if (sph == 2) {
        {
            WSL(); pg8::Gemm g{U, (const bf16_t*)(wsl + WS_WIN + l * SZ_WIN), TROWS, NIN, DM}; pg8::StaticOrder S; S.init(TROWS, NIN, G, bid);
            pg8::EpiIn E{wsl, pp->q_norm + l * 128, pp->k_norm + l * 128, (LAS float*)(l3 + PART_OFF)};
            pg8::gemm_phase<pg8::EpiIn, pg8::StaticOrder, true, true>(l3, g, S, E, wave);
        }
    } else if (sph == 3) {
        {
            WSL(); int lane = LANE_ID(); asm volatile("" : "+v"(lane)); const bf16_t* WPt = (const bf16_t*)(wsl + WS_WP + l * SZ_WP);
            const int nunits = 1024 + (l < DEPTH - 1 ? 16 : 0);
            float kmax; { const float* kn = pp->k_norm + l * 128; kmax = fmaxf(fabsf(kn[lane]), fabsf(kn[lane + 64]));
#pragma unroll
                for (int o_ = 1; o_ < 64; o_ <<= 1) kmax = fmaxf(kmax, __shfl_xor(kmax, o_)); }
            for (int un = bid; un < nunits; un += G) {
                __syncthreads();
                int b, h, rowq, seq;
                if (un < 1024) { b = un >> 9; h = (un >> 6) & 7; rowq = b * TB + CTXL + (un & 63) * 256; seq = TB; }
                else { const int c = un - 1024; b = c >> 3; h = c & 7; rowq = b * TB; seq = CTXL; }
                const size_t qoff = (size_t)rowq * DM + h * 128, koff = (size_t)b * TB * 256 + (h >> 2) * 128;
                att::attn_dense_body((const att::bf16*)(Q + qoff), (const att::bf16*)(Kb + koff), (const att::bf16*)(Vb + koff), (const att::bf16*)(ZA + qoff), (att::bf16*)(Q + qoff), seq, (char*)lds, wave, kmax, l3);
            }
            { unsigned* qctr = (unsigned*)(wsl + WS_BAR) + 8 + l; const int npool = (l < DEPTH - 1) ? (TROWS / 32) * 4 : (NBATCH * SEQ / 32) * 4;
              for (;;) { unsigned wq = 0u; if (lane == 0) wq = __hip_atomic_fetch_add(qctr, 1u, __ATOMIC_RELAXED, __HIP_MEMORY_SCOPE_AGENT);
                  const int wi = __builtin_amdgcn_readfirstlane((int)wq); if (wi >= npool) break;
                  int wu = wi; if (l == DEPTH - 1) { const int rc = wi >> 2, rcf = rc + (CTXL / 32) * (1 + rc / (SEQ / 32)); wu = (rcf << 2) | (wi & 3); }
                  pool_unit(XB, ZB, WPt, pp->pool_scale + l * 512, wu, lane); } }
        }
    } else if (sph == 4) {
        {
            WSL(); pg8::Gemm g{Q, (const bf16_t*)(wsl + WS_WA + l * SZ_WA), TROWS, DM, DM};
            pg8::EpiGate<0> E{wsl};
            { pg8::StaticOrder S; S.init(l == DEPTH - 1 ? NBATCH * SEQ : TROWS, DM, G, bid); S.skip = (l == DEPTH - 1); pg8::gemm_phase<pg8::EpiGate<0>, pg8::StaticOrder, true, true>(l3, g, S, E, wave); }
        }
        {
            WSL(); pg8::Gemm g{ZB, (const bf16_t*)(wsl + WS_WB + l * SZ_WB), TROWS, DM, 512};
            pg8::EpiGate<1> E{wsl};
            { pg8::StaticOrder S; S.init(l == DEPTH - 1 ? NBATCH * SEQ : TROWS, DM, G, bid); S.skip = (l == DEPTH - 1); pg8::gemm_phase<pg8::EpiGate<1>, pg8::StaticOrder, true, true>(l3, g, S, E, wave); }
        }
    } else if (sph == 5) {
        {
            WSL(); pg8::Gemm g{ZA, (const bf16_t*)(wsl + WS_WO + l * SZ_WO), TROWS, DM, DM};
            pg8::EpiRes E{MOD + (size_t)l * 3 * 3072, wsl};
            { pg8::StaticOrder S; S.init(l == DEPTH - 1 ? NBATCH * SEQ : TROWS, DM, G, bid); S.skip = (l == DEPTH - 1); pg8::gemm_phase<pg8::EpiRes, pg8::StaticOrder, true, true>(l3, g, S, E, wave); }
        }
    } else {
        {
            WSL(); int lane = LANE_ID(); asm volatile("" : "+v"(lane)); const float* modl = MOD + (size_t)l * 3 * 3072; const float* lg = pp->ln_g + l * DM; const float* lb = pp->ln_b + l * DM; const bool last = (l == DEPTH - 1);
            const float* xlat = l == 0 ? pp->x : pp->out; const float* xctx = l == 0 ? pp->ctx : CX;
            auto ln_row = [&](const int r, const f32x4 (&vin)[4]) {
                const int b = r / TB, rr = r - b * TB; const bool isctx = rr < CTXL; f32x4 v[4]; float s = 0.f;
#pragma unroll
                for (int j = 0; j < 4; ++j) { v[j] = vin[j]; s += (v[j][0] + v[j][1]) + (v[j][2] + v[j][3]); }
                const float mean = wave_sum(s) * (1.0f / DM); float s2 = 0.f;
#pragma unroll
                for (int j = 0; j < 4; ++j) { v[j] = v[j] - mean; s2 += (v[j][0] * v[j][0] + v[j][1] * v[j][1]) + (v[j][2] * v[j][2] + v[j][3] * v[j][3]); }
                const float rstd = 1.0f / sqrtf(wave_sum(s2) * (1.0f / DM) + EPSV);
                float* xo = isctx ? CX + ((size_t)b * CTXL + rr) * DM : pp->out + ((size_t)b * SEQ + (rr - CTXL)) * DM;
#pragma unroll
                for (int j = 0; j < 4; ++j) { const int c = 4 * lane + 256 * j; v[j] = v[j] * rstd * *(const f32x4*)(lg + c) + *(const f32x4*)(lb + c); *(f32x4*)(xo + c) = v[j]; }
                if (!last) store_u(v, modl + 3 * 3072 + (isctx ? 2 : b) * 3072, U + (size_t)r * DM, lane);
            };
            const int nrows = last ? NBATCH * SEQ : TROWS;
            for (int i0 = gw; i0 < nrows; i0 += 2 * NGW) {
                const int i1 = i0 + NGW; const bool has1 = i1 < nrows;
                const int r0 = last ? i0 + CTXL * (1 + i0 / SEQ) : i0, r1 = has1 ? (last ? i1 + CTXL * (1 + i1 / SEQ) : i1) : r0;
                f32x4 va[4], vb[4]; const float* xa = xrow_c(xlat, xctx, r0); const float* xb_ = xrow_c(xlat, xctx, r1);
                const bf16_t* da = DELTA + (size_t)r0 * DM; const bf16_t* db = DELTA + (size_t)r1 * DM;
#pragma unroll
                for (int j = 0; j < 4; ++j) { const int c = 4 * lane + 256 * j; const f32x4 x0 = *(const f32x4*)(xa + c), x1 = *(const f32x4*)(xb_ + c);
                    const u32x2v d0 = *(const u32x2v*)(da + c), d1 = *(const u32x2v*)(db + c);
                    va[j] = x0 * ALPHA_RES + (f32x4){pg8::bf_lo(d0.x), pg8::bf_hi(d0.x), pg8::bf_lo(d0.y), pg8::bf_hi(d0.y)};
                    vb[j] = x1 * ALPHA_RES + (f32x4){pg8::bf_lo(d1.x), pg8::bf_hi(d1.x), pg8::bf_lo(d1.y), pg8::bf_hi(d1.y)}; }
                ln_row(r0, va); if (has1) ln_row(r1, vb);
            }
        }
    }
    if (ph + 1 < NPH) GRID_SYNC();
    }
}

extern "C" void kernel_launch(void* const* d_in, const int* in_sizes, int n_in, void* d_out, int out_size, void* d_ws, size_t ws_size, hipStream_t stream) {
    static int grid_blocks = 0;
    if (grid_blocks == 0) {
        if (n_in != 16 || ws_size < WS_END2 || out_size != NBATCH * SEQ * DM) { fprintf(stderr, "kernel_launch: unexpected shapes: n_in %d out %d ws %zu (need %zu)\n", n_in, out_size, ws_size, (size_t)WS_END2); grid_blocks = -1; return; }
        int dev = 0, cus = 0, per_cu = 0;
        hipGetDevice(&dev); hipDeviceGetAttribute(&cus, hipDeviceAttributeMultiprocessorCount, dev);
        if (hipFuncSetAttribute((const void*)mega, hipFuncAttributeMaxDynamicSharedMemorySize, LDS_BYTES) != hipSuccess) { fprintf(stderr, "kernel_launch: hipFuncSetAttribute failed\n"); grid_blocks = -1; return; }
        if (hipOccupancyMaxActiveBlocksPerMultiprocessor(&per_cu, (const void*)mega, NTHREADS, LDS_BYTES) != hipSuccess || per_cu < 1) { fprintf(stderr, "kernel_launch: occupancy query gave %d\n", per_cu); per_cu = 1; }
        (void)hipGetLastError();
        grid_blocks = cus * per_cu;
    }
    if (grid_blocks < 0) return;
    Params p{};
    p.x = (const float*)d_in[0]; p.c = (const float*)d_in[1]; p.ctx = (const float*)d_in[2]; p.c_ctx = (const float*)d_in[3]; p.w_mod = (const float*)d_in[4]; p.b_mod = (const float*)d_in[5];
    p.w_in = (const float*)d_in[6]; p.q_norm = (const float*)d_in[7]; p.k_norm = (const float*)d_in[8]; p.w_pool = (const float*)d_in[9]; p.pool_scale = (const float*)d_in[10];
    p.w_br_a = (const float*)d_in[11]; p.w_br_b = (const float*)d_in[12]; p.w_out = (const float*)d_in[13]; p.ln_g = (const float*)d_in[14]; p.ln_b = (const float*)d_in[15];
    p.out = (float*)d_out; p.ws = (unsigned char*)d_ws;
    void* args[] = {&p};
    if (hipMemsetAsync((char*)d_ws + WS_BAR, 0, XCD_BAR_WORDS * 4, stream) != hipSuccess) { fprintf(stderr, "kernel_launch: memset of the barrier word failed\n"); return; }
    hipError_t e = hipLaunchCooperativeKernel((const void*)mega, dim3(grid_blocks), dim3(NTHREADS), args, LDS_BYTES, stream);
    if (e != hipSuccess) fprintf(stderr, "kernel_launch: cooperative launch failed: %s (grid %d)\n", hipGetErrorString(e), grid_blocks);
}
```

```cpp
#include <hip/hip_runtime.h>
#include <hip/hip_bf16.h>
#include <hip/hip_cooperative_groups.h>
#include <cstdio>
#include <cstdint>
namespace cg = cooperative_groups;

constexpr int DM = 1024, NBATCH = 2, SEQ = 16384, CTXL = 256, DEPTH = 4, HD = 128;
constexpr int TB = SEQ + CTXL;
constexpr int TROWS = NBATCH * TB;
constexpr int NIN = 5632;
constexpr float EPSV = 1e-6f;
constexpr float ALPHA_RES = 1.681792830507429f;
constexpr int NWAVES = 8, NTHREADS = 512;

constexpr size_t SZ_WIN = (size_t)NIN * DM * 2, SZ_WA = (size_t)DM * DM * 2, SZ_WB = (size_t)DM * 512 * 2, SZ_WO = SZ_WA, SZ_WP = (size_t)4 * 128 * 128 * 2;
constexpr size_t WS_WIN = 0;
constexpr size_t WS_WA = WS_WIN + DEPTH * SZ_WIN;
constexpr size_t WS_WB = WS_WA + DEPTH * SZ_WA;
constexpr size_t WS_WO = WS_WB + DEPTH * SZ_WB;
constexpr size_t WS_WP = WS_WO + DEPTH * SZ_WO;
constexpr size_t WS_MOD = WS_WP + DEPTH * SZ_WP;
constexpr size_t WS_ROPE = WS_MOD + (size_t)DEPTH * 3 * 3072 * 4;
constexpr size_t WS_CX = WS_ROPE + 2 * 256 * 32 * 4;
constexpr size_t WS_U = WS_CX + (size_t)512 * DM * 4;
constexpr size_t WS_Q = WS_U + (size_t)TROWS * DM * 2;
constexpr size_t WS_K = WS_Q + (size_t)TROWS * DM * 2;
constexpr size_t WS_V = WS_K + (size_t)TROWS * 256 * 2;
constexpr size_t WS_ZA = WS_V + (size_t)TROWS * 256 * 2;
constexpr size_t WS_XB = WS_ZA + (size_t)TROWS * DM * 2;
constexpr size_t WS_ZB = WS_XB + (size_t)TROWS * 512 * 2;
constexpr size_t WS_GA = WS_ZB + (size_t)TROWS * 512 * 2;
constexpr size_t WS_GB = WS_GA + (size_t)TROWS * DM * 2;
constexpr size_t WS_END = WS_GB + (size_t)TROWS * DM * 2;
constexpr size_t WS_BAR = WS_END, WS_END2 = WS_END + 16384;

struct Params {
    const float *x, *c, *ctx, *c_ctx, *w_mod, *b_mod, *w_in, *q_norm, *k_norm, *w_pool, *pool_scale, *w_br_a, *w_br_b, *w_out, *ln_g, *ln_b;
    float* out; unsigned char* ws;
};

namespace pg8 {
#define PG8_LAS __attribute__((address_space(3)))
typedef unsigned short bf16_t;
typedef short bf16x8 __attribute__((ext_vector_type(8)));
typedef float f32x4 __attribute__((ext_vector_type(4)));
typedef unsigned u32x4 __attribute__((ext_vector_type(4)));
constexpr int BM = 256, BK = 64, HALF = 128, HTB = HALF * BK * 2  , STAGE_BYTES = 8 * HTB, NXCD = 8, WGM = 8;

__host__ __device__ __forceinline__ int lds_byte(int r, int c) { const int st = (r >> 4) * 2 + (c >> 5), rr = r & 15, cc = c & 31, ob = rr * 64 + cc * 2; return st * 1024 + (ob ^ (((ob >> 9) & 1) << 5)); }
__host__ __device__ __forceinline__ void stage_rc(int b, int& R, int& C) { const int st = b / 1024, sb = b % 1024, swz = sb ^ (((sb >> 9) & 1) << 5); R = (st >> 1) * 16 + swz / 64; C = (st & 1) * 32 + (swz % 64) / 2; }
__host__ __device__ __forceinline__ int perm32(int rho) { const int n = rho >> 4, i = rho & 15; return 8 * (i >> 2) + 4 * n + (i & 3); }

struct Unit { int pm, pn; };
struct Gemm { const bf16_t* A; const bf16_t* Bt; int M, N, K; };

struct StaticOrder {
    int nM, nN, nwg, G, c, skip;
    __host__ __device__ void init(int M, int N, int G_, int c_) { nM = M / BM; nN = N / BM; nwg = nM * nN; G = G_; c = c_; skip = 0; }
    __host__ __device__ bool next(int i, Unit& u) const {
        const long L = (long)i * G + c; if (L >= nwg) return false;
        int wgid = (int)L; { const int q = nwg / NXCD, r = nwg % NXCD, xcd = wgid % NXCD, off = wgid / NXCD; wgid = (xcd < r ? xcd * (q + 1) : r * (q + 1) + (xcd - r) * q) + off; }
        const int nig = WGM * nN, gid = wgid / nig, fm = gid * WGM, gsz = (nM - fm) < WGM ? (nM - fm) : WGM;
        u.pm = fm + ((wgid % nig) % gsz); u.pn = (wgid % nig) / gsz; if (skip) u.pm += 1 + (u.pm >= 64 ? 1 : 0); return true;
    }
    __device__ __forceinline__ void a_ready(const Unit&) const {}
    __device__ __forceinline__ void done(const Unit&) const {}
};

typedef __bf16 bf16x2_t __attribute__((ext_vector_type(2)));
typedef float f32x2_t __attribute__((ext_vector_type(2)));
__device__ __forceinline__ unsigned cvt_pk_bf16(float lo, float hi) { const f32x2_t v = {lo, hi}; const bf16x2_t r = __builtin_convertvector(v, bf16x2_t); return __builtin_bit_cast(unsigned, r); }
typedef float f32x2 __attribute__((ext_vector_type(2)));
struct LatentOrder {
    StaticOrder S;
    __host__ __device__ void init(int N, int G_, int c_) { S.init(32768, N, G_, c_); }
    __host__ __device__ bool next(int i, Unit& u) const { if (!S.next(i, u)) return false; u.pm += 1 + (u.pm >= 64 ? 1 : 0); return true; }
    __device__ __forceinline__ void a_ready(const Unit&) const {}
    __device__ __forceinline__ void done(const Unit&) const {}
};
__device__ __forceinline__ float bf_lo(unsigned w) { return __uint_as_float(w << 16); }
__device__ __forceinline__ float bf_hi(unsigned w) { return __uint_as_float(w & 0xffff0000u); }
__device__ __forceinline__ float sigm(float x) { return __builtin_amdgcn_rcpf(1.0f + __builtin_amdgcn_exp2f(-1.4426950408889634f * x)); }
typedef unsigned u32x2 __attribute__((ext_vector_type(2)));
template <int ACT> __device__ __forceinline__ float actf(float x) { if (ACT == 1) return x * sigm(x); if (ACT == 2) return sigm(x); return x; }

struct EpiIn {
    static constexpr bool PERM = true, AFTER_DRAIN = false;
    unsigned char* ws; const float *qg, *kg;
    PG8_LAS float* part;
    template <int ACT> __device__ __forceinline__ void plain(const f32x4 (&acc)[2][2][4][2], bf16_t* base, int ldc, int colt, const Unit& u, int wr, int wc, int fr, int fq) const {
        const int row0 = u.pm * BM + wr * 64 + fr, col0 = colt + wc * 32 + 8 * fq;
#pragma unroll
        for (int ai = 0; ai < 2; ++ai)
#pragma unroll
            for (int m = 0; m < 4; ++m) { bf16_t* rowp = base + (size_t)(row0 + ai * HALF + m * 16) * ldc + col0;
#pragma unroll
                for (int bj = 0; bj < 2; ++bj) { const f32x4 v0 = acc[ai][bj][m][0], v1 = acc[ai][bj][m][1]; u32x4 w;
                    w.x = cvt_pk_bf16(actf<ACT>(v0[0]), actf<ACT>(v0[1])); w.y = cvt_pk_bf16(actf<ACT>(v0[2]), actf<ACT>(v0[3]));
                    w.z = cvt_pk_bf16(actf<ACT>(v1[0]), actf<ACT>(v1[1])); w.w = cvt_pk_bf16(actf<ACT>(v1[2]), actf<ACT>(v1[3]));
                    *(u32x4*)(rowp + bj * HALF) = w; } }
    }
    __device__ __forceinline__ void qk(const f32x4 (&acc)[2][2][4][2], const Unit& u, int wr, int wc, int fr, int fq) const {
        const bool isk = (u.pn == 4);
        const float* g = isk ? kg : qg; bf16_t* dst = (bf16_t*)(ws + (isk ? WS_K : WS_Q)); const int ldc = isk ? 256 : 1024;
        const float* cosT = (const float*)(ws + WS_ROPE); const float* sinT = cosT + 256 * 32;
        const int f0 = (wc & 1) * 16 + 4 * fq, axis = wc >> 1, e1 = axis * 64 + f0;
        const f32x4 g1 = *(const f32x4*)(g + e1), g2 = *(const f32x4*)(g + e1 + 32);
#pragma unroll
        for (int ai = 0; ai < 2; ++ai)
#pragma unroll
            for (int m = 0; m < 4; ++m)
#pragma unroll
                for (int bj = 0; bj < 2; ++bj) { const f32x4 a = acc[ai][bj][m][0], b = acc[ai][bj][m][1];
                    float s = (a[0] * a[0] + a[1] * a[1]) + (a[2] * a[2] + a[3] * a[3]) + (b[0] * b[0] + b[1] * b[1]) + (b[2] * b[2] + b[3] * b[3]);
                    s += __shfl_xor(s, 16); s += __shfl_xor(s, 32);
                    if (fq == 0) part[((ai * HALF + wr * 64 + m * 16 + fr) * 2 + bj) * 4 + wc] = s; }
        asm volatile("s_waitcnt lgkmcnt(0)" ::: "memory"); __builtin_amdgcn_s_barrier(); asm volatile("" ::: "memory");
        const int jt = u.pm % 65; const bool rope = (jt != 0);
#pragma unroll
        for (int ai = 0; ai < 2; ++ai)
#pragma unroll
            for (int m = 0; m < 4; ++m) { const int rloc = ai * HALF + wr * 64 + m * 16 + fr;
                const int pos = rope ? (axis ? (16 * m + fr) : ((jt - 1) * 4 + 2 * ai + wr)) : 0;
                f32x4 c4 = *(const f32x4*)(cosT + pos * 32 + f0), s4 = *(const f32x4*)(sinT + pos * 32 + f0);
                if (!rope) { c4 = (f32x4){1.f, 1.f, 1.f, 1.f}; s4 = (f32x4){0.f, 0.f, 0.f, 0.f}; }
#pragma unroll
                for (int bj = 0; bj < 2; ++bj) { const f32x4 p = *(const PG8_LAS f32x4*)(part + (rloc * 2 + bj) * 4);
                    const float rstd = __builtin_amdgcn_rsqf(((p[0] + p[1]) + (p[2] + p[3])) * (1.0f / 128.0f) + 1e-6f);
                    const f32x4 y1 = acc[ai][bj][m][0] * rstd * g1, y2 = acc[ai][bj][m][1] * rstd * g2;
                    f32x4 o1 = y1 * c4 - y2 * s4, o2 = y1 * s4 + y2 * c4;
                    if (!isk) { o1 = o1 * 0.12751743074602458f; o2 = o2 * 0.12751743074602458f; }
                    const int head = isk ? bj : 2 * u.pn + bj;
                    bf16_t* ptr = dst + (size_t)(u.pm * BM + rloc) * ldc + head * 128 + e1;
                    u32x2 w1, w2; w1.x = cvt_pk_bf16(o1[0], o1[1]); w1.y = cvt_pk_bf16(o1[2], o1[3]); w2.x = cvt_pk_bf16(o2[0], o2[1]); w2.y = cvt_pk_bf16(o2[2], o2[3]);
                    *(u32x2*)ptr = w1; *(u32x2*)(ptr + 32) = w2; } }
    }
    __device__ __forceinline__ void operator()(const f32x4 (&acc)[2][2][4][2], const Unit& u, int wr, int wc, int fr, int fq) const {
        const int pn = u.pn;
        if (pn < 5) { qk(acc, u, wr, wc, fr, fq); return; }
        if (pn == 5) plain<0>(acc, (bf16_t*)(ws + WS_V), 256, 0, u, wr, wc, fr, fq);
        else if (pn < 10) plain<1>(acc, (bf16_t*)(ws + WS_ZA), 1024, (pn - 6) * 256, u, wr, wc, fr, fq);
        else if (pn < 12) plain<0>(acc, (bf16_t*)(ws + WS_XB), 512, (pn - 10) * 256, u, wr, wc, fr, fq);
        else if (pn < 14) plain<1>(acc, (bf16_t*)(ws + WS_ZB), 512, (pn - 12) * 256, u, wr, wc, fr, fq);
        else if (pn < 18) plain<2>(acc, (bf16_t*)(ws + WS_GA), 1024, (pn - 14) * 256, u, wr, wc, fr, fq);
        else plain<2>(acc, (bf16_t*)(ws + WS_GB), 1024, (pn - 18) * 256, u, wr, wc, fr, fq);
    }
};
template <int MODE> struct EpiGate {
    static constexpr bool PERM = true, AFTER_DRAIN = false;
    unsigned char* ws;
    __device__ __forceinline__ void operator()(const f32x4 (&acc)[2][2][4][2], const Unit& u, int wr, int wc, int fr, int fq) const {
        bf16_t* GA = (bf16_t*)(ws + WS_GA); const bf16_t* GB = (const bf16_t*)(ws + WS_GB); bf16_t* Y = (bf16_t*)(ws + WS_ZA);
        const int row0 = u.pm * BM + wr * 64 + fr, col0 = u.pn * BM + wc * 32 + 8 * fq;
#pragma unroll
        for (int ai = 0; ai < 2; ++ai)
#pragma unroll
            for (int m = 0; m < 4; ++m) { const size_t off = (size_t)(row0 + ai * HALF + m * 16) * 1024 + col0;
#pragma unroll
                for (int bj = 0; bj < 2; ++bj) { const f32x4 v0 = acc[ai][bj][m][0], v1 = acc[ai][bj][m][1];
                    const u32x4 ga = *(const u32x4*)(GA + off + bj * HALF); u32x4 w;
                    if (MODE == 0) {
                        w.x = cvt_pk_bf16(v0[0] * bf_lo(ga.x), v0[1] * bf_hi(ga.x)); w.y = cvt_pk_bf16(v0[2] * bf_lo(ga.y), v0[3] * bf_hi(ga.y));
                        w.z = cvt_pk_bf16(v1[0] * bf_lo(ga.z), v1[1] * bf_hi(ga.z)); w.w = cvt_pk_bf16(v1[2] * bf_lo(ga.w), v1[3] * bf_hi(ga.w));
                        *(u32x4*)(GA + off + bj * HALF) = w;
                    } else {
                        const u32x4 gb = *(const u32x4*)(GB + off + bj * HALF);
                        w.x = cvt_pk_bf16(bf_lo(ga.x) + v0[0] * bf_lo(gb.x), bf_hi(ga.x) + v0[1] * bf_hi(gb.x)); w.y = cvt_pk_bf16(bf_lo(ga.y) + v0[2] * bf_lo(gb.y), bf_hi(ga.y) + v0[3] * bf_hi(gb.y));
                        w.z = cvt_pk_bf16(bf_lo(ga.z) + v1[0] * bf_lo(gb.z), bf_hi(ga.z) + v1[1] * bf_hi(gb.z)); w.w = cvt_pk_bf16(bf_lo(ga.w) + v1[2] * bf_lo(gb.w), bf_hi(ga.w) + v1[3] * bf_hi(gb.w));
                        *(u32x4*)(Y + off + bj * HALF) = w;
                    } } }
    }
};
struct EpiRes {
    static constexpr bool PERM = true, AFTER_DRAIN = false;
    const float* mod; unsigned char* ws;
    __device__ __forceinline__ void operator()(const f32x4 (&acc)[2][2][4][2], const Unit& u, int wr, int wc, int fr, int fq) const {
        const int b = u.pm / 65, jt = u.pm % 65; bf16_t* dl = (bf16_t*)(ws + WS_GA);
        const float* gate = mod + (jt ? b : 2) * 3072 + 2048;
        const int row0 = u.pm * BM + wr * 64 + fr, col0 = u.pn * BM + wc * 32 + 8 * fq;
        f32x4 gv[2][2];
#pragma unroll
        for (int bj = 0; bj < 2; ++bj)
#pragma unroll
            for (int n = 0; n < 2; ++n) gv[bj][n] = *(const f32x4*)(gate + col0 + bj * HALF + 4 * n);
#pragma unroll
        for (int ai = 0; ai < 2; ++ai)
#pragma unroll
            for (int m = 0; m < 4; ++m) { bf16_t* rowp = dl + (size_t)(row0 + ai * HALF + m * 16) * 1024 + col0;
#pragma unroll
                for (int bj = 0; bj < 2; ++bj) { const f32x4 v0 = acc[ai][bj][m][0] * gv[bj][0], v1 = acc[ai][bj][m][1] * gv[bj][1]; u32x4 w;
                    w.x = cvt_pk_bf16(v0[0], v0[1]); w.y = cvt_pk_bf16(v0[2], v0[3]); w.z = cvt_pk_bf16(v1[0], v1[1]); w.w = cvt_pk_bf16(v1[2], v1[3]);
                    *(u32x4*)(rowp + bj * HALF) = w; } }
    }
};

template <class Epi, class Sched, bool ALIGN_EPI = false, bool SP2 = false>
__device__ __forceinline__ void gemm_phase(PG8_LAS unsigned char* lds, const Gemm g, const Sched& S, const Epi& E, const int wid_in) {
    int lane = __builtin_amdgcn_mbcnt_hi(~0u, __builtin_amdgcn_mbcnt_lo(~0u, 0u)); asm volatile("" : "+v"(lane));
    const int wid = wid_in, tid = wid * 64 + lane, wr = wid >> 2, wc = wid & 3, fr = lane & 15, fq = lane >> 4;
    const int K = g.K, nt = K / BK;
    unsigned voffA[2], voffB[2];
#pragma unroll
    for (int i = 0; i < 2; ++i) { int R, C; stage_rc(tid * 16 + i * 8192, R, C); const int Rb = Epi::PERM ? ((R & ~31) + perm32(R & 31)) : R;
        voffA[i] = (unsigned)(R * K + C) * 2u; voffB[i] = (unsigned)(Rb * K + C) * 2u; }
    const size_t kstep = (size_t)(BK * 2);
    const size_t hstep = (size_t)HALF * K * 2;
    const size_t tstep = 2 * hstep;
    const unsigned ldsw = (unsigned)wid * 1024u;
    const int aoff = lds_byte(wr * 64 + fr, fq * 8), boff = lds_byte(wc * 32 + fr, fq * 8);
#define PG8_SA(b, h) (((b) * 2 + (h)) * HTB)
#define PG8_SB(b, h) ((4 + (b) * 2 + (h)) * HTB)
#define PG8_STAGE(bufoff, gbase, voff) do { _Pragma("unroll") for (int _i = 0; _i < 2; ++_i) \
        __builtin_amdgcn_global_load_lds((const unsigned*)((const char*)(gbase) + (voff)[_i]), (PG8_LAS unsigned*)(lds + (bufoff) + ldsw + _i * 8192), 16, 0, 0); } while (0)
#define PG8_LDA(dst, b, h) do { _Pragma("unroll") for (int m = 0; m < 4; ++m) _Pragma("unroll") for (int k = 0; k < 2; ++k) dst[m][k] = *(const PG8_LAS bf16x8*)(lds + PG8_SA(b, h) + aoff + m * 2048 + k * 1024); } while (0)
#define PG8_LDB(dst, b, h) do { _Pragma("unroll") for (int n = 0; n < 2; ++n) _Pragma("unroll") for (int k = 0; k < 2; ++k) dst[n][k] = *(const PG8_LAS bf16x8*)(lds + PG8_SB(b, h) + boff + n * 2048 + k * 1024); } while (0)
#define PG8_MMA(ai, bj, At, Bt) do { __builtin_amdgcn_s_setprio(1); _Pragma("unroll") for (int m = 0; m < 4; ++m) _Pragma("unroll") for (int n = 0; n < 2; ++n) _Pragma("unroll") for (int k = 0; k < 2; ++k) \
        acc[ai][bj][m][n] = __builtin_amdgcn_mfma_f32_16x16x32_bf16(Bt[n][k], At[m][k], acc[ai][bj][m][n], 0, 0, 0); __builtin_amdgcn_s_setprio(0); } while (0)
#define PG8_WAIT_V(n) asm volatile("s_waitcnt vmcnt(" #n ")" ::: "memory")
#define PG8_WAIT_L(n) asm volatile("s_waitcnt lgkmcnt(" #n ")" ::: "memory")
#define PG8_BAR __builtin_amdgcn_s_barrier()
#define PG8_SCHED __builtin_amdgcn_sched_barrier(0)
    Unit cur, nxt; int ui = 0;
    if (!S.next(0, cur)) return;
    f32x4 acc[2][2][4][2];
#pragma unroll
    for (int a = 0; a < 2; ++a)
#pragma unroll
        for (int b = 0; b < 2; ++b)
#pragma unroll
            for (int m = 0; m < 4; ++m)
#pragma unroll
                for (int n = 0; n < 2; ++n) acc[a][b][m][n] = (f32x4){0.f, 0.f, 0.f, 0.f};
    bf16x8 At[4][2], B0[2][2], B1[2][2];
    const char* cA = (const char*)g.A + (size_t)cur.pm * tstep; const char* cB = (const char*)g.Bt + (size_t)cur.pn * tstep;
    S.a_ready(cur);
    if constexpr (SP2) {
        PG8_STAGE(PG8_SB(0, 0), cB, voffB); PG8_STAGE(PG8_SB(0, 1), cB + hstep, voffB); PG8_STAGE(PG8_SA(0, 0), cA, voffA); PG8_STAGE(PG8_SA(0, 1), cA + hstep, voffA);
        if (wr == 1) PG8_BAR;
        PG8_WAIT_V(2); PG8_BAR;
        PG8_STAGE(PG8_SB(1, 0), cB + kstep, voffB); PG8_STAGE(PG8_SA(1, 0), cA + kstep, voffA); PG8_STAGE(PG8_SB(1, 1), cB + hstep + kstep, voffB);
        PG8_WAIT_V(6); PG8_BAR;
    } else {
        PG8_STAGE(PG8_SB(0, 0), cB, voffB); PG8_STAGE(PG8_SA(0, 0), cA, voffA); PG8_STAGE(PG8_SB(0, 1), cB + hstep, voffB); PG8_STAGE(PG8_SA(0, 1), cA + hstep, voffA);
        if (wr == 1) PG8_BAR;
        PG8_WAIT_V(4); PG8_BAR;
        PG8_STAGE(PG8_SB(1, 0), cB + kstep, voffB); PG8_STAGE(PG8_SA(1, 0), cA + kstep, voffA); PG8_STAGE(PG8_SB(1, 1), cB + hstep + kstep, voffB);
        PG8_WAIT_V(6); PG8_BAR;
    }
    for (;;) {
        const bool has_next = S.next(ui + 1, nxt);
        const char* nA = has_next ? (const char*)g.A + (size_t)nxt.pm * tstep : cA; const char* nB = has_next ? (const char*)g.Bt + (size_t)nxt.pn * tstep : cB;
        for (int t = 0; t < nt; t += 2) {
            const bool last = (t == nt - 2);
            const char* a1 = cA + (size_t)(t + 1) * kstep;
            const char* a2 = last ? nA : cA + (size_t)(t + 2) * kstep; const char* b2 = last ? nB : cB + (size_t)(t + 2) * kstep;
            const char* a3 = a2 + kstep; const char* b3 = b2 + kstep;
            if (last && has_next) S.a_ready(nxt);
            if constexpr (SP2) {
            PG8_LDB(B0, 0, 0); PG8_LDB(B1, 0, 1); PG8_SCHED; PG8_LDA(At, 0, 0); PG8_STAGE(PG8_SA(1, 1), a1 + hstep, voffA);
            PG8_WAIT_V(8); PG8_WAIT_L(0); PG8_BAR; PG8_MMA(0, 0, At, B0); PG8_MMA(0, 1, At, B1); PG8_BAR; PG8_SCHED;
            PG8_LDA(At, 0, 1); PG8_STAGE(PG8_SB(0, 0), b2, voffB); PG8_STAGE(PG8_SB(0, 1), b2 + hstep, voffB); PG8_STAGE(PG8_SA(0, 0), a2, voffA);
            PG8_WAIT_V(8); PG8_WAIT_L(0); PG8_BAR; PG8_MMA(1, 0, At, B0); PG8_MMA(1, 1, At, B1); PG8_BAR; PG8_SCHED;
            PG8_LDB(B0, 1, 0); PG8_LDB(B1, 1, 1); PG8_SCHED; PG8_LDA(At, 1, 0); PG8_STAGE(PG8_SA(0, 1), a2 + hstep, voffA);
            PG8_WAIT_V(8); PG8_WAIT_L(0); PG8_BAR; PG8_MMA(0, 0, At, B0); PG8_MMA(0, 1, At, B1); PG8_BAR; PG8_SCHED;
            PG8_LDA(At, 1, 1); PG8_STAGE(PG8_SB(1, 0), b3, voffB); PG8_STAGE(PG8_SB(1, 1), b3 + hstep, voffB); PG8_STAGE(PG8_SA(1, 0), a3, voffA);
            PG8_WAIT_V(8); PG8_WAIT_L(0); PG8_BAR; PG8_MMA(1, 0, At, B0); PG8_MMA(1, 1, At, B1); PG8_BAR; PG8_SCHED;
            } else {
            PG8_LDB(B0, 0, 0); PG8_SCHED; PG8_LDA(At, 0, 0); PG8_STAGE(PG8_SA(1, 1), a1 + hstep, voffA);
            PG8_WAIT_L(8); PG8_BAR; PG8_WAIT_L(0); PG8_MMA(0, 0, At, B0); PG8_BAR; PG8_SCHED;
            PG8_LDB(B1, 0, 1); PG8_STAGE(PG8_SB(0, 0), b2, voffB);
            PG8_BAR; PG8_WAIT_L(0); PG8_MMA(0, 1, At, B1); PG8_BAR;
            PG8_LDA(At, 0, 1); PG8_STAGE(PG8_SA(0, 0), a2, voffA);
            PG8_BAR; PG8_WAIT_L(0); PG8_MMA(1, 0, At, B0); PG8_BAR; PG8_SCHED;
            PG8_STAGE(PG8_SB(0, 1), b2 + hstep, voffB);
            PG8_WAIT_V(6); PG8_BAR; PG8_MMA(1, 1, At, B1); PG8_BAR;
            PG8_LDB(B0, 1, 0); PG8_SCHED; PG8_LDA(At, 1, 0); PG8_STAGE(PG8_SA(0, 1), a2 + hstep, voffA);
            PG8_WAIT_L(8); PG8_BAR; PG8_WAIT_L(0); PG8_MMA(0, 0, At, B0); PG8_BAR; PG8_SCHED;
            PG8_LDB(B1, 1, 1); PG8_STAGE(PG8_SB(1, 0), b3, voffB);
            PG8_BAR; PG8_WAIT_L(0); PG8_MMA(0, 1, At, B1); PG8_BAR;
            PG8_LDA(At, 1, 1); PG8_STAGE(PG8_SA(1, 0), a3, voffA);
            PG8_BAR; PG8_WAIT_L(0); PG8_MMA(1, 0, At, B0); PG8_BAR; PG8_SCHED;
            PG8_STAGE(PG8_SB(1, 1), b3 + hstep, voffB);
            PG8_WAIT_V(6); PG8_BAR; PG8_MMA(1, 1, At, B1); PG8_BAR;
            }
        }
        if constexpr (ALIGN_EPI) { if (wr == 0) PG8_BAR; }
        if constexpr (!Epi::AFTER_DRAIN) { int l2 = __builtin_amdgcn_mbcnt_hi(~0u, __builtin_amdgcn_mbcnt_lo(~0u, 0u)); asm volatile("" : "+v"(l2));
            E(acc, cur, wr, wc, l2 & 15, l2 >> 4); S.done(cur); }
        if (!has_next) break;
#pragma unroll
        for (int a = 0; a < 2; ++a)
#pragma unroll
            for (int b = 0; b < 2; ++b)
#pragma unroll
                for (int m = 0; m < 4; ++m)
#pragma unroll
                    for (int n = 0; n < 2; ++n) acc[a][b][m][n] = (f32x4){0.f, 0.f, 0.f, 0.f};
        cur = nxt; cA = nA; cB = nB; ++ui;
        if constexpr (ALIGN_EPI) { if (wr == 1) PG8_BAR; }
    }
    PG8_WAIT_V(0);
    if constexpr (!ALIGN_EPI) { if (wr == 0) PG8_BAR; }
    PG8_BAR;
    if constexpr (Epi::AFTER_DRAIN) { E.fused(acc, cur, wr, wc, fr, fq, lds, wid, lane); S.done(cur); }
#undef PG8_SA
#undef PG8_SB
#undef PG8_STAGE
#undef PG8_LDA
#undef PG8_LDB
#undef PG8_MMA
#undef PG8_WAIT_V
#undef PG8_WAIT_L
#undef PG8_BAR
#undef PG8_SCHED
}
}
namespace att {
using bf16 = __hip_bfloat16;
constexpr int   D = 128, NW = 8, QBLK = 32, KVBLK = 64;
constexpr float SCALE = 0.088388347648318440f;
constexpr float THR = 8.f;
constexpr int SDEPTH = 1;
constexpr int LDQ = 1024, LDK = 256, LDO = 1024;
constexpr size_t SHM_V = KVBLK * D * 2, SHM_K = KVBLK * D * 2, SHM_ATTN = 3 * SHM_V + 3 * SHM_K + NW * 64 * 4;
using bf16x8 = __attribute__((ext_vector_type(8))) short;
using s16x4  = __attribute__((ext_vector_type(4))) short;
using f32x16 = __attribute__((ext_vector_type(16))) float;
using f32x8  = __attribute__((ext_vector_type(8))) float;
using u32x4  = __attribute__((ext_vector_type(4))) unsigned;
#define KSWZ(row, colB) ((row) * 256 + ((colB) ^ (((row) & 15) << 4)))
#define SBAR() __builtin_amdgcn_sched_barrier(0)
__device__ __forceinline__ int crow(int r, int hi) { return (r & 3) + 8 * (r >> 2) + 4 * hi; }
__device__ __forceinline__ unsigned cvtpk(float lo, float hi) { return pg8::cvt_pk_bf16(lo, hi); }
template <typename TIn> struct Stage;
template <> struct Stage<bf16>  { using T = bf16x8;
  __device__ static __forceinline__ T ld8(const bf16* p) { return *reinterpret_cast<const bf16x8*>(p); }
  __device__ static __forceinline__ bf16x8 tobf(T x) { return x; } };
template <> struct Stage<float> { using T = f32x8;
  __device__ static __forceinline__ T ld8(const float* p) { return *reinterpret_cast<const f32x8*>(p); }
  __device__ static __forceinline__ bf16x8 tobf(T x) {
    u32x4 w = {cvtpk(x[0], x[1]), cvtpk(x[2], x[3]), cvtpk(x[4], x[5]), cvtpk(x[6], x[7])}; return *reinterpret_cast<bf16x8*>(&w); } };

__device__ __forceinline__ void partialSM(f32x16& p0, f32x16& p1, float& m_reg, float& mn, float& alpha) {
  constexpr float C = SCALE * 1.4426950408889634f;
  float pmax = p0[0]; for (int r = 1; r < 16; ++r) pmax = fmaxf(pmax, p0[r]); for (int r = 0; r < 16; ++r) pmax = fmaxf(pmax, p1[r]);
  { auto rr = __builtin_amdgcn_permlane32_swap(__float_as_uint(pmax), __float_as_uint(pmax), false, false);
    pmax = fmaxf(__uint_as_float(rr[0]), __uint_as_float(rr[1])); }
  if (__builtin_expect(__all(pmax - m_reg <= THR / SCALE), 1)) { mn = m_reg; alpha = 1.f; }
  else { mn = fmaxf(m_reg, pmax); alpha = __builtin_amdgcn_exp2f((m_reg - mn) * C); m_reg = mn; }
  float mnC = -mn * C;
  for (int r = 0; r < 16; ++r) p0[r] = fmaf(p0[r], C, mnC); for (int r = 0; r < 16; ++r) p1[r] = fmaf(p1[r], C, mnC);
  for (int r = 0; r < 16; ++r) p0[r] = __builtin_amdgcn_exp2f(p0[r]);
}
__device__ __forceinline__ void finishSM(f32x16& p0, f32x16& p1, float alpha, float& l_reg, bf16x8& pa0, bf16x8& pa1, bf16x8& pa2, bf16x8& pa3) {
  for (int r = 0; r < 16; ++r) p1[r] = __builtin_amdgcn_exp2f(p1[r]);
  float ps = 0; for (int r = 0; r < 16; ++r) ps += p0[r]; for (int r = 0; r < 16; ++r) ps += p1[r];
  { auto rr = __builtin_amdgcn_permlane32_swap(__float_as_uint(ps), __float_as_uint(ps), false, false);
    ps = __uint_as_float(rr[0]) + __uint_as_float(rr[1]); }
  l_reg = l_reg * alpha + ps;
#define PK4(P, BASE, OUT) do { unsigned a0 = cvtpk(P[BASE + 0], P[BASE + 1]), a1 = cvtpk(P[BASE + 2], P[BASE + 3]);   \
    unsigned b0 = cvtpk(P[BASE + 4], P[BASE + 5]), b1 = cvtpk(P[BASE + 6], P[BASE + 7]);                              \
    auto r0 = __builtin_amdgcn_permlane32_swap(a0, b0, false, false); auto r1 = __builtin_amdgcn_permlane32_swap(a1, b1, false, false); \
    u32x4 w = {r0[0], r1[0], r0[1], r1[1]}; OUT = *reinterpret_cast<bf16x8*>(&w); } while (0)
  PK4(p0, 0, pa0); PK4(p0, 8, pa1); PK4(p1, 0, pa2); PK4(p1, 8, pa3);
#undef PK4
}
__device__ __forceinline__ void partialSM2(f32x16& p0, f32x16& p1, const float negBC) {
  constexpr float C = SCALE * 1.4426950408889634f;
  for (int r = 0; r < 16; ++r) p0[r] = fmaf(p0[r], C, negBC); for (int r = 0; r < 16; ++r) p1[r] = fmaf(p1[r], C, negBC);
  for (int r = 0; r < 16; ++r) p0[r] = __builtin_amdgcn_exp2f(p0[r]);
}
__device__ __forceinline__ void finishSM2(f32x16& p0, f32x16& p1, float& l_reg, bf16x8& pa0, bf16x8& pa1, bf16x8& pa2, bf16x8& pa3) {
  for (int r = 0; r < 16; ++r) p1[r] = __builtin_amdgcn_exp2f(p1[r]);
  float ps = 0; for (int r = 0; r < 16; ++r) ps += p0[r]; for (int r = 0; r < 16; ++r) ps += p1[r];
  l_reg += ps;
#define PK4(P, BASE, OUT) do { unsigned a0 = cvtpk(P[BASE + 0], P[BASE + 1]), a1 = cvtpk(P[BASE + 2], P[BASE + 3]);   \
    unsigned b0 = cvtpk(P[BASE + 4], P[BASE + 5]), b1 = cvtpk(P[BASE + 6], P[BASE + 7]);                              \
    auto r0 = __builtin_amdgcn_permlane32_swap(a0, b0, false, false); auto r1 = __builtin_amdgcn_permlane32_swap(a1, b1, false, false); \
    u32x4 w = {r0[0], r1[0], r0[1], r1[1]}; OUT = *reinterpret_cast<bf16x8*>(&w); } while (0)
  PK4(p0, 0, pa0); PK4(p0, 8, pa1); PK4(p1, 0, pa2); PK4(p1, 8, pa3);
#undef PK4
}
__device__ __forceinline__ void qkt(f32x16& p0, f32x16& p1, const bf16* Ks, const bf16x8* qr, int r32, int hi) {
  p0 = f32x16{}; p1 = f32x16{};
  for (int d0 = 0; d0 < 8; ++d0) { int cb = (d0 * 16 + hi * 8) * 2;
    bf16x8 b0 = *reinterpret_cast<const bf16x8*>((const char*)Ks + KSWZ(r32, cb));
    bf16x8 b1 = *reinterpret_cast<const bf16x8*>((const char*)Ks + KSWZ(32 + r32, cb));
    p0 = __builtin_amdgcn_mfma_f32_32x32x16_bf16(b0, qr[d0], p0, 0, 0, 0);
    p1 = __builtin_amdgcn_mfma_f32_32x32x16_bf16(b1, qr[d0], p1, 0, 0, 0); }
}
__device__ __forceinline__ void partialSM3(f32x16& p0) { for (int r = 0; r < 16; ++r) p0[r] = __builtin_amdgcn_exp2f(p0[r]); }
__device__ __forceinline__ void qkt3(f32x16& p0, f32x16& p1, const bf16* Ks, const bf16x8* qr, int r32, int hi, const f32x16& cinit) {
  { int cb = (hi * 8) * 2;
    bf16x8 b0 = *reinterpret_cast<const bf16x8*>((const char*)Ks + KSWZ(r32, cb));
    bf16x8 b1 = *reinterpret_cast<const bf16x8*>((const char*)Ks + KSWZ(32 + r32, cb));
    p0 = __builtin_amdgcn_mfma_f32_32x32x16_bf16(b0, qr[0], cinit, 0, 0, 0);
    p1 = __builtin_amdgcn_mfma_f32_32x32x16_bf16(b1, qr[0], cinit, 0, 0, 0); }
  for (int d0 = 1; d0 < 8; ++d0) { int cb = (d0 * 16 + hi * 8) * 2;
    bf16x8 b0 = *reinterpret_cast<const bf16x8*>((const char*)Ks + KSWZ(r32, cb));
    bf16x8 b1 = *reinterpret_cast<const bf16x8*>((const char*)Ks + KSWZ(32 + r32, cb));
    p0 = __builtin_amdgcn_mfma_f32_32x32x16_bf16(b0, qr[d0], p0, 0, 0, 0);
    p1 = __builtin_amdgcn_mfma_f32_32x32x16_bf16(b1, qr[d0], p1, 0, 0, 0); }
}
__device__ __forceinline__ int v_st(int k, int c) { const int kk = (k & ~0xC) | ((k & 4) << 1) | ((k & 8) >> 1); return ((kk >> 3) * 4 + (c >> 5)) * 512 + ((kk & 7) * 32 + (c & 31)) * 2; }
__device__ __forceinline__ int v_rd_base(int lane) { return ((lane & 3) << 3) | (((lane >> 2) & 3) << 6) | (((lane >> 4) & 1) << 5) | (((lane >> 5) & 1) << 8); }
constexpr int v_rd_off(int d0, int ks, int half) { return d0 * 512 + ks * 4096 + half * 2048; }
template <int OFF> __device__ __forceinline__ s16x4 tr_read(int vb) {
  s16x4 r; asm volatile("ds_read_b64_tr_b16 %0, %1 offset:%2" : "=&v"(r) : "v"(vb), "i"(OFF) : "memory"); return r;
}
template <int D0> __device__ __forceinline__ void pv_one(f32x16& od, int vb, bf16x8 pa0, bf16x8 pa1, bf16x8 pa2, bf16x8 pa3) {
  const s16x4 l0 = tr_read<v_rd_off(D0, 0, 0)>(vb), h0 = tr_read<v_rd_off(D0, 0, 1)>(vb), l1 = tr_read<v_rd_off(D0, 1, 0)>(vb), h1 = tr_read<v_rd_off(D0, 1, 1)>(vb);
  const s16x4 l2 = tr_read<v_rd_off(D0, 2, 0)>(vb), h2 = tr_read<v_rd_off(D0, 2, 1)>(vb), l3 = tr_read<v_rd_off(D0, 3, 0)>(vb), h3 = tr_read<v_rd_off(D0, 3, 1)>(vb);
  asm volatile("s_waitcnt lgkmcnt(0)" ::: "memory"); SBAR();
#define PK(L, H) (bf16x8){L[0], L[1], L[2], L[3], H[0], H[1], H[2], H[3]}
  od = __builtin_amdgcn_mfma_f32_32x32x16_bf16(pa0, PK(l0, h0), od, 0, 0, 0);
  od = __builtin_amdgcn_mfma_f32_32x32x16_bf16(pa1, PK(l1, h1), od, 0, 0, 0);
  od = __builtin_amdgcn_mfma_f32_32x32x16_bf16(pa2, PK(l2, h2), od, 0, 0, 0);
  od = __builtin_amdgcn_mfma_f32_32x32x16_bf16(pa3, PK(l3, h3), od, 0, 0, 0);
#undef PK
}
__device__ __forceinline__ void pv_d0(f32x16* o, int vb, bf16x8 pa0, bf16x8 pa1, bf16x8 pa2, bf16x8 pa3) {
  pv_one<0>(o[0], vb, pa0, pa1, pa2, pa3); pv_one<1>(o[1], vb, pa0, pa1, pa2, pa3); pv_one<2>(o[2], vb, pa0, pa1, pa2, pa3); pv_one<3>(o[3], vb, pa0, pa1, pa2, pa3);
}

__device__ __forceinline__ void finishSM4(f32x16& p0, f32x16& p1, float& l_reg, bf16x8& pa0, bf16x8& pa1, bf16x8& pa2, bf16x8& pa3) {
  for (int r = 0; r < 16; ++r) p1[r] = __builtin_amdgcn_exp2f(p1[r]);
  float ps = 0; for (int r = 0; r < 16; ++r) ps += p0[r]; for (int r = 0; r < 16; ++r) ps += p1[r];
  l_reg += ps;
#define PK8(P, BASE, OUT) do { u32x4 w = {cvtpk(P[BASE + 0], P[BASE + 1]), cvtpk(P[BASE + 2], P[BASE + 3]), cvtpk(P[BASE + 4], P[BASE + 5]), cvtpk(P[BASE + 6], P[BASE + 7])}; OUT = *reinterpret_cast<bf16x8*>(&w); } while (0)
  PK8(p0, 0, pa0); PK8(p0, 8, pa1); PK8(p1, 0, pa2); PK8(p1, 8, pa3);
#undef PK8
}
__device__ __forceinline__ int v_rd_base2(int lane) { return ((lane & 3) << 3) | (((lane >> 2) & 3) << 6) | (((lane >> 4) & 1) << 5) | (((lane >> 5) & 1) << 11); }
constexpr int v_rd_off2(int d0, int ks, int part) { return d0 * 512 + ks * 4096 + part * 256; }
template <int D0> __device__ __forceinline__ void pv_one2(f32x16& od, int vb, bf16x8 pa0, bf16x8 pa1, bf16x8 pa2, bf16x8 pa3) {
  const s16x4 l0 = tr_read<v_rd_off2(D0, 0, 0)>(vb), h0 = tr_read<v_rd_off2(D0, 0, 1)>(vb), l1 = tr_read<v_rd_off2(D0, 1, 0)>(vb), h1 = tr_read<v_rd_off2(D0, 1, 1)>(vb);
  const s16x4 l2 = tr_read<v_rd_off2(D0, 2, 0)>(vb), h2 = tr_read<v_rd_off2(D0, 2, 1)>(vb), l3 = tr_read<v_rd_off2(D0, 3, 0)>(vb), h3 = tr_read<v_rd_off2(D0, 3, 1)>(vb);
  asm volatile("s_waitcnt lgkmcnt(0)" ::: "memory"); SBAR();
#define PK(L, H) (bf16x8){L[0], L[1], L[2], L[3], H[0], H[1], H[2], H[3]}
  od = __builtin_amdgcn_mfma_f32_32x32x16_bf16(PK(l0, h0), pa0, od, 0, 0, 0);
  od = __builtin_amdgcn_mfma_f32_32x32x16_bf16(PK(l1, h1), pa1, od, 0, 0, 0);
  od = __builtin_amdgcn_mfma_f32_32x32x16_bf16(PK(l2, h2), pa2, od, 0, 0, 0);
  od = __builtin_amdgcn_mfma_f32_32x32x16_bf16(PK(l3, h3), pa3, od, 0, 0, 0);
#undef PK
}
__device__ __forceinline__ void pv_d02(f32x16* o, int vb, bf16x8 pa0, bf16x8 pa1, bf16x8 pa2, bf16x8 pa3) {
  pv_one2<0>(o[0], vb, pa0, pa1, pa2, pa3); pv_one2<1>(o[1], vb, pa0, pa1, pa2, pa3); pv_one2<2>(o[2], vb, pa0, pa1, pa2, pa3); pv_one2<3>(o[3], vb, pa0, pa1, pa2, pa3);
}
__device__ __forceinline__ void attn_dense_body(const bf16* Qb, const bf16* __restrict__ Kh, const bf16* __restrict__ Vh, const bf16* __restrict__ Zb,
                                                bf16* Ob, int seq, char* lds, const int wid_in, const float kmax, __attribute__((address_space(3))) unsigned char* lds3) {
  using St = Stage<bf16>; using SQ = Stage<bf16>; using TQ = bf16;
  int lane = __builtin_amdgcn_mbcnt_hi(~0u, __builtin_amdgcn_mbcnt_lo(~0u, 0u)); asm volatile("" : "+v"(lane));
  const int wid = wid_in, tid = wid * 64 + lane, r32 = lane & 31, hi = lane >> 5;
  bf16* V_lds = (bf16*)lds; bf16* K_lds = (bf16*)(lds + 3 * SHM_V);
  float l_reg = 0; f32x16 o[4] = {}; bf16x8 qr[8];
  const TQ* Qw = Qb + (long)(wid * QBLK + r32) * LDQ + hi * 8;
#pragma unroll
  for (int d0 = 0; d0 < 8; ++d0) qr[d0] = SQ::tobf(SQ::ld8(Qw + d0 * 16));
  float negBC;
  { float ss = 0.f;
#pragma unroll
    for (int d0 = 0; d0 < 8; ++d0)
#pragma unroll
      for (int e = 0; e < 8; ++e) { const float qv = __uint_as_float((unsigned)(unsigned short)qr[d0][e] << 16); ss = fmaf(qv, qv, ss); }
    auto rr = __builtin_amdgcn_permlane32_swap(__float_as_uint(ss), __float_as_uint(ss), false, false);
    ss = __uint_as_float(rr[0]) + __uint_as_float(rr[1]);
    negBC = -(sqrtf(ss) * kmax * (11.313708498984761f * 1.01f) + 0.07f); }
  f32x16 cinit; for (int r = 0; r < 16; ++r) cinit[r] = negBC;
  const int vb0 = (int)(uintptr_t)V_lds + v_rd_base2(lane);
  int koff0, koff1, voff0, voff1;
  { const int rk0 = 8 * wid + (lane >> 4), rk1 = rk0 + 4; koff0 = rk0 * (LDK * 2) + (((lane & 15) ^ (rk0 & 15)) << 4); koff1 = rk1 * (LDK * 2) + (((lane & 15) ^ (rk1 & 15)) << 4);
    const int st0 = 4 * wid + (lane >> 5), st1 = st0 + 2, q8 = (lane & 31) >> 2;
    const int kk0 = ((st0 >> 2) << 3) | q8, kk1 = ((st1 >> 2) << 3) | q8;
    const int ky0 = (kk0 & ~0xC) | ((kk0 & 4) << 1) | ((kk0 & 8) >> 1), ky1 = (kk1 & ~0xC) | ((kk1 & 4) << 1) | ((kk1 & 8) >> 1);
    voff0 = ky0 * (LDK * 2) + ((st0 & 3) * 32 + (lane & 3) * 8) * 2; voff1 = ky1 * (LDK * 2) + ((st1 & 3) * 32 + (lane & 3) * 8) * 2; }
#define SDMA(s, k0) do { const char* kg_ = (const char*)(Kh + (long)(k0) * LDK); const char* vg_ = (const char*)(Vh + (long)(k0) * LDK); \
    __attribute__((address_space(3))) unsigned char* kd_ = lds3 + 3 * (int)SHM_V + (s) * (int)SHM_K + wid * 2048; __attribute__((address_space(3))) unsigned char* vd_ = lds3 + (s) * (int)SHM_V + wid * 2048; \
    __builtin_amdgcn_global_load_lds((const unsigned*)(kg_ + koff0), (__attribute__((address_space(3))) unsigned*)kd_, 16, 0, 0); \
    __builtin_amdgcn_global_load_lds((const unsigned*)(kg_ + koff1), (__attribute__((address_space(3))) unsigned*)(kd_ + 1024), 16, 0, 0); \
    __builtin_amdgcn_global_load_lds((const unsigned*)(vg_ + voff0), (__attribute__((address_space(3))) unsigned*)vd_, 16, 0, 0); \
    __builtin_amdgcn_global_load_lds((const unsigned*)(vg_ + voff1), (__attribute__((address_space(3))) unsigned*)(vd_ + 1024), 16, 0, 0); } while (0)
#define DWAIT() asm volatile("s_waitcnt vmcnt(0)" ::: "memory")
  f32x16 pA0, pA1, pB0, pB1; bf16x8 pa0, pa1, pa2, pa3; const int NT = seq / KVBLK;
  SDMA(0, 0); DWAIT(); __syncthreads();
  SDMA(1, KVBLK);
  qkt3(pA0, pA1, K_lds, qr, r32, hi, cinit); partialSM3(pA0);
  DWAIT(); __syncthreads();
  int sP = 0, sC = 1, sN = 2;
#define KSLOT(s) ((bf16*)((char*)K_lds + (s) * (int)SHM_K))
#define ROT() do { const int t_ = sP; sP = sC; sC = sN; sN = t_; } while (0)
  for (int j = 1; j + 1 < NT; j += 2) {
    SDMA(sN, (j + 1) * KVBLK);
    SBAR(); qkt3(pB0, pB1, KSLOT(sC), qr, r32, hi, cinit);
    finishSM4(pA0, pA1, l_reg, pa0, pa1, pa2, pa3);
    pv_d02(o, vb0 + sP * (int)SHM_V, pa0, pa1, pa2, pa3); partialSM3(pB0);
    DWAIT(); __syncthreads(); ROT();
    SDMA(sN, (j + 2) * KVBLK);
    SBAR(); qkt3(pA0, pA1, KSLOT(sC), qr, r32, hi, cinit);
    finishSM4(pB0, pB1, l_reg, pa0, pa1, pa2, pa3);
    pv_d02(o, vb0 + sP * (int)SHM_V, pa0, pa1, pa2, pa3); partialSM3(pA0);
    DWAIT(); __syncthreads(); ROT();
  }
  SBAR(); qkt3(pB0, pB1, KSLOT(sC), qr, r32, hi, cinit);
  finishSM4(pA0, pA1, l_reg, pa0, pa1, pa2, pa3); SBAR();
  pv_d02(o, vb0 + sP * (int)SHM_V, pa0, pa1, pa2, pa3); partialSM3(pB0);
  finishSM4(pB0, pB1, l_reg, pa0, pa1, pa2, pa3); SBAR();
  pv_d02(o, vb0 + sC * (int)SHM_V, pa0, pa1, pa2, pa3);
#undef KSLOT
#undef ROT
#undef SDMA
#undef DWAIT
  { auto rr = __builtin_amdgcn_permlane32_swap(__float_as_uint(l_reg), __float_as_uint(l_reg), false, false); l_reg = __uint_as_float(rr[0]) + __uint_as_float(rr[1]); }
  const float rl = __builtin_amdgcn_rcpf(l_reg);
  { int lb = (wid * QBLK + r32) * LDO + 4 * hi; asm volatile("" : "+v"(lb));
    unsigned short* Ow = (unsigned short*)Ob + lb; const unsigned short* Zw = (const unsigned short*)Zb + lb;
#pragma unroll
    for (int d0 = 0; d0 < 4; ++d0)
#pragma unroll
      for (int g = 0; g < 4; ++g) { const int co = d0 * 32 + 8 * g; const unsigned long long zz = *(const unsigned long long*)(Zw + co);
        const float z0 = __uint_as_float((unsigned)(zz << 16)), z1 = __uint_as_float((unsigned)zz & 0xffff0000u), z2 = __uint_as_float((unsigned)(zz >> 32) << 16), z3 = __uint_as_float((unsigned)(zz >> 32) & 0xffff0000u);
        const unsigned w0 = cvtpk(o[d0][4 * g + 0] * rl * z0, o[d0][4 * g + 1] * rl * z1), w1 = cvtpk(o[d0][4 * g + 2] * rl * z2, o[d0][4 * g + 3] * rl * z3);
        *(unsigned long long*)(Ow + co) = (unsigned long long)w0 | ((unsigned long long)w1 << 32); } }
}
}

typedef unsigned short bf16_t;
typedef float f32x4 __attribute__((ext_vector_type(4)));
typedef unsigned u32x4 __attribute__((ext_vector_type(4)));
typedef unsigned u32x2v __attribute__((ext_vector_type(2)));
typedef short bf16x8v __attribute__((ext_vector_type(8)));
typedef float f32x16v __attribute__((ext_vector_type(16)));
#define LAS __attribute__((address_space(3)))
#define XB_TMO      128
#define XB_XCNT(j)  (256  + 64 * (j))
#define XB_XSUB(j)  (1280 + 64 * (j))
#define XB_XGEN(j)  (2304 + 64 * (j))
#define XB_TOP      3328
#define XB_TOPGEN   3392
#define XCD_BAR_WORDS 3456
#define XB_SPIN_CAP (1u << 18)

__device__ __forceinline__ unsigned xb_ld(unsigned* p)              { return __hip_atomic_load(p, __ATOMIC_RELAXED, __HIP_MEMORY_SCOPE_AGENT); }
__device__ __forceinline__ unsigned xb_add(unsigned* p, unsigned v) { return __hip_atomic_fetch_add(p, v, __ATOMIC_RELAXED, __HIP_MEMORY_SCOPE_AGENT); }
__device__ __forceinline__ unsigned xb_xcc_id() { return (unsigned)__builtin_amdgcn_s_getreg((3 << 11) | 20) & 0xFu; }
#define XB_SPIN(cond, bar) do { unsigned _sp = 0; while (cond) { __builtin_amdgcn_s_sleep(1); \
    if ((++_sp & 255u) == 0u) { if (xb_ld(&(bar)[XB_TMO])) break; if (_sp > XB_SPIN_CAP) { atomicAdd(&(bar)[XB_TMO], 1u); break; } } } } while (0)

struct XcdBarrier {
    unsigned* bar; unsigned x;
    volatile LAS unsigned* st;
};

__device__ __forceinline__ XcdBarrier xcd_barrier_post(unsigned* bar, volatile LAS unsigned* st, const bool leader) {
    XcdBarrier b; b.bar = bar; b.x = xb_xcc_id(); b.st = st;
    if (leader) (void)xb_add(&bar[XB_XCNT(b.x)], 1u);
    return b;
}
__device__ __forceinline__ void xcd_barrier_complete(unsigned* bar, unsigned x, unsigned& nloc, unsigned& nx) {
    const unsigned G = gridDim.x * gridDim.y * gridDim.z;
    unsigned sum, cnt, mine, sp = 0u;
    for (;;) {
        sum = 0u; cnt = 0u; mine = 0u;
#pragma unroll
        for (unsigned j = 0; j < 16; ++j) { const unsigned c = xb_ld(&bar[XB_XCNT(j)]); sum += c; cnt += (c > 0u) ? 1u : 0u; mine = (j == x) ? c : mine; }
        if (sum == G) break;
        __builtin_amdgcn_s_sleep(1);
        if ((++sp & 255u) == 0u) { if (xb_ld(&bar[XB_TMO])) break; if (sp > XB_SPIN_CAP) { atomicAdd(&bar[XB_TMO], 1u); break; } }
    }
    nloc = mine > 0u ? mine : 1u; nx = cnt > 0u ? cnt : 1u;
}

__device__ __forceinline__ void xcd_barrier(const XcdBarrier& b, const bool leader) {
    asm volatile("s_waitcnt vmcnt(0)" ::: "memory");
    __syncthreads();
    if (leader) {
        unsigned* bar = b.bar;
        __builtin_amdgcn_s_waitcnt(0);
        unsigned nloc = b.st[0], nx = b.st[1];
        if (nloc == 0u) { xcd_barrier_complete(bar, b.x, nloc, nx); b.st[0] = nloc; b.st[1] = nx; }
        const unsigned old = xb_add(&bar[XB_XSUB(b.x)], 1u);
        const unsigned gen = old / nloc;
        if (old + 1u == (gen + 1u) * nloc) {
            __builtin_amdgcn_fence(__ATOMIC_RELEASE, "agent");
            asm volatile("s_waitcnt vmcnt(0)" ::: "memory");
            const unsigned og = xb_add(&bar[XB_TOP], 1u);
            const unsigned tg = og / nx;
            if (og + 1u == (tg + 1u) * nx) xb_add(&bar[XB_TOPGEN], 1u);
            else XB_SPIN(xb_ld(&bar[XB_TOPGEN]) == tg, bar);
            __builtin_amdgcn_fence(__ATOMIC_ACQUIRE, "agent");
            xb_add(&bar[XB_XGEN(b.x)], 1u);
            asm volatile("s_waitcnt vmcnt(0)" ::: "memory");
        } else {
            XB_SPIN(xb_ld(&bar[XB_XGEN(b.x)]) == gen, bar);
            __builtin_amdgcn_fence(__ATOMIC_ACQUIRE, "agent");
            asm volatile("s_waitcnt vmcnt(0)" ::: "memory");
        }
    }
    __syncthreads();
}

constexpr int RING_BYTES = pg8::STAGE_BYTES;
constexpr int PART_OFF = RING_BYTES;
constexpr int XBST_OFF = RING_BYTES + 8192;
constexpr int LDS_BYTES = RING_BYTES + 8192 + 16;

__device__ __forceinline__ unsigned pk2(float a, float b) { return pg8::cvt_pk_bf16(a, b); }
__device__ __forceinline__ float wave_sum(float v) {
#pragma unroll
    for (int o = 1; o < 64; o <<= 1) v += __shfl_xor(v, o);
    return v;
}
__device__ __forceinline__ const float* xrow_c(const float* lat, const float* cx, int r) {
    const int b = r / TB, rr = r - b * TB;
    return rr < CTXL ? cx + ((size_t)b * CTXL + rr) * DM : lat + ((size_t)b * SEQ + (rr - CTXL)) * DM;
}
__device__ __forceinline__ int qk_src(int c) { const int h = c & ~127, cp = c & 127;
    return h + ((cp >> 6) & 1) * 64 + ((cp >> 2) & 1) * 32 + ((cp >> 5) & 1) * 16 + ((cp >> 3) & 3) * 4 + (cp & 3); }

__device__ __forceinline__ void transpose_item(const float* W, int K, int N, bf16_t* WT, LAS float* scr, int item, int lane, int nperm) {
    const int nblk = N / 32, kb = item / nblk, nb = item % nblk, k0 = 64 * kb, n0 = 32 * nb;
    const int cdst = n0 + (lane & 31), csrc = cdst < nperm ? qk_src(cdst) : cdst;
#pragma unroll 8
    for (int i = 0; i < 32; ++i) { const int kk = 2 * i + (lane >> 5); scr[kk * 33 + (lane & 31)] = W[(size_t)(k0 + kk) * N + csrc]; }
    asm volatile("s_waitcnt lgkmcnt(0)" ::: "memory");
    const int c = lane & 7;
#pragma unroll
    for (int j = 0; j < 4; ++j) { const int n = (lane >> 3) + 8 * j; const LAS float* s = scr + (8 * c) * 33 + n;
        u32x4 o; o.x = pk2(s[0 * 33], s[1 * 33]); o.y = pk2(s[2 * 33], s[3 * 33]); o.z = pk2(s[4 * 33], s[5 * 33]); o.w = pk2(s[6 * 33], s[7 * 33]);
        *(u32x4*)(WT + (size_t)(n0 + n) * K + k0 + 8 * c) = o; }
    asm volatile("s_waitcnt lgkmcnt(0)" ::: "memory");
}

template <int GI> __device__ __forceinline__ void pool_unit_t(const bf16_t* XB, bf16_t* ZB, const bf16_t* WPt, const float* pscale, int R0, int lane) {
    constexpr int g = GI, a = 1 << GI;
    const int pm = R0 >> 8, b = pm / 65, jt = pm % 65;
    const int lo = b * TB + (jt ? CTXL : 0), hiR = jt ? (b + 1) * TB : b * TB + CTXL;
    const int r32 = lane & 31, hh = lane >> 5, t = R0 + r32;
    const int s0 = max(t - a, lo), s1 = min(t + a - 1, hiR - 1); const float inv = 1.0f / (float)(s1 - s0 + 1);
    f32x16v acc0 = {}, acc1 = {}, acc2 = {}, acc3 = {};
    const bf16_t* xb = XB + g * 128 + hh * 8;
    const bf16_t* wp = WPt + (size_t)(g * 128 + r32) * 128 + hh * 8;
    float wq[2 * a]; int rq[2 * a];
#pragma unroll
    for (int q = 0; q < 2 * a; ++q) { const int rr = t - a + q; const bool ok = (rr >= lo) && (rr < hiR); wq[q] = ok ? inv : 0.f; rq[q] = ok ? rr : t; }
#pragma unroll 1
    for (int kk = 0; kk < 8; ++kk) {
        u32x4 wv[2 * a];
#pragma unroll
        for (int q = 0; q < 2 * a; ++q) wv[q] = *(const u32x4*)(xb + (size_t)rq[q] * 512 + kk * 16);
        const u32x4 w = *(const u32x4*)(xb + (size_t)t * 512 + kk * 16);
        const bf16x8v w0 = *(const bf16x8v*)(wp + kk * 16), w1 = *(const bf16x8v*)(wp + 32 * 128 + kk * 16), w2 = *(const bf16x8v*)(wp + 64 * 128 + kk * 16), w3 = *(const bf16x8v*)(wp + 96 * 128 + kk * 16);
        float s[8] = {0.f, 0.f, 0.f, 0.f, 0.f, 0.f, 0.f, 0.f};
#pragma unroll
        for (int q = 0; q < 2 * a; ++q) { const float f = wq[q]; const u32x4 v = wv[q];
            s[0] += f * pg8::bf_lo(v.x); s[1] += f * pg8::bf_hi(v.x); s[2] += f * pg8::bf_lo(v.y); s[3] += f * pg8::bf_hi(v.y); s[4] += f * pg8::bf_lo(v.z); s[5] += f * pg8::bf_hi(v.z); s[6] += f * pg8::bf_lo(v.w); s[7] += f * pg8::bf_hi(v.w); }
        u32x4 mf; mf.x = pk2(s[0] - pg8::bf_lo(w.x), s[1] - pg8::bf_hi(w.x)); mf.y = pk2(s[2] - pg8::bf_lo(w.y), s[3] - pg8::bf_hi(w.y));
        mf.z = pk2(s[4] - pg8::bf_lo(w.z), s[5] - pg8::bf_hi(w.z)); mf.w = pk2(s[6] - pg8::bf_lo(w.w), s[7] - pg8::bf_hi(w.w));
        const bf16x8v mfrag = *reinterpret_cast<bf16x8v*>(&mf);
        acc0 = __builtin_amdgcn_mfma_f32_32x32x16_bf16(w0, mfrag, acc0, 0, 0, 0); acc1 = __builtin_amdgcn_mfma_f32_32x32x16_bf16(w1, mfrag, acc1, 0, 0, 0);
        acc2 = __builtin_amdgcn_mfma_f32_32x32x16_bf16(w2, mfrag, acc2, 0, 0, 0); acc3 = __builtin_amdgcn_mfma_f32_32x32x16_bf16(w3, mfrag, acc3, 0, 0, 0);
    }
    bf16_t* zrow = ZB + (size_t)t * 512 + g * 128; const float* ps = pscale + g * 128;
#define POOL_OUT(ACC, NS) do { _Pragma("unroll") for (int q = 0; q < 4; ++q) { const int n0 = (NS) * 32 + 8 * q + 4 * hh; const u32x2v z = *(const u32x2v*)(zrow + n0); const f32x4 p4 = *(const f32x4*)(ps + n0); \
        u32x2v o; o.x = pk2(ACC[4 * q + 0] * p4[0] * pg8::bf_lo(z.x), ACC[4 * q + 1] * p4[1] * pg8::bf_hi(z.x)); o.y = pk2(ACC[4 * q + 2] * p4[2] * pg8::bf_lo(z.y), ACC[4 * q + 3] * p4[3] * pg8::bf_hi(z.y)); \
        *(u32x2v*)(zrow + n0) = o; } } while (0)
    POOL_OUT(acc0, 0); POOL_OUT(acc1, 1); POOL_OUT(acc2, 2); POOL_OUT(acc3, 3);
#undef POOL_OUT
}
__device__ __forceinline__ void pool_unit(const bf16_t* XB, bf16_t* ZB, const bf16_t* WPt, const float* pscale, int wu, int lane) {
    const int g = wu & 3, R0 = (wu >> 2) * 32;
    if (g == 0) pool_unit_t<0>(XB, ZB, WPt, pscale, R0, lane); else if (g == 1) pool_unit_t<1>(XB, ZB, WPt, pscale, R0, lane);
    else if (g == 2) pool_unit_t<2>(XB, ZB, WPt, pscale, R0, lane); else pool_unit_t<3>(XB, ZB, WPt, pscale, R0, lane);
}

__device__ __forceinline__ void store_u(const f32x4 (&v)[4], const float* mod, bf16_t* urow, int lane) {
#pragma unroll
    for (int j = 0; j < 4; ++j) { const int c = 4 * lane + 256 * j; const f32x4 sh = *(const f32x4*)(mod + c), sc = *(const f32x4*)(mod + 1024 + c);
        const f32x4 u = v[j] * (sc + 1.0f) + sh; u32x2v o; o.x = pk2(u[0], u[1]); o.y = pk2(u[2], u[3]); *(u32x2v*)(urow + c) = o; }
}

__global__ void __launch_bounds__(NTHREADS, 2) mega(Params P) {
    extern __shared__ __attribute__((aligned(16))) unsigned char lds[];
    cg::grid_group grid = cg::this_grid();
    const int wave = __builtin_amdgcn_readfirstlane(threadIdx.x >> 6);
#define LANE_ID() (__builtin_amdgcn_mbcnt_hi(~0u, __builtin_amdgcn_mbcnt_lo(~0u, 0u)))
    const int G = gridDim.x, bid = blockIdx.x, gw = bid * NWAVES + wave, NGW = G * NWAVES;
#define GRID_SYNC() xcd_barrier(xbar, wave == 0 && LANE_ID() == 0)
#define CAS __attribute__((address_space(4)))
#define WSL() const CAS Params* pp = (const CAS Params*)__builtin_amdgcn_kernarg_segment_ptr(); asm volatile("" : "+s"(pp)); unsigned char* wsl = pp->ws; asm volatile("" : "+s"(wsl))
#define U ((bf16_t*)(wsl + WS_U))
#define Q ((bf16_t*)(wsl + WS_Q))
#define Kb ((bf16_t*)(wsl + WS_K))
#define Vb ((bf16_t*)(wsl + WS_V))
#define ZA ((bf16_t*)(wsl + WS_ZA))
#define XB ((bf16_t*)(wsl + WS_XB))
#define ZB ((bf16_t*)(wsl + WS_ZB))
#define MOD ((float*)(wsl + WS_MOD))
#define CX ((float*)(wsl + WS_CX))
#define DELTA ((const bf16_t*)(wsl + WS_GA))
    LAS unsigned char* l3 = (LAS unsigned char*)lds;
    const CAS Params* pp0 = (const CAS Params*)__builtin_amdgcn_kernarg_segment_ptr();
    { volatile LAS unsigned* st = (volatile LAS unsigned*)(l3 + XBST_OFF); if (wave == 0 && LANE_ID() == 0) { st[0] = 0u; st[1] = 0u; st[2] = 0u; st[3] = 0u; } }
    __syncthreads();
    XcdBarrier xbar = xcd_barrier_post((unsigned*)(pp0->ws + WS_BAR), (volatile LAS unsigned*)(l3 + XBST_OFF), wave == 0 && LANE_ID() == 0);
    grid.sync();

    constexpr int NPH = 2 + 5 * DEPTH;
#pragma unroll 1
    for (int ph = 0; ph < NPH; ++ph) {
    const int l = ph < 2 ? 0 : (ph - 2) / 5, sph = ph < 2 ? ph : 2 + (ph - 2) % 5;
    if (sph == 0) {
        WSL(); int lane = LANE_ID(); asm volatile("" : "+v"(lane)); const int tid = wave * 64 + lane; unsigned char* ws = wsl; float* cosT = (float*)(wsl + WS_ROPE); float* sinT = cosT + 256 * 32;
        LAS float* scr = (LAS float*)(l3 + wave * 16384);
        constexpr int I_IN = (DM / 64) * (NIN / 32), I_A = (DM / 64) * (DM / 32), I_B = (512 / 64) * (DM / 32), I_O = I_A, I_P = (128 / 64) * (128 / 32);
        constexpr int PER_L = I_IN + I_A + I_B + I_O + 4 * I_P;
        for (int it = gw; it < DEPTH * PER_L; it += NGW) {
            const int l = it / PER_L; int r = it - l * PER_L;
            if (r < I_IN) { transpose_item(pp->w_in + (size_t)l * DM * NIN, DM, NIN, (bf16_t*)(ws + WS_WIN + l * SZ_WIN), scr, r, lane, 1280); continue; } r -= I_IN;
            if (r < I_A) { transpose_item(pp->w_br_a + (size_t)l * DM * DM, DM, DM, (bf16_t*)(ws + WS_WA + l * SZ_WA), scr, r, lane, 0); continue; } r -= I_A;
            if (r < I_B) { transpose_item(pp->w_br_b + (size_t)l * 512 * DM, 512, DM, (bf16_t*)(ws + WS_WB + l * SZ_WB), scr, r, lane, 0); continue; } r -= I_B;
            if (r < I_O) { transpose_item(pp->w_out + (size_t)l * DM * DM, DM, DM, (bf16_t*)(ws + WS_WO + l * SZ_WO), scr, r, lane, 0); continue; } r -= I_O;
            const int g = r / I_P; r -= g * I_P;
            transpose_item(pp->w_pool + ((size_t)l * 4 + g) * 128 * 128, 128, 128, (bf16_t*)(ws + WS_WP + l * SZ_WP) + (size_t)g * 128 * 128, scr, r, lane, 0);
        }
        for (int i = bid * NTHREADS + tid; i < 256 * 32; i += G * NTHREADS) { const int pos = i >> 5, f = i & 31;
            const float invf = 1.0f / __builtin_amdgcn_exp2f(13.287712379549449f * (float)f * (1.0f / 32.0f)); const float ang = (float)pos * invf;
            double rev = (double)ang * 0.15915494309189535; rev -= floor(rev); const float fr_ = (float)rev;
            cosT[i] = __builtin_amdgcn_cosf(fr_); sinT[i] = __builtin_amdgcn_sinf(fr_); }
        __syncthreads();
        LAS float* sv = (LAS float*)l3;
        LAS float* red = sv + 3 * 1024;
        for (int i = tid; i < 3 * 1024; i += NTHREADS) { const int v = i >> 10, k = i & 1023; const float cv = v < 2 ? pp->c[v * 1024 + k] : pp->c_ctx[k]; sv[i] = cv * pg8::sigm(cv); }
        __syncthreads();
        for (int un = bid; un < DEPTH * 48; un += G) { const int l = un / 48, n = (un % 48) * 64 + lane, ks = wave;
            const float* wm = pp->w_mod + (size_t)l * DM * 3072 + (size_t)(ks * 128) * 3072 + n; float a0 = 0.f, a1 = 0.f, a2 = 0.f;
#pragma unroll 8
            for (int k = 0; k < 128; ++k) { const float w = wm[(size_t)k * 3072]; a0 += sv[ks * 128 + k] * w; a1 += sv[1024 + ks * 128 + k] * w; a2 += sv[2048 + ks * 128 + k] * w; }
            red[(ks * 3 + 0) * 64 + lane] = a0; red[(ks * 3 + 1) * 64 + lane] = a1; red[(ks * 3 + 2) * 64 + lane] = a2;
            __syncthreads();
            if (tid < 192) { const int v = tid >> 6, cl = tid & 63; float s = 0.f;
#pragma unroll
                for (int q = 0; q < 8; ++q) s += red[(q * 3 + v) * 64 + cl];
                const int nn = (un % 48) * 64 + cl; MOD[((size_t)l * 3 + v) * 3072 + nn] = s + pp->b_mod[l * 3072 + nn]; }
            __syncthreads();
        }
    } else if (sph == 1) {
    WSL(); int lane = LANE_ID(); asm volatile("" : "+v"(lane));
    for (int r = gw; r < TROWS; r += NGW) { const float* xr = xrow_c(pp->x, pp->ctx, r); const int b = r / TB, mi = (r - b * TB) < CTXL ? 2 : b;
        f32x4 v[4];
#pragma unroll
        for (int j = 0; j < 4; ++j) v[j] = *(const f32x4*)(xr + 4 * lane + 256 * j);
        store_u(v, MOD + mi * 3072, U + (size_t)r * DM, lane); }
    } else if (sph == 2) {
        {
            WSL(); pg8::Gemm g{U, (const bf16_t*)(wsl + WS_WIN + l * SZ_WIN), TROWS, NIN, DM}; pg8::StaticOrder S; S.init(TROWS, NIN, G, bid);
            pg8::EpiIn E{wsl, pp->q_norm + l * 128, pp->k_norm + l * 128, (LAS float*)(l3 + PART_OFF)};
            pg8::gemm_phase<pg8::EpiIn, pg8::StaticOrder, true, true>(l3, g, S, E, wave);
        }
    } else if (sph == 3) {
        {
            WSL(); int lane = LANE_ID(); asm volatile("" : "+v"(lane)); const bf16_t* WPt = (const bf16_t*)(wsl + WS_WP + l * SZ_WP);
            const int nunits = 1024 + (l < DEPTH - 1 ? 16 : 0);
            float kmax; { const float* kn = pp->k_norm + l * 128; kmax = fmaxf(fabsf(kn[lane]), fabsf(kn[lane + 64]));
#pragma unroll
                for (int o_ = 1; o_ < 64; o_ <<= 1) kmax = fmaxf(kmax, __shfl_xor(kmax, o_)); }
            for (int un = bid; un < nunits; un += G) {
                __syncthreads();
                int b, h, rowq, seq;
                if (un < 1024) { b = un >> 9; h = (un >> 6) & 7; rowq = b * TB + CTXL + (un & 63) * 256; seq = TB; }
                else { const int c = un - 1024; b = c >> 3; h = c & 7; rowq = b * TB; seq = CTXL; }
                const size_t qoff = (size_t)rowq * DM + h * 128, koff = (size_t)b * TB * 256 + (h >> 2) * 128;
                att::attn_dense_body((const att::bf16*)(Q + qoff), (const att::bf16*)(Kb + koff), (const att::bf16*)(Vb + koff), (const att::bf16*)(ZA + qoff), (att::bf16*)(Q + qoff), seq, (char*)lds, wave, kmax, l3);
            }
            { unsigned* qctr = (unsigned*)(wsl + WS_BAR) + 8 + l; const int npool = (l < DEPTH - 1) ? (TROWS / 32) * 4 : (NBATCH * SEQ / 32) * 4;
              for (;;) { unsigned wq = 0u; if (lane == 0) wq = __hip_atomic_fetch_add(qctr, 1u, __ATOMIC_RELAXED, __HIP_MEMORY_SCOPE_AGENT);
                  const int wi = __builtin_amdgcn_readfirstlane((int)wq); if (wi >= npool) break;
                  int wu = wi; if (l == DEPTH - 1) { const int rc = wi >> 2, rcf = rc + (CTXL / 32) * (1 + rc / (SEQ / 32)); wu = (rcf << 2) | (wi & 3); }
                  pool_unit(XB, ZB, WPt, pp->pool_scale + l * 512, wu, lane); } }
        }
    } else if (sph == 4) {
        {
            WSL(); pg8::Gemm g{Q, (const bf16_t*)(wsl + WS_WA + l * SZ_WA), TROWS, DM, DM};
            pg8::EpiGate<0> E{wsl};
            { pg8::StaticOrder S; S.init(l == DEPTH - 1 ? NBATCH * SEQ : TROWS, DM, G, bid); S.skip = (l == DEPTH - 1); pg8::gemm_phase<pg8::EpiGate<0>, pg8::StaticOrder, true, true>(l3, g, S, E, wave); }
        }
        {
            WSL(); pg8::Gemm g{ZB, (const bf16_t*)(wsl + WS_WB + l * SZ_WB), TROWS, DM, 512};
            pg8::EpiGate<1> E{wsl};
            { pg8::StaticOrder S; S.init(l == DEPTH - 1 ? NBATCH * SEQ : TROWS, DM, G, bid); S.skip = (l == DEPTH - 1); pg8::gemm_phase<pg8::EpiGate<1>, pg8::StaticOrder, true, true>(l3, g, S, E, wave); }
        }
    } else if (sph == 5) {
        {
            WSL(); pg8::Gemm g{ZA, (const bf16_t*)(wsl + WS_WO + l * SZ_WO), TROWS, DM, DM};
            pg8::EpiRes E{MOD + (size_t)l * 3 * 3072, wsl};
            { pg8::StaticOrder S; S.init(l == DEPTH - 1 ? NBATCH * SEQ : TROWS, DM, G, bid); S.skip = (l == DEPTH - 1); pg8::gemm_phase<pg8::EpiRes, pg8::StaticOrder, true, true>(l3, g, S, E, wave); }
        }
    } else {
        {
            WSL(); int lane = LANE_ID(); asm volatile("" : "+v"(lane)); const float* modl = MOD + (size_t)l * 3 * 3072; const float* lg = pp->ln_g + l * DM; const float* lb = pp->ln_b + l * DM; const bool last = (l == DEPTH - 1);
            const float* xlat = l == 0 ? pp->x : pp->out; const float* xctx = l == 0 ? pp->ctx : CX;
            auto ln_row = [&](const int r, const f32x4 (&vin)[4]) {
                const int b = r / TB, rr = r - b * TB; const bool isctx = rr < CTXL; f32x4 v[4]; float s = 0.f;
#pragma unroll
                for (int j = 0; j < 4; ++j) { v[j] = vin[j]; s += (v[j][0] + v[j][1]) + (v[j][2] + v[j][3]); }
                const float mean = wave_sum(s) * (1.0f / DM); float s2 = 0.f;
#pragma unroll
                for (int j = 0; j < 4; ++j) { v[j] = v[j] - mean; s2 += (v[j][0] * v[j][0] + v[j][1] * v[j][1]) + (v[j][2] * v[j][2] + v[j][3] * v[j][3]); }
                const float rstd = 1.0f / sqrtf(wave_sum(s2) * (1.0f / DM) + EPSV);
                float* xo = isctx ? CX + ((size_t)b * CTXL + rr) * DM : pp->out + ((size_t)b * SEQ + (rr - CTXL)) * DM;
#pragma unroll
                for (int j = 0; j < 4; ++j) { const int c = 4 * lane + 256 * j; v[j] = v[j] * rstd * *(const f32x4*)(lg + c) + *(const f32x4*)(lb + c); *(f32x4*)(xo + c) = v[j]; }
                if (!last) store_u(v, modl + 3 * 3072 + (isctx ? 2 : b) * 3072, U + (size_t)r * DM, lane);
            };
            const int nrows = last ? NBATCH * SEQ : TROWS;
            for (int i0 = gw; i0 < nrows; i0 += 2 * NGW) {
                const int i1 = i0 + NGW; const bool has1 = i1 < nrows;
                const int r0 = last ? i0 + CTXL * (1 + i0 / SEQ) : i0, r1 = has1 ? (last ? i1 + CTXL * (1 + i1 / SEQ) : i1) : r0;
                f32x4 va[4], vb[4]; const float* xa = xrow_c(xlat, xctx, r0); const float* xb_ = xrow_c(xlat, xctx, r1);
                const bf16_t* da = DELTA + (size_t)r0 * DM; const bf16_t* db = DELTA + (size_t)r1 * DM;
#pragma unroll
                for (int j = 0; j < 4; ++j) { const int c = 4 * lane + 256 * j; const f32x4 x0 = *(const f32x4*)(xa + c), x1 = *(const f32x4*)(xb_ + c);
                    const u32x2v d0 = *(const u32x2v*)(da + c), d1 = *(const u32x2v*)(db + c);
                    va[j] = x0 * ALPHA_RES + (f32x4){pg8::bf_lo(d0.x), pg8::bf_hi(d0.x), pg8::bf_lo(d0.y), pg8::bf_hi(d0.y)};
                    vb[j] = x1 * ALPHA_RES + (f32x4){pg8::bf_lo(d1.x), pg8::bf_hi(d1.x), pg8::bf_lo(d1.y), pg8::bf_hi(d1.y)}; }
                ln_row(r0, va); if (has1) ln_row(r1, vb);
            }
        }
    }
    if (ph + 1 < NPH) GRID_SYNC();
    }
}

extern "C" void kernel_launch(void* const* d_in, const int* in_sizes, int n_in, void* d_out, int out_size, void* d_ws, size_t ws_size, hipStream_t stream) {
    static int grid_blocks = 0;
    if (grid_blocks == 0) {
        if (n_in != 16 || ws_size < WS_END2 || out_size != NBATCH * SEQ * DM) { fprintf(stderr, "kernel_launch: unexpected shapes: n_in %d out %d ws %zu (need %zu)\n", n_in, out_size, ws_size, (size_t)WS_END2); grid_blocks = -1; return; }
        int dev = 0, cus = 0, per_cu = 0;
        hipGetDevice(&dev); hipDeviceGetAttribute(&cus, hipDeviceAttributeMultiprocessorCount, dev);
        if (hipFuncSetAttribute((const void*)mega, hipFuncAttributeMaxDynamicSharedMemorySize, LDS_BYTES) != hipSuccess) { fprintf(stderr, "kernel_launch: hipFuncSetAttribute failed\n"); grid_blocks = -1; return; }
        if (hipOccupancyMaxActiveBlocksPerMultiprocessor(&per_cu, (const void*)mega, NTHREADS, LDS_BYTES) != hipSuccess || per_cu < 1) { fprintf(stderr, "kernel_launch: occupancy query gave %d\n", per_cu); per_cu = 1; }
        (void)hipGetLastError();
        grid_blocks = cus * per_cu;
    }
    if (grid_blocks < 0) return;
    Params p{};
    p.x = (const float*)d_in[0]; p.c = (const float*)d_in[1]; p.ctx = (const float*)d_in[2]; p.c_ctx = (const float*)d_in[3]; p.w_mod = (const float*)d_in[4]; p.b_mod = (const float*)d_in[5];
    p.w_in = (const float*)d_in[6]; p.q_norm = (const float*)d_in[7]; p.k_norm = (const float*)d_in[8]; p.w_pool = (const float*)d_in[9]; p.pool_scale = (const float*)d_in[10];
    p.w_br_a = (const float*)d_in[11]; p.w_br_b = (const float*)d_in[12]; p.w_out = (const float*)d_in[13]; p.ln_g = (const float*)d_in[14]; p.ln_b = (const float*)d_in[15];
    p.out = (float*)d_out; p.ws = (unsigned char*)d_ws;
    void* args[] = {&p};
    if (hipMemsetAsync((char*)d_ws + WS_BAR, 0, XCD_BAR_WORDS * 4, stream) != hipSuccess) { fprintf(stderr, "kernel_launch: memset of the barrier word failed\n"); return; }
    hipError_t e = hipLaunchCooperativeKernel((const void*)mega, dim3(grid_blocks), dim3(NTHREADS), args, LDS_BYTES, stream);
    if (e != hipSuccess) fprintf(stderr, "kernel_launch: cooperative launch failed: %s (grid %d)\n", hipGetErrorString(e), grid_blocks);
}
```

```cpp
#include <hip/hip_runtime.h>
#include <hip/hip_bf16.h>
#include <hip/hip_cooperative_groups.h>
#include <cstdio>
#include <cstdint>
namespace cg = cooperative_groups;

constexpr int DM = 1024, NBATCH = 2, SEQ = 16384, CTXL = 256, DEPTH = 4, HD = 128;
constexpr int TB = SEQ + CTXL;
constexpr int TROWS = NBATCH * TB;
constexpr int NIN = 5632;
constexpr float EPSV = 1e-6f;
constexpr float ALPHA_RES = 1.681792830507429f;
constexpr int NWAVES = 8, NTHREADS = 512;

constexpr size_t SZ_WIN = (size_t)NIN * DM * 2, SZ_WA = (size_t)DM * DM * 2, SZ_WB = (size_t)DM * 512 * 2, SZ_WO = SZ_WA, SZ_WP = (size_t)4 * 128 * 128 * 2;
constexpr size_t WS_WIN = 0;
constexpr size_t WS_WA = WS_WIN + DEPTH * SZ_WIN;
constexpr size_t WS_WB = WS_WA + DEPTH * SZ_WA;
constexpr size_t WS_WO = WS_WB + DEPTH * SZ_WB;
constexpr size_t WS_WP = WS_WO + DEPTH * SZ_WO;
constexpr size_t WS_MOD = WS_WP + DEPTH * SZ_WP;
constexpr size_t WS_ROPE = WS_MOD + (size_t)DEPTH * 3 * 3072 * 4;
constexpr size_t WS_CX = WS_ROPE + 2 * 256 * 32 * 4;
constexpr size_t WS_U = WS_CX + (size_t)512 * DM * 4;
constexpr size_t WS_Q = WS_U + (size_t)TROWS * DM * 2;
constexpr size_t WS_K = WS_Q + (size_t)TROWS * DM * 2;
constexpr size_t WS_V = WS_K + (size_t)TROWS * 256 * 2;
constexpr size_t WS_ZA = WS_V + (size_t)TROWS * 256 * 2;
constexpr size_t WS_XB = WS_ZA + (size_t)TROWS * DM * 2;
constexpr size_t WS_ZB = WS_XB + (size_t)TROWS * 512 * 2;
constexpr size_t WS_GA = WS_ZB + (size_t)TROWS * 512 * 2;
constexpr size_t WS_GB = WS_GA + (size_t)TROWS * DM * 2;
constexpr size_t WS_END = WS_GB + (size_t)TROWS * DM * 2;
constexpr size_t WS_BAR = WS_END, WS_END2 = WS_END + 16384;

struct Params {
    const float *x, *c, *ctx, *c_ctx, *w_mod, *b_mod, *w_in, *q_norm, *k_norm, *w_pool, *pool_scale, *w_br_a, *w_br_b, *w_out, *ln_g, *ln_b;
    float* out; unsigned char* ws;
};

namespace pg8 {
#define PG8_LAS __attribute__((address_space(3)))
typedef unsigned short bf16_t;
typedef short bf16x8 __attribute__((ext_vector_type(8)));
typedef float f32x4 __attribute__((ext_vector_type(4)));
typedef unsigned u32x4 __attribute__((ext_vector_type(4)));
constexpr int BM = 256, BK = 64, HALF = 128, HTB = HALF * BK * 2  , STAGE_BYTES = 8 * HTB, NXCD = 8, WGM = 8;

__host__ __device__ __forceinline__ int lds_byte(int r, int c) { const int st = (r >> 4) * 2 + (c >> 5), rr = r & 15, cc = c & 31, ob = rr * 64 + cc * 2; return st * 1024 + (ob ^ (((ob >> 9) & 1) << 5)); }
__host__ __device__ __forceinline__ void stage_rc(int b, int& R, int& C) { const int st = b / 1024, sb = b % 1024, swz = sb ^ (((sb >> 9) & 1) << 5); R = (st >> 1) * 16 + swz / 64; C = (st & 1) * 32 + (swz % 64) / 2; }
__host__ __device__ __forceinline__ int perm32(int rho) { const int n = rho >> 4, i = rho & 15; return 8 * (i >> 2) + 4 * n + (i & 3); }

struct Unit { int pm, pn; };
struct Gemm { const bf16_t* A; const bf16_t* Bt; int M, N, K; };

struct StaticOrder {
    int nM, nN, nwg, G, c, skip;
    __host__ __device__ void init(int M, int N, int G_, int c_) { nM = M / BM; nN = N / BM; nwg = nM * nN; G = G_; c = c_; skip = 0; }
    __host__ __device__ bool next(int i, Unit& u) const {
        const long L = (long)i * G + c; if (L >= nwg) return false;
        int wgid = (int)L; { const int q = nwg / NXCD, r = nwg % NXCD, xcd = wgid % NXCD, off = wgid / NXCD; wgid = (xcd < r ? xcd * (q + 1) : r * (q + 1) + (xcd - r) * q) + off; }
        const int nig = WGM * nN, gid = wgid / nig, fm = gid * WGM, gsz = (nM - fm) < WGM ? (nM - fm) : WGM;
        u.pm = fm + ((wgid % nig) % gsz); u.pn = (wgid % nig) / gsz; if (skip) u.pm += 1 + (u.pm >= 64 ? 1 : 0); return true;
    }
    __device__ __forceinline__ void a_ready(const Unit&) const {}
    __device__ __forceinline__ void done(const Unit&) const {}
};

typedef __bf16 bf16x2_t __attribute__((ext_vector_type(2)));
typedef float f32x2_t __attribute__((ext_vector_type(2)));
__device__ __forceinline__ unsigned cvt_pk_bf16(float lo, float hi) { const f32x2_t v = {lo, hi}; const bf16x2_t r = __builtin_convertvector(v, bf16x2_t); return __builtin_bit_cast(unsigned, r); }
typedef float f32x2 __attribute__((ext_vector_type(2)));
struct LatentOrder {
    StaticOrder S;
    __host__ __device__ void init(int N, int G_, int c_) { S.init(32768, N, G_, c_); }
    __host__ __device__ bool next(int i, Unit& u) const { if (!S.next(i, u)) return false; u.pm += 1 + (u.pm >= 64 ? 1 : 0); return true; }
    __device__ __forceinline__ void a_ready(const Unit&) const {}
    __device__ __forceinline__ void done(const Unit&) const {}
};
__device__ __forceinline__ float bf_lo(unsigned w) { return __uint_as_float(w << 16); }
__device__ __forceinline__ float bf_hi(unsigned w) { return __uint_as_float(w & 0xffff0000u); }
__device__ __forceinline__ float sigm(float x) { return __builtin_amdgcn_rcpf(1.0f + __builtin_amdgcn_exp2f(-1.4426950408889634f * x)); }
typedef unsigned u32x2 __attribute__((ext_vector_type(2)));
template <int ACT> __device__ __forceinline__ float actf(float x) { if (ACT == 1) return x * sigm(x); if (ACT == 2) return sigm(x); return x; }

struct EpiIn {
    static constexpr bool PERM = true, AFTER_DRAIN = false;
    unsigned char* ws; const float *qg, *kg;
    PG8_LAS float* part;
    template <int ACT> __device__ __forceinline__ void plain(const f32x4 (&acc)[2][2][4][2], bf16_t* base, int ldc, int colt, const Unit& u, int wr, int wc, int fr, int fq) const {
        const int row0 = u.pm * BM + wr * 64 + fr, col0 = colt + wc * 32 + 8 * fq;
#pragma unroll
        for (int ai = 0; ai < 2; ++ai)
#pragma unroll
            for (int m = 0; m < 4; ++m) { bf16_t* rowp = base + (size_t)(row0 + ai * HALF + m * 16) * ldc + col0;
#pragma unroll
                for (int bj = 0; bj < 2; ++bj) { const f32x4 v0 = acc[ai][bj][m][0], v1 = acc[ai][bj][m][1]; u32x4 w;
                    w.x = cvt_pk_bf16(actf<ACT>(v0[0]), actf<ACT>(v0[1])); w.y = cvt_pk_bf16(actf<ACT>(v0[2]), actf<ACT>(v0[3]));
                    w.z = cvt_pk_bf16(actf<ACT>(v1[0]), actf<ACT>(v1[1])); w.w = cvt_pk_bf16(actf<ACT>(v1[2]), actf<ACT>(v1[3]));
                    *(u32x4*)(rowp + bj * HALF) = w; } }
    }
    __device__ __forceinline__ void qk(const f32x4 (&acc)[2][2][4][2], const Unit& u, int wr, int wc, int fr, int fq) const {
        const bool isk = (u.pn == 4);
        const float* g = isk ? kg : qg; bf16_t* dst = (bf16_t*)(ws + (isk ? WS_K : WS_Q)); const int ldc = isk ? 256 : 1024;
        const float* cosT = (const float*)(ws + WS_ROPE); const float* sinT = cosT + 256 * 32;
        const int f0 = (wc & 1) * 16 + 4 * fq, axis = wc >> 1, e1 = axis * 64 + f0;
        const f32x4 g1 = *(const f32x4*)(g + e1), g2 = *(const f32x4*)(g + e1 + 32);
#pragma unroll
        for (int ai = 0; ai < 2; ++ai)
#pragma unroll
            for (int m = 0; m < 4; ++m)
#pragma unroll
                for (int bj = 0; bj < 2; ++bj) { const f32x4 a = acc[ai][bj][m][0], b = acc[ai][bj][m][1];
                    float s = (a[0] * a[0] + a[1] * a[1]) + (a[2] * a[2] + a[3] * a[3]) + (b[0] * b[0] + b[1] * b[1]) + (b[2] * b[2] + b[3] * b[3]);
                    s += __shfl_xor(s, 16); s += __shfl_xor(s, 32);
                    if (fq == 0) part[((ai * HALF + wr * 64 + m * 16 + fr) * 2 + bj) * 4 + wc] = s; }
        asm volatile("s_waitcnt lgkmcnt(0)" ::: "memory"); __builtin_amdgcn_s_barrier(); asm volatile("" ::: "memory");
        const int jt = u.pm % 65; const bool rope = (jt != 0);
#pragma unroll
        for (int ai = 0; ai < 2; ++ai)
#pragma unroll
            for (int m = 0; m < 4; ++m) { const int rloc = ai * HALF + wr * 64 + m * 16 + fr;
                const int pos = rope ? (axis ? (16 * m + fr) : ((jt - 1) * 4 + 2 * ai + wr)) : 0;
                f32x4 c4 = *(const f32x4*)(cosT + pos * 32 + f0), s4 = *(const f32x4*)(sinT + pos * 32 + f0);
                if (!rope) { c4 = (f32x4){1.f, 1.f, 1.f, 1.f}; s4 = (f32x4){0.f, 0.f, 0.f, 0.f}; }
#pragma unroll
                for (int bj = 0; bj < 2; ++bj) { const f32x4 p = *(const PG8_LAS f32x4*)(part + (rloc * 2 + bj) * 4);
                    const float rstd = __builtin_amdgcn_rsqf(((p[0] + p[1]) + (p[2] + p[3])) * (1.0f / 128.0f) + 1e-6f);
                    const f32x4 y1 = acc[ai][bj][m][0] * rstd * g1, y2 = acc[ai][bj][m][1] * rstd * g2;
                    f32x4 o1 = y1 * c4 - y2 * s4, o2 = y1 * s4 + y2 * c4;
                    if (!isk) { o1 = o1 * 0.12751743074602458f; o2 = o2 * 0.12751743074602458f; }
                    const int head = isk ? bj : 2 * u.pn + bj;
                    bf16_t* ptr = dst + (size_t)(u.pm * BM + rloc) * ldc + head * 128 + e1;
                    u32x2 w1, w2; w1.x = cvt_pk_bf16(o1[0], o1[1]); w1.y = cvt_pk_bf16(o1[2], o1[3]); w2.x = cvt_pk_bf16(o2[0], o2[1]); w2.y = cvt_pk_bf16(o2[2], o2[3]);
                    *(u32x2*)ptr = w1; *(u32x2*)(ptr + 32) = w2; } }
    }
    __device__ __forceinline__ void operator()(const f32x4 (&acc)[2][2][4][2], const Unit& u, int wr, int wc, int fr, int fq) const {
        const int pn = u.pn;
        if (pn < 5) { qk(acc, u, wr, wc, fr, fq); return; }
        if (pn == 5) plain<0>(acc, (bf16_t*)(ws + WS_V), 256, 0, u, wr, wc, fr, fq);
        else if (pn < 10) plain<1>(acc, (bf16_t*)(ws + WS_ZA), 1024, (pn - 6) * 256, u, wr, wc, fr, fq);
        else if (pn < 12) plain<0>(acc, (bf16_t*)(ws + WS_XB), 512, (pn - 10) * 256, u, wr, wc, fr, fq);
        else if (pn < 14) plain<1>(acc, (bf16_t*)(ws + WS_ZB), 512, (pn - 12) * 256, u, wr, wc, fr, fq);
        else if (pn < 18) plain<2>(acc, (bf16_t*)(ws + WS_GA), 1024, (pn - 14) * 256, u, wr, wc, fr, fq);
        else plain<2>(acc, (bf16_t*)(ws + WS_GB), 1024, (pn - 18) * 256, u, wr, wc, fr, fq);
    }
};
template <int MODE> struct EpiGate {
    static constexpr bool PERM = true, AFTER_DRAIN = false;
    unsigned char* ws;
    __device__ __forceinline__ void operator()(const f32x4 (&acc)[2][2][4][2], const Unit& u, int wr, int wc, int fr, int fq) const {
        bf16_t* GA = (bf16_t*)(ws + WS_GA); const bf16_t* GB = (const bf16_t*)(ws + WS_GB); bf16_t* Y = (bf16_t*)(ws + WS_ZA);
        const int row0 = u.pm * BM + wr * 64 + fr, col0 = u.pn * BM + wc * 32 + 8 * fq;
#pragma unroll
        for (int ai = 0; ai < 2; ++ai)
#pragma unroll
            for (int m = 0; m < 4; ++m) { const size_t off = (size_t)(row0 + ai * HALF + m * 16) * 1024 + col0;
#pragma unroll
                for (int bj = 0; bj < 2; ++bj) { const f32x4 v0 = acc[ai][bj][m][0], v1 = acc[ai][bj][m][1];
                    const u32x4 ga = *(const u32x4*)(GA + off + bj * HALF); u32x4 w;
                    if (MODE == 0) {
                        w.x = cvt_pk_bf16(v0[0] * bf_lo(ga.x), v0[1] * bf_hi(ga.x)); w.y = cvt_pk_bf16(v0[2] * bf_lo(ga.y), v0[3] * bf_hi(ga.y));
                        w.z = cvt_pk_bf16(v1[0] * bf_lo(ga.z), v1[1] * bf_hi(ga.z)); w.w = cvt_pk_bf16(v1[2] * bf_lo(ga.w), v1[3] * bf_hi(ga.w));
                        *(u32x4*)(GA + off + bj * HALF) = w;
                    } else {
                        const u32x4 gb = *(const u32x4*)(GB + off + bj * HALF);
                        w.x = cvt_pk_bf16(bf_lo(ga.x) + v0[0] * bf_lo(gb.x), bf_hi(ga.x) + v0[1] * bf_hi(gb.x)); w.y = cvt_pk_bf16(bf_lo(ga.y) + v0[2] * bf_lo(gb.y), bf_hi(ga.y) + v0[3] * bf_hi(gb.y));
                        w.z = cvt_pk_bf16(bf_lo(ga.z) + v1[0] * bf_lo(gb.z), bf_hi(ga.z) + v1[1] * bf_hi(gb.z)); w.w = cvt_pk_bf16(bf_lo(ga.w) + v1[2] * bf_lo(gb.w), bf_hi(ga.w) + v1[3] * bf_hi(gb.w));
                        *(u32x4*)(Y + off + bj * HALF) = w;
                    } } }
    }
};
struct EpiRes {
    static constexpr bool PERM = true, AFTER_DRAIN = false;
    const float* mod; unsigned char* ws;
    __device__ __forceinline__ void operator()(const f32x4 (&acc)[2][2][4][2], const Unit& u, int wr, int wc, int fr, int fq) const {
        const int b = u.pm / 65, jt = u.pm % 65; bf16_t* dl = (bf16_t*)(ws + WS_GA);
        const float* gate = mod + (jt ? b : 2) * 3072 + 2048;
        const int row0 = u.pm * BM + wr * 64 + fr, col0 = u.pn * BM + wc * 32 + 8 * fq;
        f32x4 gv[2][2];
#pragma unroll
        for (int bj = 0; bj < 2; ++bj)
#pragma unroll
            for (int n = 0; n < 2; ++n) gv[bj][n] = *(const f32x4*)(gate + col0 + bj * HALF + 4 * n);
#pragma unroll
        for (int ai = 0; ai < 2; ++ai)
#pragma unroll
            for (int m = 0; m < 4; ++m) { bf16_t* rowp = dl + (size_t)(row0 + ai * HALF + m * 16) * 1024 + col0;
#pragma unroll
                for (int bj = 0; bj < 2; ++bj) { const f32x4 v0 = acc[ai][bj][m][0] * gv[bj][0], v1 = acc[ai][bj][m][1] * gv[bj][1]; u32x4 w;
                    w.x = cvt_pk_bf16(v0[0], v0[1]); w.y = cvt_pk_bf16(v0[2], v0[3]); w.z = cvt_pk_bf16(v1[0], v1[1]); w.w = cvt_pk_bf16(v1[2], v1[3]);
                    *(u32x4*)(rowp + bj * HALF) = w; } }
    }
};

template <class Epi, class Sched, bool ALIGN_EPI = false, bool SP2 = false>
__device__ __forceinline__ void gemm_phase(PG8_LAS unsigned char* lds, const Gemm g, const Sched& S, const Epi& E, const int wid_in) {
    int lane = __builtin_amdgcn_mbcnt_hi(~0u, __builtin_amdgcn_mbcnt_lo(~0u, 0u)); asm volatile("" : "+v"(lane));
    const int wid = wid_in, tid = wid * 64 + lane, wr = wid >> 2, wc = wid & 3, fr = lane & 15, fq = lane >> 4;
    const int K = g.K, nt = K / BK;
    unsigned voffA[2], voffB[2];
#pragma unroll
    for (int i = 0; i < 2; ++i) { int R, C; stage_rc(tid * 16 + i * 8192, R, C); const int Rb = Epi::PERM ? ((R & ~31) + perm32(R & 31)) : R;
        voffA[i] = (unsigned)(R * K + C) * 2u; voffB[i] = (unsigned)(Rb * K + C) * 2u; }
    const size_t kstep = (size_t)(BK * 2);
    const size_t hstep = (size_t)HALF * K * 2;
    const size_t tstep = 2 * hstep;
    const unsigned ldsw = (unsigned)wid * 1024u;
    const int aoff = lds_byte(wr * 64 + fr, fq * 8), boff = lds_byte(wc * 32 + fr, fq * 8);
#define PG8_SA(b, h) (((b) * 2 + (h)) * HTB)
#define PG8_SB(b, h) ((4 + (b) * 2 + (h)) * HTB)
#define PG8_STAGE(bufoff, gbase, voff) do { _Pragma("unroll") for (int _i = 0; _i < 2; ++_i) \
        __builtin_amdgcn_global_load_lds((const unsigned*)((const char*)(gbase) + (voff)[_i]), (PG8_LAS unsigned*)(lds + (bufoff) + ldsw + _i * 8192), 16, 0, 0); } while (0)
#define PG8_LDA(dst, b, h) do { _Pragma("unroll") for (int m = 0; m < 4; ++m) _Pragma("unroll") for (int k = 0; k < 2; ++k) dst[m][k] = *(const PG8_LAS bf16x8*)(lds + PG8_SA(b, h) + aoff + m * 2048 + k * 1024); } while (0)
#define PG8_LDB(dst, b, h) do { _Pragma("unroll") for (int n = 0; n < 2; ++n) _Pragma("unroll") for (int k = 0; k < 2; ++k) dst[n][k] = *(const PG8_LAS bf16x8*)(lds + PG8_SB(b, h) + boff + n * 2048 + k * 1024); } while (0)
#define PG8_MMA(ai, bj, At, Bt) do { __builtin_amdgcn_s_setprio(1); _Pragma("unroll") for (int m = 0; m < 4; ++m) _Pragma("unroll") for (int n = 0; n < 2; ++n) _Pragma("unroll") for (int k = 0; k < 2; ++k) \
        acc[ai][bj][m][n] = __builtin_amdgcn_mfma_f32_16x16x32_bf16(Bt[n][k], At[m][k], acc[ai][bj][m][n], 0, 0, 0); __builtin_amdgcn_s_setprio(0); } while (0)
#define PG8_WAIT_V(n) asm volatile("s_waitcnt vmcnt(" #n ")" ::: "memory")
#define PG8_WAIT_L(n) asm volatile("s_waitcnt lgkmcnt(" #n ")" ::: "memory")
#define PG8_BAR __builtin_amdgcn_s_barrier()
#define PG8_SCHED __builtin_amdgcn_sched_barrier(0)
    Unit cur, nxt; int ui = 0;
    if (!S.next(0, cur)) return;
    f32x4 acc[2][2][4][2];
#pragma unroll
    for (int a = 0; a < 2; ++a)
#pragma unroll
        for (int b = 0; b < 2; ++b)
#pragma unroll
            for (int m = 0; m < 4; ++m)
#pragma unroll
                for (int n = 0; n < 2; ++n) acc[a][b][m][n] = (f32x4){0.f, 0.f, 0.f, 0.f};
    bf16x8 At[4][2], B0[2][2], B1[2][2];
    const char* cA = (const char*)g.A + (size_t)cur.pm * tstep; const char* cB = (const char*)g.Bt + (size_t)cur.pn * tstep;
    S.a_ready(cur);
    if constexpr (SP2) {
        PG8_STAGE(PG8_SB(0, 0), cB, voffB); PG8_STAGE(PG8_SB(0, 1), cB + hstep, voffB); PG8_STAGE(PG8_SA(0, 0), cA, voffA); PG8_STAGE(PG8_SA(0, 1), cA + hstep, voffA);
        if (wr == 1) PG8_BAR;
        PG8_WAIT_V(2); PG8_BAR;
        PG8_STAGE(PG8_SB(1, 0), cB + kstep, voffB); PG8_STAGE(PG8_SA(1, 0), cA + kstep, voffA); PG8_STAGE(PG8_SB(1, 1), cB + hstep + kstep, voffB);
        PG8_WAIT_V(6); PG8_BAR;
    } else {
        PG8_STAGE(PG8_SB(0, 0), cB, voffB); PG8_STAGE(PG8_SA(0, 0), cA, voffA); PG8_STAGE(PG8_SB(0, 1), cB + hstep, voffB); PG8_STAGE(PG8_SA(0, 1), cA + hstep, voffA);
        if (wr == 1) PG8_BAR;
        PG8_WAIT_V(4); PG8_BAR;
        PG8_STAGE(PG8_SB(1, 0), cB + kstep, voffB); PG8_STAGE(PG8_SA(1, 0), cA + kstep, voffA); PG8_STAGE(PG8_SB(1, 1), cB + hstep + kstep, voffB);
        PG8_WAIT_V(6); PG8_BAR;
    }
    for (;;) {
        const bool has_next = S.next(ui + 1, nxt);
        const char* nA = has_next ? (const char*)g.A + (size_t)nxt.pm * tstep : cA; const char* nB = has_next ? (const char*)g.Bt + (size_t)nxt.pn * tstep : cB;
        for (int t = 0; t < nt; t += 2) {
            const bool last = (t == nt - 2);
            const char* a1 = cA + (size_t)(t + 1) * kstep;
            const char* a2 = last ? nA : cA + (size_t)(t + 2) * kstep; const char* b2 = last ? nB : cB + (size_t)(t + 2) * kstep;
            const char* a3 = a2 + kstep; const char* b3 = b2 + kstep;
            if (last && has_next) S.a_ready(nxt);
            if constexpr (SP2) {
            PG8_LDB(B0, 0, 0); PG8_LDB(B1, 0, 1); PG8_SCHED; PG8_LDA(At, 0, 0); PG8_STAGE(PG8_SA(1, 1), a1 + hstep, voffA);
            PG8_WAIT_V(8); PG8_WAIT_L(0); PG8_BAR; PG8_MMA(0, 0, At, B0); PG8_MMA(0, 1, At, B1); PG8_BAR; PG8_SCHED;
            PG8_LDA(At, 0, 1); PG8_STAGE(PG8_SB(0, 0), b2, voffB); PG8_STAGE(PG8_SB(0, 1), b2 + hstep, voffB); PG8_STAGE(PG8_SA(0, 0), a2, voffA);
            PG8_WAIT_V(8); PG8_WAIT_L(0); PG8_BAR; PG8_MMA(1, 0, At, B0); PG8_MMA(1, 1, At, B1); PG8_BAR; PG8_SCHED;
            PG8_LDB(B0, 1, 0); PG8_LDB(B1, 1, 1); PG8_SCHED; PG8_LDA(At, 1, 0); PG8_STAGE(PG8_SA(0, 1), a2 + hstep, voffA);
            PG8_WAIT_V(8); PG8_WAIT_L(0); PG8_BAR; PG8_MMA(0, 0, At, B0); PG8_MMA(0, 1, At, B1); PG8_BAR; PG8_SCHED;
            PG8_LDA(At, 1, 1); PG8_STAGE(PG8_SB(1, 0), b3, voffB); PG8_STAGE(PG8_SB(1, 1), b3 + hstep, voffB); PG8_STAGE(PG8_SA(1, 0), a3, voffA);
            PG8_WAIT_V(8); PG8_WAIT_L(0); PG8_BAR; PG8_MMA(1, 0, At, B0); PG8_MMA(1, 1, At, B1); PG8_BAR; PG8_SCHED;
            } else {
            PG8_LDB(B0, 0, 0); PG8_SCHED; PG8_LDA(At, 0, 0); PG8_STAGE(PG8_SA(1, 1), a1 + hstep, voffA);
            PG8_WAIT_L(8); PG8_BAR; PG8_WAIT_L(0); PG8_MMA(0, 0, At, B0); PG8_BAR; PG8_SCHED;
            PG8_LDB(B1, 0, 1); PG8_STAGE(PG8_SB(0, 0), b2, voffB);
            PG8_BAR; PG8_WAIT_L(0); PG8_MMA(0, 1, At, B1); PG8_BAR;
            PG8_LDA(At, 0, 1); PG8_STAGE(PG8_SA(0, 0), a2, voffA);
            PG8_BAR; PG8_WAIT_L(0); PG8_MMA(1, 0, At, B0); PG8_BAR; PG8_SCHED;
            PG8_STAGE(PG8_SB(0, 1), b2 + hstep, voffB);
            PG8_WAIT_V(6); PG8_BAR; PG8_MMA(1, 1, At, B1); PG8_BAR;
            PG8_LDB(B0, 1, 0); PG8_SCHED; PG8_LDA(At, 1, 0); PG8_STAGE(PG8_SA(0, 1), a2 + hstep, voffA);
            PG8_WAIT_L(8); PG8_BAR; PG8_WAIT_L(0); PG8_MMA(0, 0, At, B0); PG8_BAR; PG8_SCHED;
            PG8_LDB(B1, 1, 1); PG8_STAGE(PG8_SB(1, 0), b3, voffB);
            PG8_BAR; PG8_WAIT_L(0); PG8_MMA(0, 1, At, B1); PG8_BAR;
            PG8_LDA(At, 1, 1); PG8_STAGE(PG8_SA(1, 0), a3, voffA);
            PG8_BAR; PG8_WAIT_L(0); PG8_MMA(1, 0, At, B0); PG8_BAR; PG8_SCHED;
            PG8_STAGE(PG8_SB(1, 1), b3 + hstep, voffB);
            PG8_WAIT_V(6); PG8_BAR; PG8_MMA(1, 1, At, B1); PG8_BAR;
            }
        }
        if constexpr (ALIGN_EPI) { if (wr == 0) PG8_BAR; }
        if constexpr (!Epi::AFTER_DRAIN) { int l2 = __builtin_amdgcn_mbcnt_hi(~0u, __builtin_amdgcn_mbcnt_lo(~0u, 0u)); asm volatile("" : "+v"(l2));
            E(acc, cur, wr, wc, l2 & 15, l2 >> 4); S.done(cur); }
        if (!has_next) break;
#pragma unroll
        for (int a = 0; a < 2; ++a)
#pragma unroll
            for (int b = 0; b < 2; ++b)
#pragma unroll
                for (int m = 0; m < 4; ++m)
#pragma unroll
                    for (int n = 0; n < 2; ++n) acc[a][b][m][n] = (f32x4){0.f, 0.f, 0.f, 0.f};
        cur = nxt; cA = nA; cB = nB; ++ui;
        if constexpr (ALIGN_EPI) { if (wr == 1) PG8_BAR; }
    }
    PG8_WAIT_V(0);
    if constexpr (!ALIGN_EPI) { if (wr == 0) PG8_BAR; }
    PG8_BAR;
    if constexpr (Epi::AFTER_DRAIN) { E.fused(acc, cur, wr, wc, fr, fq, lds, wid, lane); S.done(cur); }
#undef PG8_SA
#undef PG8_SB
#undef PG8_STAGE
#undef PG8_LDA
#undef PG8_LDB
#undef PG8_MMA
#undef PG8_WAIT_V
#undef PG8_WAIT_L
#undef PG8_BAR
#undef PG8_SCHED
}
}
namespace att {
using bf16 = __hip_bfloat16;
constexpr int   D = 128, NW = 8, QBLK = 32, KVBLK = 64;
constexpr float SCALE = 0.088388347648318440f;
constexpr float THR = 8.f;
constexpr int SDEPTH = 1;
constexpr int LDQ = 1024, LDK = 256, LDO = 1024;
constexpr size_t SHM_V = KVBLK * D * 2, SHM_K = KVBLK * D * 2, SHM_ATTN = 3 * SHM_V + 3 * SHM_K + NW * 64 * 4;
using bf16x8 = __attribute__((ext_vector_type(8))) short;
using s16x4  = __attribute__((ext_vector_type(4))) short;
using f32x16 = __attribute__((ext_vector_type(16))) float;
using f32x8  = __attribute__((ext_vector_type(8))) float;
using u32x4  = __attribute__((ext_vector_type(4))) unsigned;
#define KSWZ(row, colB) ((row) * 256 + ((colB) ^ (((row) & 15) << 4)))
#define SBAR() __builtin_amdgcn_sched_barrier(0)
__device__ __forceinline__ int crow(int r, int hi) { return (r & 3) + 8 * (r >> 2) + 4 * hi; }
__device__ __forceinline__ unsigned cvtpk(float lo, float hi) { return pg8::cvt_pk_bf16(lo, hi); }
template <typename TIn> struct Stage;
template <> struct Stage<bf16>  { using T = bf16x8;
  __device__ static __forceinline__ T ld8(const bf16* p) { return *reinterpret_cast<const bf16x8*>(p); }
  __device__ static __forceinline__ bf16x8 tobf(T x) { return x; } };
template <> struct Stage<float> { using T = f32x8;
  __device__ static __forceinline__ T ld8(const float* p) { return *reinterpret_cast<const f32x8*>(p); }
  __device__ static __forceinline__ bf16x8 tobf(T x) {
    u32x4 w = {cvtpk(x[0], x[1]), cvtpk(x[2], x[3]), cvtpk(x[4], x[5]), cvtpk(x[6], x[7])}; return *reinterpret_cast<bf16x8*>(&w); } };

__device__ __forceinline__ void partialSM(f32x16& p0, f32x16& p1, float& m_reg, float& mn, float& alpha) {
  constexpr float C = SCALE * 1.4426950408889634f;
  float pmax = p0[0]; for (int r = 1; r < 16; ++r) pmax = fmaxf(pmax, p0[r]); for (int r = 0; r < 16; ++r) pmax = fmaxf(pmax, p1[r]);
  { auto rr = __builtin_amdgcn_permlane32_swap(__float_as_uint(pmax), __float_as_uint(pmax), false, false);
    pmax = fmaxf(__uint_as_float(rr[0]), __uint_as_float(rr[1])); }
  if (__builtin_expect(__all(pmax - m_reg <= THR / SCALE), 1)) { mn = m_reg; alpha = 1.f; }
  else { mn = fmaxf(m_reg, pmax); alpha = __builtin_amdgcn_exp2f((m_reg - mn) * C); m_reg = mn; }
  float mnC = -mn * C;
  for (int r = 0; r < 16; ++r) p0[r] = fmaf(p0[r], C, mnC); for (int r = 0; r < 16; ++r) p1[r] = fmaf(p1[r], C, mnC);
  for (int r = 0; r < 16; ++r) p0[r] = __builtin_amdgcn_exp2f(p0[r]);
}
__device__ __forceinline__ void finishSM(f32x16& p0, f32x16& p1, float alpha, float& l_reg, bf16x8& pa0, bf16x8& pa1, bf16x8& pa2, bf16x8& pa3) {
  for (int r = 0; r < 16; ++r) p1[r] = __builtin_amdgcn_exp2f(p1[r]);
  float ps = 0; for (int r = 0; r < 16; ++r) ps += p0[r]; for (int r = 0; r < 16; ++r) ps += p1[r];
  { auto rr = __builtin_amdgcn_permlane32_swap(__float_as_uint(ps), __float_as_uint(ps), false, false);
    ps = __uint_as_float(rr[0]) + __uint_as_float(rr[1]); }
  l_reg = l_reg * alpha + ps;
#define PK4(P, BASE, OUT) do { unsigned a0 = cvtpk(P[BASE + 0], P[BASE + 1]), a1 = cvtpk(P[BASE + 2], P[BASE + 3]);   \
    unsigned b0 = cvtpk(P[BASE + 4], P[BASE + 5]), b1 = cvtpk(P[BASE + 6], P[BASE + 7]);                              \
    auto r0 = __builtin_amdgcn_permlane32_swap(a0, b0, false, false); auto r1 = __builtin_amdgcn_permlane32_swap(a1, b1, false, false); \
    u32x4 w = {r0[0], r1[0], r0[1], r1[1]}; OUT = *reinterpret_cast<bf16x8*>(&w); } while (0)
  PK4(p0, 0, pa0); PK4(p0, 8, pa1); PK4(p1, 0, pa2); PK4(p1, 8, pa3);
#undef PK4
}
__device__ __forceinline__ void partialSM2(f32x16& p0, f32x16& p1, const float negBC) {
  constexpr float C = SCALE * 1.4426950408889634f;
  for (int r = 0; r < 16; ++r) p0[r] = fmaf(p0[r], C, negBC); for (int r = 0; r < 16; ++r) p1[r] = fmaf(p1[r], C, negBC);
  for (int r = 0; r < 16; ++r) p0[r] = __builtin_amdgcn_exp2f(p0[r]);
}
__device__ __forceinline__ void finishSM2(f32x16& p0, f32x16& p1, float& l_reg, bf16x8& pa0, bf16x8& pa1, bf16x8& pa2, bf16x8& pa3) {
  for (int r = 0; r < 16; ++r) p1[r] = __builtin_amdgcn_exp2f(p1[r]);
  float ps = 0; for (int r = 0; r < 16; ++r) ps += p0[r]; for (int r = 0; r < 16; ++r) ps += p1[r];
  l_reg += ps;
#define PK4(P, BASE, OUT) do { unsigned a0 = cvtpk(P[BASE + 0], P[BASE + 1]), a1 = cvtpk(P[BASE + 2], P[BASE + 3]);   \
    unsigned b0 = cvtpk(P[BASE + 4], P[BASE + 5]), b1 = cvtpk(P[BASE + 6], P[BASE + 7]);                              \
    auto r0 = __builtin_amdgcn_permlane32_swap(a0, b0, false, false); auto r1 = __builtin_amdgcn_permlane32_swap(a1, b1, false, false); \
    u32x4 w = {r0[0], r1[0], r0[1], r1[1]}; OUT = *reinterpret_cast<bf16x8*>(&w); } while (0)
  PK4(p0, 0, pa0); PK4(p0, 8, pa1); PK4(p1, 0, pa2); PK4(p1, 8, pa3);
#undef PK4
}
__device__ __forceinline__ void qkt(f32x16& p0, f32x16& p1, const bf16* Ks, const bf16x8* qr, int r32, int hi) {
  p0 = f32x16{}; p1 = f32x16{};
  for (int d0 = 0; d0 < 8; ++d0) { int cb = (d0 * 16 + hi * 8) * 2;
    bf16x8 b0 = *reinterpret_cast<const bf16x8*>((const char*)Ks + KSWZ(r32, cb));
    bf16x8 b1 = *reinterpret_cast<const bf16x8*>((const char*)Ks + KSWZ(32 + r32, cb));
    p0 = __builtin_amdgcn_mfma_f32_32x32x16_bf16(b0, qr[d0], p0, 0, 0, 0);
    p1 = __builtin_amdgcn_mfma_f32_32x32x16_bf16(b1, qr[d0], p1, 0, 0, 0); }
}
__device__ __forceinline__ void partialSM3(f32x16& p0) { for (int r = 0; r < 16; ++r) p0[r] = __builtin_amdgcn_exp2f(p0[r]); }
__device__ __forceinline__ void qkt3(f32x16& p0, f32x16& p1, const bf16* Ks, const bf16x8* qr, int r32, int hi, const f32x16& cinit) {
  { int cb = (hi * 8) * 2;
    bf16x8 b0 = *reinterpret_cast<const bf16x8*>((const char*)Ks + KSWZ(r32, cb));
    bf16x8 b1 = *reinterpret_cast<const bf16x8*>((const char*)Ks + KSWZ(32 + r32, cb));
    p0 = __builtin_amdgcn_mfma_f32_32x32x16_bf16(b0, qr[0], cinit, 0, 0, 0);
    p1 = __builtin_amdgcn_mfma_f32_32x32x16_bf16(b1, qr[0], cinit, 0, 0, 0); }
  for (int d0 = 1; d0 < 8; ++d0) { int cb = (d0 * 16 + hi * 8) * 2;
    bf16x8 b0 = *reinterpret_cast<const bf16x8*>((const char*)Ks + KSWZ(r32, cb));
    bf16x8 b1 = *reinterpret_cast<const bf16x8*>((const char*)Ks + KSWZ(32 + r32, cb));
    p0 = __builtin_amdgcn_mfma_f32_32x32x16_bf16(b0, qr[d0], p0, 0, 0, 0);
    p1 = __builtin_amdgcn_mfma_f32_32x32x16_bf16(b1, qr[d0], p1, 0, 0, 0); }
}
__device__ __forceinline__ int v_st(int k, int c) { const int kk = (k & ~0xC) | ((k & 4) << 1) | ((k & 8) >> 1); return ((kk >> 3) * 4 + (c >> 5)) * 512 + ((kk & 7) * 32 + (c & 31)) * 2; }
__device__ __forceinline__ int v_rd_base(int lane) { return ((lane & 3) << 3) | (((lane >> 2) & 3) << 6) | (((lane >> 4) & 1) << 5) | (((lane >> 5) & 1) << 8); }
constexpr int v_rd_off(int d0, int ks, int half) { return d0 * 512 + ks * 4096 + half * 2048; }
template <int OFF> __device__ __forceinline__ s16x4 tr_read(int vb) {
  s16x4 r; asm volatile("ds_read_b64_tr_b16 %0, %1 offset:%2" : "=&v"(r) : "v"(vb), "i"(OFF) : "memory"); return r;
}
template <int D0> __device__ __forceinline__ void pv_one(f32x16& od, int vb, bf16x8 pa0, bf16x8 pa1, bf16x8 pa2, bf16x8 pa3) {
  const s16x4 l0 = tr_read<v_rd_off(D0, 0, 0)>(vb), h0 = tr_read<v_rd_off(D0, 0, 1)>(vb), l1 = tr_read<v_rd_off(D0, 1, 0)>(vb), h1 = tr_read<v_rd_off(D0, 1, 1)>(vb);
  const s16x4 l2 = tr_read<v_rd_off(D0, 2, 0)>(vb), h2 = tr_read<v_rd_off(D0, 2, 1)>(vb), l3 = tr_read<v_rd_off(D0, 3, 0)>(vb), h3 = tr_read<v_rd_off(D0, 3, 1)>(vb);
  asm volatile("s_waitcnt lgkmcnt(0)" ::: "memory"); SBAR();
#define PK(L, H) (bf16x8){L[0], L[1], L[2], L[3], H[0], H[1], H[2], H[3]}
  od = __builtin_amdgcn_mfma_f32_32x32x16_bf16(pa0, PK(l0, h0), od, 0, 0, 0);
  od = __builtin_amdgcn_mfma_f32_32x32x16_bf16(pa1, PK(l1, h1), od, 0, 0, 0);
  od = __builtin_amdgcn_mfma_f32_32x32x16_bf16(pa2, PK(l2, h2), od, 0, 0, 0);
  od = __builtin_amdgcn_mfma_f32_32x32x16_bf16(pa3, PK(l3, h3), od, 0, 0, 0);
#undef PK
}
__device__ __forceinline__ void pv_d0(f32x16* o, int vb, bf16x8 pa0, bf16x8 pa1, bf16x8 pa2, bf16x8 pa3) {
  pv_one<0>(o[0], vb, pa0, pa1, pa2, pa3); pv_one<1>(o[1], vb, pa0, pa1, pa2, pa3); pv_one<2>(o[2], vb, pa0, pa1, pa2, pa3); pv_one<3>(o[3], vb, pa0, pa1, pa2, pa3);
}

__device__ __forceinline__ void finishSM4(f32x16& p0, f32x16& p1, float& l_reg, bf16x8& pa0, bf16x8& pa1, bf16x8& pa2, bf16x8& pa3) {
  for (int r = 0; r < 16; ++r) p1[r] = __builtin_amdgcn_exp2f(p1[r]);
  float ps = 0; for (int r = 0; r < 16; ++r) ps += p0[r]; for (int r = 0; r < 16; ++r) ps += p1[r];
  l_reg += ps;
#define PK8(P, BASE, OUT) do { u32x4 w = {cvtpk(P[BASE + 0], P[BASE + 1]), cvtpk(P[BASE + 2], P[BASE + 3]), cvtpk(P[BASE + 4], P[BASE + 5]), cvtpk(P[BASE + 6], P[BASE + 7])}; OUT = *reinterpret_cast<bf16x8*>(&w); } while (0)
  PK8(p0, 0, pa0); PK8(p0, 8, pa1); PK8(p1, 0, pa2); PK8(p1, 8, pa3);
#undef PK8
}
__device__ __forceinline__ int v_rd_base2(int lane) { return ((lane & 3) << 3) | (((lane >> 2) & 3) << 6) | (((lane >> 4) & 1) << 5) | (((lane >> 5) & 1) << 11); }
constexpr int v_rd_off2(int d0, int ks, int part) { return d0 * 512 + ks * 4096 + part * 256; }
template <int D0> __device__ __forceinline__ void pv_one2(f32x16& od, int vb, bf16x8 pa0, bf16x8 pa1, bf16x8 pa2, bf16x8 pa3) {
  const s16x4 l0 = tr_read<v_rd_off2(D0, 0, 0)>(vb), h0 = tr_read<v_rd_off2(D0, 0, 1)>(vb), l1 = tr_read<v_rd_off2(D0, 1, 0)>(vb), h1 = tr_read<v_rd_off2(D0, 1, 1)>(vb);
  const s16x4 l2 = tr_read<v_rd_off2(D0, 2, 0)>(vb), h2 = tr_read<v_rd_off2(D0, 2, 1)>(vb), l3 = tr_read<v_rd_off2(D0, 3, 0)>(vb), h3 = tr_read<v_rd_off2(D0, 3, 1)>(vb);
  asm volatile("s_waitcnt lgkmcnt(0)" ::: "memory"); SBAR();
#define PK(L, H) (bf16x8){L[0], L[1], L[2], L[3], H[0], H[1], H[2], H[3]}
  od = __builtin_amdgcn_mfma_f32_32x32x16_bf16(PK(l0, h0), pa0, od, 0, 0, 0);
  od = __builtin_amdgcn_mfma_f32_32x32x16_bf16(PK(l1, h1), pa1, od, 0, 0, 0);
  od = __builtin_amdgcn_mfma_f32_32x32x16_bf16(PK(l2, h2), pa2, od, 0, 0, 0);
  od = __builtin_amdgcn_mfma_f32_32x32x16_bf16(PK(l3, h3), pa3, od, 0, 0, 0);
#undef PK
}
#define PV_RD2(D0, X) const s16x4 X##l0 = tr_read<v_rd_off2(D0, 0, 0)>(vb), X##h0 = tr_read<v_rd_off2(D0, 0, 1)>(vb), X##l1 = tr_read<v_rd_off2(D0, 1, 0)>(vb), X##h1 = tr_read<v_rd_off2(D0, 1, 1)>(vb), \
                              X##l2 = tr_read<v_rd_off2(D0, 2, 0)>(vb), X##h2 = tr_read<v_rd_off2(D0, 2, 1)>(vb), X##l3 = tr_read<v_rd_off2(D0, 3, 0)>(vb), X##h3 = tr_read<v_rd_off2(D0, 3, 1)>(vb)
#define PV_PK2(L, H) (bf16x8){L[0], L[1], L[2], L[3], H[0], H[1], H[2], H[3]}
#define PV_MM2(OD, X) do { OD = __builtin_amdgcn_mfma_f32_32x32x16_bf16(PV_PK2(X##l0, X##h0), pa0, OD, 0, 0, 0); OD = __builtin_amdgcn_mfma_f32_32x32x16_bf16(PV_PK2(X##l1, X##h1), pa1, OD, 0, 0, 0); \
                           OD = __builtin_amdgcn_mfma_f32_32x32x16_bf16(PV_PK2(X##l2, X##h2), pa2, OD, 0, 0, 0); OD = __builtin_amdgcn_mfma_f32_32x32x16_bf16(PV_PK2(X##l3, X##h3), pa3, OD, 0, 0, 0); } while (0)
__device__ __forceinline__ void pv_d02(f32x16* o, int vb, bf16x8 pa0, bf16x8 pa1, bf16x8 pa2, bf16x8 pa3) {
  PV_RD2(0, a);
  PV_RD2(1, b); asm volatile("s_waitcnt lgkmcnt(8)" ::: "memory"); SBAR(); PV_MM2(o[0], a); SBAR();
  PV_RD2(2, c); asm volatile("s_waitcnt lgkmcnt(8)" ::: "memory"); SBAR(); PV_MM2(o[1], b); SBAR();
  PV_RD2(3, d); asm volatile("s_waitcnt lgkmcnt(8)" ::: "memory"); SBAR(); PV_MM2(o[2], c); SBAR();
  asm volatile("s_waitcnt lgkmcnt(0)" ::: "memory"); SBAR(); PV_MM2(o[3], d);
}
__device__ __forceinline__ void attn_dense_body(const bf16* Qb, const bf16* __restrict__ Kh, const bf16* __restrict__ Vh, const bf16* __restrict__ Zb,
                                                bf16* Ob, int seq, char* lds, const int wid_in, const float kmax, __attribute__((address_space(3))) unsigned char* lds3) {
  using St = Stage<bf16>; using SQ = Stage<bf16>; using TQ = bf16;
  int lane = __builtin_amdgcn_mbcnt_hi(~0u, __builtin_amdgcn_mbcnt_lo(~0u, 0u)); asm volatile("" : "+v"(lane));
  const int wid = wid_in, tid = wid * 64 + lane, r32 = lane & 31, hi = lane >> 5;
  bf16* V_lds = (bf16*)lds; bf16* K_lds = (bf16*)(lds + 3 * SHM_V);
  float l_reg = 0; f32x16 o[4] = {}; bf16x8 qr[8];
  const TQ* Qw = Qb + (long)(wid * QBLK + r32) * LDQ + hi * 8;
#pragma unroll
  for (int d0 = 0; d0 < 8; ++d0) qr[d0] = SQ::tobf(SQ::ld8(Qw + d0 * 16));
  float negBC;
  { float ss = 0.f;
#pragma unroll
    for (int d0 = 0; d0 < 8; ++d0)
#pragma unroll
      for (int e = 0; e < 8; ++e) { const float qv = __uint_as_float((unsigned)(unsigned short)qr[d0][e] << 16); ss = fmaf(qv, qv, ss); }
    auto rr = __builtin_amdgcn_permlane32_swap(__float_as_uint(ss), __float_as_uint(ss), false, false);
    ss = __uint_as_float(rr[0]) + __uint_as_float(rr[1]);
    negBC = -(sqrtf(ss) * kmax * (11.313708498984761f * 1.01f) + 0.07f); }
  f32x16 cinit; for (int r = 0; r < 16; ++r) cinit[r] = negBC;
  const int vb0 = (int)(uintptr_t)V_lds + v_rd_base2(lane);
  int koff0, koff1, voff0, voff1;
  { const int rk0 = 8 * wid + (lane >> 4), rk1 = rk0 + 4; koff0 = rk0 * (LDK * 2) + (((lane & 15) ^ (rk0 & 15)) << 4); koff1 = rk1 * (LDK * 2) + (((lane & 15) ^ (rk1 & 15)) << 4);
    const int st0 = 4 * wid + (lane >> 5), st1 = st0 + 2, q8 = (lane & 31) >> 2;
    const int kk0 = ((st0 >> 2) << 3) | q8, kk1 = ((st1 >> 2) << 3) | q8;
    const int ky0 = (kk0 & ~0xC) | ((kk0 & 4) << 1) | ((kk0 & 8) >> 1), ky1 = (kk1 & ~0xC) | ((kk1 & 4) << 1) | ((kk1 & 8) >> 1);
    voff0 = ky0 * (LDK * 2) + ((st0 & 3) * 32 + (lane & 3) * 8) * 2; voff1 = ky1 * (LDK * 2) + ((st1 & 3) * 32 + (lane & 3) * 8) * 2; }
#define SDMA(s, k0) do { const char* kg_ = (const char*)(Kh + (long)(k0) * LDK); const char* vg_ = (const char*)(Vh + (long)(k0) * LDK); \
    __attribute__((address_space(3))) unsigned char* kd_ = lds3 + 3 * (int)SHM_V + (s) * (int)SHM_K + wid * 2048; __attribute__((address_space(3))) unsigned char* vd_ = lds3 + (s) * (int)SHM_V + wid * 2048; \
    __builtin_amdgcn_global_load_lds((const unsigned*)(kg_ + koff0), (__attribute__((address_space(3))) unsigned*)kd_, 16, 0, 0); \
    __builtin_amdgcn_global_load_lds((const unsigned*)(kg_ + koff1), (__attribute__((address_space(3))) unsigned*)(kd_ + 1024), 16, 0, 0); \
    __builtin_amdgcn_global_load_lds((const unsigned*)(vg_ + voff0), (__attribute__((address_space(3))) unsigned*)vd_, 16, 0, 0); \
    __builtin_amdgcn_global_load_lds((const unsigned*)(vg_ + voff1), (__attribute__((address_space(3))) unsigned*)(vd_ + 1024), 16, 0, 0); } while (0)
#define DWAIT() asm volatile("s_waitcnt vmcnt(0)" ::: "memory")
  f32x16 pA0, pA1, pB0, pB1; bf16x8 pa0, pa1, pa2, pa3; const int NT = seq / KVBLK;
  SDMA(0, 0); DWAIT(); __syncthreads();
  SDMA(1, KVBLK);
  qkt3(pA0, pA1, K_lds, qr, r32, hi, cinit); partialSM3(pA0);
  DWAIT(); __syncthreads();
  int sP = 0, sC = 1, sN = 2;
#define KSLOT(s) ((bf16*)((char*)K_lds + (s) * (int)SHM_K))
#define ROT() do { const int t_ = sP; sP = sC; sC = sN; sN = t_; } while (0)
  for (int j = 1; j + 1 < NT; j += 2) {
    SDMA(sN, (j + 1) * KVBLK);
    SBAR(); qkt3(pB0, pB1, KSLOT(sC), qr, r32, hi, cinit);
    finishSM4(pA0, pA1, l_reg, pa0, pa1, pa2, pa3);
    pv_d02(o, vb0 + sP * (int)SHM_V, pa0, pa1, pa2, pa3); partialSM3(pB0);
    DWAIT(); __syncthreads(); ROT();
    SDMA(sN, (j + 2) * KVBLK);
    SBAR(); qkt3(pA0, pA1, KSLOT(sC), qr, r32, hi, cinit);
    finishSM4(pB0, pB1, l_reg, pa0, pa1, pa2, pa3);
    pv_d02(o, vb0 + sP * (int)SHM_V, pa0, pa1, pa2, pa3); partialSM3(pA0);
    DWAIT(); __syncthreads(); ROT();
  }
  SBAR(); qkt3(pB0, pB1, KSLOT(sC), qr, r32, hi, cinit);
  finishSM4(pA0, pA1, l_reg, pa0, pa1, pa2, pa3); SBAR();
  pv_d02(o, vb0 + sP * (int)SHM_V, pa0, pa1, pa2, pa3); partialSM3(pB0);
  finishSM4(pB0, pB1, l_reg, pa0, pa1, pa2, pa3); SBAR();
  pv_d02(o, vb0 + sC * (int)SHM_V, pa0, pa1, pa2, pa3);
#undef KSLOT
#undef ROT
#undef SDMA
#undef DWAIT
  { auto rr = __builtin_amdgcn_permlane32_swap(__float_as_uint(l_reg), __float_as_uint(l_reg), false, false); l_reg = __uint_as_float(rr[0]) + __uint_as_float(rr[1]); }
  const float rl = __builtin_amdgcn_rcpf(l_reg);
  { int lb = (wid * QBLK + r32) * LDO + 4 * hi; asm volatile("" : "+v"(lb));
    unsigned short* Ow = (unsigned short*)Ob + lb; const unsigned short* Zw = (const unsigned short*)Zb + lb;
#pragma unroll
    for (int d0 = 0; d0 < 4; ++d0)
#pragma unroll
      for (int g = 0; g < 4; ++g) { const int co = d0 * 32 + 8 * g; const unsigned long long zz = *(const unsigned long long*)(Zw + co);
        const float z0 = __uint_as_float((unsigned)(zz << 16)), z1 = __uint_as_float((unsigned)zz & 0xffff0000u), z2 = __uint_as_float((unsigned)(zz >> 32) << 16), z3 = __uint_as_float((unsigned)(zz >> 32) & 0xffff0000u);
        const unsigned w0 = cvtpk(o[d0][4 * g + 0] * rl * z0, o[d0][4 * g + 1] * rl * z1), w1 = cvtpk(o[d0][4 * g + 2] * rl * z2, o[d0][4 * g + 3] * rl * z3);
        *(unsigned long long*)(Ow + co) = (unsigned long long)w0 | ((unsigned long long)w1 << 32); } }
}
}

typedef unsigned short bf16_t;
typedef float f32x4 __attribute__((ext_vector_type(4)));
typedef unsigned u32x4 __attribute__((ext_vector_type(4)));
typedef unsigned u32x2v __attribute__((ext_vector_type(2)));
typedef short bf16x8v __attribute__((ext_vector_type(8)));
typedef float f32x16v __attribute__((ext_vector_type(16)));
#define LAS __attribute__((address_space(3)))
#define XB_TMO      128
#define XB_XCNT(j)  (256  + 64 * (j))
#define XB_XSUB(j)  (1280 + 64 * (j))
#define XB_XGEN(j)  (2304 + 64 * (j))
#define XB_TOP      3328
#define XB_TOPGEN   3392
#define XCD_BAR_WORDS 3456
#define XB_SPIN_CAP (1u << 18)

__device__ __forceinline__ unsigned xb_ld(unsigned* p)              { return __hip_atomic_load(p, __ATOMIC_RELAXED, __HIP_MEMORY_SCOPE_AGENT); }
__device__ __forceinline__ unsigned xb_add(unsigned* p, unsigned v) { return __hip_atomic_fetch_add(p, v, __ATOMIC_RELAXED, __HIP_MEMORY_SCOPE_AGENT); }
__device__ __forceinline__ unsigned xb_xcc_id() { return (unsigned)__builtin_amdgcn_s_getreg((3 << 11) | 20) & 0xFu; }
#define XB_SPIN(cond, bar) do { unsigned _sp = 0; while (cond) { __builtin_amdgcn_s_sleep(1); \
    if ((++_sp & 255u) == 0u) { if (xb_ld(&(bar)[XB_TMO])) break; if (_sp > XB_SPIN_CAP) { atomicAdd(&(bar)[XB_TMO], 1u); break; } } } } while (0)

struct XcdBarrier {
    unsigned* bar; unsigned x;
    volatile LAS unsigned* st;
};

__device__ __forceinline__ XcdBarrier xcd_barrier_post(unsigned* bar, volatile LAS unsigned* st, const bool leader) {
    XcdBarrier b; b.bar = bar; b.x = xb_xcc_id(); b.st = st;
    if (leader) (void)xb_add(&bar[XB_XCNT(b.x)], 1u);
    return b;
}
__device__ __forceinline__ void xcd_barrier_complete(unsigned* bar, unsigned x, unsigned& nloc, unsigned& nx) {
    const unsigned G = gridDim.x * gridDim.y * gridDim.z;
    unsigned sum, cnt, mine, sp = 0u;
    for (;;) {
        sum = 0u; cnt = 0u; mine = 0u;
#pragma unroll
        for (unsigned j = 0; j < 16; ++j) { const unsigned c = xb_ld(&bar[XB_XCNT(j)]); sum += c; cnt += (c > 0u) ? 1u : 0u; mine = (j == x) ? c : mine; }
        if (sum == G) break;
        __builtin_amdgcn_s_sleep(1);
        if ((++sp & 255u) == 0u) { if (xb_ld(&bar[XB_TMO])) break; if (sp > XB_SPIN_CAP) { atomicAdd(&bar[XB_TMO], 1u); break; } }
    }
    nloc = mine > 0u ? mine : 1u; nx = cnt > 0u ? cnt : 1u;
}

__device__ __forceinline__ void xcd_barrier(const XcdBarrier& b, const bool leader) {
    asm volatile("s_waitcnt vmcnt(0)" ::: "memory");
    __syncthreads();
    if (leader) {
        unsigned* bar = b.bar;
        __builtin_amdgcn_s_waitcnt(0);
        unsigned nloc = b.st[0], nx = b.st[1];
        if (nloc == 0u) { xcd_barrier_complete(bar, b.x, nloc, nx); b.st[0] = nloc; b.st[1] = nx; }
        const unsigned old = xb_add(&bar[XB_XSUB(b.x)], 1u);
        const unsigned gen = old / nloc;
        if (old + 1u == (gen + 1u) * nloc) {
            __builtin_amdgcn_fence(__ATOMIC_RELEASE, "agent");
            asm volatile("s_waitcnt vmcnt(0)" ::: "memory");
            const unsigned og = xb_add(&bar[XB_TOP], 1u);
            const unsigned tg = og / nx;
            if (og + 1u == (tg + 1u) * nx) xb_add(&bar[XB_TOPGEN], 1u);
            else XB_SPIN(xb_ld(&bar[XB_TOPGEN]) == tg, bar);
            __builtin_amdgcn_fence(__ATOMIC_ACQUIRE, "agent");
            xb_add(&bar[XB_XGEN(b.x)], 1u);
            asm volatile("s_waitcnt vmcnt(0)" ::: "memory");
        } else {
            XB_SPIN(xb_ld(&bar[XB_XGEN(b.x)]) == gen, bar);
            __builtin_amdgcn_fence(__ATOMIC_ACQUIRE, "agent");
            asm volatile("s_waitcnt vmcnt(0)" ::: "memory");
        }
    }
    __syncthreads();
}

constexpr int RING_BYTES = pg8::STAGE_BYTES;
constexpr int PART_OFF = RING_BYTES;
constexpr int XBST_OFF = RING_BYTES + 8192;
constexpr int LDS_BYTES = RING_BYTES + 8192 + 16;

__device__ __forceinline__ unsigned pk2(float a, float b) { return pg8::cvt_pk_bf16(a, b); }
__device__ __forceinline__ float wave_sum(float v) {
#pragma unroll
    for (int o = 1; o < 64; o <<= 1) v += __shfl_xor(v, o);
    return v;
}
__device__ __forceinline__ const float* xrow_c(const float* lat, const float* cx, int r) {
    const int b = r / TB, rr = r - b * TB;
    return rr < CTXL ? cx + ((size_t)b * CTXL + rr) * DM : lat + ((size_t)b * SEQ + (rr - CTXL)) * DM;
}
__device__ __forceinline__ int qk_src(int c) { const int h = c & ~127, cp = c & 127;
    return h + ((cp >> 6) & 1) * 64 + ((cp >> 2) & 1) * 32 + ((cp >> 5) & 1) * 16 + ((cp >> 3) & 3) * 4 + (cp & 3); }

__device__ __forceinline__ void transpose_item(const float* W, int K, int N, bf16_t* WT, LAS float* scr, int item, int lane, int nperm) {
    const int nblk = N / 32, kb = item / nblk, nb = item % nblk, k0 = 64 * kb, n0 = 32 * nb;
    const int cdst = n0 + (lane & 31), csrc = cdst < nperm ? qk_src(cdst) : cdst;
#pragma unroll 8
    for (int i = 0; i < 32; ++i) { const int kk = 2 * i + (lane >> 5); scr[kk * 33 + (lane & 31)] = W[(size_t)(k0 + kk) * N + csrc]; }
    asm volatile("s_waitcnt lgkmcnt(0)" ::: "memory");
    const int c = lane & 7;
#pragma unroll
    for (int j = 0; j < 4; ++j) { const int n = (lane >> 3) + 8 * j; const LAS float* s = scr + (8 * c) * 33 + n;
        u32x4 o; o.x = pk2(s[0 * 33], s[1 * 33]); o.y = pk2(s[2 * 33], s[3 * 33]); o.z = pk2(s[4 * 33], s[5 * 33]); o.w = pk2(s[6 * 33], s[7 * 33]);
        *(u32x4*)(WT + (size_t)(n0 + n) * K + k0 + 8 * c) = o; }
    asm volatile("s_waitcnt lgkmcnt(0)" ::: "memory");
}

template <int GI> __device__ __forceinline__ void pool_unit_t(const bf16_t* XB, bf16_t* ZB, const bf16_t* WPt, const float* pscale, int R0, int lane) {
    constexpr int g = GI, a = 1 << GI;
    const int pm = R0 >> 8, b = pm / 65, jt = pm % 65;
    const int lo = b * TB + (jt ? CTXL : 0), hiR = jt ? (b + 1) * TB : b * TB + CTXL;
    const int r32 = lane & 31, hh = lane >> 5, t = R0 + r32;
    const int s0 = max(t - a, lo), s1 = min(t + a - 1, hiR - 1); const float inv = 1.0f / (float)(s1 - s0 + 1);
    f32x16v acc0 = {}, acc1 = {}, acc2 = {}, acc3 = {};
    const bf16_t* xb = XB + g * 128 + hh * 8;
    const bf16_t* wp = WPt + (size_t)(g * 128 + r32) * 128 + hh * 8;
    float wq[2 * a]; int rq[2 * a];
#pragma unroll
    for (int q = 0; q < 2 * a; ++q) { const int rr = t - a + q; const bool ok = (rr >= lo) && (rr < hiR); wq[q] = ok ? inv : 0.f; rq[q] = ok ? rr : t; }
#pragma unroll 1
    for (int kk = 0; kk < 8; ++kk) {
        u32x4 wv[2 * a];
#pragma unroll
        for (int q = 0; q < 2 * a; ++q) wv[q] = *(const u32x4*)(xb + (size_t)rq[q] * 512 + kk * 16);
        const u32x4 w = *(const u32x4*)(xb + (size_t)t * 512 + kk * 16);
        const bf16x8v w0 = *(const bf16x8v*)(wp + kk * 16), w1 = *(const bf16x8v*)(wp + 32 * 128 + kk * 16), w2 = *(const bf16x8v*)(wp + 64 * 128 + kk * 16), w3 = *(const bf16x8v*)(wp + 96 * 128 + kk * 16);
        float s[8] = {0.f, 0.f, 0.f, 0.f, 0.f, 0.f, 0.f, 0.f};
#pragma unroll
        for (int q = 0; q < 2 * a; ++q) { const float f = wq[q]; const u32x4 v = wv[q];
            s[0] += f * pg8::bf_lo(v.x); s[1] += f * pg8::bf_hi(v.x); s[2] += f * pg8::bf_lo(v.y); s[3] += f * pg8::bf_hi(v.y); s[4] += f * pg8::bf_lo(v.z); s[5] += f * pg8::bf_hi(v.z); s[6] += f * pg8::bf_lo(v.w); s[7] += f * pg8::bf_hi(v.w); }
        u32x4 mf; mf.x = pk2(s[0] - pg8::bf_lo(w.x), s[1] - pg8::bf_hi(w.x)); mf.y = pk2(s[2] - pg8::bf_lo(w.y), s[3] - pg8::bf_hi(w.y));
        mf.z = pk2(s[4] - pg8::bf_lo(w.z), s[5] - pg8::bf_hi(w.z)); mf.w = pk2(s[6] - pg8::bf_lo(w.w), s[7] - pg8::bf_hi(w.w));
        const bf16x8v mfrag = *reinterpret_cast<bf16x8v*>(&mf);
        acc0 = __builtin_amdgcn_mfma_f32_32x32x16_bf16(w0, mfrag, acc0, 0, 0, 0); acc1 = __builtin_amdgcn_mfma_f32_32x32x16_bf16(w1, mfrag, acc1, 0, 0, 0);
        acc2 = __builtin_amdgcn_mfma_f32_32x32x16_bf16(w2, mfrag, acc2, 0, 0, 0); acc3 = __builtin_amdgcn_mfma_f32_32x32x16_bf16(w3, mfrag, acc3, 0, 0, 0);
    }
    bf16_t* zrow = ZB + (size_t)t * 512 + g * 128; const float* ps = pscale + g * 128;
#define POOL_OUT(ACC, NS) do { _Pragma("unroll") for (int q = 0; q < 4; ++q) { const int n0 = (NS) * 32 + 8 * q + 4 * hh; const u32x2v z = *(const u32x2v*)(zrow + n0); const f32x4 p4 = *(const f32x4*)(ps + n0); \
        u32x2v o; o.x = pk2(ACC[4 * q + 0] * p4[0] * pg8::bf_lo(z.x), ACC[4 * q + 1] * p4[1] * pg8::bf_hi(z.x)); o.y = pk2(ACC[4 * q + 2] * p4[2] * pg8::bf_lo(z.y), ACC[4 * q + 3] * p4[3] * pg8::bf_hi(z.y)); \
        *(u32x2v*)(zrow + n0) = o; } } while (0)
    POOL_OUT(acc0, 0); POOL_OUT(acc1, 1); POOL_OUT(acc2, 2); POOL_OUT(acc3, 3);
#undef POOL_OUT
}
__device__ __forceinline__ void pool_unit(const bf16_t* XB, bf16_t* ZB, const bf16_t* WPt, const float* pscale, int wu, int lane) {
    const int g = wu & 3, R0 = (wu >> 2) * 32;
    if (g == 0) pool_unit_t<0>(XB, ZB, WPt, pscale, R0, lane); else if (g == 1) pool_unit_t<1>(XB, ZB, WPt, pscale, R0, lane);
    else if (g == 2) pool_unit_t<2>(XB, ZB, WPt, pscale, R0, lane); else pool_unit_t<3>(XB, ZB, WPt, pscale, R0, lane);
}

__device__ __forceinline__ void store_u(const f32x4 (&v)[4], const float* mod, bf16_t* urow, int lane) {
#pragma unroll
    for (int j = 0; j < 4; ++j) { const int c = 4 * lane + 256 * j; const f32x4 sh = *(const f32x4*)(mod + c), sc = *(const f32x4*)(mod + 1024 + c);
        const f32x4 u = v[j] * (sc + 1.0f) + sh; u32x2v o; o.x = pk2(u[0], u[1]); o.y = pk2(u[2], u[3]); *(u32x2v*)(urow + c) = o; }
}

__global__ void __launch_bounds__(NTHREADS, 2) mega(Params P) {
    extern __shared__ __attribute__((aligned(16))) unsigned char lds[];
    cg::grid_group grid = cg::this_grid();
    const int wave = __builtin_amdgcn_readfirstlane(threadIdx.x >> 6);
#define LANE_ID() (__builtin_amdgcn_mbcnt_hi(~0u, __builtin_amdgcn_mbcnt_lo(~0u, 0u)))
    const int G = gridDim.x, bid = blockIdx.x, gw = bid * NWAVES + wave, NGW = G * NWAVES;
#define GRID_SYNC() xcd_barrier(xbar, wave == 0 && LANE_ID() == 0)
#define CAS __attribute__((address_space(4)))
#define WSL() const CAS Params* pp = (const CAS Params*)__builtin_amdgcn_kernarg_segment_ptr(); asm volatile("" : "+s"(pp)); unsigned char* wsl = pp->ws; asm volatile("" : "+s"(wsl))
#define U ((bf16_t*)(wsl + WS_U))
#define Q ((bf16_t*)(wsl + WS_Q))
#define Kb ((bf16_t*)(wsl + WS_K))
#define Vb ((bf16_t*)(wsl + WS_V))
#define ZA ((bf16_t*)(wsl + WS_ZA))
#define XB ((bf16_t*)(wsl + WS_XB))
#define ZB ((bf16_t*)(wsl + WS_ZB))
#define MOD ((float*)(wsl + WS_MOD))
#define CX ((float*)(wsl + WS_CX))
#define DELTA ((const bf16_t*)(wsl + WS_GA))
    LAS unsigned char* l3 = (LAS unsigned char*)lds;
    const CAS Params* pp0 = (const CAS Params*)__builtin_amdgcn_kernarg_segment_ptr();
    { volatile LAS unsigned* st = (volatile LAS unsigned*)(l3 + XBST_OFF); if (wave == 0 && LANE_ID() == 0) { st[0] = 0u; st[1] = 0u; st[2] = 0u; st[3] = 0u; } }
    __syncthreads();
    XcdBarrier xbar = xcd_barrier_post((unsigned*)(pp0->ws + WS_BAR), (volatile LAS unsigned*)(l3 + XBST_OFF), wave == 0 && LANE_ID() == 0);
    grid.sync();

    constexpr int NPH = 2 + 5 * DEPTH;
#pragma unroll 1
    for (int ph = 0; ph < NPH; ++ph) {
    const int l = ph < 2 ? 0 : (ph - 2) / 5, sph = ph < 2 ? ph : 2 + (ph - 2) % 5;
    if (sph == 0) {
        WSL(); int lane = LANE_ID(); asm volatile("" : "+v"(lane)); const int tid = wave * 64 + lane; unsigned char* ws = wsl; float* cosT = (float*)(wsl + WS_ROPE); float* sinT = cosT + 256 * 32;
        LAS float* scr = (LAS float*)(l3 + wave * 16384);
        constexpr int I_IN = (DM / 64) * (NIN / 32), I_A = (DM / 64) * (DM / 32), I_B = (512 / 64) * (DM / 32), I_O = I_A, I_P = (128 / 64) * (128 / 32);
        constexpr int PER_L = I_IN + I_A + I_B + I_O + 4 * I_P;
        for (int it = gw; it < DEPTH * PER_L; it += NGW) {
            const int l = it / PER_L; int r = it - l * PER_L;
            if (r < I_IN) { transpose_item(pp->w_in + (size_t)l * DM * NIN, DM, NIN, (bf16_t*)(ws + WS_WIN + l * SZ_WIN), scr, r, lane, 1280); continue; } r -= I_IN;
            if (r < I_A) { transpose_item(pp->w_br_a + (size_t)l * DM * DM, DM, DM, (bf16_t*)(ws + WS_WA + l * SZ_WA), scr, r, lane, 0); continue; } r -= I_A;
            if (r < I_B) { transpose_item(pp->w_br_b + (size_t)l * 512 * DM, 512, DM, (bf16_t*)(ws + WS_WB + l * SZ_WB), scr, r, lane, 0); continue; } r -= I_B;
            if (r < I_O) { transpose_item(pp->w_out + (size_t)l * DM * DM, DM, DM, (bf16_t*)(ws + WS_WO + l * SZ_WO), scr, r, lane, 0); continue; } r -= I_O;
            const int g = r / I_P; r -= g * I_P;
            transpose_item(pp->w_pool + ((size_t)l * 4 + g) * 128 * 128, 128, 128, (bf16_t*)(ws + WS_WP + l * SZ_WP) + (size_t)g * 128 * 128, scr, r, lane, 0);
        }
        for (int i = bid * NTHREADS + tid; i < 256 * 32; i += G * NTHREADS) { const int pos = i >> 5, f = i & 31;
            const float invf = 1.0f / __builtin_amdgcn_exp2f(13.287712379549449f * (float)f * (1.0f / 32.0f)); const float ang = (float)pos * invf;
            double rev = (double)ang * 0.15915494309189535; rev -= floor(rev); const float fr_ = (float)rev;
            cosT[i] = __builtin_amdgcn_cosf(fr_); sinT[i] = __builtin_amdgcn_sinf(fr_); }
        __syncthreads();
        LAS float* sv = (LAS float*)l3;
        LAS float* red = sv + 3 * 1024;
        for (int i = tid; i < 3 * 1024; i += NTHREADS) { const int v = i >> 10, k = i & 1023; const float cv = v < 2 ? pp->c[v * 1024 + k] : pp->c_ctx[k]; sv[i] = cv * pg8::sigm(cv); }
        __syncthreads();
        for (int un = bid; un < DEPTH * 48; un += G) { const int l = un / 48, n = (un % 48) * 64 + lane, ks = wave;
            const float* wm = pp->w_mod + (size_t)l * DM * 3072 + (size_t)(ks * 128) * 3072 + n; float a0 = 0.f, a1 = 0.f, a2 = 0.f;
#pragma unroll 8
            for (int k = 0; k < 128; ++k) { const float w = wm[(size_t)k * 3072]; a0 += sv[ks * 128 + k] * w; a1 += sv[1024 + ks * 128 + k] * w; a2 += sv[2048 + ks * 128 + k] * w; }
            red[(ks * 3 + 0) * 64 + lane] = a0; red[(ks * 3 + 1) * 64 + lane] = a1; red[(ks * 3 + 2) * 64 + lane] = a2;
            __syncthreads();
            if (tid < 192) { const int v = tid >> 6, cl = tid & 63; float s = 0.f;
#pragma unroll
                for (int q = 0; q < 8; ++q) s += red[(q * 3 + v) * 64 + cl];
                const int nn = (un % 48) * 64 + cl; MOD[((size_t)l * 3 + v) * 3072 + nn] = s + pp->b_mod[l * 3072 + nn]; }
            __syncthreads();
        }
    } else if (sph == 1) {
    WSL(); int lane = LANE_ID(); asm volatile("" : "+v"(lane));
    for (int r = gw; r < TROWS; r += NGW) { const float* xr = xrow_c(pp->x, pp->ctx, r); const int b = r / TB, mi = (r - b * TB) < CTXL ? 2 : b;
        f32x4 v[4];
#pragma unroll
        for (int j = 0; j < 4; ++j) v[j] = *(const f32x4*)(xr + 4 * lane + 256 * j);
        store_u(v, MOD + mi * 3072, U + (size_t)r * DM, lane); }
    } else if (sph == 2) {
        {
            WSL(); pg8::Gemm g{U, (const bf16_t*)(wsl + WS_WIN + l * SZ_WIN), TROWS, NIN, DM}; pg8::StaticOrder S; S.init(TROWS, NIN, G, bid);
            pg8::EpiIn E{wsl, pp->q_norm + l * 128, pp->k_norm + l * 128, (LAS float*)(l3 + PART_OFF)};
            pg8::gemm_phase<pg8::EpiIn, pg8::StaticOrder, true, true>(l3, g, S, E, wave);
        }
    } else if (sph == 3) {
        {
            WSL(); int lane = LANE_ID(); asm volatile("" : "+v"(lane)); const bf16_t* WPt = (const bf16_t*)(wsl + WS_WP + l * SZ_WP);
            const int nunits = 1024 + (l < DEPTH - 1 ? 16 : 0);
            float kmax; { const float* kn = pp->k_norm + l * 128; kmax = fmaxf(fabsf(kn[lane]), fabsf(kn[lane + 64]));
#pragma unroll
                for (int o_ = 1; o_ < 64; o_ <<= 1) kmax = fmaxf(kmax, __shfl_xor(kmax, o_)); }
            for (int un = bid; un < nunits; un += G) {
                __syncthreads();
                int b, h, rowq, seq;
                if (un < 1024) { b = un >> 9; h = (un >> 6) & 7; rowq = b * TB + CTXL + (un & 63) * 256; seq = TB; }
                else { const int c = un - 1024; b = c >> 3; h = c & 7; rowq = b * TB; seq = CTXL; }
                const size_t qoff = (size_t)rowq * DM + h * 128, koff = (size_t)b * TB * 256 + (h >> 2) * 128;
                att::attn_dense_body((const att::bf16*)(Q + qoff), (const att::bf16*)(Kb + koff), (const att::bf16*)(Vb + koff), (const att::bf16*)(ZA + qoff), (att::bf16*)(Q + qoff), seq, (char*)lds, wave, kmax, l3);
            }
            { unsigned* qctr = (unsigned*)(wsl + WS_BAR) + 8 + l; const int npool = (l < DEPTH - 1) ? (TROWS / 32) * 4 : (NBATCH * SEQ / 32) * 4;
              for (;;) { unsigned wq = 0u; if (lane == 0) wq = __hip_atomic_fetch_add(qctr, 1u, __ATOMIC_RELAXED, __HIP_MEMORY_SCOPE_AGENT);
                  const int wi = __builtin_amdgcn_readfirstlane((int)wq); if (wi >= npool) break;
                  int wu = wi; if (l == DEPTH - 1) { const int rc = wi >> 2, rcf = rc + (CTXL / 32) * (1 + rc / (SEQ / 32)); wu = (rcf << 2) | (wi & 3); }
                  pool_unit(XB, ZB, WPt, pp->pool_scale + l * 512, wu, lane); } }
        }
    } else if (sph == 4) {
        {
            WSL(); pg8::Gemm g{Q, (const bf16_t*)(wsl + WS_WA + l * SZ_WA), TROWS, DM, DM};
            pg8::EpiGate<0> E{wsl};
            { pg8::StaticOrder S; S.init(l == DEPTH - 1 ? NBATCH * SEQ : TROWS, DM, G, bid); S.skip = (l == DEPTH - 1); pg8::gemm_phase<pg8::EpiGate<0>, pg8::StaticOrder, true, true>(l3, g, S, E, wave); }
        }
        {
            WSL(); pg8::Gemm g{ZB, (const bf16_t*)(wsl + WS_WB + l * SZ_WB), TROWS, DM, 512};
            pg8::EpiGate<1> E{wsl};
            { pg8::StaticOrder S; S.init(l == DEPTH - 1 ? NBATCH * SEQ : TROWS, DM, G, bid); S.skip = (l == DEPTH - 1); pg8::gemm_phase<pg8::EpiGate<1>, pg8::StaticOrder, true, true>(l3, g, S, E, wave); }
        }
    } else if (sph == 5) {
        {
            WSL(); pg8::Gemm g{ZA, (const bf16_t*)(wsl + WS_WO + l * SZ_WO), TROWS, DM, DM};
            pg8::EpiRes E{MOD + (size_t)l * 3 * 3072, wsl};
            { pg8::StaticOrder S; S.init(l == DEPTH - 1 ? NBATCH * SEQ : TROWS, DM, G, bid); S.skip = (l == DEPTH - 1); pg8::gemm_phase<pg8::EpiRes, pg8::StaticOrder, true, true>(l3, g, S, E, wave); }
        }
    } else {
        {
            WSL(); int lane = LANE_ID(); asm volatile("" : "+v"(lane)); const float* modl = MOD + (size_t)l * 3 * 3072; const float* lg = pp->ln_g + l * DM; const float* lb = pp->ln_b + l * DM; const bool last = (l == DEPTH - 1);
            const float* xlat = l == 0 ? pp->x : pp->out; const float* xctx = l == 0 ? pp->ctx : CX;
            auto ln_row = [&](const int r, const f32x4 (&vin)[4]) {
                const int b = r / TB, rr = r - b * TB; const bool isctx = rr < CTXL; f32x4 v[4]; float s = 0.f;
#pragma unroll
                for (int j = 0; j < 4; ++j) { v[j] = vin[j]; s += (v[j][0] + v[j][1]) + (v[j][2] + v[j][3]); }
                const float mean = wave_sum(s) * (1.0f / DM); float s2 = 0.f;
#pragma unroll
                for (int j = 0; j < 4; ++j) { v[j] = v[j] - mean; s2 += (v[j][0] * v[j][0] + v[j][1] * v[j][1]) + (v[j][2] * v[j][2] + v[j][3] * v[j][3]); }
                const float rstd = 1.0f / sqrtf(wave_sum(s2) * (1.0f / DM) + EPSV);
                float* xo = isctx ? CX + ((size_t)b * CTXL + rr) * DM : pp->out + ((size_t)b * SEQ + (rr - CTXL)) * DM;
#pragma unroll
                for (int j = 0; j < 4; ++j) { const int c = 4 * lane + 256 * j; v[j] = v[j] * rstd * *(const f32x4*)(lg + c) + *(const f32x4*)(lb + c); *(f32x4*)(xo + c) = v[j]; }
                if (!last) store_u(v, modl + 3 * 3072 + (isctx ? 2 : b) * 3072, U + (size_t)r * DM, lane);
            };
            const int nrows = last ? NBATCH * SEQ : TROWS;
            for (int i0 = gw; i0 < nrows; i0 += 2 * NGW) {
                const int i1 = i0 + NGW; const bool has1 = i1 < nrows;
                const int r0 = last ? i0 + CTXL * (1 + i0 / SEQ) : i0, r1 = has1 ? (last ? i1 + CTXL * (1 + i1 / SEQ) : i1) : r0;
                f32x4 va[4], vb[4]; const float* xa = xrow_c(xlat, xctx, r0); const float* xb_ = xrow_c(xlat, xctx, r1);
                const bf16_t* da = DELTA + (size_t)r0 * DM; const bf16_t* db = DELTA + (size_t)r1 * DM;
#pragma unroll
                for (int j = 0; j < 4; ++j) { const int c = 4 * lane + 256 * j; const f32x4 x0 = *(const f32x4*)(xa + c), x1 = *(const f32x4*)(xb_ + c);
                    const u32x2v d0 = *(const u32x2v*)(da + c), d1 = *(const u32x2v*)(db + c);
                    va[j] = x0 * ALPHA_RES + (f32x4){pg8::bf_lo(d0.x), pg8::bf_hi(d0.x), pg8::bf_lo(d0.y), pg8::bf_hi(d0.y)};
                    vb[j] = x1 * ALPHA_RES + (f32x4){pg8::bf_lo(d1.x), pg8::bf_hi(d1.x), pg8::bf_lo(d1.y), pg8::bf_hi(d1.y)}; }
                ln_row(r0, va); if (has1) ln_row(r1, vb);
            }
        }
    }
    if (ph + 1 < NPH) GRID_SYNC();
    }
}

extern "C" void kernel_launch(void* const* d_in, const int* in_sizes, int n_in, void* d_out, int out_size, void* d_ws, size_t ws_size, hipStream_t stream) {
    static int grid_blocks = 0;
    if (grid_blocks == 0) {
        if (n_in != 16 || ws_size < WS_END2 || out_size != NBATCH * SEQ * DM) { fprintf(stderr, "kernel_launch: unexpected shapes: n_in %d out %d ws %zu (need %zu)\n", n_in, out_size, ws_size, (size_t)WS_END2); grid_blocks = -1; return; }
        int dev = 0, cus = 0, per_cu = 0;
        hipGetDevice(&dev); hipDeviceGetAttribute(&cus, hipDeviceAttributeMultiprocessorCount, dev);
        if (hipFuncSetAttribute((const void*)mega, hipFuncAttributeMaxDynamicSharedMemorySize, LDS_BYTES) != hipSuccess) { fprintf(stderr, "kernel_launch: hipFuncSetAttribute failed\n"); grid_blocks = -1; return; }
        if (hipOccupancyMaxActiveBlocksPerMultiprocessor(&per_cu, (const void*)mega, NTHREADS, LDS_BYTES) != hipSuccess || per_cu < 1) { fprintf(stderr, "kernel_launch: occupancy query gave %d\n", per_cu); per_cu = 1; }
        (void)hipGetLastError();
        grid_blocks = cus * per_cu;
    }
    if (grid_blocks < 0) return;
    Params p{};
    p.x = (const float*)d_in[0]; p.c = (const float*)d_in[1]; p.ctx = (const float*)d_in[2]; p.c_ctx = (const float*)d_in[3]; p.w_mod = (const float*)d_in[4]; p.b_mod = (const float*)d_in[5];
    p.w_in = (const float*)d_in[6]; p.q_norm = (const float*)d_in[7]; p.k_norm = (const float*)d_in[8]; p.w_pool = (const float*)d_in[9]; p.pool_scale = (const float*)d_in[10];
    p.w_br_a = (const float*)d_in[11]; p.w_br_b = (const float*)d_in[12]; p.w_out = (const float*)d_in[13]; p.ln_g = (const float*)d_in[14]; p.ln_b = (const float*)d_in[15];
    p.out = (float*)d_out; p.ws = (unsigned char*)d_ws;
    void* args[] = {&p};
    if (hipMemsetAsync((char*)d_ws + WS_BAR, 0, XCD_BAR_WORDS * 4, stream) != hipSuccess) { fprintf(stderr, "kernel_launch: memset of the barrier word failed\n"); return; }
    hipError_t e = hipLaunchCooperativeKernel((const void*)mega, dim3(grid_blocks), dim3(NTHREADS), args, LDS_BYTES, stream);
    if (e != hipSuccess) fprintf(stderr, "kernel_launch: cooperative launch failed: %s (grid %d)\n", hipGetErrorString(e), grid_blocks);
}
```

```cpp
#include <hip/hip_runtime.h>
#include <hip/hip_bf16.h>
#include <hip/hip_cooperative_groups.h>
#include <cstdio>
#include <cstdint>
namespace cg = cooperative_groups;

constexpr int DM = 1024, NBATCH = 2, SEQ = 16384, CTXL = 256, DEPTH = 4, HD = 128;
constexpr int TB = SEQ + CTXL;
constexpr int TROWS = NBATCH * TB;
constexpr int NIN = 5632;
constexpr float EPSV = 1e-6f;
constexpr float ALPHA_RES = 1.681792830507429f;
constexpr int NWAVES = 8, NTHREADS = 512;

constexpr size_t SZ_WIN = (size_t)NIN * DM * 2, SZ_WA = (size_t)DM * DM * 2, SZ_WB = (size_t)DM * 512 * 2, SZ_WO = SZ_WA, SZ_WP = (size_t)4 * 128 * 128 * 2;
constexpr size_t WS_WIN = 0;
constexpr size_t WS_WA = WS_WIN + DEPTH * SZ_WIN;
constexpr size_t WS_WB = WS_WA + DEPTH * SZ_WA;
constexpr size_t WS_WO = WS_WB + DEPTH * SZ_WB;
constexpr size_t WS_WP = WS_WO + DEPTH * SZ_WO;
constexpr size_t WS_MOD = WS_WP + DEPTH * SZ_WP;
constexpr size_t WS_ROPE = WS_MOD + (size_t)DEPTH * 3 * 3072 * 4;
constexpr size_t WS_CX = WS_ROPE + 2 * 256 * 32 * 4;
constexpr size_t WS_U = WS_CX + (size_t)512 * DM * 4;
constexpr size_t WS_Q = WS_U + (size_t)TROWS * DM * 2;
constexpr size_t WS_K = WS_Q + (size_t)TROWS * DM * 2;
constexpr size_t WS_V = WS_K + (size_t)TROWS * 256 * 2;
constexpr size_t WS_ZA = WS_V + (size_t)TROWS * 256 * 2;
constexpr size_t WS_XB = WS_ZA + (size_t)TROWS * DM * 2;
constexpr size_t WS_ZB = WS_XB + (size_t)TROWS * 512 * 2;
constexpr size_t WS_GA = WS_ZB + (size_t)TROWS * 512 * 2;
constexpr size_t WS_GB = WS_GA + (size_t)TROWS * DM * 2;
constexpr size_t WS_END = WS_GB + (size_t)TROWS * DM * 2;
constexpr size_t WS_BAR = WS_END, WS_END2 = WS_END + 16384;

struct Params {
    const float *x, *c, *ctx, *c_ctx, *w_mod, *b_mod, *w_in, *q_norm, *k_norm, *w_pool, *pool_scale, *w_br_a, *w_br_b, *w_out, *ln_g, *ln_b;
    float* out; unsigned char* ws;
};

namespace pg8 {
#define PG8_LAS __attribute__((address_space(3)))
typedef unsigned short bf16_t;
typedef short bf16x8 __attribute__((ext_vector_type(8)));
typedef float f32x4 __attribute__((ext_vector_type(4)));
typedef unsigned u32x4 __attribute__((ext_vector_type(4)));
constexpr int BM = 256, BK = 64, HALF = 128, HTB = HALF * BK * 2  , STAGE_BYTES = 8 * HTB, NXCD = 8, WGM = 8;

__host__ __device__ __forceinline__ int lds_byte(int r, int c) { const int st = (r >> 4) * 2 + (c >> 5), rr = r & 15, cc = c & 31, ob = rr * 64 + cc * 2; return st * 1024 + (ob ^ (((ob >> 9) & 1) << 5)); }
__host__ __device__ __forceinline__ void stage_rc(int b, int& R, int& C) { const int st = b / 1024, sb = b % 1024, swz = sb ^ (((sb >> 9) & 1) << 5); R = (st >> 1) * 16 + swz / 64; C = (st & 1) * 32 + (swz % 64) / 2; }
__host__ __device__ __forceinline__ int perm32(int rho) { const int n = rho >> 4, i = rho & 15; return 8 * (i >> 2) + 4 * n + (i & 3); }

struct Unit { int pm, pn; };
struct Gemm { const bf16_t* A; const bf16_t* Bt; int M, N, K; };

struct StaticOrder {
    int nM, nN, nwg, G, c, skip;
    __host__ __device__ void init(int M, int N, int G_, int c_) { nM = M / BM; nN = N / BM; nwg = nM * nN; G = G_; c = c_; skip = 0; }
    __host__ __device__ bool next(int i, Unit& u) const {
        const long L = (long)i * G + c; if (L >= nwg) return false;
        int wgid = (int)L; { const int q = nwg / NXCD, r = nwg % NXCD, xcd = wgid % NXCD, off = wgid / NXCD; wgid = (xcd < r ? xcd * (q + 1) : r * (q + 1) + (xcd - r) * q) + off; }
        const int nig = WGM * nN, gid = wgid / nig, fm = gid * WGM, gsz = (nM - fm) < WGM ? (nM - fm) : WGM;
        u.pm = fm + ((wgid % nig) % gsz); u.pn = (wgid % nig) / gsz; if (skip) u.pm += 1 + (u.pm >= 64 ? 1 : 0); return true;
    }
    __device__ __forceinline__ void a_ready(const Unit&) const {}
    __device__ __forceinline__ void done(const Unit&) const {}
};

typedef __bf16 bf16x2_t __attribute__((ext_vector_type(2)));
typedef float f32x2_t __attribute__((ext_vector_type(2)));
__device__ __forceinline__ unsigned cvt_pk_bf16(float lo, float hi) { const f32x2_t v = {lo, hi}; const bf16x2_t r = __builtin_convertvector(v, bf16x2_t); return __builtin_bit_cast(unsigned, r); }
typedef float f32x2 __attribute__((ext_vector_type(2)));
struct LatentOrder {
    StaticOrder S;
    __host__ __device__ void init(int N, int G_, int c_) { S.init(32768, N, G_, c_); }
    __host__ __device__ bool next(int i, Unit& u) const { if (!S.next(i, u)) return false; u.pm += 1 + (u.pm >= 64 ? 1 : 0); return true; }
    __device__ __forceinline__ void a_ready(const Unit&) const {}
    __device__ __forceinline__ void done(const Unit&) const {}
};
__device__ __forceinline__ float bf_lo(unsigned w) { return __uint_as_float(w << 16); }
__device__ __forceinline__ float bf_hi(unsigned w) { return __uint_as_float(w & 0xffff0000u); }
__device__ __forceinline__ float sigm(float x) { return __builtin_amdgcn_rcpf(1.0f + __builtin_amdgcn_exp2f(-1.4426950408889634f * x)); }
typedef unsigned u32x2 __attribute__((ext_vector_type(2)));
template <int ACT> __device__ __forceinline__ float actf(float x) { if (ACT == 1) return x * sigm(x); if (ACT == 2) return sigm(x); return x; }

struct EpiIn {
    static constexpr bool PERM = true, AFTER_DRAIN = false;
    unsigned char* ws; const float *qg, *kg;
    PG8_LAS float* part;
    template <int ACT> __device__ __forceinline__ void plain(const f32x4 (&acc)[2][2][4][2], bf16_t* base, int ldc, int colt, const Unit& u, int wr, int wc, int fr, int fq) const {
        const int row0 = u.pm * BM + wr * 64 + fr, col0 = colt + wc * 32 + 8 * fq;
#pragma unroll
        for (int ai = 0; ai < 2; ++ai)
#pragma unroll
            for (int m = 0; m < 4; ++m) { bf16_t* rowp = base + (size_t)(row0 + ai * HALF + m * 16) * ldc + col0;
#pragma unroll
                for (int bj = 0; bj < 2; ++bj) { const f32x4 v0 = acc[ai][bj][m][0], v1 = acc[ai][bj][m][1]; u32x4 w;
                    w.x = cvt_pk_bf16(actf<ACT>(v0[0]), actf<ACT>(v0[1])); w.y = cvt_pk_bf16(actf<ACT>(v0[2]), actf<ACT>(v0[3]));
                    w.z = cvt_pk_bf16(actf<ACT>(v1[0]), actf<ACT>(v1[1])); w.w = cvt_pk_bf16(actf<ACT>(v1[2]), actf<ACT>(v1[3]));
                    *(u32x4*)(rowp + bj * HALF) = w; } }
    }
    __device__ __forceinline__ void qk(const f32x4 (&acc)[2][2][4][2], const Unit& u, int wr, int wc, int fr, int fq) const {
        const bool isk = (u.pn == 4);
        const float* g = isk ? kg : qg; bf16_t* dst = (bf16_t*)(ws + (isk ? WS_K : WS_Q)); const int ldc = isk ? 256 : 1024;
        const float* cosT = (const float*)(ws + WS_ROPE); const float* sinT = cosT + 256 * 32;
        const int f0 = (wc & 1) * 16 + 4 * fq, axis = wc >> 1, e1 = axis * 64 + f0;
        const f32x4 g1 = *(const f32x4*)(g + e1), g2 = *(const f32x4*)(g + e1 + 32);
#pragma unroll
        for (int ai = 0; ai < 2; ++ai)
#pragma unroll
            for (int m = 0; m < 4; ++m)
#pragma unroll
                for (int bj = 0; bj < 2; ++bj) { const f32x4 a = acc[ai][bj][m][0], b = acc[ai][bj][m][1];
                    float s = (a[0] * a[0] + a[1] * a[1]) + (a[2] * a[2] + a[3] * a[3]) + (b[0] * b[0] + b[1] * b[1]) + (b[2] * b[2] + b[3] * b[3]);
                    s += __shfl_xor(s, 16); s += __shfl_xor(s, 32);
                    if (fq == 0) part[((ai * HALF + wr * 64 + m * 16 + fr) * 2 + bj) * 4 + wc] = s; }
        asm volatile("s_waitcnt lgkmcnt(0)" ::: "memory"); __builtin_amdgcn_s_barrier(); asm volatile("" ::: "memory");
        const int jt = u.pm % 65; const bool rope = (jt != 0);
#pragma unroll
        for (int ai = 0; ai < 2; ++ai)
#pragma unroll
            for (int m = 0; m < 4; ++m) { const int rloc = ai * HALF + wr * 64 + m * 16 + fr;
                const int pos = rope ? (axis ? (16 * m + fr) : ((jt - 1) * 4 + 2 * ai + wr)) : 0;
                f32x4 c4 = *(const f32x4*)(cosT + pos * 32 + f0), s4 = *(const f32x4*)(sinT + pos * 32 + f0);
                if (!rope) { c4 = (f32x4){1.f, 1.f, 1.f, 1.f}; s4 = (f32x4){0.f, 0.f, 0.f, 0.f}; }
#pragma unroll
                for (int bj = 0; bj < 2; ++bj) { const f32x4 p = *(const PG8_LAS f32x4*)(part + (rloc * 2 + bj) * 4);
                    const float rstd = __builtin_amdgcn_rsqf(((p[0] + p[1]) + (p[2] + p[3])) * (1.0f / 128.0f) + 1e-6f);
                    const f32x4 y1 = acc[ai][bj][m][0] * rstd * g1, y2 = acc[ai][bj][m][1] * rstd * g2;
                    f32x4 o1 = y1 * c4 - y2 * s4, o2 = y1 * s4 + y2 * c4;
                    if (!isk) { o1 = o1 * 0.12751743074602458f; o2 = o2 * 0.12751743074602458f; }
                    const int head = isk ? bj : 2 * u.pn + bj;
                    bf16_t* ptr = dst + (size_t)(u.pm * BM + rloc) * ldc + head * 128 + e1;
                    u32x2 w1, w2; w1.x = cvt_pk_bf16(o1[0], o1[1]); w1.y = cvt_pk_bf16(o1[2], o1[3]); w2.x = cvt_pk_bf16(o2[0], o2[1]); w2.y = cvt_pk_bf16(o2[2], o2[3]);
                    *(u32x2*)ptr = w1; *(u32x2*)(ptr + 32) = w2; } }
    }
    __device__ __forceinline__ void operator()(const f32x4 (&acc)[2][2][4][2], const Unit& u, int wr, int wc, int fr, int fq) const {
        const int pn = u.pn;
        if (pn < 5) { qk(acc, u, wr, wc, fr, fq); return; }
        if (pn == 5) plain<0>(acc, (bf16_t*)(ws + WS_V), 256, 0, u, wr, wc, fr, fq);
        else if (pn < 10) plain<1>(acc, (bf16_t*)(ws + WS_ZA), 1024, (pn - 6) * 256, u, wr, wc, fr, fq);
        else if (pn < 12) plain<0>(acc, (bf16_t*)(ws + WS_XB), 512, (pn - 10) * 256, u, wr, wc, fr, fq);
        else if (pn < 14) plain<1>(acc, (bf16_t*)(ws + WS_ZB), 512, (pn - 12) * 256, u, wr, wc, fr, fq);
        else if (pn < 18) plain<2>(acc, (bf16_t*)(ws + WS_GA), 1024, (pn - 14) * 256, u, wr, wc, fr, fq);
        else plain<2>(acc, (bf16_t*)(ws + WS_GB), 1024, (pn - 18) * 256, u, wr, wc, fr, fq);
    }
};
template <int MODE> struct EpiGate {
    static constexpr bool PERM = true, AFTER_DRAIN = false;
    unsigned char* ws;
    __device__ __forceinline__ void operator()(const f32x4 (&acc)[2][2][4][2], const Unit& u, int wr, int wc, int fr, int fq) const {
        bf16_t* GA = (bf16_t*)(ws + WS_GA); const bf16_t* GB = (const bf16_t*)(ws + WS_GB); bf16_t* Y = (bf16_t*)(ws + WS_ZA);
        const int row0 = u.pm * BM + wr * 64 + fr, col0 = u.pn * BM + wc * 32 + 8 * fq;
#pragma unroll
        for (int ai = 0; ai < 2; ++ai)
#pragma unroll
            for (int m = 0; m < 4; ++m) { const size_t off = (size_t)(row0 + ai * HALF + m * 16) * 1024 + col0;
#pragma unroll
                for (int bj = 0; bj < 2; ++bj) { const f32x4 v0 = acc[ai][bj][m][0], v1 = acc[ai][bj][m][1];
                    const u32x4 ga = *(const u32x4*)(GA + off + bj * HALF); u32x4 w;
                    if (MODE == 0) {
                        w.x = cvt_pk_bf16(v0[0] * bf_lo(ga.x), v0[1] * bf_hi(ga.x)); w.y = cvt_pk_bf16(v0[2] * bf_lo(ga.y), v0[3] * bf_hi(ga.y));
                        w.z = cvt_pk_bf16(v1[0] * bf_lo(ga.z), v1[1] * bf_hi(ga.z)); w.w = cvt_pk_bf16(v1[2] * bf_lo(ga.w), v1[3] * bf_hi(ga.w));
                        *(u32x4*)(GA + off + bj * HALF) = w;
                    } else {
                        const u32x4 gb = *(const u32x4*)(GB + off + bj * HALF);
                        w.x = cvt_pk_bf16(bf_lo(ga.x) + v0[0] * bf_lo(gb.x), bf_hi(ga.x) + v0[1] * bf_hi(gb.x)); w.y = cvt_pk_bf16(bf_lo(ga.y) + v0[2] * bf_lo(gb.y), bf_hi(ga.y) + v0[3] * bf_hi(gb.y));
                        w.z = cvt_pk_bf16(bf_lo(ga.z) + v1[0] * bf_lo(gb.z), bf_hi(ga.z) + v1[1] * bf_hi(gb.z)); w.w = cvt_pk_bf16(bf_lo(ga.w) + v1[2] * bf_lo(gb.w), bf_hi(ga.w) + v1[3] * bf_hi(gb.w));
                        *(u32x4*)(Y + off + bj * HALF) = w;
                    } } }
    }
};
struct EpiRes {
    static constexpr bool PERM = true, AFTER_DRAIN = false;
    const float* mod; unsigned char* ws;
    __device__ __forceinline__ void operator()(const f32x4 (&acc)[2][2][4][2], const Unit& u, int wr, int wc, int fr, int fq) const {
        const int b = u.pm / 65, jt = u.pm % 65; bf16_t* dl = (bf16_t*)(ws + WS_GA);
        const float* gate = mod + (jt ? b : 2) * 3072 + 2048;
        const int row0 = u.pm * BM + wr * 64 + fr, col0 = u.pn * BM + wc * 32 + 8 * fq;
        f32x4 gv[2][2];
#pragma unroll
        for (int bj = 0; bj < 2; ++bj)
#pragma unroll
            for (int n = 0; n < 2; ++n) gv[bj][n] = *(const f32x4*)(gate + col0 + bj * HALF + 4 * n);
#pragma unroll
        for (int ai = 0; ai < 2; ++ai)
#pragma unroll
            for (int m = 0; m < 4; ++m) { bf16_t* rowp = dl + (size_t)(row0 + ai * HALF + m * 16) * 1024 + col0;
#pragma unroll
                for (int bj = 0; bj < 2; ++bj) { const f32x4 v0 = acc[ai][bj][m][0] * gv[bj][0], v1 = acc[ai][bj][m][1] * gv[bj][1]; u32x4 w;
                    w.x = cvt_pk_bf16(v0[0], v0[1]); w.y = cvt_pk_bf16(v0[2], v0[3]); w.z = cvt_pk_bf16(v1[0], v1[1]); w.w = cvt_pk_bf16(v1[2], v1[3]);
                    *(u32x4*)(rowp + bj * HALF) = w; } }
    }
};

template <class Epi, class Sched, bool ALIGN_EPI = false, bool SP2 = false>
__device__ __forceinline__ void gemm_phase(PG8_LAS unsigned char* lds, const Gemm g, const Sched& S, const Epi& E, const int wid_in) {
    int lane = __builtin_amdgcn_mbcnt_hi(~0u, __builtin_amdgcn_mbcnt_lo(~0u, 0u)); asm volatile("" : "+v"(lane));
    const int wid = wid_in, tid = wid * 64 + lane, wr = wid >> 2, wc = wid & 3, fr = lane & 15, fq = lane >> 4;
    const int K = g.K, nt = K / BK;
    unsigned voffA[2], voffB[2];
#pragma unroll
    for (int i = 0; i < 2; ++i) { int R, C; stage_rc(tid * 16 + i * 8192, R, C); const int Rb = Epi::PERM ? ((R & ~31) + perm32(R & 31)) : R;
        voffA[i] = (unsigned)(R * K + C) * 2u; voffB[i] = (unsigned)(Rb * K + C) * 2u; }
    const size_t kstep = (size_t)(BK * 2);
    const size_t hstep = (size_t)HALF * K * 2;
    const size_t tstep = 2 * hstep;
    const unsigned ldsw = (unsigned)wid * 1024u;
    const int aoff = lds_byte(wr * 64 + fr, fq * 8), boff = lds_byte(wc * 32 + fr, fq * 8);
#define PG8_SA(b, h) (((b) * 2 + (h)) * HTB)
#define PG8_SB(b, h) ((4 + (b) * 2 + (h)) * HTB)
#define PG8_STAGE(bufoff, gbase, voff) do { _Pragma("unroll") for (int _i = 0; _i < 2; ++_i) \
        __builtin_amdgcn_global_load_lds((const unsigned*)((const char*)(gbase) + (voff)[_i]), (PG8_LAS unsigned*)(lds + (bufoff) + ldsw + _i * 8192), 16, 0, 0); } while (0)
#define PG8_LDA(dst, b, h) do { _Pragma("unroll") for (int m = 0; m < 4; ++m) _Pragma("unroll") for (int k = 0; k < 2; ++k) dst[m][k] = *(const PG8_LAS bf16x8*)(lds + PG8_SA(b, h) + aoff + m * 2048 + k * 1024); } while (0)
#define PG8_LDB(dst, b, h) do { _Pragma("unroll") for (int n = 0; n < 2; ++n) _Pragma("unroll") for (int k = 0; k < 2; ++k) dst[n][k] = *(const PG8_LAS bf16x8*)(lds + PG8_SB(b, h) + boff + n * 2048 + k * 1024); } while (0)
#define PG8_MMA(ai, bj, At, Bt) do { __builtin_amdgcn_s_setprio(1); _Pragma("unroll") for (int m = 0; m < 4; ++m) _Pragma("unroll") for (int n = 0; n < 2; ++n) _Pragma("unroll") for (int k = 0; k < 2; ++k) \
        acc[ai][bj][m][n] = __builtin_amdgcn_mfma_f32_16x16x32_bf16(Bt[n][k], At[m][k], acc[ai][bj][m][n], 0, 0, 0); __builtin_amdgcn_s_setprio(0); } while (0)
#define PG8_WAIT_V(n) asm volatile("s_waitcnt vmcnt(" #n ")" ::: "memory")
#define PG8_WAIT_L(n) asm volatile("s_waitcnt lgkmcnt(" #n ")" ::: "memory")
#define PG8_BAR __builtin_amdgcn_s_barrier()
#define PG8_SCHED __builtin_amdgcn_sched_barrier(0)
    Unit cur, nxt; int ui = 0;
    if (!S.next(0, cur)) return;
    f32x4 acc[2][2][4][2];
#pragma unroll
    for (int a = 0; a < 2; ++a)
#pragma unroll
        for (int b = 0; b < 2; ++b)
#pragma unroll
            for (int m = 0; m < 4; ++m)
#pragma unroll
                for (int n = 0; n < 2; ++n) acc[a][b][m][n] = (f32x4){0.f, 0.f, 0.f, 0.f};
    bf16x8 At[4][2], B0[2][2], B1[2][2];
    const char* cA = (const char*)g.A + (size_t)cur.pm * tstep; const char* cB = (const char*)g.Bt + (size_t)cur.pn * tstep;
    S.a_ready(cur);
    if constexpr (SP2) {
        PG8_STAGE(PG8_SB(0, 0), cB, voffB); PG8_STAGE(PG8_SB(0, 1), cB + hstep, voffB); PG8_STAGE(PG8_SA(0, 0), cA, voffA); PG8_STAGE(PG8_SA(0, 1), cA + hstep, voffA);
        if (wr == 1) PG8_BAR;
        PG8_WAIT_V(2); PG8_BAR;
        PG8_STAGE(PG8_SB(1, 0), cB + kstep, voffB); PG8_STAGE(PG8_SA(1, 0), cA + kstep, voffA); PG8_STAGE(PG8_SB(1, 1), cB + hstep + kstep, voffB);
        PG8_WAIT_V(6); PG8_BAR;
    } else {
        PG8_STAGE(PG8_SB(0, 0), cB, voffB); PG8_STAGE(PG8_SA(0, 0), cA, voffA); PG8_STAGE(PG8_SB(0, 1), cB + hstep, voffB); PG8_STAGE(PG8_SA(0, 1), cA + hstep, voffA);
        if (wr == 1) PG8_BAR;
        PG8_WAIT_V(4); PG8_BAR;
        PG8_STAGE(PG8_SB(1, 0), cB + kstep, voffB); PG8_STAGE(PG8_SA(1, 0), cA + kstep, voffA); PG8_STAGE(PG8_SB(1, 1), cB + hstep + kstep, voffB);
        PG8_WAIT_V(6); PG8_BAR;
    }
    for (;;) {
        const bool has_next = S.next(ui + 1, nxt);
        const char* nA = has_next ? (const char*)g.A + (size_t)nxt.pm * tstep : cA; const char* nB = has_next ? (const char*)g.Bt + (size_t)nxt.pn * tstep : cB;
        for (int t = 0; t < nt; t += 2) {
            const bool last = (t == nt - 2);
            const char* a1 = cA + (size_t)(t + 1) * kstep;
            const char* a2 = last ? nA : cA + (size_t)(t + 2) * kstep; const char* b2 = last ? nB : cB + (size_t)(t + 2) * kstep;
            const char* a3 = a2 + kstep; const char* b3 = b2 + kstep;
            if (last && has_next) S.a_ready(nxt);
            if constexpr (SP2) {
            PG8_LDB(B0, 0, 0); PG8_LDB(B1, 0, 1); PG8_SCHED; PG8_LDA(At, 0, 0); PG8_STAGE(PG8_SA(1, 1), a1 + hstep, voffA);
            PG8_WAIT_V(8); PG8_WAIT_L(0); PG8_BAR; PG8_MMA(0, 0, At, B0); PG8_MMA(0, 1, At, B1); PG8_BAR; PG8_SCHED;
            PG8_LDA(At, 0, 1); PG8_STAGE(PG8_SB(0, 0), b2, voffB); PG8_STAGE(PG8_SB(0, 1), b2 + hstep, voffB); PG8_STAGE(PG8_SA(0, 0), a2, voffA);
            PG8_WAIT_V(8); PG8_WAIT_L(0); PG8_BAR; PG8_MMA(1, 0, At, B0); PG8_MMA(1, 1, At, B1); PG8_BAR; PG8_SCHED;
            PG8_LDB(B0, 1, 0); PG8_LDB(B1, 1, 1); PG8_SCHED; PG8_LDA(At, 1, 0); PG8_STAGE(PG8_SA(0, 1), a2 + hstep, voffA);
            PG8_WAIT_V(8); PG8_WAIT_L(0); PG8_BAR; PG8_MMA(0, 0, At, B0); PG8_MMA(0, 1, At, B1); PG8_BAR; PG8_SCHED;
            PG8_LDA(At, 1, 1); PG8_STAGE(PG8_SB(1, 0), b3, voffB); PG8_STAGE(PG8_SB(1, 1), b3 + hstep, voffB); PG8_STAGE(PG8_SA(1, 0), a3, voffA);
            PG8_WAIT_V(8); PG8_WAIT_L(0); PG8_BAR; PG8_MMA(1, 0, At, B0); PG8_MMA(1, 1, At, B1); PG8_BAR; PG8_SCHED;
            } else {
            PG8_LDB(B0, 0, 0); PG8_SCHED; PG8_LDA(At, 0, 0); PG8_STAGE(PG8_SA(1, 1), a1 + hstep, voffA);
            PG8_WAIT_L(8); PG8_BAR; PG8_WAIT_L(0); PG8_MMA(0, 0, At, B0); PG8_BAR; PG8_SCHED;
            PG8_LDB(B1, 0, 1); PG8_STAGE(PG8_SB(0, 0), b2, voffB);
            PG8_BAR; PG8_WAIT_L(0); PG8_MMA(0, 1, At, B1); PG8_BAR;
            PG8_LDA(At, 0, 1); PG8_STAGE(PG8_SA(0, 0), a2, voffA);
            PG8_BAR; PG8_WAIT_L(0); PG8_MMA(1, 0, At, B0); PG8_BAR; PG8_SCHED;
            PG8_STAGE(PG8_SB(0, 1), b2 + hstep, voffB);
            PG8_WAIT_V(6); PG8_BAR; PG8_MMA(1, 1, At, B1); PG8_BAR;
            PG8_LDB(B0, 1, 0); PG8_SCHED; PG8_LDA(At, 1, 0); PG8_STAGE(PG8_SA(0, 1), a2 + hstep, voffA);
            PG8_WAIT_L(8); PG8_BAR; PG8_WAIT_L(0); PG8_MMA(0, 0, At, B0); PG8_BAR; PG8_SCHED;
            PG8_LDB(B1, 1, 1); PG8_STAGE(PG8_SB(1, 0), b3, voffB);
            PG8_BAR; PG8_WAIT_L(0); PG8_MMA(0, 1, At, B1); PG8_BAR;
            PG8_LDA(At, 1, 1); PG8_STAGE(PG8_SA(1, 0), a3, voffA);
            PG8_BAR; PG8_WAIT_L(0); PG8_MMA(1, 0, At, B0); PG8_BAR; PG8_SCHED;
            PG8_STAGE(PG8_SB(1, 1), b3 + hstep, voffB);
            PG8_WAIT_V(6); PG8_BAR; PG8_MMA(1, 1, At, B1); PG8_BAR;
            }
        }
        if constexpr (ALIGN_EPI) { if (wr == 0) PG8_BAR; }
        if constexpr (!Epi::AFTER_DRAIN) { int l2 = __builtin_amdgcn_mbcnt_hi(~0u, __builtin_amdgcn_mbcnt_lo(~0u, 0u)); asm volatile("" : "+v"(l2));
            E(acc, cur, wr, wc, l2 & 15, l2 >> 4); S.done(cur); }
        if (!has_next) break;
#pragma unroll
        for (int a = 0; a < 2; ++a)
#pragma unroll
            for (int b = 0; b < 2; ++b)
#pragma unroll
                for (int m = 0; m < 4; ++m)
#pragma unroll
                    for (int n = 0; n < 2; ++n) acc[a][b][m][n] = (f32x4){0.f, 0.f, 0.f, 0.f};
        cur = nxt; cA = nA; cB = nB; ++ui;
        if constexpr (ALIGN_EPI) { if (wr == 1) PG8_BAR; }
    }
    PG8_WAIT_V(0);
    if constexpr (!ALIGN_EPI) { if (wr == 0) PG8_BAR; }
    PG8_BAR;
    if constexpr (Epi::AFTER_DRAIN) { E.fused(acc, cur, wr, wc, fr, fq, lds, wid, lane); S.done(cur); }
#undef PG8_SA
#undef PG8_SB
#undef PG8_STAGE
#undef PG8_LDA
#undef PG8_LDB
#undef PG8_MMA
#undef PG8_WAIT_V
#undef PG8_WAIT_L
#undef PG8_BAR
#undef PG8_SCHED
}
}
namespace att {
using bf16 = __hip_bfloat16;
constexpr int   D = 128, NW = 8, QBLK = 32, KVBLK = 64;
constexpr float SCALE = 0.088388347648318440f;
constexpr float THR = 8.f;
constexpr int SDEPTH = 1;
constexpr int LDQ = 1024, LDK = 256, LDO = 1024;
constexpr size_t SHM_V = KVBLK * D * 2, SHM_K = KVBLK * D * 2, SHM_ATTN = 3 * SHM_V + 3 * SHM_K + NW * 64 * 4;
using bf16x8 = __attribute__((ext_vector_type(8))) short;
using s16x4  = __attribute__((ext_vector_type(4))) short;
using f32x16 = __attribute__((ext_vector_type(16))) float;
using f32x8  = __attribute__((ext_vector_type(8))) float;
using u32x4  = __attribute__((ext_vector_type(4))) unsigned;
#define KSWZ(row, colB) ((row) * 256 + ((colB) ^ (((row) & 15) << 4)))
#define SBAR() __builtin_amdgcn_sched_barrier(0)
__device__ __forceinline__ int crow(int r, int hi) { return (r & 3) + 8 * (r >> 2) + 4 * hi; }
__device__ __forceinline__ unsigned cvtpk(float lo, float hi) { return pg8::cvt_pk_bf16(lo, hi); }
template <typename TIn> struct Stage;
template <> struct Stage<bf16>  { using T = bf16x8;
  __device__ static __forceinline__ T ld8(const bf16* p) { return *reinterpret_cast<const bf16x8*>(p); }
  __device__ static __forceinline__ bf16x8 tobf(T x) { return x; } };
template <> struct Stage<float> { using T = f32x8;
  __device__ static __forceinline__ T ld8(const float* p) { return *reinterpret_cast<const f32x8*>(p); }
  __device__ static __forceinline__ bf16x8 tobf(T x) {
    u32x4 w = {cvtpk(x[0], x[1]), cvtpk(x[2], x[3]), cvtpk(x[4], x[5]), cvtpk(x[6], x[7])}; return *reinterpret_cast<bf16x8*>(&w); } };

__device__ __forceinline__ void partialSM(f32x16& p0, f32x16& p1, float& m_reg, float& mn, float& alpha) {
  constexpr float C = SCALE * 1.4426950408889634f;
  float pmax = p0[0]; for (int r = 1; r < 16; ++r) pmax = fmaxf(pmax, p0[r]); for (int r = 0; r < 16; ++r) pmax = fmaxf(pmax, p1[r]);
  { auto rr = __builtin_amdgcn_permlane32_swap(__float_as_uint(pmax), __float_as_uint(pmax), false, false);
    pmax = fmaxf(__uint_as_float(rr[0]), __uint_as_float(rr[1])); }
  if (__builtin_expect(__all(pmax - m_reg <= THR / SCALE), 1)) { mn = m_reg; alpha = 1.f; }
  else { mn = fmaxf(m_reg, pmax); alpha = __builtin_amdgcn_exp2f((m_reg - mn) * C); m_reg = mn; }
  float mnC = -mn * C;
  for (int r = 0; r < 16; ++r) p0[r] = fmaf(p0[r], C, mnC); for (int r = 0; r < 16; ++r) p1[r] = fmaf(p1[r], C, mnC);
  for (int r = 0; r < 16; ++r) p0[r] = __builtin_amdgcn_exp2f(p0[r]);
}
__device__ __forceinline__ void finishSM(f32x16& p0, f32x16& p1, float alpha, float& l_reg, bf16x8& pa0, bf16x8& pa1, bf16x8& pa2, bf16x8& pa3) {
  for (int r = 0; r < 16; ++r) p1[r] = __builtin_amdgcn_exp2f(p1[r]);
  float ps = 0; for (int r = 0; r < 16; ++r) ps += p0[r]; for (int r = 0; r < 16; ++r) ps += p1[r];
  { auto rr = __builtin_amdgcn_permlane32_swap(__float_as_uint(ps), __float_as_uint(ps), false, false);
    ps = __uint_as_float(rr[0]) + __uint_as_float(rr[1]); }
  l_reg = l_reg * alpha + ps;
#define PK4(P, BASE, OUT) do { unsigned a0 = cvtpk(P[BASE + 0], P[BASE + 1]), a1 = cvtpk(P[BASE + 2], P[BASE + 3]);   \
    unsigned b0 = cvtpk(P[BASE + 4], P[BASE + 5]), b1 = cvtpk(P[BASE + 6], P[BASE + 7]);                              \
    auto r0 = __builtin_amdgcn_permlane32_swap(a0, b0, false, false); auto r1 = __builtin_amdgcn_permlane32_swap(a1, b1, false, false); \
    u32x4 w = {r0[0], r1[0], r0[1], r1[1]}; OUT = *reinterpret_cast<bf16x8*>(&w); } while (0)
  PK4(p0, 0, pa0); PK4(p0, 8, pa1); PK4(p1, 0, pa2); PK4(p1, 8, pa3);
#undef PK4
}
__device__ __forceinline__ void partialSM2(f32x16& p0, f32x16& p1, const float negBC) {
  constexpr float C = SCALE * 1.4426950408889634f;
  for (int r = 0; r < 16; ++r) p0[r] = fmaf(p0[r], C, negBC); for (int r = 0; r < 16; ++r) p1[r] = fmaf(p1[r], C, negBC);
  for (int r = 0; r < 16; ++r) p0[r] = __builtin_amdgcn_exp2f(p0[r]);
}
__device__ __forceinline__ void finishSM2(f32x16& p0, f32x16& p1, float& l_reg, bf16x8& pa0, bf16x8& pa1, bf16x8& pa2, bf16x8& pa3) {
  for (int r = 0; r < 16; ++r) p1[r] = __builtin_amdgcn_exp2f(p1[r]);
  float ps = 0; for (int r = 0; r < 16; ++r) ps += p0[r]; for (int r = 0; r < 16; ++r) ps += p1[r];
  l_reg += ps;
#define PK4(P, BASE, OUT) do { unsigned a0 = cvtpk(P[BASE + 0], P[BASE + 1]), a1 = cvtpk(P[BASE + 2], P[BASE + 3]);   \
    unsigned b0 = cvtpk(P[BASE + 4], P[BASE + 5]), b1 = cvtpk(P[BASE + 6], P[BASE + 7]);                              \
    auto r0 = __builtin_amdgcn_permlane32_swap(a0, b0, false, false); auto r1 = __builtin_amdgcn_permlane32_swap(a1, b1, false, false); \
    u32x4 w = {r0[0], r1[0], r0[1], r1[1]}; OUT = *reinterpret_cast<bf16x8*>(&w); } while (0)
  PK4(p0, 0, pa0); PK4(p0, 8, pa1); PK4(p1, 0, pa2); PK4(p1, 8, pa3);
#undef PK4
}
__device__ __forceinline__ void qkt(f32x16& p0, f32x16& p1, const bf16* Ks, const bf16x8* qr, int r32, int hi) {
  p0 = f32x16{}; p1 = f32x16{};
  for (int d0 = 0; d0 < 8; ++d0) { int cb = (d0 * 16 + hi * 8) * 2;
    bf16x8 b0 = *reinterpret_cast<const bf16x8*>((const char*)Ks + KSWZ(r32, cb));
    bf16x8 b1 = *reinterpret_cast<const bf16x8*>((const char*)Ks + KSWZ(32 + r32, cb));
    p0 = __builtin_amdgcn_mfma_f32_32x32x16_bf16(b0, qr[d0], p0, 0, 0, 0);
    p1 = __builtin_amdgcn_mfma_f32_32x32x16_bf16(b1, qr[d0], p1, 0, 0, 0); }
}
__device__ __forceinline__ void partialSM3(f32x16& p0) { for (int r = 0; r < 16; ++r) p0[r] = __builtin_amdgcn_exp2f(p0[r]); }
__device__ __forceinline__ void qkt3(f32x16& p0, f32x16& p1, const bf16* Ks, const bf16x8* qr, int r32, int hi, const f32x16& cinit) {
  { int cb = (hi * 8) * 2;
    bf16x8 b0 = *reinterpret_cast<const bf16x8*>((const char*)Ks + KSWZ(r32, cb));
    bf16x8 b1 = *reinterpret_cast<const bf16x8*>((const char*)Ks + KSWZ(32 + r32, cb));
    p0 = __builtin_amdgcn_mfma_f32_32x32x16_bf16(b0, qr[0], cinit, 0, 0, 0);
    p1 = __builtin_amdgcn_mfma_f32_32x32x16_bf16(b1, qr[0], cinit, 0, 0, 0); }
  for (int d0 = 1; d0 < 8; ++d0) { int cb = (d0 * 16 + hi * 8) * 2;
    bf16x8 b0 = *reinterpret_cast<const bf16x8*>((const char*)Ks + KSWZ(r32, cb));
    bf16x8 b1 = *reinterpret_cast<const bf16x8*>((const char*)Ks + KSWZ(32 + r32, cb));
    p0 = __builtin_amdgcn_mfma_f32_32x32x16_bf16(b0, qr[d0], p0, 0, 0, 0);
    p1 = __builtin_amdgcn_mfma_f32_32x32x16_bf16(b1, qr[d0], p1, 0, 0, 0); }
}
__device__ __forceinline__ int v_st(int k, int c) { const int kk = (k & ~0xC) | ((k & 4) << 1) | ((k & 8) >> 1); return ((kk >> 3) * 4 + (c >> 5)) * 512 + ((kk & 7) * 32 + (c & 31)) * 2; }
__device__ __forceinline__ int v_rd_base(int lane) { return ((lane & 3) << 3) | (((lane >> 2) & 3) << 6) | (((lane >> 4) & 1) << 5) | (((lane >> 5) & 1) << 8); }
constexpr int v_rd_off(int d0, int ks, int half) { return d0 * 512 + ks * 4096 + half * 2048; }
template <int OFF> __device__ __forceinline__ s16x4 tr_read(int vb) {
  s16x4 r; asm volatile("ds_read_b64_tr_b16 %0, %1 offset:%2" : "=&v"(r) : "v"(vb), "i"(OFF) : "memory"); return r;
}
template <int D0> __device__ __forceinline__ void pv_one(f32x16& od, int vb, bf16x8 pa0, bf16x8 pa1, bf16x8 pa2, bf16x8 pa3) {
  const s16x4 l0 = tr_read<v_rd_off(D0, 0, 0)>(vb), h0 = tr_read<v_rd_off(D0, 0, 1)>(vb), l1 = tr_read<v_rd_off(D0, 1, 0)>(vb), h1 = tr_read<v_rd_off(D0, 1, 1)>(vb);
  const s16x4 l2 = tr_read<v_rd_off(D0, 2, 0)>(vb), h2 = tr_read<v_rd_off(D0, 2, 1)>(vb), l3 = tr_read<v_rd_off(D0, 3, 0)>(vb), h3 = tr_read<v_rd_off(D0, 3, 1)>(vb);
  asm volatile("s_waitcnt lgkmcnt(0)" ::: "memory"); SBAR();
#define PK(L, H) (bf16x8){L[0], L[1], L[2], L[3], H[0], H[1], H[2], H[3]}
  od = __builtin_amdgcn_mfma_f32_32x32x16_bf16(pa0, PK(l0, h0), od, 0, 0, 0);
  od = __builtin_amdgcn_mfma_f32_32x32x16_bf16(pa1, PK(l1, h1), od, 0, 0, 0);
  od = __builtin_amdgcn_mfma_f32_32x32x16_bf16(pa2, PK(l2, h2), od, 0, 0, 0);
  od = __builtin_amdgcn_mfma_f32_32x32x16_bf16(pa3, PK(l3, h3), od, 0, 0, 0);
#undef PK
}
__device__ __forceinline__ void pv_d0(f32x16* o, int vb, bf16x8 pa0, bf16x8 pa1, bf16x8 pa2, bf16x8 pa3) {
  pv_one<0>(o[0], vb, pa0, pa1, pa2, pa3); pv_one<1>(o[1], vb, pa0, pa1, pa2, pa3); pv_one<2>(o[2], vb, pa0, pa1, pa2, pa3); pv_one<3>(o[3], vb, pa0, pa1, pa2, pa3);
}

__device__ __forceinline__ void finishSM4(f32x16& p0, f32x16& p1, float& l_reg, bf16x8& pa0, bf16x8& pa1, bf16x8& pa2, bf16x8& pa3) {
  for (int r = 0; r < 16; ++r) p1[r] = __builtin_amdgcn_exp2f(p1[r]);
  float ps = 0; for (int r = 0; r < 16; ++r) ps += p0[r]; for (int r = 0; r < 16; ++r) ps += p1[r];
  l_reg += ps;
#define PK8(P, BASE, OUT) do { u32x4 w = {cvtpk(P[BASE + 0], P[BASE + 1]), cvtpk(P[BASE + 2], P[BASE + 3]), cvtpk(P[BASE + 4], P[BASE + 5]), cvtpk(P[BASE + 6], P[BASE + 7])}; OUT = *reinterpret_cast<bf16x8*>(&w); } while (0)
  PK8(p0, 0, pa0); PK8(p0, 8, pa1); PK8(p1, 0, pa2); PK8(p1, 8, pa3);
#undef PK8
}
__device__ __forceinline__ int v_rd_base2(int lane) { return ((lane & 3) << 3) | (((lane >> 2) & 3) << 6) | (((lane >> 4) & 1) << 5) | (((lane >> 5) & 1) << 11); }
constexpr int v_rd_off2(int d0, int ks, int part) { return d0 * 512 + ks * 4096 + part * 256; }
template <int D0> __device__ __forceinline__ void pv_one2(f32x16& od, int vb, bf16x8 pa0, bf16x8 pa1, bf16x8 pa2, bf16x8 pa3) {
  const s16x4 l0 = tr_read<v_rd_off2(D0, 0, 0)>(vb), h0 = tr_read<v_rd_off2(D0, 0, 1)>(vb), l1 = tr_read<v_rd_off2(D0, 1, 0)>(vb), h1 = tr_read<v_rd_off2(D0, 1, 1)>(vb);
  const s16x4 l2 = tr_read<v_rd_off2(D0, 2, 0)>(vb), h2 = tr_read<v_rd_off2(D0, 2, 1)>(vb), l3 = tr_read<v_rd_off2(D0, 3, 0)>(vb), h3 = tr_read<v_rd_off2(D0, 3, 1)>(vb);
  asm volatile("s_waitcnt lgkmcnt(0)" ::: "memory"); SBAR();
#define PK(L, H) (bf16x8){L[0], L[1], L[2], L[3], H[0], H[1], H[2], H[3]}
  od = __builtin_amdgcn_mfma_f32_32x32x16_bf16(PK(l0, h0), pa0, od, 0, 0, 0);
  od = __builtin_amdgcn_mfma_f32_32x32x16_bf16(PK(l1, h1), pa1, od, 0, 0, 0);
  od = __builtin_amdgcn_mfma_f32_32x32x16_bf16(PK(l2, h2), pa2, od, 0, 0, 0);
  od = __builtin_amdgcn_mfma_f32_32x32x16_bf16(PK(l3, h3), pa3, od, 0, 0, 0);
#undef PK
}
#define PV_RD2(D0, X) const s16x4 X##l0 = tr_read<v_rd_off2(D0, 0, 0)>(vb), X##h0 = tr_read<v_rd_off2(D0, 0, 1)>(vb), X##l1 = tr_read<v_rd_off2(D0, 1, 0)>(vb), X##h1 = tr_read<v_rd_off2(D0, 1, 1)>(vb), \
                              X##l2 = tr_read<v_rd_off2(D0, 2, 0)>(vb), X##h2 = tr_read<v_rd_off2(D0, 2, 1)>(vb), X##l3 = tr_read<v_rd_off2(D0, 3, 0)>(vb), X##h3 = tr_read<v_rd_off2(D0, 3, 1)>(vb)
#define PV_PK2(L, H) (bf16x8){L[0], L[1], L[2], L[3], H[0], H[1], H[2], H[3]}
#define PV_MM2(OD, X) do { OD = __builtin_amdgcn_mfma_f32_32x32x16_bf16(PV_PK2(X##l0, X##h0), pa0, OD, 0, 0, 0); OD = __builtin_amdgcn_mfma_f32_32x32x16_bf16(PV_PK2(X##l1, X##h1), pa1, OD, 0, 0, 0); \
                           OD = __builtin_amdgcn_mfma_f32_32x32x16_bf16(PV_PK2(X##l2, X##h2), pa2, OD, 0, 0, 0); OD = __builtin_amdgcn_mfma_f32_32x32x16_bf16(PV_PK2(X##l3, X##h3), pa3, OD, 0, 0, 0); } while (0)
__device__ __forceinline__ void pv_d02(f32x16* o, int vb, bf16x8 pa0, bf16x8 pa1, bf16x8 pa2, bf16x8 pa3) {
  PV_RD2(0, a);
  PV_RD2(1, b); asm volatile("s_waitcnt lgkmcnt(8)" ::: "memory"); SBAR(); PV_MM2(o[0], a); SBAR();
  PV_RD2(2, c); asm volatile("s_waitcnt lgkmcnt(8)" ::: "memory"); SBAR(); PV_MM2(o[1], b); SBAR();
  PV_RD2(3, d); asm volatile("s_waitcnt lgkmcnt(8)" ::: "memory"); SBAR(); PV_MM2(o[2], c); SBAR();
  asm volatile("s_waitcnt lgkmcnt(0)" ::: "memory"); SBAR(); PV_MM2(o[3], d);
}
#define EXP4(P, B) do { P[(B) + 0] = __builtin_amdgcn_exp2f(P[(B) + 0]); P[(B) + 1] = __builtin_amdgcn_exp2f(P[(B) + 1]); P[(B) + 2] = __builtin_amdgcn_exp2f(P[(B) + 2]); P[(B) + 3] = __builtin_amdgcn_exp2f(P[(B) + 3]); } while (0)
__device__ __forceinline__ void pv_d03(f32x16* o, int vb, bf16x8 pa0, bf16x8 pa1, bf16x8 pa2, bf16x8 pa3, f32x16& pn) {
  PV_RD2(0, a);
  PV_RD2(1, b); asm volatile("s_waitcnt lgkmcnt(8)" ::: "memory"); SBAR(); PV_MM2(o[0], a); EXP4(pn, 0); SBAR();
  PV_RD2(2, c); asm volatile("s_waitcnt lgkmcnt(8)" ::: "memory"); SBAR(); PV_MM2(o[1], b); EXP4(pn, 4); SBAR();
  PV_RD2(3, d); asm volatile("s_waitcnt lgkmcnt(8)" ::: "memory"); SBAR(); PV_MM2(o[2], c); EXP4(pn, 8); SBAR();
  asm volatile("s_waitcnt lgkmcnt(0)" ::: "memory"); SBAR(); PV_MM2(o[3], d); EXP4(pn, 12);
}
__device__ __forceinline__ void attn_dense_body(const bf16* Qb, const bf16* __restrict__ Kh, const bf16* __restrict__ Vh, const bf16* __restrict__ Zb,
                                                bf16* Ob, int seq, char* lds, const int wid_in, const float kmax, __attribute__((address_space(3))) unsigned char* lds3) {
  using St = Stage<bf16>; using SQ = Stage<bf16>; using TQ = bf16;
  int lane = __builtin_amdgcn_mbcnt_hi(~0u, __builtin_amdgcn_mbcnt_lo(~0u, 0u)); asm volatile("" : "+v"(lane));
  const int wid = wid_in, tid = wid * 64 + lane, r32 = lane & 31, hi = lane >> 5;
  bf16* V_lds = (bf16*)lds; bf16* K_lds = (bf16*)(lds + 3 * SHM_V);
  float l_reg = 0; f32x16 o[4] = {}; bf16x8 qr[8];
  const TQ* Qw = Qb + (long)(wid * QBLK + r32) * LDQ + hi * 8;
#pragma unroll
  for (int d0 = 0; d0 < 8; ++d0) qr[d0] = SQ::tobf(SQ::ld8(Qw + d0 * 16));
  float negBC;
  { float ss = 0.f;
#pragma unroll
    for (int d0 = 0; d0 < 8; ++d0)
#pragma unroll
      for (int e = 0; e < 8; ++e) { const float qv = __uint_as_float((unsigned)(unsigned short)qr[d0][e] << 16); ss = fmaf(qv, qv, ss); }
    auto rr = __builtin_amdgcn_permlane32_swap(__float_as_uint(ss), __float_as_uint(ss), false, false);
    ss = __uint_as_float(rr[0]) + __uint_as_float(rr[1]);
    negBC = -(sqrtf(ss) * kmax * (11.313708498984761f * 1.01f) + 0.07f); }
  f32x16 cinit; for (int r = 0; r < 16; ++r) cinit[r] = negBC;
  const int vb0 = (int)(uintptr_t)V_lds + v_rd_base2(lane);
  int koff0, koff1, voff0, voff1;
  { const int rk0 = 8 * wid + (lane >> 4), rk1 = rk0 + 4; koff0 = rk0 * (LDK * 2) + (((lane & 15) ^ (rk0 & 15)) << 4); koff1 = rk1 * (LDK * 2) + (((lane & 15) ^ (rk1 & 15)) << 4);
    const int st0 = 4 * wid + (lane >> 5), st1 = st0 + 2, q8 = (lane & 31) >> 2;
    const int kk0 = ((st0 >> 2) << 3) | q8, kk1 = ((st1 >> 2) << 3) | q8;
    const int ky0 = (kk0 & ~0xC) | ((kk0 & 4) << 1) | ((kk0 & 8) >> 1), ky1 = (kk1 & ~0xC) | ((kk1 & 4) << 1) | ((kk1 & 8) >> 1);
    voff0 = ky0 * (LDK * 2) + ((st0 & 3) * 32 + (lane & 3) * 8) * 2; voff1 = ky1 * (LDK * 2) + ((st1 & 3) * 32 + (lane & 3) * 8) * 2; }
#define SDMA(s, k0) do { const char* kg_ = (const char*)(Kh + (long)(k0) * LDK); const char* vg_ = (const char*)(Vh + (long)(k0) * LDK); \
    __attribute__((address_space(3))) unsigned char* kd_ = lds3 + 3 * (int)SHM_V + (s) * (int)SHM_K + wid * 2048; __attribute__((address_space(3))) unsigned char* vd_ = lds3 + (s) * (int)SHM_V + wid * 2048; \
    __builtin_amdgcn_global_load_lds((const unsigned*)(kg_ + koff0), (__attribute__((address_space(3))) unsigned*)kd_, 16, 0, 0); \
    __builtin_amdgcn_global_load_lds((const unsigned*)(kg_ + koff1), (__attribute__((address_space(3))) unsigned*)(kd_ + 1024), 16, 0, 0); \
    __builtin_amdgcn_global_load_lds((const unsigned*)(vg_ + voff0), (__attribute__((address_space(3))) unsigned*)vd_, 16, 0, 0); \
    __builtin_amdgcn_global_load_lds((const unsigned*)(vg_ + voff1), (__attribute__((address_space(3))) unsigned*)(vd_ + 1024), 16, 0, 0); } while (0)
#define DWAIT() asm volatile("s_waitcnt vmcnt(0)" ::: "memory")
  f32x16 pA0, pA1, pB0, pB1; bf16x8 pa0, pa1, pa2, pa3; const int NT = seq / KVBLK;
  SDMA(0, 0); DWAIT(); __syncthreads();
  SDMA(1, KVBLK);
  qkt3(pA0, pA1, K_lds, qr, r32, hi, cinit); partialSM3(pA0);
  DWAIT(); __syncthreads();
  int sP = 0, sC = 1, sN = 2;
#define KSLOT(s) ((bf16*)((char*)K_lds + (s) * (int)SHM_K))
#define ROT() do { const int t_ = sP; sP = sC; sC = sN; sN = t_; } while (0)
  for (int j = 1; j + 1 < NT; j += 2) {
    SDMA(sN, (j + 1) * KVBLK);
    SBAR(); qkt3(pB0, pB1, KSLOT(sC), qr, r32, hi, cinit);
    finishSM4(pA0, pA1, l_reg, pa0, pa1, pa2, pa3);
    pv_d03(o, vb0 + sP * (int)SHM_V, pa0, pa1, pa2, pa3, pB0);
    DWAIT(); __syncthreads(); ROT();
    SDMA(sN, (j + 2) * KVBLK);
    SBAR(); qkt3(pA0, pA1, KSLOT(sC), qr, r32, hi, cinit);
    finishSM4(pB0, pB1, l_reg, pa0, pa1, pa2, pa3);
    pv_d03(o, vb0 + sP * (int)SHM_V, pa0, pa1, pa2, pa3, pA0);
    DWAIT(); __syncthreads(); ROT();
  }
  SBAR(); qkt3(pB0, pB1, KSLOT(sC), qr, r32, hi, cinit);
  finishSM4(pA0, pA1, l_reg, pa0, pa1, pa2, pa3); SBAR();
  pv_d03(o, vb0 + sP * (int)SHM_V, pa0, pa1, pa2, pa3, pB0);
  finishSM4(pB0, pB1, l_reg, pa0, pa1, pa2, pa3); SBAR();
  pv_d02(o, vb0 + sC * (int)SHM_V, pa0, pa1, pa2, pa3);
#undef KSLOT
#undef ROT
#undef SDMA
#undef DWAIT
  { auto rr = __builtin_amdgcn_permlane32_swap(__float_as_uint(l_reg), __float_as_uint(l_reg), false, false); l_reg = __uint_as_float(rr[0]) + __uint_as_float(rr[1]); }
  const float rl = __builtin_amdgcn_rcpf(l_reg);
  { int lb = (wid * QBLK + r32) * LDO + 4 * hi; asm volatile("" : "+v"(lb));
    unsigned short* Ow = (unsigned short*)Ob + lb; const unsigned short* Zw = (const unsigned short*)Zb + lb;
#pragma unroll
    for (int d0 = 0; d0 < 4; ++d0)
#pragma unroll
      for (int g = 0; g < 4; ++g) { const int co = d0 * 32 + 8 * g; const unsigned long long zz = *(const unsigned long long*)(Zw + co);
        const float z0 = __uint_as_float((unsigned)(zz << 16)), z1 = __uint_as_float((unsigned)zz & 0xffff0000u), z2 = __uint_as_float((unsigned)(zz >> 32) << 16), z3 = __uint_as_float((unsigned)(zz >> 32) & 0xffff0000u);
        const unsigned w0 = cvtpk(o[d0][4 * g + 0] * rl * z0, o[d0][4 * g + 1] * rl * z1), w1 = cvtpk(o[d0][4 * g + 2] * rl * z2, o[d0][4 * g + 3] * rl * z3);
        *(unsigned long long*)(Ow + co) = (unsigned long long)w0 | ((unsigned long long)w1 << 32); } }
}
}

typedef unsigned short bf16_t;
typedef float f32x4 __attribute__((ext_vector_type(4)));
typedef unsigned u32x4 __attribute__((ext_vector_type(4)));
typedef unsigned u32x2v __attribute__((ext_vector_type(2)));
typedef short bf16x8v __attribute__((ext_vector_type(8)));
typedef float f32x16v __attribute__((ext_vector_type(16)));
#define LAS __attribute__((address_space(3)))
#define XB_TMO      128
#define XB_XCNT(j)  (256  + 64 * (j))
#define XB_XSUB(j)  (1280 + 64 * (j))
#define XB_XGEN(j)  (2304 + 64 * (j))
#define XB_TOP      3328
#define XB_TOPGEN   3392
#define XCD_BAR_WORDS 3456
#define XB_SPIN_CAP (1u << 18)

__device__ __forceinline__ unsigned xb_ld(unsigned* p)              { return __hip_atomic_load(p, __ATOMIC_RELAXED, __HIP_MEMORY_SCOPE_AGENT); }
__device__ __forceinline__ unsigned xb_add(unsigned* p, unsigned v) { return __hip_atomic_fetch_add(p, v, __ATOMIC_RELAXED, __HIP_MEMORY_SCOPE_AGENT); }
__device__ __forceinline__ unsigned xb_xcc_id() { return (unsigned)__builtin_amdgcn_s_getreg((3 << 11) | 20) & 0xFu; }
#define XB_SPIN(cond, bar) do { unsigned _sp = 0; while (cond) { __builtin_amdgcn_s_sleep(1); \
    if ((++_sp & 255u) == 0u) { if (xb_ld(&(bar)[XB_TMO])) break; if (_sp > XB_SPIN_CAP) { atomicAdd(&(bar)[XB_TMO], 1u); break; } } } } while (0)

struct XcdBarrier {
    unsigned* bar; unsigned x;
    volatile LAS unsigned* st;
};

__device__ __forceinline__ XcdBarrier xcd_barrier_post(unsigned* bar, volatile LAS unsigned* st, const bool leader) {
    XcdBarrier b; b.bar = bar; b.x = xb_xcc_id(); b.st = st;
    if (leader) (void)xb_add(&bar[XB_XCNT(b.x)], 1u);
    return b;
}
__device__ __forceinline__ void xcd_barrier_complete(unsigned* bar, unsigned x, unsigned& nloc, unsigned& nx) {
    const unsigned G = gridDim.x * gridDim.y * gridDim.z;
    unsigned sum, cnt, mine, sp = 0u;
    for (;;) {
        sum = 0u; cnt = 0u; mine = 0u;
#pragma unroll
        for (unsigned j = 0; j < 16; ++j) { const unsigned c = xb_ld(&bar[XB_XCNT(j)]); sum += c; cnt += (c > 0u) ? 1u : 0u; mine = (j == x) ? c : mine; }
        if (sum == G) break;
        __builtin_amdgcn_s_sleep(1);
        if ((++sp & 255u) == 0u) { if (xb_ld(&bar[XB_TMO])) break; if (sp > XB_SPIN_CAP) { atomicAdd(&bar[XB_TMO], 1u); break; } }
    }
    nloc = mine > 0u ? mine : 1u; nx = cnt > 0u ? cnt : 1u;
}

__device__ __forceinline__ void xcd_barrier(const XcdBarrier& b, const bool leader) {
    asm volatile("s_waitcnt vmcnt(0)" ::: "memory");
    __syncthreads();
    if (leader) {
        unsigned* bar = b.bar;
        __builtin_amdgcn_s_waitcnt(0);
        unsigned nloc = b.st[0], nx = b.st[1];
        if (nloc == 0u) { xcd_barrier_complete(bar, b.x, nloc, nx); b.st[0] = nloc; b.st[1] = nx; }
        const unsigned old = xb_add(&bar[XB_XSUB(b.x)], 1u);
        const unsigned gen = old / nloc;
        if (old + 1u == (gen + 1u) * nloc) {
            __builtin_amdgcn_fence(__ATOMIC_RELEASE, "agent");
            asm volatile("s_waitcnt vmcnt(0)" ::: "memory");
            const unsigned og = xb_add(&bar[XB_TOP], 1u);
            const unsigned tg = og / nx;
            if (og + 1u == (tg + 1u) * nx) xb_add(&bar[XB_TOPGEN], 1u);
            else XB_SPIN(xb_ld(&bar[XB_TOPGEN]) == tg, bar);
            __builtin_amdgcn_fence(__ATOMIC_ACQUIRE, "agent");
            xb_add(&bar[XB_XGEN(b.x)], 1u);
            asm volatile("s_waitcnt vmcnt(0)" ::: "memory");
        } else {
            XB_SPIN(xb_ld(&bar[XB_XGEN(b.x)]) == gen, bar);
            __builtin_amdgcn_fence(__ATOMIC_ACQUIRE, "agent");
            asm volatile("s_waitcnt vmcnt(0)" ::: "memory");
        }
    }
    __syncthreads();
}

constexpr int RING_BYTES = pg8::STAGE_BYTES;
constexpr int PART_OFF = RING_BYTES;
constexpr int XBST_OFF = RING_BYTES + 8192;
constexpr int LDS_BYTES = RING_BYTES + 8192 + 16;

__device__ __forceinline__ unsigned pk2(float a, float b) { return pg8::cvt_pk_bf16(a, b); }
__device__ __forceinline__ float wave_sum(float v) {
#pragma unroll
    for (int o = 1; o < 64; o <<= 1) v += __shfl_xor(v, o);
    return v;
}
__device__ __forceinline__ const float* xrow_c(const float* lat, const float* cx, int r) {
    const int b = r / TB, rr = r - b * TB;
    return rr < CTXL ? cx + ((size_t)b * CTXL + rr) * DM : lat + ((size_t)b * SEQ + (rr - CTXL)) * DM;
}
__device__ __forceinline__ int qk_src(int c) { const int h = c & ~127, cp = c & 127;
    return h + ((cp >> 6) & 1) * 64 + ((cp >> 2) & 1) * 32 + ((cp >> 5) & 1) * 16 + ((cp >> 3) & 3) * 4 + (cp & 3); }

__device__ __forceinline__ void transpose_item(const float* W, int K, int N, bf16_t* WT, LAS float* scr, int item, int lane, int nperm) {
    const int nblk = N / 32, kb = item / nblk, nb = item % nblk, k0 = 64 * kb, n0 = 32 * nb;
    const int cdst = n0 + (lane & 31), csrc = cdst < nperm ? qk_src(cdst) : cdst;
#pragma unroll 8
    for (int i = 0; i < 32; ++i) { const int kk = 2 * i + (lane >> 5); scr[kk * 33 + (lane & 31)] = W[(size_t)(k0 + kk) * N + csrc]; }
    asm volatile("s_waitcnt lgkmcnt(0)" ::: "memory");
    const int c = lane & 7;
#pragma unroll
    for (int j = 0; j < 4; ++j) { const int n = (lane >> 3) + 8 * j; const LAS float* s = scr + (8 * c) * 33 + n;
        u32x4 o; o.x = pk2(s[0 * 33], s[1 * 33]); o.y = pk2(s[2 * 33], s[3 * 33]); o.z = pk2(s[4 * 33], s[5 * 33]); o.w = pk2(s[6 * 33], s[7 * 33]);
        *(u32x4*)(WT + (size_t)(n0 + n) * K + k0 + 8 * c) = o; }
    asm volatile("s_waitcnt lgkmcnt(0)" ::: "memory");
}

template <int GI> __device__ __forceinline__ void pool_unit_t(const bf16_t* XB, bf16_t* ZB, const bf16_t* WPt, const float* pscale, int R0, int lane) {
    constexpr int g = GI, a = 1 << GI;
    const int pm = R0 >> 8, b = pm / 65, jt = pm % 65;
    const int lo = b * TB + (jt ? CTXL : 0), hiR = jt ? (b + 1) * TB : b * TB + CTXL;
    const int r32 = lane & 31, hh = lane >> 5, t = R0 + r32;
    const int s0 = max(t - a, lo), s1 = min(t + a - 1, hiR - 1); const float inv = 1.0f / (float)(s1 - s0 + 1);
    f32x16v acc0 = {}, acc1 = {}, acc2 = {}, acc3 = {};
    const bf16_t* xb = XB + g * 128 + hh * 8;
    const bf16_t* wp = WPt + (size_t)(g * 128 + r32) * 128 + hh * 8;
    float wq[2 * a]; int rq[2 * a];
#pragma unroll
    for (int q = 0; q < 2 * a; ++q) { const int rr = t - a + q; const bool ok = (rr >= lo) && (rr < hiR); wq[q] = ok ? inv : 0.f; rq[q] = ok ? rr : t; }
#pragma unroll 1
    for (int kk = 0; kk < 8; ++kk) {
        u32x4 wv[2 * a];
#pragma unroll
        for (int q = 0; q < 2 * a; ++q) wv[q] = *(const u32x4*)(xb + (size_t)rq[q] * 512 + kk * 16);
        const u32x4 w = *(const u32x4*)(xb + (size_t)t * 512 + kk * 16);
        const bf16x8v w0 = *(const bf16x8v*)(wp + kk * 16), w1 = *(const bf16x8v*)(wp + 32 * 128 + kk * 16), w2 = *(const bf16x8v*)(wp + 64 * 128 + kk * 16), w3 = *(const bf16x8v*)(wp + 96 * 128 + kk * 16);
        float s[8] = {0.f, 0.f, 0.f, 0.f, 0.f, 0.f, 0.f, 0.f};
#pragma unroll
        for (int q = 0; q < 2 * a; ++q) { const float f = wq[q]; const u32x4 v = wv[q];
            s[0] += f * pg8::bf_lo(v.x); s[1] += f * pg8::bf_hi(v.x); s[2] += f * pg8::bf_lo(v.y); s[3] += f * pg8::bf_hi(v.y); s[4] += f * pg8::bf_lo(v.z); s[5] += f * pg8::bf_hi(v.z); s[6] += f * pg8::bf_lo(v.w); s[7] += f * pg8::bf_hi(v.w); }
        u32x4 mf; mf.x = pk2(s[0] - pg8::bf_lo(w.x), s[1] - pg8::bf_hi(w.x)); mf.y = pk2(s[2] - pg8::bf_lo(w.y), s[3] - pg8::bf_hi(w.y));
        mf.z = pk2(s[4] - pg8::bf_lo(w.z), s[5] - pg8::bf_hi(w.z)); mf.w = pk2(s[6] - pg8::bf_lo(w.w), s[7] - pg8::bf_hi(w.w));
        const bf16x8v mfrag = *reinterpret_cast<bf16x8v*>(&mf);
        acc0 = __builtin_amdgcn_mfma_f32_32x32x16_bf16(w0, mfrag, acc0, 0, 0, 0); acc1 = __builtin_amdgcn_mfma_f32_32x32x16_bf16(w1, mfrag, acc1, 0, 0, 0);
        acc2 = __builtin_amdgcn_mfma_f32_32x32x16_bf16(w2, mfrag, acc2, 0, 0, 0); acc3 = __builtin_amdgcn_mfma_f32_32x32x16_bf16(w3, mfrag, acc3, 0, 0, 0);
    }
    bf16_t* zrow = ZB + (size_t)t * 512 + g * 128; const float* ps = pscale + g * 128;
#define POOL_OUT(ACC, NS) do { _Pragma("unroll") for (int q = 0; q < 4; ++q) { const int n0 = (NS) * 32 + 8 * q + 4 * hh; const u32x2v z = *(const u32x2v*)(zrow + n0); const f32x4 p4 = *(const f32x4*)(ps + n0); \
        u32x2v o; o.x = pk2(ACC[4 * q + 0] * p4[0] * pg8::bf_lo(z.x), ACC[4 * q + 1] * p4[1] * pg8::bf_hi(z.x)); o.y = pk2(ACC[4 * q + 2] * p4[2] * pg8::bf_lo(z.y), ACC[4 * q + 3] * p4[3] * pg8::bf_hi(z.y)); \
        *(u32x2v*)(zrow + n0) = o; } } while (0)
    POOL_OUT(acc0, 0); POOL_OUT(acc1, 1); POOL_OUT(acc2, 2); POOL_OUT(acc3, 3);
#undef POOL_OUT
}
__device__ __forceinline__ void pool_unit(const bf16_t* XB, bf16_t* ZB, const bf16_t* WPt, const float* pscale, int wu, int lane) {
    const int g = wu & 3, R0 = (wu >> 2) * 32;
    if (g == 0) pool_unit_t<0>(XB, ZB, WPt, pscale, R0, lane); else if (g == 1) pool_unit_t<1>(XB, ZB, WPt, pscale, R0, lane);
    else if (g == 2) pool_unit_t<2>(XB, ZB, WPt, pscale, R0, lane); else pool_unit_t<3>(XB, ZB, WPt, pscale, R0, lane);
}

__device__ __forceinline__ void store_u(const f32x4 (&v)[4], const float* mod, bf16_t* urow, int lane) {
#pragma unroll
    for (int j = 0; j < 4; ++j) { const int c = 4 * lane + 256 * j; const f32x4 sh = *(const f32x4*)(mod + c), sc = *(const f32x4*)(mod + 1024 + c);
        const f32x4 u = v[j] * (sc + 1.0f) + sh; u32x2v o; o.x = pk2(u[0], u[1]); o.y = pk2(u[2], u[3]); *(u32x2v*)(urow + c) = o; }
}

__global__ void __launch_bounds__(NTHREADS, 2) mega(Params P) {
    extern __shared__ __attribute__((aligned(16))) unsigned char lds[];
    cg::grid_group grid = cg::this_grid();
    const int wave = __builtin_amdgcn_readfirstlane(threadIdx.x >> 6);
#define LANE_ID() (__builtin_amdgcn_mbcnt_hi(~0u, __builtin_amdgcn_mbcnt_lo(~0u, 0u)))
    const int G = gridDim.x, bid = blockIdx.x, gw = bid * NWAVES + wave, NGW = G * NWAVES;
#define GRID_SYNC() xcd_barrier(xbar, wave == 0 && LANE_ID() == 0)
#define CAS __attribute__((address_space(4)))
#define WSL() const CAS Params* pp = (const CAS Params*)__builtin_amdgcn_kernarg_segment_ptr(); asm volatile("" : "+s"(pp)); unsigned char* wsl = pp->ws; asm volatile("" : "+s"(wsl))
#define U ((bf16_t*)(wsl + WS_U))
#define Q ((bf16_t*)(wsl + WS_Q))
#define Kb ((bf16_t*)(wsl + WS_K))
#define Vb ((bf16_t*)(wsl + WS_V))
#define ZA ((bf16_t*)(wsl + WS_ZA))
#define XB ((bf16_t*)(wsl + WS_XB))
#define ZB ((bf16_t*)(wsl + WS_ZB))
#define MOD ((float*)(wsl + WS_MOD))
#define CX ((float*)(wsl + WS_CX))
#define DELTA ((const bf16_t*)(wsl + WS_GA))
    LAS unsigned char* l3 = (LAS unsigned char*)lds;
    const CAS Params* pp0 = (const CAS Params*)__builtin_amdgcn_kernarg_segment_ptr();
    { volatile LAS unsigned* st = (volatile LAS unsigned*)(l3 + XBST_OFF); if (wave == 0 && LANE_ID() == 0) { st[0] = 0u; st[1] = 0u; st[2] = 0u; st[3] = 0u; } }
    __syncthreads();
    XcdBarrier xbar = xcd_barrier_post((unsigned*)(pp0->ws + WS_BAR), (volatile LAS unsigned*)(l3 + XBST_OFF), wave == 0 && LANE_ID() == 0);
    grid.sync();

    constexpr int NPH = 2 + 5 * DEPTH;
#pragma unroll 1
    for (int ph = 0; ph < NPH; ++ph) {
    const int l = ph < 2 ? 0 : (ph - 2) / 5, sph = ph < 2 ? ph : 2 + (ph - 2) % 5;
    if (sph == 0) {
        WSL(); int lane = LANE_ID(); asm volatile("" : "+v"(lane)); const int tid = wave * 64 + lane; unsigned char* ws = wsl; float* cosT = (float*)(wsl + WS_ROPE); float* sinT = cosT + 256 * 32;
        LAS float* scr = (LAS float*)(l3 + wave * 16384);
        constexpr int I_IN = (DM / 64) * (NIN / 32), I_A = (DM / 64) * (DM / 32), I_B = (512 / 64) * (DM / 32), I_O = I_A, I_P = (128 / 64) * (128 / 32);
        constexpr int PER_L = I_IN + I_A + I_B + I_O + 4 * I_P;
        for (int it = gw; it < DEPTH * PER_L; it += NGW) {
            const int l = it / PER_L; int r = it - l * PER_L;
            if (r < I_IN) { transpose_item(pp->w_in + (size_t)l * DM * NIN, DM, NIN, (bf16_t*)(ws + WS_WIN + l * SZ_WIN), scr, r, lane, 1280); continue; } r -= I_IN;
            if (r < I_A) { transpose_item(pp->w_br_a + (size_t)l * DM * DM, DM, DM, (bf16_t*)(ws + WS_WA + l * SZ_WA), scr, r, lane, 0); continue; } r -= I_A;
            if (r < I_B) { transpose_item(pp->w_br_b + (size_t)l * 512 * DM, 512, DM, (bf16_t*)(ws + WS_WB + l * SZ_WB), scr, r, lane, 0); continue; } r -= I_B;
            if (r < I_O) { transpose_item(pp->w_out + (size_t)l * DM * DM, DM, DM, (bf16_t*)(ws + WS_WO + l * SZ_WO), scr, r, lane, 0); continue; } r -= I_O;
            const int g = r / I_P; r -= g * I_P;
            transpose_item(pp->w_pool + ((size_t)l * 4 + g) * 128 * 128, 128, 128, (bf16_t*)(ws + WS_WP + l * SZ_WP) + (size_t)g * 128 * 128, scr, r, lane, 0);
        }
        for (int i = bid * NTHREADS + tid; i < 256 * 32; i += G * NTHREADS) { const int pos = i >> 5, f = i & 31;
            const float invf = 1.0f / __builtin_amdgcn_exp2f(13.287712379549449f * (float)f * (1.0f / 32.0f)); const float ang = (float)pos * invf;
            double rev = (double)ang * 0.15915494309189535; rev -= floor(rev); const float fr_ = (float)rev;
            cosT[i] = __builtin_amdgcn_cosf(fr_); sinT[i] = __builtin_amdgcn_sinf(fr_); }
        __syncthreads();
        LAS float* sv = (LAS float*)l3;
        LAS float* red = sv + 3 * 1024;
        for (int i = tid; i < 3 * 1024; i += NTHREADS) { const int v = i >> 10, k = i & 1023; const float cv = v < 2 ? pp->c[v * 1024 + k] : pp->c_ctx[k]; sv[i] = cv * pg8::sigm(cv); }
        __syncthreads();
        for (int un = bid; un < DEPTH * 48; un += G) { const int l = un / 48, n = (un % 48) * 64 + lane, ks = wave;
            const float* wm = pp->w_mod + (size_t)l * DM * 3072 + (size_t)(ks * 128) * 3072 + n; float a0 = 0.f, a1 = 0.f, a2 = 0.f;
#pragma unroll 8
            for (int k = 0; k < 128; ++k) { const float w = wm[(size_t)k * 3072]; a0 += sv[ks * 128 + k] * w; a1 += sv[1024 + ks * 128 + k] * w; a2 += sv[2048 + ks * 128 + k] * w; }
            red[(ks * 3 + 0) * 64 + lane] = a0; red[(ks * 3 + 1) * 64 + lane] = a1; red[(ks * 3 + 2) * 64 + lane] = a2;
            __syncthreads();
            if (tid < 192) { const int v = tid >> 6, cl = tid & 63; float s = 0.f;
#pragma unroll
                for (int q = 0; q < 8; ++q) s += red[(q * 3 + v) * 64 + cl];
                const int nn = (un % 48) * 64 + cl; MOD[((size_t)l * 3 + v) * 3072 + nn] = s + pp->b_mod[l * 3072 + nn]; }
            __syncthreads();
        }
    } else if (sph == 1) {
    WSL(); int lane = LANE_ID(); asm volatile("" : "+v"(lane));
    for (int r = gw; r < TROWS; r += NGW) { const float* xr = xrow_c(pp->x, pp->ctx, r); const int b = r / TB, mi = (r - b * TB) < CTXL ? 2 : b;
        f32x4 v[4];
#pragma unroll
        for (int j = 0; j < 4; ++j) v[j] = *(const f32x4*)(xr + 4 * lane + 256 * j);
        store_u(v, MOD + mi * 3072, U + (size_t)r * DM, lane); }
    } else if (sph == 2) {
        {
            WSL(); pg8::Gemm g{U, (const bf16_t*)(wsl + WS_WIN + l * SZ_WIN), TROWS, NIN, DM}; pg8::StaticOrder S; S.init(TROWS, NIN, G, bid);
            pg8::EpiIn E{wsl, pp->q_norm + l * 128, pp->k_norm + l * 128, (LAS float*)(l3 + PART_OFF)};
            pg8::gemm_phase<pg8::EpiIn, pg8::StaticOrder, true, true>(l3, g, S, E, wave);
        }
    } else if (sph == 3) {
        {
            WSL(); int lane = LANE_ID(); asm volatile("" : "+v"(lane)); const bf16_t* WPt = (const bf16_t*)(wsl + WS_WP + l * SZ_WP);
            const int nunits = 1024 + (l < DEPTH - 1 ? 16 : 0);
            float kmax; { const float* kn = pp->k_norm + l * 128; kmax = fmaxf(fabsf(kn[lane]), fabsf(kn[lane + 64]));
#pragma unroll
                for (int o_ = 1; o_ < 64; o_ <<= 1) kmax = fmaxf(kmax, __shfl_xor(kmax, o_)); }
            for (int un = bid; un < nunits; un += G) {
                __syncthreads();
                int b, h, rowq, seq;
                if (un < 1024) { b = un >> 9; h = (un >> 6) & 7; rowq = b * TB + CTXL + (un & 63) * 256; seq = TB; }
                else { const int c = un - 1024; b = c >> 3; h = c & 7; rowq = b * TB; seq = CTXL; }
                const size_t qoff = (size_t)rowq * DM + h * 128, koff = (size_t)b * TB * 256 + (h >> 2) * 128;
                att::attn_dense_body((const att::bf16*)(Q + qoff), (const att::bf16*)(Kb + koff), (const att::bf16*)(Vb + koff), (const att::bf16*)(ZA + qoff), (att::bf16*)(Q + qoff), seq, (char*)lds, wave, kmax, l3);
            }
            { unsigned* qctr = (unsigned*)(wsl + WS_BAR) + 8 + l; const int npool = (l < DEPTH - 1) ? (TROWS / 32) * 4 : (NBATCH * SEQ / 32) * 4;
              for (;;) { unsigned wq = 0u; if (lane == 0) wq = __hip_atomic_fetch_add(qctr, 1u, __ATOMIC_RELAXED, __HIP_MEMORY_SCOPE_AGENT);
                  const int wi = __builtin_amdgcn_readfirstlane((int)wq); if (wi >= npool) break;
                  int wu = wi; if (l == DEPTH - 1) { const int rc = wi >> 2, rcf = rc + (CTXL / 32) * (1 + rc / (SEQ / 32)); wu = (rcf << 2) | (wi & 3); }
                  pool_unit(XB, ZB, WPt, pp->pool_scale + l * 512, wu, lane); } }
        }
    } else if (sph == 4) {
        {
            WSL(); pg8::Gemm g{Q, (const bf16_t*)(wsl + WS_WA + l * SZ_WA), TROWS, DM, DM};
            pg8::EpiGate<0> E{wsl};
            { pg8::StaticOrder S; S.init(l == DEPTH - 1 ? NBATCH * SEQ : TROWS, DM, G, bid); S.skip = (l == DEPTH - 1); pg8::gemm_phase<pg8::EpiGate<0>, pg8::StaticOrder, true, true>(l3, g, S, E, wave); }
        }
        {
            WSL(); pg8::Gemm g{ZB, (const bf16_t*)(wsl + WS_WB + l * SZ_WB), TROWS, DM, 512};
            pg8::EpiGate<1> E{wsl};
            { pg8::StaticOrder S; S.init(l == DEPTH - 1 ? NBATCH * SEQ : TROWS, DM, G, bid); S.skip = (l == DEPTH - 1); pg8::gemm_phase<pg8::EpiGate<1>, pg8::StaticOrder, true, true>(l3, g, S, E, wave); }
        }
    } else if (sph == 5) {
        {
            WSL(); pg8::Gemm g{ZA, (const bf16_t*)(wsl + WS_WO + l * SZ_WO), TROWS, DM, DM};
            pg8::EpiRes E{MOD + (size_t)l * 3 * 3072, wsl};
            { pg8::StaticOrder S; S.init(l == DEPTH - 1 ? NBATCH * SEQ : TROWS, DM, G, bid); S.skip = (l == DEPTH - 1); pg8::gemm_phase<pg8::EpiRes, pg8::StaticOrder, true, true>(l3, g, S, E, wave); }
        }
    } else {
        {
            WSL(); int lane = LANE_ID(); asm volatile("" : "+v"(lane)); const float* modl = MOD + (size_t)l * 3 * 3072; const float* lg = pp->ln_g + l * DM; const float* lb = pp->ln_b + l * DM; const bool last = (l == DEPTH - 1);
            const float* xlat = l == 0 ? pp->x : pp->out; const float* xctx = l == 0 ? pp->ctx : CX;
            auto ln_row = [&](const int r, const f32x4 (&vin)[4]) {
                const int b = r / TB, rr = r - b * TB; const bool isctx = rr < CTXL; f32x4 v[4]; float s = 0.f;
#pragma unroll
                for (int j = 0; j < 4; ++j) { v[j] = vin[j]; s += (v[j][0] + v[j][1]) + (v[j][2] + v[j][3]); }
                const float mean = wave_sum(s) * (1.0f / DM); float s2 = 0.f;
#pragma unroll
                for (int j = 0; j < 4; ++j) { v[j] = v[j] - mean; s2 += (v[j][0] * v[j][0] + v[j][1] * v[j][1]) + (v[j][2] * v[j][2] + v[j][3] * v[j][3]); }
                const float rstd = 1.0f / sqrtf(wave_sum(s2) * (1.0f / DM) + EPSV);
                float* xo = isctx ? CX + ((size_t)b * CTXL + rr) * DM : pp->out + ((size_t)b * SEQ + (rr - CTXL)) * DM;
#pragma unroll
                for (int j = 0; j < 4; ++j) { const int c = 4 * lane + 256 * j; v[j] = v[j] * rstd * *(const f32x4*)(lg + c) + *(const f32x4*)(lb + c); *(f32x4*)(xo + c) = v[j]; }
                if (!last) store_u(v, modl + 3 * 3072 + (isctx ? 2 : b) * 3072, U + (size_t)r * DM, lane);
            };
            const int nrows = last ? NBATCH * SEQ : TROWS;
            for (int i0 = gw; i0 < nrows; i0 += 2 * NGW) {
                const int i1 = i0 + NGW; const bool has1 = i1 < nrows;
                const int r0 = last ? i0 + CTXL * (1 + i0 / SEQ) : i0, r1 = has1 ? (last ? i1 + CTXL * (1 + i1 / SEQ) : i1) : r0;
                f32x4 va[4], vb[4]; const float* xa = xrow_c(xlat, xctx, r0); const float* xb_ = xrow_c(xlat, xctx, r1);
                const bf16_t* da = DELTA + (size_t)r0 * DM; const bf16_t* db = DELTA + (size_t)r1 * DM;
#pragma unroll
                for (int j = 0; j < 4; ++j) { const int c = 4 * lane + 256 * j; const f32x4 x0 = *(const f32x4*)(xa + c), x1 = *(const f32x4*)(xb_ + c);
                    const u32x2v d0 = *(const u32x2v*)(da + c), d1 = *(const u32x2v*)(db + c);
                    va[j] = x0 * ALPHA_RES + (f32x4){pg8::bf_lo(d0.x), pg8::bf_hi(d0.x), pg8::bf_lo(d0.y), pg8::bf_hi(d0.y)};
                    vb[j] = x1 * ALPHA_RES + (f32x4){pg8::bf_lo(d1.x), pg8::bf_hi(d1.x), pg8::bf_lo(d1.y), pg8::bf_hi(d1.y)}; }
                ln_row(r0, va); if (has1) ln_row(r1, vb);
            }
        }
    }
    if (ph + 1 < NPH) GRID_SYNC();
    }
}

extern "C" void kernel_launch(void* const* d_in, const int* in_sizes, int n_in, void* d_out, int out_size, void* d_ws, size_t ws_size, hipStream_t stream) {
    static int grid_blocks = 0;
    if (grid_blocks == 0) {
        if (n_in != 16 || ws_size < WS_END2 || out_size != NBATCH * SEQ * DM) { fprintf(stderr, "kernel_launch: unexpected shapes: n_in %d out %d ws %zu (need %zu)\n", n_in, out_size, ws_size, (size_t)WS_END2); grid_blocks = -1; return; }
        int dev = 0, cus = 0, per_cu = 0;
        hipGetDevice(&dev); hipDeviceGetAttribute(&cus, hipDeviceAttributeMultiprocessorCount, dev);
        if (hipFuncSetAttribute((const void*)mega, hipFuncAttributeMaxDynamicSharedMemorySize, LDS_BYTES) != hipSuccess) { fprintf(stderr, "kernel_launch: hipFuncSetAttribute failed\n"); grid_blocks = -1; return; }
        if (hipOccupancyMaxActiveBlocksPerMultiprocessor(&per_cu, (const void*)mega, NTHREADS, LDS_BYTES) != hipSuccess || per_cu < 1) { fprintf(stderr, "kernel_launch: occupancy query gave %d\n", per_cu); per_cu = 1; }
        (void)hipGetLastError();
        grid_blocks = cus * per_cu;
    }
    if (grid_blocks < 0) return;
    Params p{};
    p.x = (const float*)d_in[0]; p.c = (const float*)d_in[1]; p.ctx = (const float*)d_in[2]; p.c_ctx = (const float*)d_in[3]; p.w_mod = (const float*)d_in[4]; p.b_mod = (const float*)d_in[5];
    p.w_in = (const float*)d_in[6]; p.q_norm = (const float*)d_in[7]; p.k_norm = (const float*)d_in[8]; p.w_pool = (const float*)d_in[9]; p.pool_scale = (const float*)d_in[10];
    p.w_br_a = (const float*)d_in[11]; p.w_br_b = (const float*)d_in[12]; p.w_out = (const float*)d_in[13]; p.ln_g = (const float*)d_in[14]; p.ln_b = (const float*)d_in[15];
    p.out = (float*)d_out; p.ws = (unsigned char*)d_ws;
    void* args[] = {&p};
    if (hipMemsetAsync((char*)d_ws + WS_BAR, 0, XCD_BAR_WORDS * 4, stream) != hipSuccess) { fprintf(stderr, "kernel_launch: memset of the barrier word failed\n"); return; }
    hipError_t e = hipLaunchCooperativeKernel((const void*)mega, dim3(grid_blocks), dim3(NTHREADS), args, LDS_BYTES, stream);
    if (e != hipSuccess) fprintf(stderr, "kernel_launch: cooperative launch failed: %s (grid %d)\n", hipGetErrorString(e), grid_blocks);
}
```

```cpp
#include <hip/hip_runtime.h>
#include <hip/hip_bf16.h>
#include <hip/hip_cooperative_groups.h>
#include <cstdio>
#include <cstdint>
namespace cg = cooperative_groups;

constexpr int DM = 1024, NBATCH = 2, SEQ = 16384, CTXL = 256, DEPTH = 4, HD = 128;
constexpr int TB = SEQ + CTXL;
constexpr int TROWS = NBATCH * TB;
constexpr int NIN = 5632;
constexpr float EPSV = 1e-6f;
constexpr float ALPHA_RES = 1.681792830507429f;
constexpr int NWAVES = 8, NTHREADS = 512;

constexpr size_t SZ_WIN = (size_t)NIN * DM * 2, SZ_WA = (size_t)DM * DM * 2, SZ_WB = (size_t)DM * 512 * 2, SZ_WO = SZ_WA, SZ_WP = (size_t)4 * 128 * 128 * 2;
constexpr size_t WS_WIN = 0;
constexpr size_t WS_WA = WS_WIN + DEPTH * SZ_WIN;
constexpr size_t WS_WB = WS_WA + DEPTH * SZ_WA;
constexpr size_t WS_WO = WS_WB + DEPTH * SZ_WB;
constexpr size_t WS_WP = WS_WO + DEPTH * SZ_WO;
constexpr size_t WS_MOD = WS_WP + DEPTH * SZ_WP;
constexpr size_t WS_ROPE = WS_MOD + (size_t)DEPTH * 3 * 3072 * 4;
constexpr size_t WS_CX = WS_ROPE + 2 * 256 * 32 * 4;
constexpr size_t WS_U = WS_CX + (size_t)512 * DM * 4;
constexpr size_t WS_Q = WS_U + (size_t)TROWS * DM * 2;
constexpr size_t WS_K = WS_Q + (size_t)TROWS * DM * 2;
constexpr size_t WS_V = WS_K + (size_t)TROWS * 256 * 2;
constexpr size_t WS_ZA = WS_V + (size_t)TROWS * 256 * 2;
constexpr size_t WS_XB = WS_ZA + (size_t)TROWS * DM * 2;
constexpr size_t WS_ZB = WS_XB + (size_t)TROWS * 512 * 2;
constexpr size_t WS_GA = WS_ZB + (size_t)TROWS * 512 * 2;
constexpr size_t WS_GB = WS_GA + (size_t)TROWS * DM * 2;
constexpr size_t WS_END = WS_GB + (size_t)TROWS * DM * 2;
constexpr size_t WS_BAR = WS_END, WS_END2 = WS_END + 16384;

struct Params {
    const float *x, *c, *ctx, *c_ctx, *w_mod, *b_mod, *w_in, *q_norm, *k_norm, *w_pool, *pool_scale, *w_br_a, *w_br_b, *w_out, *ln_g, *ln_b;
    float* out; unsigned char* ws;
};

namespace pg8 {
#define PG8_LAS __attribute__((address_space(3)))
typedef unsigned short bf16_t;
typedef short bf16x8 __attribute__((ext_vector_type(8)));
typedef float f32x4 __attribute__((ext_vector_type(4)));
typedef unsigned u32x4 __attribute__((ext_vector_type(4)));
constexpr int BM = 256, BK = 64, HALF = 128, HTB = HALF * BK * 2  , STAGE_BYTES = 8 * HTB, NXCD = 8, WGM = 8;

__host__ __device__ __forceinline__ int lds_byte(int r, int c) { const int st = (r >> 4) * 2 + (c >> 5), rr = r & 15, cc = c & 31, ob = rr * 64 + cc * 2; return st * 1024 + (ob ^ (((ob >> 9) & 1) << 5)); }
__host__ __device__ __forceinline__ void stage_rc(int b, int& R, int& C) { const int st = b / 1024, sb = b % 1024, swz = sb ^ (((sb >> 9) & 1) << 5); R = (st >> 1) * 16 + swz / 64; C = (st & 1) * 32 + (swz % 64) / 2; }
__host__ __device__ __forceinline__ int perm32(int rho) { const int n = rho >> 4, i = rho & 15; return 8 * (i >> 2) + 4 * n + (i & 3); }

struct Unit { int pm, pn; };
struct Gemm { const bf16_t* A; const bf16_t* Bt; int M, N, K; };

struct StaticOrder {
    int nM, nN, nwg, G, c, skip;
    __host__ __device__ void init(int M, int N, int G_, int c_) { nM = M / BM; nN = N / BM; nwg = nM * nN; G = G_; c = c_; skip = 0; }
    __host__ __device__ bool next(int i, Unit& u) const {
        const long L = (long)i * G + c; if (L >= nwg) return false;
        int wgid = (int)L; { const int q = nwg / NXCD, r = nwg % NXCD, xcd = wgid % NXCD, off = wgid / NXCD; wgid = (xcd < r ? xcd * (q + 1) : r * (q + 1) + (xcd - r) * q) + off; }
        const int nig = WGM * nN, gid = wgid / nig, fm = gid * WGM, gsz = (nM - fm) < WGM ? (nM - fm) : WGM;
        u.pm = fm + ((wgid % nig) % gsz); u.pn = (wgid % nig) / gsz; if (skip) u.pm += 1 + (u.pm >= 64 ? 1 : 0); return true;
    }
    __device__ __forceinline__ void a_ready(const Unit&) const {}
    __device__ __forceinline__ void done(const Unit&) const {}
};

typedef __bf16 bf16x2_t __attribute__((ext_vector_type(2)));
typedef float f32x2_t __attribute__((ext_vector_type(2)));
__device__ __forceinline__ unsigned cvt_pk_bf16(float lo, float hi) { const f32x2_t v = {lo, hi}; const bf16x2_t r = __builtin_convertvector(v, bf16x2_t); return __builtin_bit_cast(unsigned, r); }
typedef float f32x2 __attribute__((ext_vector_type(2)));
struct LatentOrder {
    StaticOrder S;
    __host__ __device__ void init(int N, int G_, int c_) { S.init(32768, N, G_, c_); }
    __host__ __device__ bool next(int i, Unit& u) const { if (!S.next(i, u)) return false; u.pm += 1 + (u.pm >= 64 ? 1 : 0); return true; }
    __device__ __forceinline__ void a_ready(const Unit&) const {}
    __device__ __forceinline__ void done(const Unit&) const {}
};
__device__ __forceinline__ float bf_lo(unsigned w) { return __uint_as_float(w << 16); }
__device__ __forceinline__ float bf_hi(unsigned w) { return __uint_as_float(w & 0xffff0000u); }
__device__ __forceinline__ float sigm(float x) { return __builtin_amdgcn_rcpf(1.0f + __builtin_amdgcn_exp2f(-1.4426950408889634f * x)); }
typedef unsigned u32x2 __attribute__((ext_vector_type(2)));
template <int ACT> __device__ __forceinline__ float actf(float x) { if (ACT == 1) return x * sigm(x); if (ACT == 2) return sigm(x); return x; }

struct EpiIn {
    static constexpr bool PERM = true, AFTER_DRAIN = false;
    unsigned char* ws; const float *qg, *kg;
    PG8_LAS float* part;
    template <int ACT> __device__ __forceinline__ void plain(const f32x4 (&acc)[2][2][4][2], bf16_t* base, int ldc, int colt, const Unit& u, int wr, int wc, int fr, int fq) const {
        const int row0 = u.pm * BM + wr * 64 + fr, col0 = colt + wc * 32 + 8 * fq;
#pragma unroll
        for (int ai = 0; ai < 2; ++ai)
#pragma unroll
            for (int m = 0; m < 4; ++m) { bf16_t* rowp = base + (size_t)(row0 + ai * HALF + m * 16) * ldc + col0;
#pragma unroll
                for (int bj = 0; bj < 2; ++bj) { const f32x4 v0 = acc[ai][bj][m][0], v1 = acc[ai][bj][m][1]; u32x4 w;
                    w.x = cvt_pk_bf16(actf<ACT>(v0[0]), actf<ACT>(v0[1])); w.y = cvt_pk_bf16(actf<ACT>(v0[2]), actf<ACT>(v0[3]));
                    w.z = cvt_pk_bf16(actf<ACT>(v1[0]), actf<ACT>(v1[1])); w.w = cvt_pk_bf16(actf<ACT>(v1[2]), actf<ACT>(v1[3]));
                    *(u32x4*)(rowp + bj * HALF) = w; } }
    }
    __device__ __forceinline__ void qk(const f32x4 (&acc)[2][2][4][2], const Unit& u, int wr, int wc, int fr, int fq) const {
        const bool isk = (u.pn == 4);
        const float* g = isk ? kg : qg; bf16_t* dst = (bf16_t*)(ws + (isk ? WS_K : WS_Q)); const int ldc = isk ? 256 : 1024;
        const float* cosT = (const float*)(ws + WS_ROPE); const float* sinT = cosT + 256 * 32;
        const int f0 = (wc & 1) * 16 + 4 * fq, axis = wc >> 1, e1 = axis * 64 + f0;
        const f32x4 g1 = *(const f32x4*)(g + e1), g2 = *(const f32x4*)(g + e1 + 32);
#pragma unroll
        for (int ai = 0; ai < 2; ++ai)
#pragma unroll
            for (int m = 0; m < 4; ++m)
#pragma unroll
                for (int bj = 0; bj < 2; ++bj) { const f32x4 a = acc[ai][bj][m][0], b = acc[ai][bj][m][1];
                    float s = (a[0] * a[0] + a[1] * a[1]) + (a[2] * a[2] + a[3] * a[3]) + (b[0] * b[0] + b[1] * b[1]) + (b[2] * b[2] + b[3] * b[3]);
                    s += __shfl_xor(s, 16); s += __shfl_xor(s, 32);
                    if (fq == 0) part[((ai * HALF + wr * 64 + m * 16 + fr) * 2 + bj) * 4 + wc] = s; }
        asm volatile("s_waitcnt lgkmcnt(0)" ::: "memory"); __builtin_amdgcn_s_barrier(); asm volatile("" ::: "memory");
        const int jt = u.pm % 65; const bool rope = (jt != 0);
#pragma unroll
        for (int ai = 0; ai < 2; ++ai)
#pragma unroll
            for (int m = 0; m < 4; ++m) { const int rloc = ai * HALF + wr * 64 + m * 16 + fr;
                const int pos = rope ? (axis ? (16 * m + fr) : ((jt - 1) * 4 + 2 * ai + wr)) : 0;
                f32x4 c4 = *(const f32x4*)(cosT + pos * 32 + f0), s4 = *(const f32x4*)(sinT + pos * 32 + f0);
                if (!rope) { c4 = (f32x4){1.f, 1.f, 1.f, 1.f}; s4 = (f32x4){0.f, 0.f, 0.f, 0.f}; }
#pragma unroll
                for (int bj = 0; bj < 2; ++bj) { const f32x4 p = *(const PG8_LAS f32x4*)(part + (rloc * 2 + bj) * 4);
                    const float rstd = __builtin_amdgcn_rsqf(((p[0] + p[1]) + (p[2] + p[3])) * (1.0f / 128.0f) + 1e-6f);
                    const f32x4 y1 = acc[ai][bj][m][0] * rstd * g1, y2 = acc[ai][bj][m][1] * rstd * g2;
                    f32x4 o1 = y1 * c4 - y2 * s4, o2 = y1 * s4 + y2 * c4;
                    if (!isk) { o1 = o1 * 0.12751743074602458f; o2 = o2 * 0.12751743074602458f; }
                    const int head = isk ? bj : 2 * u.pn + bj;
                    bf16_t* ptr = dst + (size_t)(u.pm * BM + rloc) * ldc + head * 128 + e1;
                    u32x2 w1, w2; w1.x = cvt_pk_bf16(o1[0], o1[1]); w1.y = cvt_pk_bf16(o1[2], o1[3]); w2.x = cvt_pk_bf16(o2[0], o2[1]); w2.y = cvt_pk_bf16(o2[2], o2[3]);
                    *(u32x2*)ptr = w1; *(u32x2*)(ptr + 32) = w2; } }
    }
    __device__ __forceinline__ void operator()(const f32x4 (&acc)[2][2][4][2], const Unit& u, int wr, int wc, int fr, int fq) const {
        const int pn = u.pn;
        if (pn < 5) { qk(acc, u, wr, wc, fr, fq); return; }
        if (pn == 5) plain<0>(acc, (bf16_t*)(ws + WS_V), 256, 0, u, wr, wc, fr, fq);
        else if (pn < 10) plain<1>(acc, (bf16_t*)(ws + WS_ZA), 1024, (pn - 6) * 256, u, wr, wc, fr, fq);
        else if (pn < 12) plain<0>(acc, (bf16_t*)(ws + WS_XB), 512, (pn - 10) * 256, u, wr, wc, fr, fq);
        else if (pn < 14) plain<1>(acc, (bf16_t*)(ws + WS_ZB), 512, (pn - 12) * 256, u, wr, wc, fr, fq);
        else if (pn < 18) plain<2>(acc, (bf16_t*)(ws + WS_GA), 1024, (pn - 14) * 256, u, wr, wc, fr, fq);
        else plain<2>(acc, (bf16_t*)(ws + WS_GB), 1024, (pn - 18) * 256, u, wr, wc, fr, fq);
    }
};
template <int MODE> struct EpiGate {
    static constexpr bool PERM = true, AFTER_DRAIN = false;
    unsigned char* ws;
    __device__ __forceinline__ void operator()(const f32x4 (&acc)[2][2][4][2], const Unit& u, int wr, int wc, int fr, int fq) const {
        bf16_t* GA = (bf16_t*)(ws + WS_GA); const bf16_t* GB = (const bf16_t*)(ws + WS_GB); bf16_t* Y = (bf16_t*)(ws + WS_ZA);
        const int row0 = u.pm * BM + wr * 64 + fr, col0 = u.pn * BM + wc * 32 + 8 * fq;
#pragma unroll
        for (int ai = 0; ai < 2; ++ai)
#pragma unroll
            for (int m = 0; m < 4; ++m) { const size_t off = (size_t)(row0 + ai * HALF + m * 16) * 1024 + col0;
#pragma unroll
                for (int bj = 0; bj < 2; ++bj) { const f32x4 v0 = acc[ai][bj][m][0], v1 = acc[ai][bj][m][1];
                    const u32x4 ga = *(const u32x4*)(GA + off + bj * HALF); u32x4 w;
                    if (MODE == 0) {
                        w.x = cvt_pk_bf16(v0[0] * bf_lo(ga.x), v0[1] * bf_hi(ga.x)); w.y = cvt_pk_bf16(v0[2] * bf_lo(ga.y), v0[3] * bf_hi(ga.y));
                        w.z = cvt_pk_bf16(v1[0] * bf_lo(ga.z), v1[1] * bf_hi(ga.z)); w.w = cvt_pk_bf16(v1[2] * bf_lo(ga.w), v1[3] * bf_hi(ga.w));
                        *(u32x4*)(GA + off + bj * HALF) = w;
                    } else {
                        const u32x4 gb = *(const u32x4*)(GB + off + bj * HALF);
                        w.x = cvt_pk_bf16(bf_lo(ga.x) + v0[0] * bf_lo(gb.x), bf_hi(ga.x) + v0[1] * bf_hi(gb.x)); w.y = cvt_pk_bf16(bf_lo(ga.y) + v0[2] * bf_lo(gb.y), bf_hi(ga.y) + v0[3] * bf_hi(gb.y));
                        w.z = cvt_pk_bf16(bf_lo(ga.z) + v1[0] * bf_lo(gb.z), bf_hi(ga.z) + v1[1] * bf_hi(gb.z)); w.w = cvt_pk_bf16(bf_lo(ga.w) + v1[2] * bf_lo(gb.w), bf_hi(ga.w) + v1[3] * bf_hi(gb.w));
                        *(u32x4*)(Y + off + bj * HALF) = w;
                    } } }
    }
};
struct EpiRes {
    static constexpr bool PERM = true, AFTER_DRAIN = false;
    const float* mod; unsigned char* ws;
    __device__ __forceinline__ void operator()(const f32x4 (&acc)[2][2][4][2], const Unit& u, int wr, int wc, int fr, int fq) const {
        const int b = u.pm / 65, jt = u.pm % 65; bf16_t* dl = (bf16_t*)(ws + WS_GA);
        const float* gate = mod + (jt ? b : 2) * 3072 + 2048;
        const int row0 = u.pm * BM + wr * 64 + fr, col0 = u.pn * BM + wc * 32 + 8 * fq;
        f32x4 gv[2][2];
#pragma unroll
        for (int bj = 0; bj < 2; ++bj)
#pragma unroll
            for (int n = 0; n < 2; ++n) gv[bj][n] = *(const f32x4*)(gate + col0 + bj * HALF + 4 * n);
#pragma unroll
        for (int ai = 0; ai < 2; ++ai)
#pragma unroll
            for (int m = 0; m < 4; ++m) { bf16_t* rowp = dl + (size_t)(row0 + ai * HALF + m * 16) * 1024 + col0;
#pragma unroll
                for (int bj = 0; bj < 2; ++bj) { const f32x4 v0 = acc[ai][bj][m][0] * gv[bj][0], v1 = acc[ai][bj][m][1] * gv[bj][1]; u32x4 w;
                    w.x = cvt_pk_bf16(v0[0], v0[1]); w.y = cvt_pk_bf16(v0[2], v0[3]); w.z = cvt_pk_bf16(v1[0], v1[1]); w.w = cvt_pk_bf16(v1[2], v1[3]);
                    *(u32x4*)(rowp + bj * HALF) = w; } }
    }
};

template <class Epi, class Sched, bool ALIGN_EPI = false, bool SP2 = false>
__device__ __forceinline__ void gemm_phase(PG8_LAS unsigned char* lds, const Gemm g, const Sched& S, const Epi& E, const int wid_in) {
    int lane = __builtin_amdgcn_mbcnt_hi(~0u, __builtin_amdgcn_mbcnt_lo(~0u, 0u)); asm volatile("" : "+v"(lane));
    const int wid = wid_in, tid = wid * 64 + lane, wr = wid >> 2, wc = wid & 3, fr = lane & 15, fq = lane >> 4;
    const int K = g.K, nt = K / BK;
    unsigned voffA[2], voffB[2];
#pragma unroll
    for (int i = 0; i < 2; ++i) { int R, C; stage_rc(tid * 16 + i * 8192, R, C); const int Rb = Epi::PERM ? ((R & ~31) + perm32(R & 31)) : R;
        voffA[i] = (unsigned)(R * K + C) * 2u; voffB[i] = (unsigned)(Rb * K + C) * 2u; }
    const size_t kstep = (size_t)(BK * 2);
    const size_t hstep = (size_t)HALF * K * 2;
    const size_t tstep = 2 * hstep;
    const unsigned ldsw = (unsigned)wid * 1024u;
    const int aoff = lds_byte(wr * 64 + fr, fq * 8), boff = lds_byte(wc * 32 + fr, fq * 8);
#define PG8_SA(b, h) (((b) * 2 + (h)) * HTB)
#define PG8_SB(b, h) ((4 + (b) * 2 + (h)) * HTB)
#define PG8_STAGE(bufoff, gbase, voff) do { _Pragma("unroll") for (int _i = 0; _i < 2; ++_i) \
        __builtin_amdgcn_global_load_lds((const unsigned*)((const char*)(gbase) + (voff)[_i]), (PG8_LAS unsigned*)(lds + (bufoff) + ldsw + _i * 8192), 16, 0, 0); } while (0)
#define PG8_LDA(dst, b, h) do { _Pragma("unroll") for (int m = 0; m < 4; ++m) _Pragma("unroll") for (int k = 0; k < 2; ++k) dst[m][k] = *(const PG8_LAS bf16x8*)(lds + PG8_SA(b, h) + aoff + m * 2048 + k * 1024); } while (0)
#define PG8_LDB(dst, b, h) do { _Pragma("unroll") for (int n = 0; n < 2; ++n) _Pragma("unroll") for (int k = 0; k < 2; ++k) dst[n][k] = *(const PG8_LAS bf16x8*)(lds + PG8_SB(b, h) + boff + n * 2048 + k * 1024); } while (0)
#define PG8_MMA(ai, bj, At, Bt) do { __builtin_amdgcn_s_setprio(1); _Pragma("unroll") for (int m = 0; m < 4; ++m) _Pragma("unroll") for (int n = 0; n < 2; ++n) _Pragma("unroll") for (int k = 0; k < 2; ++k) \
        acc[ai][bj][m][n] = __builtin_amdgcn_mfma_f32_16x16x32_bf16(Bt[n][k], At[m][k], acc[ai][bj][m][n], 0, 0, 0); __builtin_amdgcn_s_setprio(0); } while (0)
#define PG8_WAIT_V(n) asm volatile("s_waitcnt vmcnt(" #n ")" ::: "memory")
#define PG8_WAIT_L(n) asm volatile("s_waitcnt lgkmcnt(" #n ")" ::: "memory")
#define PG8_BAR __builtin_amdgcn_s_barrier()
#define PG8_SCHED __builtin_amdgcn_sched_barrier(0)
    Unit cur, nxt; int ui = 0;
    if (!S.next(0, cur)) return;
    f32x4 acc[2][2][4][2];
#pragma unroll
    for (int a = 0; a < 2; ++a)
#pragma unroll
        for (int b = 0; b < 2; ++b)
#pragma unroll
            for (int m = 0; m < 4; ++m)
#pragma unroll
                for (int n = 0; n < 2; ++n) acc[a][b][m][n] = (f32x4){0.f, 0.f, 0.f, 0.f};
    bf16x8 At[4][2], B0[2][2], B1[2][2];
    const char* cA = (const char*)g.A + (size_t)cur.pm * tstep; const char* cB = (const char*)g.Bt + (size_t)cur.pn * tstep;
    S.a_ready(cur);
    if constexpr (SP2) {
        PG8_STAGE(PG8_SB(0, 0), cB, voffB); PG8_STAGE(PG8_SB(0, 1), cB + hstep, voffB); PG8_STAGE(PG8_SA(0, 0), cA, voffA); PG8_STAGE(PG8_SA(0, 1), cA + hstep, voffA);
        if (wr == 1) PG8_BAR;
        PG8_WAIT_V(2); PG8_BAR;
        PG8_STAGE(PG8_SB(1, 0), cB + kstep, voffB); PG8_STAGE(PG8_SA(1, 0), cA + kstep, voffA); PG8_STAGE(PG8_SB(1, 1), cB + hstep + kstep, voffB);
        PG8_WAIT_V(6); PG8_BAR;
    } else {
        PG8_STAGE(PG8_SB(0, 0), cB, voffB); PG8_STAGE(PG8_SA(0, 0), cA, voffA); PG8_STAGE(PG8_SB(0, 1), cB + hstep, voffB); PG8_STAGE(PG8_SA(0, 1), cA + hstep, voffA);
        if (wr == 1) PG8_BAR;
        PG8_WAIT_V(4); PG8_BAR;
        PG8_STAGE(PG8_SB(1, 0), cB + kstep, voffB); PG8_STAGE(PG8_SA(1, 0), cA + kstep, voffA); PG8_STAGE(PG8_SB(1, 1), cB + hstep + kstep, voffB);
        PG8_WAIT_V(6); PG8_BAR;
    }
    for (;;) {
        const bool has_next = S.next(ui + 1, nxt);
        const char* nA = has_next ? (const char*)g.A + (size_t)nxt.pm * tstep : cA; const char* nB = has_next ? (const char*)g.Bt + (size_t)nxt.pn * tstep : cB;
        for (int t = 0; t < nt; t += 2) {
            const bool last = (t == nt - 2);
            const char* a1 = cA + (size_t)(t + 1) * kstep;
            const char* a2 = last ? nA : cA + (size_t)(t + 2) * kstep; const char* b2 = last ? nB : cB + (size_t)(t + 2) * kstep;
            const char* a3 = a2 + kstep; const char* b3 = b2 + kstep;
            if (last && has_next) S.a_ready(nxt);
            if constexpr (SP2) {
            PG8_LDB(B0, 0, 0); PG8_LDB(B1, 0, 1); PG8_SCHED; PG8_LDA(At, 0, 0); PG8_STAGE(PG8_SA(1, 1), a1 + hstep, voffA);
            PG8_WAIT_V(8); PG8_WAIT_L(0); PG8_BAR; PG8_MMA(0, 0, At, B0); PG8_MMA(0, 1, At, B1); PG8_BAR; PG8_SCHED;
            PG8_LDA(At, 0, 1); PG8_STAGE(PG8_SB(0, 0), b2, voffB); PG8_STAGE(PG8_SB(0, 1), b2 + hstep, voffB); PG8_STAGE(PG8_SA(0, 0), a2, voffA);
            PG8_WAIT_V(8); PG8_WAIT_L(0); PG8_BAR; PG8_MMA(1, 0, At, B0); PG8_MMA(1, 1, At, B1); PG8_BAR; PG8_SCHED;
            PG8_LDB(B0, 1, 0); PG8_LDB(B1, 1, 1); PG8_SCHED; PG8_LDA(At, 1, 0); PG8_STAGE(PG8_SA(0, 1), a2 + hstep, voffA);
            PG8_WAIT_V(8); PG8_WAIT_L(0); PG8_BAR; PG8_MMA(0, 0, At, B0); PG8_MMA(0, 1, At, B1); PG8_BAR; PG8_SCHED;
            PG8_LDA(At, 1, 1); PG8_STAGE(PG8_SB(1, 0), b3, voffB); PG8_STAGE(PG8_SB(1, 1), b3 + hstep, voffB); PG8_STAGE(PG8_SA(1, 0), a3, voffA);
            PG8_WAIT_V(8); PG8_WAIT_L(0); PG8_BAR; PG8_MMA(1, 0, At, B0); PG8_MMA(1, 1, At, B1); PG8_BAR; PG8_SCHED;
            } else {
            PG8_LDB(B0, 0, 0); PG8_SCHED; PG8_LDA(At, 0, 0); PG8_STAGE(PG8_SA(1, 1), a1 + hstep, voffA);
            PG8_WAIT_L(8); PG8_BAR; PG8_WAIT_L(0); PG8_MMA(0, 0, At, B0); PG8_BAR; PG8_SCHED;
            PG8_LDB(B1, 0, 1); PG8_STAGE(PG8_SB(0, 0), b2, voffB);
            PG8_BAR; PG8_WAIT_L(0); PG8_MMA(0, 1, At, B1); PG8_BAR;
            PG8_LDA(At, 0, 1); PG8_STAGE(PG8_SA(0, 0), a2, voffA);
            PG8_BAR; PG8_WAIT_L(0); PG8_MMA(1, 0, At, B0); PG8_BAR; PG8_SCHED;
            PG8_STAGE(PG8_SB(0, 1), b2 + hstep, voffB);
            PG8_WAIT_V(6); PG8_BAR; PG8_MMA(1, 1, At, B1); PG8_BAR;
            PG8_LDB(B0, 1, 0); PG8_SCHED; PG8_LDA(At, 1, 0); PG8_STAGE(PG8_SA(0, 1), a2 + hstep, voffA);
            PG8_WAIT_L(8); PG8_BAR; PG8_WAIT_L(0); PG8_MMA(0, 0, At, B0); PG8_BAR; PG8_SCHED;
            PG8_LDB(B1, 1, 1); PG8_STAGE(PG8_SB(1, 0), b3, voffB);
            PG8_BAR; PG8_WAIT_L(0); PG8_MMA(0, 1, At, B1); PG8_BAR;
            PG8_LDA(At, 1, 1); PG8_STAGE(PG8_SA(1, 0), a3, voffA);
            PG8_BAR; PG8_WAIT_L(0); PG8_MMA(1, 0, At, B0); PG8_BAR; PG8_SCHED;
            PG8_STAGE(PG8_SB(1, 1), b3 + hstep, voffB);
            PG8_WAIT_V(6); PG8_BAR; PG8_MMA(1, 1, At, B1); PG8_BAR;
            }
        }
        if constexpr (ALIGN_EPI) { if (wr == 0) PG8_BAR; }
        if constexpr (!Epi::AFTER_DRAIN) { int l2 = __builtin_amdgcn_mbcnt_hi(~0u, __builtin_amdgcn_mbcnt_lo(~0u, 0u)); asm volatile("" : "+v"(l2));
            E(acc, cur, wr, wc, l2 & 15, l2 >> 4); S.done(cur); }
        if (!has_next) break;
#pragma unroll
        for (int a = 0; a < 2; ++a)
#pragma unroll
            for (int b = 0; b < 2; ++b)
#pragma unroll
                for (int m = 0; m < 4; ++m)
#pragma unroll
                    for (int n = 0; n < 2; ++n) acc[a][b][m][n] = (f32x4){0.f, 0.f, 0.f, 0.f};
        cur = nxt; cA = nA; cB = nB; ++ui;
        if constexpr (ALIGN_EPI) { if (wr == 1) PG8_BAR; }
    }
    PG8_WAIT_V(0);
    if constexpr (!ALIGN_EPI) { if (wr == 0) PG8_BAR; }
    PG8_BAR;
    if constexpr (Epi::AFTER_DRAIN) { E.fused(acc, cur, wr, wc, fr, fq, lds, wid, lane); S.done(cur); }
#undef PG8_SA
#undef PG8_SB
#undef PG8_STAGE
#undef PG8_LDA
#undef PG8_LDB
#undef PG8_MMA
#undef PG8_WAIT_V
#undef PG8_WAIT_L
#undef PG8_BAR
#undef PG8_SCHED
}
}
namespace att {
using bf16 = __hip_bfloat16;
constexpr int   D = 128, NW = 8, QBLK = 32, KVBLK = 64;
constexpr float SCALE = 0.088388347648318440f;
constexpr float THR = 8.f;
constexpr int SDEPTH = 1;
constexpr int LDQ = 1024, LDK = 256, LDO = 1024;
constexpr size_t SHM_V = KVBLK * D * 2, SHM_K = KVBLK * D * 2, SHM_ATTN = 3 * SHM_V + 3 * SHM_K + NW * 64 * 4;
using bf16x8 = __attribute__((ext_vector_type(8))) short;
using s16x4  = __attribute__((ext_vector_type(4))) short;
using f32x16 = __attribute__((ext_vector_type(16))) float;
using f32x8  = __attribute__((ext_vector_type(8))) float;
using u32x4  = __attribute__((ext_vector_type(4))) unsigned;
#define KSWZ(row, colB) ((row) * 256 + ((colB) ^ (((row) & 15) << 4)))
#define SBAR() __builtin_amdgcn_sched_barrier(0)
__device__ __forceinline__ int crow(int r, int hi) { return (r & 3) + 8 * (r >> 2) + 4 * hi; }
__device__ __forceinline__ unsigned cvtpk(float lo, float hi) { return pg8::cvt_pk_bf16(lo, hi); }
template <typename TIn> struct Stage;
template <> struct Stage<bf16>  { using T = bf16x8;
  __device__ static __forceinline__ T ld8(const bf16* p) { return *reinterpret_cast<const bf16x8*>(p); }
  __device__ static __forceinline__ bf16x8 tobf(T x) { return x; } };
template <> struct Stage<float> { using T = f32x8;
  __device__ static __forceinline__ T ld8(const float* p) { return *reinterpret_cast<const f32x8*>(p); }
  __device__ static __forceinline__ bf16x8 tobf(T x) {
    u32x4 w = {cvtpk(x[0], x[1]), cvtpk(x[2], x[3]), cvtpk(x[4], x[5]), cvtpk(x[6], x[7])}; return *reinterpret_cast<bf16x8*>(&w); } };

__device__ __forceinline__ void partialSM(f32x16& p0, f32x16& p1, float& m_reg, float& mn, float& alpha) {
  constexpr float C = SCALE * 1.4426950408889634f;
  float pmax = p0[0]; for (int r = 1; r < 16; ++r) pmax = fmaxf(pmax, p0[r]); for (int r = 0; r < 16; ++r) pmax = fmaxf(pmax, p1[r]);
  { auto rr = __builtin_amdgcn_permlane32_swap(__float_as_uint(pmax), __float_as_uint(pmax), false, false);
    pmax = fmaxf(__uint_as_float(rr[0]), __uint_as_float(rr[1])); }
  if (__builtin_expect(__all(pmax - m_reg <= THR / SCALE), 1)) { mn = m_reg; alpha = 1.f; }
  else { mn = fmaxf(m_reg, pmax); alpha = __builtin_amdgcn_exp2f((m_reg - mn) * C); m_reg = mn; }
  float mnC = -mn * C;
  for (int r = 0; r < 16; ++r) p0[r] = fmaf(p0[r], C, mnC); for (int r = 0; r < 16; ++r) p1[r] = fmaf(p1[r], C, mnC);
  for (int r = 0; r < 16; ++r) p0[r] = __builtin_amdgcn_exp2f(p0[r]);
}
__device__ __forceinline__ void finishSM(f32x16& p0, f32x16& p1, float alpha, float& l_reg, bf16x8& pa0, bf16x8& pa1, bf16x8& pa2, bf16x8& pa3) {
  for (int r = 0; r < 16; ++r) p1[r] = __builtin_amdgcn_exp2f(p1[r]);
  float ps = 0; for (int r = 0; r < 16; ++r) ps += p0[r]; for (int r = 0; r < 16; ++r) ps += p1[r];
  { auto rr = __builtin_amdgcn_permlane32_swap(__float_as_uint(ps), __float_as_uint(ps), false, false);
    ps = __uint_as_float(rr[0]) + __uint_as_float(rr[1]); }
  l_reg = l_reg * alpha + ps;
#define PK4(P, BASE, OUT) do { unsigned a0 = cvtpk(P[BASE + 0], P[BASE + 1]), a1 = cvtpk(P[BASE + 2], P[BASE + 3]);   \
    unsigned b0 = cvtpk(P[BASE + 4], P[BASE + 5]), b1 = cvtpk(P[BASE + 6], P[BASE + 7]);                              \
    auto r0 = __builtin_amdgcn_permlane32_swap(a0, b0, false, false); auto r1 = __builtin_amdgcn_permlane32_swap(a1, b1, false, false); \
    u32x4 w = {r0[0], r1[0], r0[1], r1[1]}; OUT = *reinterpret_cast<bf16x8*>(&w); } while (0)
  PK4(p0, 0, pa0); PK4(p0, 8, pa1); PK4(p1, 0, pa2); PK4(p1, 8, pa3);
#undef PK4
}
__device__ __forceinline__ void partialSM2(f32x16& p0, f32x16& p1, const float negBC) {
  constexpr float C = SCALE * 1.4426950408889634f;
  for (int r = 0; r < 16; ++r) p0[r] = fmaf(p0[r], C, negBC); for (int r = 0; r < 16; ++r) p1[r] = fmaf(p1[r], C, negBC);
  for (int r = 0; r < 16; ++r) p0[r] = __builtin_amdgcn_exp2f(p0[r]);
}
__device__ __forceinline__ void finishSM2(f32x16& p0, f32x16& p1, float& l_reg, bf16x8& pa0, bf16x8& pa1, bf16x8& pa2, bf16x8& pa3) {
  for (int r = 0; r < 16; ++r) p1[r] = __builtin_amdgcn_exp2f(p1[r]);
  float ps = 0; for (int r = 0; r < 16; ++r) ps += p0[r]; for (int r = 0; r < 16; ++r) ps += p1[r];
  l_reg += ps;
#define PK4(P, BASE, OUT) do { unsigned a0 = cvtpk(P[BASE + 0], P[BASE + 1]), a1 = cvtpk(P[BASE + 2], P[BASE + 3]);   \
    unsigned b0 = cvtpk(P[BASE + 4], P[BASE + 5]), b1 = cvtpk(P[BASE + 6], P[BASE + 7]);                              \
    auto r0 = __builtin_amdgcn_permlane32_swap(a0, b0, false, false); auto r1 = __builtin_amdgcn_permlane32_swap(a1, b1, false, false); \
    u32x4 w = {r0[0], r1[0], r0[1], r1[1]}; OUT = *reinterpret_cast<bf16x8*>(&w); } while (0)
  PK4(p0, 0, pa0); PK4(p0, 8, pa1); PK4(p1, 0, pa2); PK4(p1, 8, pa3);
#undef PK4
}
__device__ __forceinline__ void qkt(f32x16& p0, f32x16& p1, const bf16* Ks, const bf16x8* qr, int r32, int hi) {
  p0 = f32x16{}; p1 = f32x16{};
  for (int d0 = 0; d0 < 8; ++d0) { int cb = (d0 * 16 + hi * 8) * 2;
    bf16x8 b0 = *reinterpret_cast<const bf16x8*>((const char*)Ks + KSWZ(r32, cb));
    bf16x8 b1 = *reinterpret_cast<const bf16x8*>((const char*)Ks + KSWZ(32 + r32, cb));
    p0 = __builtin_amdgcn_mfma_f32_32x32x16_bf16(b0, qr[d0], p0, 0, 0, 0);
    p1 = __builtin_amdgcn_mfma_f32_32x32x16_bf16(b1, qr[d0], p1, 0, 0, 0); }
}
__device__ __forceinline__ void partialSM3(f32x16& p0) { for (int r = 0; r < 16; ++r) p0[r] = __builtin_amdgcn_exp2f(p0[r]); }
__device__ __forceinline__ void qkt3(f32x16& p0, f32x16& p1, const bf16* Ks, const bf16x8* qr, int r32, int hi, const f32x16& cinit) {
  { int cb = (hi * 8) * 2;
    bf16x8 b0 = *reinterpret_cast<const bf16x8*>((const char*)Ks + KSWZ(r32, cb));
    bf16x8 b1 = *reinterpret_cast<const bf16x8*>((const char*)Ks + KSWZ(32 + r32, cb));
    p0 = __builtin_amdgcn_mfma_f32_32x32x16_bf16(b0, qr[0], cinit, 0, 0, 0);
    p1 = __builtin_amdgcn_mfma_f32_32x32x16_bf16(b1, qr[0], cinit, 0, 0, 0); }
  for (int d0 = 1; d0 < 8; ++d0) { int cb = (d0 * 16 + hi * 8) * 2;
    bf16x8 b0 = *reinterpret_cast<const bf16x8*>((const char*)Ks + KSWZ(r32, cb));
    bf16x8 b1 = *reinterpret_cast<const bf16x8*>((const char*)Ks + KSWZ(32 + r32, cb));
    p0 = __builtin_amdgcn_mfma_f32_32x32x16_bf16(b0, qr[d0], p0, 0, 0, 0);
    p1 = __builtin_amdgcn_mfma_f32_32x32x16_bf16(b1, qr[d0], p1, 0, 0, 0); }
}
__device__ __forceinline__ int v_st(int k, int c) { const int kk = (k & ~0xC) | ((k & 4) << 1) | ((k & 8) >> 1); return ((kk >> 3) * 4 + (c >> 5)) * 512 + ((kk & 7) * 32 + (c & 31)) * 2; }
__device__ __forceinline__ int v_rd_base(int lane) { return ((lane & 3) << 3) | (((lane >> 2) & 3) << 6) | (((lane >> 4) & 1) << 5) | (((lane >> 5) & 1) << 8); }
constexpr int v_rd_off(int d0, int ks, int half) { return d0 * 512 + ks * 4096 + half * 2048; }
template <int OFF> __device__ __forceinline__ s16x4 tr_read(int vb) {
  s16x4 r; asm volatile("ds_read_b64_tr_b16 %0, %1 offset:%2" : "=&v"(r) : "v"(vb), "i"(OFF) : "memory"); return r;
}
template <int D0> __device__ __forceinline__ void pv_one(f32x16& od, int vb, bf16x8 pa0, bf16x8 pa1, bf16x8 pa2, bf16x8 pa3) {
  const s16x4 l0 = tr_read<v_rd_off(D0, 0, 0)>(vb), h0 = tr_read<v_rd_off(D0, 0, 1)>(vb), l1 = tr_read<v_rd_off(D0, 1, 0)>(vb), h1 = tr_read<v_rd_off(D0, 1, 1)>(vb);
  const s16x4 l2 = tr_read<v_rd_off(D0, 2, 0)>(vb), h2 = tr_read<v_rd_off(D0, 2, 1)>(vb), l3 = tr_read<v_rd_off(D0, 3, 0)>(vb), h3 = tr_read<v_rd_off(D0, 3, 1)>(vb);
  asm volatile("s_waitcnt lgkmcnt(0)" ::: "memory"); SBAR();
#define PK(L, H) (bf16x8){L[0], L[1], L[2], L[3], H[0], H[1], H[2], H[3]}
  od = __builtin_amdgcn_mfma_f32_32x32x16_bf16(pa0, PK(l0, h0), od, 0, 0, 0);
  od = __builtin_amdgcn_mfma_f32_32x32x16_bf16(pa1, PK(l1, h1), od, 0, 0, 0);
  od = __builtin_amdgcn_mfma_f32_32x32x16_bf16(pa2, PK(l2, h2), od, 0, 0, 0);
  od = __builtin_amdgcn_mfma_f32_32x32x16_bf16(pa3, PK(l3, h3), od, 0, 0, 0);
#undef PK
}
__device__ __forceinline__ void pv_d0(f32x16* o, int vb, bf16x8 pa0, bf16x8 pa1, bf16x8 pa2, bf16x8 pa3) {
  pv_one<0>(o[0], vb, pa0, pa1, pa2, pa3); pv_one<1>(o[1], vb, pa0, pa1, pa2, pa3); pv_one<2>(o[2], vb, pa0, pa1, pa2, pa3); pv_one<3>(o[3], vb, pa0, pa1, pa2, pa3);
}

template <int FIRST> __device__ __forceinline__ void finishSM4(f32x16& p0, f32x16& p1, float& l_reg, bf16x8& pa0, bf16x8& pa1, bf16x8& pa2, bf16x8& pa3) {
  for (int r = FIRST; r < 16; ++r) p1[r] = __builtin_amdgcn_exp2f(p1[r]);
  float ps = 0; for (int r = 0; r < 16; ++r) ps += p0[r]; for (int r = 0; r < 16; ++r) ps += p1[r];
  l_reg += ps;
#define PK8(P, BASE, OUT) do { u32x4 w = {cvtpk(P[BASE + 0], P[BASE + 1]), cvtpk(P[BASE + 2], P[BASE + 3]), cvtpk(P[BASE + 4], P[BASE + 5]), cvtpk(P[BASE + 6], P[BASE + 7])}; OUT = *reinterpret_cast<bf16x8*>(&w); } while (0)
  PK8(p0, 0, pa0); PK8(p0, 8, pa1); PK8(p1, 0, pa2); PK8(p1, 8, pa3);
#undef PK8
}
__device__ __forceinline__ int v_rd_base2(int lane) { return ((lane & 3) << 3) | (((lane >> 2) & 3) << 6) | (((lane >> 4) & 1) << 5) | (((lane >> 5) & 1) << 11); }
constexpr int v_rd_off2(int d0, int ks, int part) { return d0 * 512 + ks * 4096 + part * 256; }
template <int D0> __device__ __forceinline__ void pv_one2(f32x16& od, int vb, bf16x8 pa0, bf16x8 pa1, bf16x8 pa2, bf16x8 pa3) {
  const s16x4 l0 = tr_read<v_rd_off2(D0, 0, 0)>(vb), h0 = tr_read<v_rd_off2(D0, 0, 1)>(vb), l1 = tr_read<v_rd_off2(D0, 1, 0)>(vb), h1 = tr_read<v_rd_off2(D0, 1, 1)>(vb);
  const s16x4 l2 = tr_read<v_rd_off2(D0, 2, 0)>(vb), h2 = tr_read<v_rd_off2(D0, 2, 1)>(vb), l3 = tr_read<v_rd_off2(D0, 3, 0)>(vb), h3 = tr_read<v_rd_off2(D0, 3, 1)>(vb);
  asm volatile("s_waitcnt lgkmcnt(0)" ::: "memory"); SBAR();
#define PK(L, H) (bf16x8){L[0], L[1], L[2], L[3], H[0], H[1], H[2], H[3]}
  od = __builtin_amdgcn_mfma_f32_32x32x16_bf16(PK(l0, h0), pa0, od, 0, 0, 0);
  od = __builtin_amdgcn_mfma_f32_32x32x16_bf16(PK(l1, h1), pa1, od, 0, 0, 0);
  od = __builtin_amdgcn_mfma_f32_32x32x16_bf16(PK(l2, h2), pa2, od, 0, 0, 0);
  od = __builtin_amdgcn_mfma_f32_32x32x16_bf16(PK(l3, h3), pa3, od, 0, 0, 0);
#undef PK
}
#define PV_RD2(D0, X) const s16x4 X##l0 = tr_read<v_rd_off2(D0, 0, 0)>(vb), X##h0 = tr_read<v_rd_off2(D0, 0, 1)>(vb), X##l1 = tr_read<v_rd_off2(D0, 1, 0)>(vb), X##h1 = tr_read<v_rd_off2(D0, 1, 1)>(vb), \
                              X##l2 = tr_read<v_rd_off2(D0, 2, 0)>(vb), X##h2 = tr_read<v_rd_off2(D0, 2, 1)>(vb), X##l3 = tr_read<v_rd_off2(D0, 3, 0)>(vb), X##h3 = tr_read<v_rd_off2(D0, 3, 1)>(vb)
#define PV_PK2(L, H) (bf16x8){L[0], L[1], L[2], L[3], H[0], H[1], H[2], H[3]}
#define PV_MM2(OD, X) do { OD = __builtin_amdgcn_mfma_f32_32x32x16_bf16(PV_PK2(X##l0, X##h0), pa0, OD, 0, 0, 0); OD = __builtin_amdgcn_mfma_f32_32x32x16_bf16(PV_PK2(X##l1, X##h1), pa1, OD, 0, 0, 0); \
                           OD = __builtin_amdgcn_mfma_f32_32x32x16_bf16(PV_PK2(X##l2, X##h2), pa2, OD, 0, 0, 0); OD = __builtin_amdgcn_mfma_f32_32x32x16_bf16(PV_PK2(X##l3, X##h3), pa3, OD, 0, 0, 0); } while (0)
__device__ __forceinline__ void pv_d02(f32x16* o, int vb, bf16x8 pa0, bf16x8 pa1, bf16x8 pa2, bf16x8 pa3) {
  PV_RD2(0, a);
  PV_RD2(1, b); asm volatile("s_waitcnt lgkmcnt(8)" ::: "memory"); SBAR(); PV_MM2(o[0], a); SBAR();
  PV_RD2(2, c); asm volatile("s_waitcnt lgkmcnt(8)" ::: "memory"); SBAR(); PV_MM2(o[1], b); SBAR();
  PV_RD2(3, d); asm volatile("s_waitcnt lgkmcnt(8)" ::: "memory"); SBAR(); PV_MM2(o[2], c); SBAR();
  asm volatile("s_waitcnt lgkmcnt(0)" ::: "memory"); SBAR(); PV_MM2(o[3], d);
}
#define EXP4(P, B) do { P[(B) + 0] = __builtin_amdgcn_exp2f(P[(B) + 0]); P[(B) + 1] = __builtin_amdgcn_exp2f(P[(B) + 1]); P[(B) + 2] = __builtin_amdgcn_exp2f(P[(B) + 2]); P[(B) + 3] = __builtin_amdgcn_exp2f(P[(B) + 3]); } while (0)
#define EXP2_(P, B) do { P[(B) + 0] = __builtin_amdgcn_exp2f(P[(B) + 0]); P[(B) + 1] = __builtin_amdgcn_exp2f(P[(B) + 1]); } while (0)
__device__ __forceinline__ void pv_d03(f32x16* o, int vb, bf16x8 pa0, bf16x8 pa1, bf16x8 pa2, bf16x8 pa3, f32x16& pn, f32x16& pm) {
  PV_RD2(0, a);
  PV_RD2(1, b); asm volatile("s_waitcnt lgkmcnt(8)" ::: "memory"); SBAR(); PV_MM2(o[0], a); EXP4(pn, 0); EXP2_(pm, 0); SBAR();
  PV_RD2(2, c); asm volatile("s_waitcnt lgkmcnt(8)" ::: "memory"); SBAR(); PV_MM2(o[1], b); EXP4(pn, 4); EXP2_(pm, 2); SBAR();
  PV_RD2(3, d); asm volatile("s_waitcnt lgkmcnt(8)" ::: "memory"); SBAR(); PV_MM2(o[2], c); EXP4(pn, 8); EXP2_(pm, 4); SBAR();
  asm volatile("s_waitcnt lgkmcnt(0)" ::: "memory"); SBAR(); PV_MM2(o[3], d); EXP4(pn, 12); EXP2_(pm, 6);
}
__device__ __forceinline__ void attn_dense_body(const bf16* Qb, const bf16* __restrict__ Kh, const bf16* __restrict__ Vh, const bf16* __restrict__ Zb,
                                                bf16* Ob, int seq, char* lds, const int wid_in, const float kmax, __attribute__((address_space(3))) unsigned char* lds3) {
  using St = Stage<bf16>; using SQ = Stage<bf16>; using TQ = bf16;
  int lane = __builtin_amdgcn_mbcnt_hi(~0u, __builtin_amdgcn_mbcnt_lo(~0u, 0u)); asm volatile("" : "+v"(lane));
  const int wid = wid_in, tid = wid * 64 + lane, r32 = lane & 31, hi = lane >> 5;
  bf16* V_lds = (bf16*)lds; bf16* K_lds = (bf16*)(lds + 3 * SHM_V);
  float l_reg = 0; f32x16 o[4] = {}; bf16x8 qr[8];
  const TQ* Qw = Qb + (long)(wid * QBLK + r32) * LDQ + hi * 8;
#pragma unroll
  for (int d0 = 0; d0 < 8; ++d0) qr[d0] = SQ::tobf(SQ::ld8(Qw + d0 * 16));
  float negBC;
  { float ss = 0.f;
#pragma unroll
    for (int d0 = 0; d0 < 8; ++d0)
#pragma unroll
      for (int e = 0; e < 8; ++e) { const float qv = __uint_as_float((unsigned)(unsigned short)qr[d0][e] << 16); ss = fmaf(qv, qv, ss); }
    auto rr = __builtin_amdgcn_permlane32_swap(__float_as_uint(ss), __float_as_uint(ss), false, false);
    ss = __uint_as_float(rr[0]) + __uint_as_float(rr[1]);
    negBC = -(sqrtf(ss) * kmax * (11.313708498984761f * 1.01f) + 0.07f); }
  f32x16 cinit; for (int r = 0; r < 16; ++r) cinit[r] = negBC;
  const int vb0 = (int)(uintptr_t)V_lds + v_rd_base2(lane);
  int koff0, koff1, voff0, voff1;
  { const int rk0 = 8 * wid + (lane >> 4), rk1 = rk0 + 4; koff0 = rk0 * (LDK * 2) + (((lane & 15) ^ (rk0 & 15)) << 4); koff1 = rk1 * (LDK * 2) + (((lane & 15) ^ (rk1 & 15)) << 4);
    const int st0 = 4 * wid + (lane >> 5), st1 = st0 + 2, q8 = (lane & 31) >> 2;
    const int kk0 = ((st0 >> 2) << 3) | q8, kk1 = ((st1 >> 2) << 3) | q8;
    const int ky0 = (kk0 & ~0xC) | ((kk0 & 4) << 1) | ((kk0 & 8) >> 1), ky1 = (kk1 & ~0xC) | ((kk1 & 4) << 1) | ((kk1 & 8) >> 1);
    voff0 = ky0 * (LDK * 2) + ((st0 & 3) * 32 + (lane & 3) * 8) * 2; voff1 = ky1 * (LDK * 2) + ((st1 & 3) * 32 + (lane & 3) * 8) * 2; }
#define SDMA(s, k0) do { const char* kg_ = (const char*)(Kh + (long)(k0) * LDK); const char* vg_ = (const char*)(Vh + (long)(k0) * LDK); \
    __attribute__((address_space(3))) unsigned char* kd_ = lds3 + 3 * (int)SHM_V + (s) * (int)SHM_K + wid * 2048; __attribute__((address_space(3))) unsigned char* vd_ = lds3 + (s) * (int)SHM_V + wid * 2048; \
    __builtin_amdgcn_global_load_lds((const unsigned*)(kg_ + koff0), (__attribute__((address_space(3))) unsigned*)kd_, 16, 0, 0); \
    __builtin_amdgcn_global_load_lds((const unsigned*)(kg_ + koff1), (__attribute__((address_space(3))) unsigned*)(kd_ + 1024), 16, 0, 0); \
    __builtin_amdgcn_global_load_lds((const unsigned*)(vg_ + voff0), (__attribute__((address_space(3))) unsigned*)vd_, 16, 0, 0); \
    __builtin_amdgcn_global_load_lds((const unsigned*)(vg_ + voff1), (__attribute__((address_space(3))) unsigned*)(vd_ + 1024), 16, 0, 0); } while (0)
#define DWAIT() asm volatile("s_waitcnt vmcnt(0)" ::: "memory")
  f32x16 pA0, pA1, pB0, pB1; bf16x8 pa0, pa1, pa2, pa3; const int NT = seq / KVBLK;
  SDMA(0, 0); DWAIT(); __syncthreads();
  SDMA(1, KVBLK);
  qkt3(pA0, pA1, K_lds, qr, r32, hi, cinit); partialSM3(pA0);
  for (int r = 0; r < 8; ++r) pA1[r] = __builtin_amdgcn_exp2f(pA1[r]);
  DWAIT(); __syncthreads();
  int sP = 0, sC = 1, sN = 2;
#define KSLOT(s) ((bf16*)((char*)K_lds + (s) * (int)SHM_K))
#define ROT() do { const int t_ = sP; sP = sC; sC = sN; sN = t_; } while (0)
  for (int j = 1; j + 1 < NT; j += 2) {
    SDMA(sN, (j + 1) * KVBLK);
    SBAR(); qkt3(pB0, pB1, KSLOT(sC), qr, r32, hi, cinit);
    finishSM4<8>(pA0, pA1, l_reg, pa0, pa1, pa2, pa3);
    pv_d03(o, vb0 + sP * (int)SHM_V, pa0, pa1, pa2, pa3, pB0, pB1);
    DWAIT(); __syncthreads(); ROT();
    SDMA(sN, (j + 2) * KVBLK);
    SBAR(); qkt3(pA0, pA1, KSLOT(sC), qr, r32, hi, cinit);
    finishSM4<8>(pB0, pB1, l_reg, pa0, pa1, pa2, pa3);
    pv_d03(o, vb0 + sP * (int)SHM_V, pa0, pa1, pa2, pa3, pA0, pA1);
    DWAIT(); __syncthreads(); ROT();
  }
  SBAR(); qkt3(pB0, pB1, KSLOT(sC), qr, r32, hi, cinit);
  finishSM4<8>(pA0, pA1, l_reg, pa0, pa1, pa2, pa3); SBAR();
  pv_d03(o, vb0 + sP * (int)SHM_V, pa0, pa1, pa2, pa3, pB0, pB1);
  finishSM4<8>(pB0, pB1, l_reg, pa0, pa1, pa2, pa3); SBAR();
  pv_d02(o, vb0 + sC * (int)SHM_V, pa0, pa1, pa2, pa3);
#undef KSLOT
#undef ROT
#undef SDMA
#undef DWAIT
  { auto rr = __builtin_amdgcn_permlane32_swap(__float_as_uint(l_reg), __float_as_uint(l_reg), false, false); l_reg = __uint_as_float(rr[0]) + __uint_as_float(rr[1]); }
  const float rl = __builtin_amdgcn_rcpf(l_reg);
  { int lb = (wid * QBLK + r32) * LDO + 4 * hi; asm volatile("" : "+v"(lb));
    unsigned short* Ow = (unsigned short*)Ob + lb; const unsigned short* Zw = (const unsigned short*)Zb + lb;
#pragma unroll
    for (int d0 = 0; d0 < 4; ++d0)
#pragma unroll
      for (int g = 0; g < 4; ++g) { const int co = d0 * 32 + 8 * g; const unsigned long long zz = *(const unsigned long long*)(Zw + co);
        const float z0 = __uint_as_float((unsigned)(zz << 16)), z1 = __uint_as_float((unsigned)zz & 0xffff0000u), z2 = __uint_as_float((unsigned)(zz >> 32) << 16), z3 = __uint_as_float((unsigned)(zz >> 32) & 0xffff0000u);
        const unsigned w0 = cvtpk(o[d0][4 * g + 0] * rl * z0, o[d0][4 * g + 1] * rl * z1), w1 = cvtpk(o[d0][4 * g + 2] * rl * z2, o[d0][4 * g + 3] * rl * z3);
        *(unsigned long long*)(Ow + co) = (unsigned long long)w0 | ((unsigned long long)w1 << 32); } }
}
}

typedef unsigned short bf16_t;
typedef float f32x4 __attribute__((ext_vector_type(4)));
typedef unsigned u32x4 __attribute__((ext_vector_type(4)));
typedef unsigned u32x2v __attribute__((ext_vector_type(2)));
typedef short bf16x8v __attribute__((ext_vector_type(8)));
typedef float f32x16v __attribute__((ext_vector_type(16)));
#define LAS __attribute__((address_space(3)))
#define XB_TMO      128
#define XB_XCNT(j)  (256  + 64 * (j))
#define XB_XSUB(j)  (1280 + 64 * (j))
#define XB_XGEN(j)  (2304 + 64 * (j))
#define XB_TOP      3328
#define XB_TOPGEN   3392
#define XCD_BAR_WORDS 3456
#define XB_SPIN_CAP (1u << 18)

__device__ __forceinline__ unsigned xb_ld(unsigned* p)              { return __hip_atomic_load(p, __ATOMIC_RELAXED, __HIP_MEMORY_SCOPE_AGENT); }
__device__ __forceinline__ unsigned xb_add(unsigned* p, unsigned v) { return __hip_atomic_fetch_add(p, v, __ATOMIC_RELAXED, __HIP_MEMORY_SCOPE_AGENT); }
__device__ __forceinline__ unsigned xb_xcc_id() { return (unsigned)__builtin_amdgcn_s_getreg((3 << 11) | 20) & 0xFu; }
#define XB_SPIN(cond, bar) do { unsigned _sp = 0; while (cond) { __builtin_amdgcn_s_sleep(1); \
    if ((++_sp & 255u) == 0u) { if (xb_ld(&(bar)[XB_TMO])) break; if (_sp > XB_SPIN_CAP) { atomicAdd(&(bar)[XB_TMO], 1u); break; } } } } while (0)

struct XcdBarrier {
    unsigned* bar; unsigned x;
    volatile LAS unsigned* st;
};

__device__ __forceinline__ XcdBarrier xcd_barrier_post(unsigned* bar, volatile LAS unsigned* st, const bool leader) {
    XcdBarrier b; b.bar = bar; b.x = xb_xcc_id(); b.st = st;
    if (leader) (void)xb_add(&bar[XB_XCNT(b.x)], 1u);
    return b;
}
__device__ __forceinline__ void xcd_barrier_complete(unsigned* bar, unsigned x, unsigned& nloc, unsigned& nx) {
    const unsigned G = gridDim.x * gridDim.y * gridDim.z;
    unsigned sum, cnt, mine, sp = 0u;
    for (;;) {
        sum = 0u; cnt = 0u; mine = 0u;
#pragma unroll
        for (unsigned j = 0; j < 16; ++j) { const unsigned c = xb_ld(&bar[XB_XCNT(j)]); sum += c; cnt += (c > 0u) ? 1u : 0u; mine = (j == x) ? c : mine; }
        if (sum == G) break;
        __builtin_amdgcn_s_sleep(1);
        if ((++sp & 255u) == 0u) { if (xb_ld(&bar[XB_TMO])) break; if (sp > XB_SPIN_CAP) { atomicAdd(&bar[XB_TMO], 1u); break; } }
    }
    nloc = mine > 0u ? mine : 1u; nx = cnt > 0u ? cnt : 1u;
}

__device__ __forceinline__ void xcd_barrier(const XcdBarrier& b, const bool leader) {
    asm volatile("s_waitcnt vmcnt(0)" ::: "memory");
    __syncthreads();
    if (leader) {
        unsigned* bar = b.bar;
        __builtin_amdgcn_s_waitcnt(0);
        unsigned nloc = b.st[0], nx = b.st[1];
        if (nloc == 0u) { xcd_barrier_complete(bar, b.x, nloc, nx); b.st[0] = nloc; b.st[1] = nx; }
        const unsigned old = xb_add(&bar[XB_XSUB(b.x)], 1u);
        const unsigned gen = old / nloc;
        if (old + 1u == (gen + 1u) * nloc) {
            __builtin_amdgcn_fence(__ATOMIC_RELEASE, "agent");
            asm volatile("s_waitcnt vmcnt(0)" ::: "memory");
            const unsigned og = xb_add(&bar[XB_TOP], 1u);
            const unsigned tg = og / nx;
            if (og + 1u == (tg + 1u) * nx) xb_add(&bar[XB_TOPGEN], 1u);
            else XB_SPIN(xb_ld(&bar[XB_TOPGEN]) == tg, bar);
            __builtin_amdgcn_fence(__ATOMIC_ACQUIRE, "agent");
            xb_add(&bar[XB_XGEN(b.x)], 1u);
            asm volatile("s_waitcnt vmcnt(0)" ::: "memory");
        } else {
            XB_SPIN(xb_ld(&bar[XB_XGEN(b.x)]) == gen, bar);
            __builtin_amdgcn_fence(__ATOMIC_ACQUIRE, "agent");
            asm volatile("s_waitcnt vmcnt(0)" ::: "memory");
        }
    }
    __syncthreads();
}

constexpr int RING_BYTES = pg8::STAGE_BYTES;
constexpr int PART_OFF = RING_BYTES;
constexpr int XBST_OFF = RING_BYTES + 8192;
constexpr int LDS_BYTES = RING_BYTES + 8192 + 16;

__device__ __forceinline__ unsigned pk2(float a, float b) { return pg8::cvt_pk_bf16(a, b); }
__device__ __forceinline__ float wave_sum(float v) {
#pragma unroll
    for (int o = 1; o < 64; o <<= 1) v += __shfl_xor(v, o);
    return v;
}
__device__ __forceinline__ const float* xrow_c(const float* lat, const float* cx, int r) {
    const int b = r / TB, rr = r - b * TB;
    return rr < CTXL ? cx + ((size_t)b * CTXL + rr) * DM : lat + ((size_t)b * SEQ + (rr - CTXL)) * DM;
}
__device__ __forceinline__ int qk_src(int c) { const int h = c & ~127, cp = c & 127;
    return h + ((cp >> 6) & 1) * 64 + ((cp >> 2) & 1) * 32 + ((cp >> 5) & 1) * 16 + ((cp >> 3) & 3) * 4 + (cp & 3); }

__device__ __forceinline__ void transpose_item(const float* W, int K, int N, bf16_t* WT, LAS float* scr, int item, int lane, int nperm) {
    const int nblk = N / 32, kb = item / nblk, nb = item % nblk, k0 = 64 * kb, n0 = 32 * nb;
    const int cdst = n0 + (lane & 31), csrc = cdst < nperm ? qk_src(cdst) : cdst;
#pragma unroll 8
    for (int i = 0; i < 32; ++i) { const int kk = 2 * i + (lane >> 5); scr[kk * 33 + (lane & 31)] = W[(size_t)(k0 + kk) * N + csrc]; }
    asm volatile("s_waitcnt lgkmcnt(0)" ::: "memory");
    const int c = lane & 7;
#pragma unroll
    for (int j = 0; j < 4; ++j) { const int n = (lane >> 3) + 8 * j; const LAS float* s = scr + (8 * c) * 33 + n;
        u32x4 o; o.x = pk2(s[0 * 33], s[1 * 33]); o.y = pk2(s[2 * 33], s[3 * 33]); o.z = pk2(s[4 * 33], s[5 * 33]); o.w = pk2(s[6 * 33], s[7 * 33]);
        *(u32x4*)(WT + (size_t)(n0 + n) * K + k0 + 8 * c) = o; }
    asm volatile("s_waitcnt lgkmcnt(0)" ::: "memory");
}

template <int GI> __device__ __forceinline__ void pool_unit_t(const bf16_t* XB, bf16_t* ZB, const bf16_t* WPt, const float* pscale, int R0, int lane) {
    constexpr int g = GI, a = 1 << GI;
    const int pm = R0 >> 8, b = pm / 65, jt = pm % 65;
    const int lo = b * TB + (jt ? CTXL : 0), hiR = jt ? (b + 1) * TB : b * TB + CTXL;
    const int r32 = lane & 31, hh = lane >> 5, t = R0 + r32;
    const int s0 = max(t - a, lo), s1 = min(t + a - 1, hiR - 1); const float inv = 1.0f / (float)(s1 - s0 + 1);
    f32x16v acc0 = {}, acc1 = {}, acc2 = {}, acc3 = {};
    const bf16_t* xb = XB + g * 128 + hh * 8;
    const bf16_t* wp = WPt + (size_t)(g * 128 + r32) * 128 + hh * 8;
    float wq[2 * a]; int rq[2 * a];
#pragma unroll
    for (int q = 0; q < 2 * a; ++q) { const int rr = t - a + q; const bool ok = (rr >= lo) && (rr < hiR); wq[q] = ok ? inv : 0.f; rq[q] = ok ? rr : t; }
#pragma unroll 1
    for (int kk = 0; kk < 8; ++kk) {
        u32x4 wv[2 * a];
#pragma unroll
        for (int q = 0; q < 2 * a; ++q) wv[q] = *(const u32x4*)(xb + (size_t)rq[q] * 512 + kk * 16);
        const u32x4 w = *(const u32x4*)(xb + (size_t)t * 512 + kk * 16);
        const bf16x8v w0 = *(const bf16x8v*)(wp + kk * 16), w1 = *(const bf16x8v*)(wp + 32 * 128 + kk * 16), w2 = *(const bf16x8v*)(wp + 64 * 128 + kk * 16), w3 = *(const bf16x8v*)(wp + 96 * 128 + kk * 16);
        float s[8] = {0.f, 0.f, 0.f, 0.f, 0.f, 0.f, 0.f, 0.f};
#pragma unroll
        for (int q = 0; q < 2 * a; ++q) { const float f = wq[q]; const u32x4 v = wv[q];
            s[0] += f * pg8::bf_lo(v.x); s[1] += f * pg8::bf_hi(v.x); s[2] += f * pg8::bf_lo(v.y); s[3] += f * pg8::bf_hi(v.y); s[4] += f * pg8::bf_lo(v.z); s[5] += f * pg8::bf_hi(v.z); s[6] += f * pg8::bf_lo(v.w); s[7] += f * pg8::bf_hi(v.w); }
        u32x4 mf; mf.x = pk2(s[0] - pg8::bf_lo(w.x), s[1] - pg8::bf_hi(w.x)); mf.y = pk2(s[2] - pg8::bf_lo(w.y), s[3] - pg8::bf_hi(w.y));
        mf.z = pk2(s[4] - pg8::bf_lo(w.z), s[5] - pg8::bf_hi(w.z)); mf.w = pk2(s[6] - pg8::bf_lo(w.w), s[7] - pg8::bf_hi(w.w));
        const bf16x8v mfrag = *reinterpret_cast<bf16x8v*>(&mf);
        acc0 = __builtin_amdgcn_mfma_f32_32x32x16_bf16(w0, mfrag, acc0, 0, 0, 0); acc1 = __builtin_amdgcn_mfma_f32_32x32x16_bf16(w1, mfrag, acc1, 0, 0, 0);
        acc2 = __builtin_amdgcn_mfma_f32_32x32x16_bf16(w2, mfrag, acc2, 0, 0, 0); acc3 = __builtin_amdgcn_mfma_f32_32x32x16_bf16(w3, mfrag, acc3, 0, 0, 0);
    }
    bf16_t* zrow = ZB + (size_t)t * 512 + g * 128; const float* ps = pscale + g * 128;
#define POOL_OUT(ACC, NS) do { _Pragma("unroll") for (int q = 0; q < 4; ++q) { const int n0 = (NS) * 32 + 8 * q + 4 * hh; const u32x2v z = *(const u32x2v*)(zrow + n0); const f32x4 p4 = *(const f32x4*)(ps + n0); \
        u32x2v o; o.x = pk2(ACC[4 * q + 0] * p4[0] * pg8::bf_lo(z.x), ACC[4 * q + 1] * p4[1] * pg8::bf_hi(z.x)); o.y = pk2(ACC[4 * q + 2] * p4[2] * pg8::bf_lo(z.y), ACC[4 * q + 3] * p4[3] * pg8::bf_hi(z.y)); \
        *(u32x2v*)(zrow + n0) = o; } } while (0)
    POOL_OUT(acc0, 0); POOL_OUT(acc1, 1); POOL_OUT(acc2, 2); POOL_OUT(acc3, 3);
#undef POOL_OUT
}
__device__ __forceinline__ void pool_unit(const bf16_t* XB, bf16_t* ZB, const bf16_t* WPt, const float* pscale, int wu, int lane) {
    const int g = wu & 3, R0 = (wu >> 2) * 32;
    if (g == 0) pool_unit_t<0>(XB, ZB, WPt, pscale, R0, lane); else if (g == 1) pool_unit_t<1>(XB, ZB, WPt, pscale, R0, lane);
    else if (g == 2) pool_unit_t<2>(XB, ZB, WPt, pscale, R0, lane); else pool_unit_t<3>(XB, ZB, WPt, pscale, R0, lane);
}

__device__ __forceinline__ void store_u(const f32x4 (&v)[4], const float* mod, bf16_t* urow, int lane) {
#pragma unroll
    for (int j = 0; j < 4; ++j) { const int c = 4 * lane + 256 * j; const f32x4 sh = *(const f32x4*)(mod + c), sc = *(const f32x4*)(mod + 1024 + c);
        const f32x4 u = v[j] * (sc + 1.0f) + sh; u32x2v o; o.x = pk2(u[0], u[1]); o.y = pk2(u[2], u[3]); *(u32x2v*)(urow + c) = o; }
}

__global__ void __launch_bounds__(NTHREADS, 2) mega(Params P) {
    extern __shared__ __attribute__((aligned(16))) unsigned char lds[];
    cg::grid_group grid = cg::this_grid();
    const int wave = __builtin_amdgcn_readfirstlane(threadIdx.x >> 6);
#define LANE_ID() (__builtin_amdgcn_mbcnt_hi(~0u, __builtin_amdgcn_mbcnt_lo(~0u, 0u)))
    const int G = gridDim.x, bid = blockIdx.x, gw = bid * NWAVES + wave, NGW = G * NWAVES;
#define GRID_SYNC() xcd_barrier(xbar, wave == 0 && LANE_ID() == 0)
#define CAS __attribute__((address_space(4)))
#define WSL() const CAS Params* pp = (const CAS Params*)__builtin_amdgcn_kernarg_segment_ptr(); asm volatile("" : "+s"(pp)); unsigned char* wsl = pp->ws; asm volatile("" : "+s"(wsl))
#define U ((bf16_t*)(wsl + WS_U))
#define Q ((bf16_t*)(wsl + WS_Q))
#define Kb ((bf16_t*)(wsl + WS_K))
#define Vb ((bf16_t*)(wsl + WS_V))
#define ZA ((bf16_t*)(wsl + WS_ZA))
#define XB ((bf16_t*)(wsl + WS_XB))
#define ZB ((bf16_t*)(wsl + WS_ZB))
#define MOD ((float*)(wsl + WS_MOD))
#define CX ((float*)(wsl + WS_CX))
#define DELTA ((const bf16_t*)(wsl + WS_GA))
    LAS unsigned char* l3 = (LAS unsigned char*)lds;
    const CAS Params* pp0 = (const CAS Params*)__builtin_amdgcn_kernarg_segment_ptr();
    { volatile LAS unsigned* st = (volatile LAS unsigned*)(l3 + XBST_OFF); if (wave == 0 && LANE_ID() == 0) { st[0] = 0u; st[1] = 0u; st[2] = 0u; st[3] = 0u; } }
    __syncthreads();
    XcdBarrier xbar = xcd_barrier_post((unsigned*)(pp0->ws + WS_BAR), (volatile LAS unsigned*)(l3 + XBST_OFF), wave == 0 && LANE_ID() == 0);
    grid.sync();

    constexpr int NPH = 2 + 5 * DEPTH;
#pragma unroll 1
    for (int ph = 0; ph < NPH; ++ph) {
    const int l = ph < 2 ? 0 : (ph - 2) / 5, sph = ph < 2 ? ph : 2 + (ph - 2) % 5;
    if (sph == 0) {
        WSL(); int lane = LANE_ID(); asm volatile("" : "+v"(lane)); const int tid = wave * 64 + lane; unsigned char* ws = wsl; float* cosT = (float*)(wsl + WS_ROPE); float* sinT = cosT + 256 * 32;
        LAS float* scr = (LAS float*)(l3 + wave * 16384);
        constexpr int I_IN = (DM / 64) * (NIN / 32), I_A = (DM / 64) * (DM / 32), I_B = (512 / 64) * (DM / 32), I_O = I_A, I_P = (128 / 64) * (128 / 32);
        constexpr int PER_L = I_IN + I_A + I_B + I_O + 4 * I_P;
        for (int it = gw; it < DEPTH * PER_L; it += NGW) {
            const int l = it / PER_L; int r = it - l * PER_L;
            if (r < I_IN) { transpose_item(pp->w_in + (size_t)l * DM * NIN, DM, NIN, (bf16_t*)(ws + WS_WIN + l * SZ_WIN), scr, r, lane, 1280); continue; } r -= I_IN;
            if (r < I_A) { transpose_item(pp->w_br_a + (size_t)l * DM * DM, DM, DM, (bf16_t*)(ws + WS_WA + l * SZ_WA), scr, r, lane, 0); continue; } r -= I_A;
            if (r < I_B) { transpose_item(pp->w_br_b + (size_t)l * 512 * DM, 512, DM, (bf16_t*)(ws + WS_WB + l * SZ_WB), scr, r, lane, 0); continue; } r -= I_B;
            if (r < I_O) { transpose_item(pp->w_out + (size_t)l * DM * DM, DM, DM, (bf16_t*)(ws + WS_WO + l * SZ_WO), scr, r, lane, 0); continue; } r -= I_O;
            const int g = r / I_P; r -= g * I_P;
            transpose_item(pp->w_pool + ((size_t)l * 4 + g) * 128 * 128, 128, 128, (bf16_t*)(ws + WS_WP + l * SZ_WP) + (size_t)g * 128 * 128, scr, r, lane, 0);
        }
        for (int i = bid * NTHREADS + tid; i < 256 * 32; i += G * NTHREADS) { const int pos = i >> 5, f = i & 31;
            const float invf = 1.0f / __builtin_amdgcn_exp2f(13.287712379549449f * (float)f * (1.0f / 32.0f)); const float ang = (float)pos * invf;
            double rev = (double)ang * 0.15915494309189535; rev -= floor(rev); const float fr_ = (float)rev;
            cosT[i] = __builtin_amdgcn_cosf(fr_); sinT[i] = __builtin_amdgcn_sinf(fr_); }
        __syncthreads();
        LAS float* sv = (LAS float*)l3;
        LAS float* red = sv + 3 * 1024;
        for (int i = tid; i < 3 * 1024; i += NTHREADS) { const int v = i >> 10, k = i & 1023; const float cv = v < 2 ? pp->c[v * 1024 + k] : pp->c_ctx[k]; sv[i] = cv * pg8::sigm(cv); }
        __syncthreads();
        for (int un = bid; un < DEPTH * 48; un += G) { const int l = un / 48, n = (un % 48) * 64 + lane, ks = wave;
            const float* wm = pp->w_mod + (size_t)l * DM * 3072 + (size_t)(ks * 128) * 3072 + n; float a0 = 0.f, a1 = 0.f, a2 = 0.f;
#pragma unroll 8
            for (int k = 0; k < 128; ++k) { const float w = wm[(size_t)k * 3072]; a0 += sv[ks * 128 + k] * w; a1 += sv[1024 + ks * 128 + k] * w; a2 += sv[2048 + ks * 128 + k] * w; }
            red[(ks * 3 + 0) * 64 + lane] = a0; red[(ks * 3 + 1) * 64 + lane] = a1; red[(ks * 3 + 2) * 64 + lane] = a2;
            __syncthreads();
            if (tid < 192) { const int v = tid >> 6, cl = tid & 63; float s = 0.f;
#pragma unroll
                for (int q = 0; q < 8; ++q) s += red[(q * 3 + v) * 64 + cl];
                const int nn = (un % 48) * 64 + cl; MOD[((size_t)l * 3 + v) * 3072 + nn] = s + pp->b_mod[l * 3072 + nn]; }
            __syncthreads();
        }
    } else if (sph == 1) {
    WSL(); int lane = LANE_ID(); asm volatile("" : "+v"(lane));
    for (int r = gw; r < TROWS; r += NGW) { const float* xr = xrow_c(pp->x, pp->ctx, r); const int b = r / TB, mi = (r - b * TB) < CTXL ? 2 : b;
        f32x4 v[4];
#pragma unroll
        for (int j = 0; j < 4; ++j) v[j] = *(const f32x4*)(xr + 4 * lane + 256 * j);
        store_u(v, MOD + mi * 3072, U + (size_t)r * DM, lane); }
    } else if (sph == 2) {
        {
            WSL(); pg8::Gemm g{U, (const bf16_t*)(wsl + WS_WIN + l * SZ_WIN), TROWS, NIN, DM}; pg8::StaticOrder S; S.init(TROWS, NIN, G, bid);
            pg8::EpiIn E{wsl, pp->q_norm + l * 128, pp->k_norm + l * 128, (LAS float*)(l3 + PART_OFF)};
            pg8::gemm_phase<pg8::EpiIn, pg8::StaticOrder, true, true>(l3, g, S, E, wave);
        }
    } else if (sph == 3) {
        {
            WSL(); int lane = LANE_ID(); asm volatile("" : "+v"(lane)); const bf16_t* WPt = (const bf16_t*)(wsl + WS_WP + l * SZ_WP);
            const int nunits = 1024 + (l < DEPTH - 1 ? 16 : 0);
            float kmax; { const float* kn = pp->k_norm + l * 128; kmax = fmaxf(fabsf(kn[lane]), fabsf(kn[lane + 64]));
#pragma unroll
                for (int o_ = 1; o_ < 64; o_ <<= 1) kmax = fmaxf(kmax, __shfl_xor(kmax, o_)); }
            for (int un = bid; un < nunits; un += G) {
                __syncthreads();
                int b, h, rowq, seq;
                if (un < 1024) { b = un >> 9; h = (un >> 6) & 7; rowq = b * TB + CTXL + (un & 63) * 256; seq = TB; }
                else { const int c = un - 1024; b = c >> 3; h = c & 7; rowq = b * TB; seq = CTXL; }
                const size_t qoff = (size_t)rowq * DM + h * 128, koff = (size_t)b * TB * 256 + (h >> 2) * 128;
                att::attn_dense_body((const att::bf16*)(Q + qoff), (const att::bf16*)(Kb + koff), (const att::bf16*)(Vb + koff), (const att::bf16*)(ZA + qoff), (att::bf16*)(Q + qoff), seq, (char*)lds, wave, kmax, l3);
            }
            { unsigned* qctr = (unsigned*)(wsl + WS_BAR) + 8 + l; const int npool = (l < DEPTH - 1) ? (TROWS / 32) * 4 : (NBATCH * SEQ / 32) * 4;
              for (;;) { unsigned wq = 0u; if (lane == 0) wq = __hip_atomic_fetch_add(qctr, 1u, __ATOMIC_RELAXED, __HIP_MEMORY_SCOPE_AGENT);
                  const int wi = __builtin_amdgcn_readfirstlane((int)wq); if (wi >= npool) break;
                  int wu = wi; if (l == DEPTH - 1) { const int rc = wi >> 2, rcf = rc + (CTXL / 32) * (1 + rc / (SEQ / 32)); wu = (rcf << 2) | (wi & 3); }
                  pool_unit(XB, ZB, WPt, pp->pool_scale + l * 512, wu, lane); } }
        }
    } else if (sph == 4) {
        {
            WSL(); pg8::Gemm g{Q, (const bf16_t*)(wsl + WS_WA + l * SZ_WA), TROWS, DM, DM};
            pg8::EpiGate<0> E{wsl};
            { pg8::StaticOrder S; S.init(l == DEPTH - 1 ? NBATCH * SEQ : TROWS, DM, G, bid); S.skip = (l == DEPTH - 1); pg8::gemm_phase<pg8::EpiGate<0>, pg8::StaticOrder, true, true>(l3, g, S, E, wave); }
        }
        {
            WSL(); pg8::Gemm g{ZB, (const bf16_t*)(wsl + WS_WB + l * SZ_WB), TROWS, DM, 512};
            pg8::EpiGate<1> E{wsl};
            { pg8::StaticOrder S; S.init(l == DEPTH - 1 ? NBATCH * SEQ : TROWS, DM, G, bid); S.skip = (l == DEPTH - 1); pg8::gemm_phase<pg8::EpiGate<1>, pg8::StaticOrder, true, true>(l3, g, S, E, wave); }
        }
    } else if (sph == 5) {
        {
            WSL(); pg8::Gemm g{ZA, (const bf16_t*)(wsl + WS_WO + l * SZ_WO), TROWS, DM, DM};
            pg8::EpiRes E{MOD + (size_t)l * 3 * 3072, wsl};
            { pg8::StaticOrder S; S.init(l == DEPTH - 1 ? NBATCH * SEQ : TROWS, DM, G, bid); S.skip = (l == DEPTH - 1); pg8::gemm_phase<pg8::EpiRes, pg8::StaticOrder, true, true>(l3, g, S, E, wave); }
        }
    } else {
        {
            WSL(); int lane = LANE_ID(); asm volatile("" : "+v"(lane)); const float* modl = MOD + (size_t)l * 3 * 3072; const float* lg = pp->ln_g + l * DM; const float* lb = pp->ln_b + l * DM; const bool last = (l == DEPTH - 1);
            const float* xlat = l == 0 ? pp->x : pp->out; const float* xctx = l == 0 ? pp->ctx : CX;
            auto ln_row = [&](const int r, const f32x4 (&vin)[4]) {
                const int b = r / TB, rr = r - b * TB; const bool isctx = rr < CTXL; f32x4 v[4]; float s = 0.f;
#pragma unroll
                for (int j = 0; j < 4; ++j) { v[j] = vin[j]; s += (v[j][0] + v[j][1]) + (v[j][2] + v[j][3]); }
                const float mean = wave_sum(s) * (1.0f / DM); float s2 = 0.f;
#pragma unroll
                for (int j = 0; j < 4; ++j) { v[j] = v[j] - mean; s2 += (v[j][0] * v[j][0] + v[j][1] * v[j][1]) + (v[j][2] * v[j][2] + v[j][3] * v[j][3]); }
                const float rstd = 1.0f / sqrtf(wave_sum(s2) * (1.0f / DM) + EPSV);
                float* xo = isctx ? CX + ((size_t)b * CTXL + rr) * DM : pp->out + ((size_t)b * SEQ + (rr - CTXL)) * DM;
#pragma unroll
                for (int j = 0; j < 4; ++j) { const int c = 4 * lane + 256 * j; v[j] = v[j] * rstd * *(const f32x4*)(lg + c) + *(const f32x4*)(lb + c); *(f32x4*)(xo + c) = v[j]; }
                if (!last) store_u(v, modl + 3 * 3072 + (isctx ? 2 : b) * 3072, U + (size_t)r * DM, lane);
            };
            const int nrows = last ? NBATCH * SEQ : TROWS;
            for (int i0 = gw; i0 < nrows; i0 += 2 * NGW) {
                const int i1 = i0 + NGW; const bool has1 = i1 < nrows;
                const int r0 = last ? i0 + CTXL * (1 + i0 / SEQ) : i0, r1 = has1 ? (last ? i1 + CTXL * (1 + i1 / SEQ) : i1) : r0;
                f32x4 va[4], vb[4]; const float* xa = xrow_c(xlat, xctx, r0); const float* xb_ = xrow_c(xlat, xctx, r1);
                const bf16_t* da = DELTA + (size_t)r0 * DM; const bf16_t* db = DELTA + (size_t)r1 * DM;
#pragma unroll
                for (int j = 0; j < 4; ++j) { const int c = 4 * lane + 256 * j; const f32x4 x0 = *(const f32x4*)(xa + c), x1 = *(const f32x4*)(xb_ + c);
                    const u32x2v d0 = *(const u32x2v*)(da + c), d1 = *(const u32x2v*)(db + c);
                    va[j] = x0 * ALPHA_RES + (f32x4){pg8::bf_lo(d0.x), pg8::bf_hi(d0.x), pg8::bf_lo(d0.y), pg8::bf_hi(d0.y)};
                    vb[j] = x1 * ALPHA_RES + (f32x4){pg8::bf_lo(d1.x), pg8::bf_hi(d1.x), pg8::bf_lo(d1.y), pg8::bf_hi(d1.y)}; }
                ln_row(r0, va); if (has1) ln_row(r1, vb);
            }
        }
    }
    if (ph + 1 < NPH) GRID_SYNC();
    }
}

extern "C" void kernel_launch(void* const* d_in, const int* in_sizes, int n_in, void* d_out, int out_size, void* d_ws, size_t ws_size, hipStream_t stream) {
    static int grid_blocks = 0;
    if (grid_blocks == 0) {
        if (n_in != 16 || ws_size < WS_END2 || out_size != NBATCH * SEQ * DM) { fprintf(stderr, "kernel_launch: unexpected shapes: n_in %d out %d ws %zu (need %zu)\n", n_in, out_size, ws_size, (size_t)WS_END2); grid_blocks = -1; return; }
        int dev = 0, cus = 0, per_cu = 0;
        hipGetDevice(&dev); hipDeviceGetAttribute(&cus, hipDeviceAttributeMultiprocessorCount, dev);
        if (hipFuncSetAttribute((const void*)mega, hipFuncAttributeMaxDynamicSharedMemorySize, LDS_BYTES) != hipSuccess) { fprintf(stderr, "kernel_launch: hipFuncSetAttribute failed\n"); grid_blocks = -1; return; }
        if (hipOccupancyMaxActiveBlocksPerMultiprocessor(&per_cu, (const void*)mega, NTHREADS, LDS_BYTES) != hipSuccess || per_cu < 1) { fprintf(stderr, "kernel_launch: occupancy query gave %d\n", per_cu); per_cu = 1; }
        (void)hipGetLastError();
        grid_blocks = cus * per_cu;
    }
    if (grid_blocks < 0) return;
    Params p{};
    p.x = (const float*)d_in[0]; p.c = (const float*)d_in[1]; p.ctx = (const float*)d_in[2]; p.c_ctx = (const float*)d_in[3]; p.w_mod = (const float*)d_in[4]; p.b_mod = (const float*)d_in[5];
    p.w_in = (const float*)d_in[6]; p.q_norm = (const float*)d_in[7]; p.k_norm = (const float*)d_in[8]; p.w_pool = (const float*)d_in[9]; p.pool_scale = (const float*)d_in[10];
    p.w_br_a = (const float*)d_in[11]; p.w_br_b = (const float*)d_in[12]; p.w_out = (const float*)d_in[13]; p.ln_g = (const float*)d_in[14]; p.ln_b = (const float*)d_in[15];
    p.out = (float*)d_out; p.ws = (unsigned char*)d_ws;
    void* args[] = {&p};
    if (hipMemsetAsync((char*)d_ws + WS_BAR, 0, XCD_BAR_WORDS * 4, stream) != hipSuccess) { fprintf(stderr, "kernel_launch: memset of the barrier word failed\n"); return; }
    hipError_t e = hipLaunchCooperativeKernel((const void*)mega, dim3(grid_blocks), dim3(NTHREADS), args, LDS_BYTES, stream);
    if (e != hipSuccess) fprintf(stderr, "kernel_launch: cooperative launch failed: %s (grid %d)\n", hipGetErrorString(e), grid_blocks);
}
```

```cpp
#include <hip/hip_runtime.h>
#include <hip/hip_bf16.h>
#include <hip/hip_cooperative_groups.h>
#include <cstdio>
#include <cstdint>
namespace cg = cooperative_groups;

constexpr int DM = 1024, NBATCH = 2, SEQ = 16384, CTXL = 256, DEPTH = 4, HD = 128;
constexpr int TB = SEQ + CTXL;
constexpr int TROWS = NBATCH * TB;
constexpr int NIN = 5632;
constexpr float EPSV = 1e-6f;
constexpr float ALPHA_RES = 1.681792830507429f;
constexpr int NWAVES = 8, NTHREADS = 512;

constexpr size_t SZ_WIN = (size_t)NIN * DM * 2, SZ_WA = (size_t)DM * DM * 2, SZ_WB = (size_t)DM * 512 * 2, SZ_WO = SZ_WA, SZ_WP = (size_t)4 * 128 * 128 * 2;
constexpr size_t WS_WIN = 0;
constexpr size_t WS_WA = WS_WIN + DEPTH * SZ_WIN;
constexpr size_t WS_WB = WS_WA + DEPTH * SZ_WA;
constexpr size_t WS_WO = WS_WB + DEPTH * SZ_WB;
constexpr size_t WS_WP = WS_WO + DEPTH * SZ_WO;
constexpr size_t WS_MOD = WS_WP + DEPTH * SZ_WP;
constexpr size_t WS_ROPE = WS_MOD + (size_t)DEPTH * 3 * 3072 * 4;
constexpr size_t WS_CX = WS_ROPE + 2 * 256 * 32 * 4;
constexpr size_t WS_U = WS_CX + (size_t)512 * DM * 4;
constexpr size_t WS_Q = WS_U + (size_t)TROWS * DM * 2;
constexpr size_t WS_K = WS_Q + (size_t)TROWS * DM * 2;
constexpr size_t WS_V = WS_K + (size_t)TROWS * 256 * 2;
constexpr size_t WS_ZA = WS_V + (size_t)TROWS * 256 * 2;
constexpr size_t WS_XB = WS_ZA + (size_t)TROWS * DM * 2;
constexpr size_t WS_ZB = WS_XB + (size_t)TROWS * 512 * 2;
constexpr size_t WS_GA = WS_ZB + (size_t)TROWS * 512 * 2;
constexpr size_t WS_GB = WS_GA + (size_t)TROWS * DM * 2;
constexpr size_t WS_END = WS_GB + (size_t)TROWS * DM * 2;
constexpr size_t WS_BAR = WS_END, WS_END2 = WS_END + 16384;

struct Params {
    const float *x, *c, *ctx, *c_ctx, *w_mod, *b_mod, *w_in, *q_norm, *k_norm, *w_pool, *pool_scale, *w_br_a, *w_br_b, *w_out, *ln_g, *ln_b;
    float* out; unsigned char* ws;
};

namespace pg8 {
#define PG8_LAS __attribute__((address_space(3)))
typedef unsigned short bf16_t;
typedef short bf16x8 __attribute__((ext_vector_type(8)));
typedef float f32x4 __attribute__((ext_vector_type(4)));
typedef unsigned u32x4 __attribute__((ext_vector_type(4)));
constexpr int BM = 256, BK = 64, HALF = 128, HTB = HALF * BK * 2  , STAGE_BYTES = 8 * HTB, NXCD = 8, WGM = 8;

__host__ __device__ __forceinline__ int lds_byte(int r, int c) { const int st = (r >> 4) * 2 + (c >> 5), rr = r & 15, cc = c & 31, ob = rr * 64 + cc * 2; return st * 1024 + (ob ^ (((ob >> 9) & 1) << 5)); }
__host__ __device__ __forceinline__ void stage_rc(int b, int& R, int& C) { const int st = b / 1024, sb = b % 1024, swz = sb ^ (((sb >> 9) & 1) << 5); R = (st >> 1) * 16 + swz / 64; C = (st & 1) * 32 + (swz % 64) / 2; }
__host__ __device__ __forceinline__ int perm32(int rho) { const int n = rho >> 4, i = rho & 15; return 8 * (i >> 2) + 4 * n + (i & 3); }

struct Unit { int pm, pn; };
struct Gemm { const bf16_t* A; const bf16_t* Bt; int M, N, K; };

struct StaticOrder {
    int nM, nN, nwg, G, c, skip;
    __host__ __device__ void init(int M, int N, int G_, int c_) { nM = M / BM; nN = N / BM; nwg = nM * nN; G = G_; c = c_; skip = 0; }
    __host__ __device__ bool next(int i, Unit& u) const {
        const long L = (long)i * G + c; if (L >= nwg) return false;
        int wgid = (int)L; { const int q = nwg / NXCD, r = nwg % NXCD, xcd = wgid % NXCD, off = wgid / NXCD; wgid = (xcd < r ? xcd * (q + 1) : r * (q + 1) + (xcd - r) * q) + off; }
        const int nig = WGM * nN, gid = wgid / nig, fm = gid * WGM, gsz = (nM - fm) < WGM ? (nM - fm) : WGM;
        u.pm = fm + ((wgid % nig) % gsz); u.pn = (wgid % nig) / gsz; if (skip) u.pm += 1 + (u.pm >= 64 ? 1 : 0); return true;
    }
    __device__ __forceinline__ void a_ready(const Unit&) const {}
    __device__ __forceinline__ void done(const Unit&) const {}
};

typedef __bf16 bf16x2_t __attribute__((ext_vector_type(2)));
typedef float f32x2_t __attribute__((ext_vector_type(2)));
__device__ __forceinline__ unsigned cvt_pk_bf16(float lo, float hi) { const f32x2_t v = {lo, hi}; const bf16x2_t r = __builtin_convertvector(v, bf16x2_t); return __builtin_bit_cast(unsigned, r); }
typedef float f32x2 __attribute__((ext_vector_type(2)));
struct LatentOrder {
    StaticOrder S;
    __host__ __device__ void init(int N, int G_, int c_) { S.init(32768, N, G_, c_); }
    __host__ __device__ bool next(int i, Unit& u) const { if (!S.next(i, u)) return false; u.pm += 1 + (u.pm >= 64 ? 1 : 0); return true; }
    __device__ __forceinline__ void a_ready(const Unit&) const {}
    __device__ __forceinline__ void done(const Unit&) const {}
};
__device__ __forceinline__ float bf_lo(unsigned w) { return __uint_as_float(w << 16); }
__device__ __forceinline__ float bf_hi(unsigned w) { return __uint_as_float(w & 0xffff0000u); }
__device__ __forceinline__ float sigm(float x) { return __builtin_amdgcn_rcpf(1.0f + __builtin_amdgcn_exp2f(-1.4426950408889634f * x)); }
typedef unsigned u32x2 __attribute__((ext_vector_type(2)));
template <int ACT> __device__ __forceinline__ float actf(float x) { if (ACT == 1) return x * sigm(x); if (ACT == 2) return sigm(x); return x; }

struct EpiIn {
    static constexpr bool PERM = true, AFTER_DRAIN = false;
    unsigned char* ws; const float *qg, *kg;
    PG8_LAS float* part;
    template <int ACT> __device__ __forceinline__ void plain(const f32x4 (&acc)[2][2][4][2], bf16_t* base, int ldc, int colt, const Unit& u, int wr, int wc, int fr, int fq) const {
        const int row0 = u.pm * BM + wr * 64 + fr, col0 = colt + wc * 32 + 8 * fq;
#pragma unroll
        for (int ai = 0; ai < 2; ++ai)
#pragma unroll
            for (int m = 0; m < 4; ++m) { bf16_t* rowp = base + (size_t)(row0 + ai * HALF + m * 16) * ldc + col0;
#pragma unroll
                for (int bj = 0; bj < 2; ++bj) { const f32x4 v0 = acc[ai][bj][m][0], v1 = acc[ai][bj][m][1]; u32x4 w;
                    w.x = cvt_pk_bf16(actf<ACT>(v0[0]), actf<ACT>(v0[1])); w.y = cvt_pk_bf16(actf<ACT>(v0[2]), actf<ACT>(v0[3]));
                    w.z = cvt_pk_bf16(actf<ACT>(v1[0]), actf<ACT>(v1[1])); w.w = cvt_pk_bf16(actf<ACT>(v1[2]), actf<ACT>(v1[3]));
                    *(u32x4*)(rowp + bj * HALF) = w; } }
    }
    __device__ __forceinline__ void qk(const f32x4 (&acc)[2][2][4][2], const Unit& u, int wr, int wc, int fr, int fq) const {
        const bool isk = (u.pn == 4);
        const float* g = isk ? kg : qg; bf16_t* dst = (bf16_t*)(ws + (isk ? WS_K : WS_Q)); const int ldc = isk ? 256 : 1024;
        const float* cosT = (const float*)(ws + WS_ROPE); const float* sinT = cosT + 256 * 32;
        const int f0 = (wc & 1) * 16 + 4 * fq, axis = wc >> 1, e1 = axis * 64 + f0;
        const f32x4 g1 = *(const f32x4*)(g + e1), g2 = *(const f32x4*)(g + e1 + 32);
#pragma unroll
        for (int ai = 0; ai < 2; ++ai)
#pragma unroll
            for (int m = 0; m < 4; ++m)
#pragma unroll
                for (int bj = 0; bj < 2; ++bj) { const f32x4 a = acc[ai][bj][m][0], b = acc[ai][bj][m][1];
                    float s = (a[0] * a[0] + a[1] * a[1]) + (a[2] * a[2] + a[3] * a[3]) + (b[0] * b[0] + b[1] * b[1]) + (b[2] * b[2] + b[3] * b[3]);
                    s += __shfl_xor(s, 16); s += __shfl_xor(s, 32);
                    if (fq == 0) part[((ai * HALF + wr * 64 + m * 16 + fr) * 2 + bj) * 4 + wc] = s; }
        asm volatile("s_waitcnt lgkmcnt(0)" ::: "memory"); __builtin_amdgcn_s_barrier(); asm volatile("" ::: "memory");
        const int jt = u.pm % 65; const bool rope = (jt != 0);
#pragma unroll
        for (int ai = 0; ai < 2; ++ai)
#pragma unroll
            for (int m = 0; m < 4; ++m) { const int rloc = ai * HALF + wr * 64 + m * 16 + fr;
                const int pos = rope ? (axis ? (16 * m + fr) : ((jt - 1) * 4 + 2 * ai + wr)) : 0;
                f32x4 c4 = *(const f32x4*)(cosT + pos * 32 + f0), s4 = *(const f32x4*)(sinT + pos * 32 + f0);
                if (!rope) { c4 = (f32x4){1.f, 1.f, 1.f, 1.f}; s4 = (f32x4){0.f, 0.f, 0.f, 0.f}; }
#pragma unroll
                for (int bj = 0; bj < 2; ++bj) { const f32x4 p = *(const PG8_LAS f32x4*)(part + (rloc * 2 + bj) * 4);
                    const float rstd = __builtin_amdgcn_rsqf(((p[0] + p[1]) + (p[2] + p[3])) * (1.0f / 128.0f) + 1e-6f);
                    const f32x4 y1 = acc[ai][bj][m][0] * rstd * g1, y2 = acc[ai][bj][m][1] * rstd * g2;
                    f32x4 o1 = y1 * c4 - y2 * s4, o2 = y1 * s4 + y2 * c4;
                    if (!isk) { o1 = o1 * 0.12751743074602458f; o2 = o2 * 0.12751743074602458f; }
                    const int head = isk ? bj : 2 * u.pn + bj;
                    bf16_t* ptr = dst + (size_t)(u.pm * BM + rloc) * ldc + head * 128 + e1;
                    u32x2 w1, w2; w1.x = cvt_pk_bf16(o1[0], o1[1]); w1.y = cvt_pk_bf16(o1[2], o1[3]); w2.x = cvt_pk_bf16(o2[0], o2[1]); w2.y = cvt_pk_bf16(o2[2], o2[3]);
                    *(u32x2*)ptr = w1; *(u32x2*)(ptr + 32) = w2; } }
    }
    __device__ __forceinline__ void operator()(const f32x4 (&acc)[2][2][4][2], const Unit& u, int wr, int wc, int fr, int fq) const {
        const int pn = u.pn;
        if (pn < 5) { qk(acc, u, wr, wc, fr, fq); return; }
        if (pn == 5) plain<0>(acc, (bf16_t*)(ws + WS_V), 256, 0, u, wr, wc, fr, fq);
        else if (pn < 10) plain<1>(acc, (bf16_t*)(ws + WS_ZA), 1024, (pn - 6) * 256, u, wr, wc, fr, fq);
        else if (pn < 12) plain<0>(acc, (bf16_t*)(ws + WS_XB), 512, (pn - 10) * 256, u, wr, wc, fr, fq);
        else if (pn < 14) plain<1>(acc, (bf16_t*)(ws + WS_ZB), 512, (pn - 12) * 256, u, wr, wc, fr, fq);
        else if (pn < 18) plain<2>(acc, (bf16_t*)(ws + WS_GA), 1024, (pn - 14) * 256, u, wr, wc, fr, fq);
        else plain<2>(acc, (bf16_t*)(ws + WS_GB), 1024, (pn - 18) * 256, u, wr, wc, fr, fq);
    }
};
template <int MODE> struct EpiGate {
    static constexpr bool PERM = true, AFTER_DRAIN = false;
    unsigned char* ws;
    __device__ __forceinline__ void operator()(const f32x4 (&acc)[2][2][4][2], const Unit& u, int wr, int wc, int fr, int fq) const {
        bf16_t* GA = (bf16_t*)(ws + WS_GA); const bf16_t* GB = (const bf16_t*)(ws + WS_GB); bf16_t* Y = (bf16_t*)(ws + WS_ZA);
        const int row0 = u.pm * BM + wr * 64 + fr, col0 = u.pn * BM + wc * 32 + 8 * fq;
#pragma unroll
        for (int ai = 0; ai < 2; ++ai)
#pragma unroll
            for (int m = 0; m < 4; ++m) { const size_t off = (size_t)(row0 + ai * HALF + m * 16) * 1024 + col0;
#pragma unroll
                for (int bj = 0; bj < 2; ++bj) { const f32x4 v0 = acc[ai][bj][m][0], v1 = acc[ai][bj][m][1];
                    const u32x4 ga = *(const u32x4*)(GA + off + bj * HALF); u32x4 w;
                    if (MODE == 0) {
                        w.x = cvt_pk_bf16(v0[0] * bf_lo(ga.x), v0[1] * bf_hi(ga.x)); w.y = cvt_pk_bf16(v0[2] * bf_lo(ga.y), v0[3] * bf_hi(ga.y));
                        w.z = cvt_pk_bf16(v1[0] * bf_lo(ga.z), v1[1] * bf_hi(ga.z)); w.w = cvt_pk_bf16(v1[2] * bf_lo(ga.w), v1[3] * bf_hi(ga.w));
                        *(u32x4*)(GA + off + bj * HALF) = w;
                    } else {
                        const u32x4 gb = *(const u32x4*)(GB + off + bj * HALF);
                        w.x = cvt_pk_bf16(bf_lo(ga.x) + v0[0] * bf_lo(gb.x), bf_hi(ga.x) + v0[1] * bf_hi(gb.x)); w.y = cvt_pk_bf16(bf_lo(ga.y) + v0[2] * bf_lo(gb.y), bf_hi(ga.y) + v0[3] * bf_hi(gb.y));
                        w.z = cvt_pk_bf16(bf_lo(ga.z) + v1[0] * bf_lo(gb.z), bf_hi(ga.z) + v1[1] * bf_hi(gb.z)); w.w = cvt_pk_bf16(bf_lo(ga.w) + v1[2] * bf_lo(gb.w), bf_hi(ga.w) + v1[3] * bf_hi(gb.w));
                        *(u32x4*)(Y + off + bj * HALF) = w;
                    } } }
    }
};
struct EpiRes {
    static constexpr bool PERM = true, AFTER_DRAIN = false;
    const float* mod; unsigned char* ws;
    __device__ __forceinline__ void operator()(const f32x4 (&acc)[2][2][4][2], const Unit& u, int wr, int wc, int fr, int fq) const {
        const int b = u.pm / 65, jt = u.pm % 65; bf16_t* dl = (bf16_t*)(ws + WS_GA);
        const float* gate = mod + (jt ? b : 2) * 3072 + 2048;
        const int row0 = u.pm * BM + wr * 64 + fr, col0 = u.pn * BM + wc * 32 + 8 * fq;
        f32x4 gv[2][2];
#pragma unroll
        for (int bj = 0; bj < 2; ++bj)
#pragma unroll
            for (int n = 0; n < 2; ++n) gv[bj][n] = *(const f32x4*)(gate + col0 + bj * HALF + 4 * n);
#pragma unroll
        for (int ai = 0; ai < 2; ++ai)
#pragma unroll
            for (int m = 0; m < 4; ++m) { bf16_t* rowp = dl + (size_t)(row0 + ai * HALF + m * 16) * 1024 + col0;
#pragma unroll
                for (int bj = 0; bj < 2; ++bj) { const f32x4 v0 = acc[ai][bj][m][0] * gv[bj][0], v1 = acc[ai][bj][m][1] * gv[bj][1]; u32x4 w;
                    w.x = cvt_pk_bf16(v0[0], v0[1]); w.y = cvt_pk_bf16(v0[2], v0[3]); w.z = cvt_pk_bf16(v1[0], v1[1]); w.w = cvt_pk_bf16(v1[2], v1[3]);
                    *(u32x4*)(rowp + bj * HALF) = w; } }
    }
};

template <class Epi, class Sched, bool ALIGN_EPI = false, bool SP2 = false>
__device__ __forceinline__ void gemm_phase(PG8_LAS unsigned char* lds, const Gemm g, const Sched& S, const Epi& E, const int wid_in) {
    int lane = __builtin_amdgcn_mbcnt_hi(~0u, __builtin_amdgcn_mbcnt_lo(~0u, 0u)); asm volatile("" : "+v"(lane));
    const int wid = wid_in, tid = wid * 64 + lane, wr = wid >> 2, wc = wid & 3, fr = lane & 15, fq = lane >> 4;
    const int K = g.K, nt = K / BK;
    unsigned voffA[2], voffB[2];
#pragma unroll
    for (int i = 0; i < 2; ++i) { int R, C; stage_rc(tid * 16 + i * 8192, R, C); const int Rb = Epi::PERM ? ((R & ~31) + perm32(R & 31)) : R;
        voffA[i] = (unsigned)(R * K + C) * 2u; voffB[i] = (unsigned)(Rb * K + C) * 2u; }
    const size_t kstep = (size_t)(BK * 2);
    const size_t hstep = (size_t)HALF * K * 2;
    const size_t tstep = 2 * hstep;
    const unsigned ldsw = (unsigned)wid * 1024u;
    const int aoff = lds_byte(wr * 64 + fr, fq * 8), boff = lds_byte(wc * 32 + fr, fq * 8);
#define PG8_SA(b, h) (((b) * 2 + (h)) * HTB)
#define PG8_SB(b, h) ((4 + (b) * 2 + (h)) * HTB)
#define PG8_STAGE(bufoff, gbase, voff) do { _Pragma("unroll") for (int _i = 0; _i < 2; ++_i) \
        __builtin_amdgcn_global_load_lds((const unsigned*)((const char*)(gbase) + (voff)[_i]), (PG8_LAS unsigned*)(lds + (bufoff) + ldsw + _i * 8192), 16, 0, 0); } while (0)
#define PG8_LDA(dst, b, h) do { _Pragma("unroll") for (int m = 0; m < 4; ++m) _Pragma("unroll") for (int k = 0; k < 2; ++k) dst[m][k] = *(const PG8_LAS bf16x8*)(lds + PG8_SA(b, h) + aoff + m * 2048 + k * 1024); } while (0)
#define PG8_LDB(dst, b, h) do { _Pragma("unroll") for (int n = 0; n < 2; ++n) _Pragma("unroll") for (int k = 0; k < 2; ++k) dst[n][k] = *(const PG8_LAS bf16x8*)(lds + PG8_SB(b, h) + boff + n * 2048 + k * 1024); } while (0)
#define PG8_MMA(ai, bj, At, Bt) do { __builtin_amdgcn_s_setprio(1); _Pragma("unroll") for (int m = 0; m < 4; ++m) _Pragma("unroll") for (int n = 0; n < 2; ++n) _Pragma("unroll") for (int k = 0; k < 2; ++k) \
        acc[ai][bj][m][n] = __builtin_amdgcn_mfma_f32_16x16x32_bf16(Bt[n][k], At[m][k], acc[ai][bj][m][n], 0, 0, 0); __builtin_amdgcn_s_setprio(0); } while (0)
#define PG8_WAIT_V(n) asm volatile("s_waitcnt vmcnt(" #n ")" ::: "memory")
#define PG8_WAIT_L(n) asm volatile("s_waitcnt lgkmcnt(" #n ")" ::: "memory")
#define PG8_BAR __builtin_amdgcn_s_barrier()
#define PG8_SCHED __builtin_amdgcn_sched_barrier(0)
    Unit cur, nxt; int ui = 0;
    if (!S.next(0, cur)) return;
    f32x4 acc[2][2][4][2];
#pragma unroll
    for (int a = 0; a < 2; ++a)
#pragma unroll
        for (int b = 0; b < 2; ++b)
#pragma unroll
            for (int m = 0; m < 4; ++m)
#pragma unroll
                for (int n = 0; n < 2; ++n) acc[a][b][m][n] = (f32x4){0.f, 0.f, 0.f, 0.f};
    bf16x8 At[4][2], B0[2][2], B1[2][2];
    const char* cA = (const char*)g.A + (size_t)cur.pm * tstep; const char* cB = (const char*)g.Bt + (size_t)cur.pn * tstep;
    S.a_ready(cur);
    if constexpr (SP2) {
        PG8_STAGE(PG8_SB(0, 0), cB, voffB); PG8_STAGE(PG8_SB(0, 1), cB + hstep, voffB); PG8_STAGE(PG8_SA(0, 0), cA, voffA); PG8_STAGE(PG8_SA(0, 1), cA + hstep, voffA);
        if (wr == 1) PG8_BAR;
        PG8_WAIT_V(2); PG8_BAR;
        PG8_STAGE(PG8_SB(1, 0), cB + kstep, voffB); PG8_STAGE(PG8_SA(1, 0), cA + kstep, voffA); PG8_STAGE(PG8_SB(1, 1), cB + hstep + kstep, voffB);
        PG8_WAIT_V(6); PG8_BAR;
    } else {
        PG8_STAGE(PG8_SB(0, 0), cB, voffB); PG8_STAGE(PG8_SA(0, 0), cA, voffA); PG8_STAGE(PG8_SB(0, 1), cB + hstep, voffB); PG8_STAGE(PG8_SA(0, 1), cA + hstep, voffA);
        if (wr == 1) PG8_BAR;
        PG8_WAIT_V(4); PG8_BAR;
        PG8_STAGE(PG8_SB(1, 0), cB + kstep, voffB); PG8_STAGE(PG8_SA(1, 0), cA + kstep, voffA); PG8_STAGE(PG8_SB(1, 1), cB + hstep + kstep, voffB);
        PG8_WAIT_V(6); PG8_BAR;
    }
    for (;;) {
        const bool has_next = S.next(ui + 1, nxt);
        const char* nA = has_next ? (const char*)g.A + (size_t)nxt.pm * tstep : cA; const char* nB = has_next ? (const char*)g.Bt + (size_t)nxt.pn * tstep : cB;
        for (int t = 0; t < nt; t += 2) {
            const bool last = (t == nt - 2);
            const char* a1 = cA + (size_t)(t + 1) * kstep;
            const char* a2 = last ? nA : cA + (size_t)(t + 2) * kstep; const char* b2 = last ? nB : cB + (size_t)(t + 2) * kstep;
            const char* a3 = a2 + kstep; const char* b3 = b2 + kstep;
            if (last && has_next) S.a_ready(nxt);
            if constexpr (SP2) {
            PG8_LDB(B0, 0, 0); PG8_LDB(B1, 0, 1); PG8_SCHED; PG8_LDA(At, 0, 0); PG8_STAGE(PG8_SA(1, 1), a1 + hstep, voffA);
            PG8_WAIT_V(8); PG8_WAIT_L(0); PG8_BAR; PG8_MMA(0, 0, At, B0); PG8_MMA(0, 1, At, B1); PG8_BAR; PG8_SCHED;
            PG8_LDA(At, 0, 1); PG8_STAGE(PG8_SB(0, 0), b2, voffB); PG8_STAGE(PG8_SB(0, 1), b2 + hstep, voffB); PG8_STAGE(PG8_SA(0, 0), a2, voffA);
            PG8_WAIT_V(8); PG8_WAIT_L(0); PG8_BAR; PG8_MMA(1, 0, At, B0); PG8_MMA(1, 1, At, B1); PG8_BAR; PG8_SCHED;
            PG8_LDB(B0, 1, 0); PG8_LDB(B1, 1, 1); PG8_SCHED; PG8_LDA(At, 1, 0); PG8_STAGE(PG8_SA(0, 1), a2 + hstep, voffA);
            PG8_WAIT_V(8); PG8_WAIT_L(0); PG8_BAR; PG8_MMA(0, 0, At, B0); PG8_MMA(0, 1, At, B1); PG8_BAR; PG8_SCHED;
            PG8_LDA(At, 1, 1); PG8_STAGE(PG8_SB(1, 0), b3, voffB); PG8_STAGE(PG8_SB(1, 1), b3 + hstep, voffB); PG8_STAGE(PG8_SA(1, 0), a3, voffA);
            PG8_WAIT_V(8); PG8_WAIT_L(0); PG8_BAR; PG8_MMA(1, 0, At, B0); PG8_MMA(1, 1, At, B1); PG8_BAR; PG8_SCHED;
            } else {
            PG8_LDB(B0, 0, 0); PG8_SCHED; PG8_LDA(At, 0, 0); PG8_STAGE(PG8_SA(1, 1), a1 + hstep, voffA);
            PG8_WAIT_L(8); PG8_BAR; PG8_WAIT_L(0); PG8_MMA(0, 0, At, B0); PG8_BAR; PG8_SCHED;
            PG8_LDB(B1, 0, 1); PG8_STAGE(PG8_SB(0, 0), b2, voffB);
            PG8_BAR; PG8_WAIT_L(0); PG8_MMA(0, 1, At, B1); PG8_BAR;
            PG8_LDA(At, 0, 1); PG8_STAGE(PG8_SA(0, 0), a2, voffA);
            PG8_BAR; PG8_WAIT_L(0); PG8_MMA(1, 0, At, B0); PG8_BAR; PG8_SCHED;
            PG8_STAGE(PG8_SB(0, 1), b2 + hstep, voffB);
            PG8_WAIT_V(6); PG8_BAR; PG8_MMA(1, 1, At, B1); PG8_BAR;
            PG8_LDB(B0, 1, 0); PG8_SCHED; PG8_LDA(At, 1, 0); PG8_STAGE(PG8_SA(0, 1), a2 + hstep, voffA);
            PG8_WAIT_L(8); PG8_BAR; PG8_WAIT_L(0); PG8_MMA(0, 0, At, B0); PG8_BAR; PG8_SCHED;
            PG8_LDB(B1, 1, 1); PG8_STAGE(PG8_SB(1, 0), b3, voffB);
            PG8_BAR; PG8_WAIT_L(0); PG8_MMA(0, 1, At, B1); PG8_BAR;
            PG8_LDA(At, 1, 1); PG8_STAGE(PG8_SA(1, 0), a3, voffA);
            PG8_BAR; PG8_WAIT_L(0); PG8_MMA(1, 0, At, B0); PG8_BAR; PG8_SCHED;
            PG8_STAGE(PG8_SB(1, 1), b3 + hstep, voffB);
            PG8_WAIT_V(6); PG8_BAR; PG8_MMA(1, 1, At, B1); PG8_BAR;
            }
        }
        if constexpr (ALIGN_EPI) { if (wr == 0) PG8_BAR; }
        if constexpr (!Epi::AFTER_DRAIN) { int l2 = __builtin_amdgcn_mbcnt_hi(~0u, __builtin_amdgcn_mbcnt_lo(~0u, 0u)); asm volatile("" : "+v"(l2));
            E(acc, cur, wr, wc, l2 & 15, l2 >> 4); S.done(cur); }
        if (!has_next) break;
#pragma unroll
        for (int a = 0; a < 2; ++a)
#pragma unroll
            for (int b = 0; b < 2; ++b)
#pragma unroll
                for (int m = 0; m < 4; ++m)
#pragma unroll
                    for (int n = 0; n < 2; ++n) acc[a][b][m][n] = (f32x4){0.f, 0.f, 0.f, 0.f};
        cur = nxt; cA = nA; cB = nB; ++ui;
        if constexpr (ALIGN_EPI) { if (wr == 1) PG8_BAR; }
    }
    PG8_WAIT_V(0);
    if constexpr (!ALIGN_EPI) { if (wr == 0) PG8_BAR; }
    PG8_BAR;
    if constexpr (Epi::AFTER_DRAIN) { E.fused(acc, cur, wr, wc, fr, fq, lds, wid, lane); S.done(cur); }
#undef PG8_SA
#undef PG8_SB
#undef PG8_STAGE
#undef PG8_LDA
#undef PG8_LDB
#undef PG8_MMA
#undef PG8_WAIT_V
#undef PG8_WAIT_L
#undef PG8_BAR
#undef PG8_SCHED
}
}
namespace att {
using bf16 = __hip_bfloat16;
constexpr int   D = 128, NW = 8, QBLK = 32, KVBLK = 64;
constexpr float SCALE = 0.088388347648318440f;
constexpr float THR = 8.f;
constexpr int SDEPTH = 1;
constexpr int LDQ = 1024, LDK = 256, LDO = 1024;
constexpr size_t SHM_V = KVBLK * D * 2, SHM_K = KVBLK * D * 2, SHM_ATTN = 3 * SHM_V + 3 * SHM_K + NW * 64 * 4;
using bf16x8 = __attribute__((ext_vector_type(8))) short;
using s16x4  = __attribute__((ext_vector_type(4))) short;
using f32x16 = __attribute__((ext_vector_type(16))) float;
using f32x8  = __attribute__((ext_vector_type(8))) float;
using u32x4  = __attribute__((ext_vector_type(4))) unsigned;
#define KSWZ(row, colB) ((row) * 256 + ((colB) ^ (((row) & 15) << 4)))
#define SBAR() __builtin_amdgcn_sched_barrier(0)
__device__ __forceinline__ int crow(int r, int hi) { return (r & 3) + 8 * (r >> 2) + 4 * hi; }
__device__ __forceinline__ unsigned cvtpk(float lo, float hi) { return pg8::cvt_pk_bf16(lo, hi); }
template <typename TIn> struct Stage;
template <> struct Stage<bf16>  { using T = bf16x8;
  __device__ static __forceinline__ T ld8(const bf16* p) { return *reinterpret_cast<const bf16x8*>(p); }
  __device__ static __forceinline__ bf16x8 tobf(T x) { return x; } };
template <> struct Stage<float> { using T = f32x8;
  __device__ static __forceinline__ T ld8(const float* p) { return *reinterpret_cast<const f32x8*>(p); }
  __device__ static __forceinline__ bf16x8 tobf(T x) {
    u32x4 w = {cvtpk(x[0], x[1]), cvtpk(x[2], x[3]), cvtpk(x[4], x[5]), cvtpk(x[6], x[7])}; return *reinterpret_cast<bf16x8*>(&w); } };

__device__ __forceinline__ void partialSM(f32x16& p0, f32x16& p1, float& m_reg, float& mn, float& alpha) {
  constexpr float C = SCALE * 1.4426950408889634f;
  float pmax = p0[0]; for (int r = 1; r < 16; ++r) pmax = fmaxf(pmax, p0[r]); for (int r = 0; r < 16; ++r) pmax = fmaxf(pmax, p1[r]);
  { auto rr = __builtin_amdgcn_permlane32_swap(__float_as_uint(pmax), __float_as_uint(pmax), false, false);
    pmax = fmaxf(__uint_as_float(rr[0]), __uint_as_float(rr[1])); }
  if (__builtin_expect(__all(pmax - m_reg <= THR / SCALE), 1)) { mn = m_reg; alpha = 1.f; }
  else { mn = fmaxf(m_reg, pmax); alpha = __builtin_amdgcn_exp2f((m_reg - mn) * C); m_reg = mn; }
  float mnC = -mn * C;
  for (int r = 0; r < 16; ++r) p0[r] = fmaf(p0[r], C, mnC); for (int r = 0; r < 16; ++r) p1[r] = fmaf(p1[r], C, mnC);
  for (int r = 0; r < 16; ++r) p0[r] = __builtin_amdgcn_exp2f(p0[r]);
}
__device__ __forceinline__ void finishSM(f32x16& p0, f32x16& p1, float alpha, float& l_reg, bf16x8& pa0, bf16x8& pa1, bf16x8& pa2, bf16x8& pa3) {
  for (int r = 0; r < 16; ++r) p1[r] = __builtin_amdgcn_exp2f(p1[r]);
  float ps = 0; for (int r = 0; r < 16; ++r) ps += p0[r]; for (int r = 0; r < 16; ++r) ps += p1[r];
  { auto rr = __builtin_amdgcn_permlane32_swap(__float_as_uint(ps), __float_as_uint(ps), false, false);
    ps = __uint_as_float(rr[0]) + __uint_as_float(rr[1]); }
  l_reg = l_reg * alpha + ps;
#define PK4(P, BASE, OUT) do { unsigned a0 = cvtpk(P[BASE + 0], P[BASE + 1]), a1 = cvtpk(P[BASE + 2], P[BASE + 3]);   \
    unsigned b0 = cvtpk(P[BASE + 4], P[BASE + 5]), b1 = cvtpk(P[BASE + 6], P[BASE + 7]);                              \
    auto r0 = __builtin_amdgcn_permlane32_swap(a0, b0, false, false); auto r1 = __builtin_amdgcn_permlane32_swap(a1, b1, false, false); \
    u32x4 w = {r0[0], r1[0], r0[1], r1[1]}; OUT = *reinterpret_cast<bf16x8*>(&w); } while (0)
  PK4(p0, 0, pa0); PK4(p0, 8, pa1); PK4(p1, 0, pa2); PK4(p1, 8, pa3);
#undef PK4
}
__device__ __forceinline__ void partialSM2(f32x16& p0, f32x16& p1, const float negBC) {
  constexpr float C = SCALE * 1.4426950408889634f;
  for (int r = 0; r < 16; ++r) p0[r] = fmaf(p0[r], C, negBC); for (int r = 0; r < 16; ++r) p1[r] = fmaf(p1[r], C, negBC);
  for (int r = 0; r < 16; ++r) p0[r] = __builtin_amdgcn_exp2f(p0[r]);
}
__device__ __forceinline__ void finishSM2(f32x16& p0, f32x16& p1, float& l_reg, bf16x8& pa0, bf16x8& pa1, bf16x8& pa2, bf16x8& pa3) {
  for (int r = 0; r < 16; ++r) p1[r] = __builtin_amdgcn_exp2f(p1[r]);
  float ps = 0; for (int r = 0; r < 16; ++r) ps += p0[r]; for (int r = 0; r < 16; ++r) ps += p1[r];
  l_reg += ps;
#define PK4(P, BASE, OUT) do { unsigned a0 = cvtpk(P[BASE + 0], P[BASE + 1]), a1 = cvtpk(P[BASE + 2], P[BASE + 3]);   \
    unsigned b0 = cvtpk(P[BASE + 4], P[BASE + 5]), b1 = cvtpk(P[BASE + 6], P[BASE + 7]);                              \
    auto r0 = __builtin_amdgcn_permlane32_swap(a0, b0, false, false); auto r1 = __builtin_amdgcn_permlane32_swap(a1, b1, false, false); \
    u32x4 w = {r0[0], r1[0], r0[1], r1[1]}; OUT = *reinterpret_cast<bf16x8*>(&w); } while (0)
  PK4(p0, 0, pa0); PK4(p0, 8, pa1); PK4(p1, 0, pa2); PK4(p1, 8, pa3);
#undef PK4
}
__device__ __forceinline__ void qkt(f32x16& p0, f32x16& p1, const bf16* Ks, const bf16x8* qr, int r32, int hi) {
  p0 = f32x16{}; p1 = f32x16{};
  for (int d0 = 0; d0 < 8; ++d0) { int cb = (d0 * 16 + hi * 8) * 2;
    bf16x8 b0 = *reinterpret_cast<const bf16x8*>((const char*)Ks + KSWZ(r32, cb));
    bf16x8 b1 = *reinterpret_cast<const bf16x8*>((const char*)Ks + KSWZ(32 + r32, cb));
    p0 = __builtin_amdgcn_mfma_f32_32x32x16_bf16(b0, qr[d0], p0, 0, 0, 0);
    p1 = __builtin_amdgcn_mfma_f32_32x32x16_bf16(b1, qr[d0], p1, 0, 0, 0); }
}
__device__ __forceinline__ void partialSM3(f32x16& p0) { for (int r = 0; r < 16; ++r) p0[r] = __builtin_amdgcn_exp2f(p0[r]); }
__device__ __forceinline__ void qkt3(f32x16& p0, f32x16& p1, const bf16* Ks, const bf16x8* qr, int r32, int hi, const f32x16& cinit) {
  { int cb = (hi * 8) * 2;
    bf16x8 b0 = *reinterpret_cast<const bf16x8*>((const char*)Ks + KSWZ(r32, cb));
    bf16x8 b1 = *reinterpret_cast<const bf16x8*>((const char*)Ks + KSWZ(32 + r32, cb));
    p0 = __builtin_amdgcn_mfma_f32_32x32x16_bf16(b0, qr[0], cinit, 0, 0, 0);
    p1 = __builtin_amdgcn_mfma_f32_32x32x16_bf16(b1, qr[0], cinit, 0, 0, 0); }
  for (int d0 = 1; d0 < 8; ++d0) { int cb = (d0 * 16 + hi * 8) * 2;
    bf16x8 b0 = *reinterpret_cast<const bf16x8*>((const char*)Ks + KSWZ(r32, cb));
    bf16x8 b1 = *reinterpret_cast<const bf16x8*>((const char*)Ks + KSWZ(32 + r32, cb));
    p0 = __builtin_amdgcn_mfma_f32_32x32x16_bf16(b0, qr[d0], p0, 0, 0, 0);
    p1 = __builtin_amdgcn_mfma_f32_32x32x16_bf16(b1, qr[d0], p1, 0, 0, 0); }
}
__device__ __forceinline__ int v_st(int k, int c) { const int kk = (k & ~0xC) | ((k & 4) << 1) | ((k & 8) >> 1); return ((kk >> 3) * 4 + (c >> 5)) * 512 + ((kk & 7) * 32 + (c & 31)) * 2; }
__device__ __forceinline__ int v_rd_base(int lane) { return ((lane & 3) << 3) | (((lane >> 2) & 3) << 6) | (((lane >> 4) & 1) << 5) | (((lane >> 5) & 1) << 8); }
constexpr int v_rd_off(int d0, int ks, int half) { return d0 * 512 + ks * 4096 + half * 2048; }
template <int OFF> __device__ __forceinline__ s16x4 tr_read(int vb) {
  s16x4 r; asm volatile("ds_read_b64_tr_b16 %0, %1 offset:%2" : "=&v"(r) : "v"(vb), "i"(OFF) : "memory"); return r;
}
template <int D0> __device__ __forceinline__ void pv_one(f32x16& od, int vb, bf16x8 pa0, bf16x8 pa1, bf16x8 pa2, bf16x8 pa3) {
  const s16x4 l0 = tr_read<v_rd_off(D0, 0, 0)>(vb), h0 = tr_read<v_rd_off(D0, 0, 1)>(vb), l1 = tr_read<v_rd_off(D0, 1, 0)>(vb), h1 = tr_read<v_rd_off(D0, 1, 1)>(vb);
  const s16x4 l2 = tr_read<v_rd_off(D0, 2, 0)>(vb), h2 = tr_read<v_rd_off(D0, 2, 1)>(vb), l3 = tr_read<v_rd_off(D0, 3, 0)>(vb), h3 = tr_read<v_rd_off(D0, 3, 1)>(vb);
  asm volatile("s_waitcnt lgkmcnt(0)" ::: "memory"); SBAR();
#define PK(L, H) (bf16x8){L[0], L[1], L[2], L[3], H[0], H[1], H[2], H[3]}
  od = __builtin_amdgcn_mfma_f32_32x32x16_bf16(pa0, PK(l0, h0), od, 0, 0, 0);
  od = __builtin_amdgcn_mfma_f32_32x32x16_bf16(pa1, PK(l1, h1), od, 0, 0, 0);
  od = __builtin_amdgcn_mfma_f32_32x32x16_bf16(pa2, PK(l2, h2), od, 0, 0, 0);
  od = __builtin_amdgcn_mfma_f32_32x32x16_bf16(pa3, PK(l3, h3), od, 0, 0, 0);
#undef PK
}
__device__ __forceinline__ void pv_d0(f32x16* o, int vb, bf16x8 pa0, bf16x8 pa1, bf16x8 pa2, bf16x8 pa3) {
  pv_one<0>(o[0], vb, pa0, pa1, pa2, pa3); pv_one<1>(o[1], vb, pa0, pa1, pa2, pa3); pv_one<2>(o[2], vb, pa0, pa1, pa2, pa3); pv_one<3>(o[3], vb, pa0, pa1, pa2, pa3);
}

template <int FIRST> __device__ __forceinline__ void finishSM4(f32x16& p0, f32x16& p1, float& l_reg, bf16x8& pa0, bf16x8& pa1, bf16x8& pa2, bf16x8& pa3) {
  for (int r = FIRST; r < 16; ++r) p1[r] = __builtin_amdgcn_exp2f(p1[r]);
  float ps = 0; for (int r = 0; r < 16; ++r) ps += p0[r]; for (int r = 0; r < 16; ++r) ps += p1[r];
  l_reg += ps;
#define PK8(P, BASE, OUT) do { u32x4 w = {cvtpk(P[BASE + 0], P[BASE + 1]), cvtpk(P[BASE + 2], P[BASE + 3]), cvtpk(P[BASE + 4], P[BASE + 5]), cvtpk(P[BASE + 6], P[BASE + 7])}; OUT = *reinterpret_cast<bf16x8*>(&w); } while (0)
  PK8(p0, 0, pa0); PK8(p0, 8, pa1); PK8(p1, 0, pa2); PK8(p1, 8, pa3);
#undef PK8
}
__device__ __forceinline__ int v_rd_base2(int lane) { return ((lane & 3) << 3) | (((lane >> 2) & 3) << 6) | (((lane >> 4) & 1) << 5) | (((lane >> 5) & 1) << 11); }
constexpr int v_rd_off2(int d0, int ks, int part) { return d0 * 512 + ks * 4096 + part * 256; }
template <int D0> __device__ __forceinline__ void pv_one2(f32x16& od, int vb, bf16x8 pa0, bf16x8 pa1, bf16x8 pa2, bf16x8 pa3) {
  const s16x4 l0 = tr_read<v_rd_off2(D0, 0, 0)>(vb), h0 = tr_read<v_rd_off2(D0, 0, 1)>(vb), l1 = tr_read<v_rd_off2(D0, 1, 0)>(vb), h1 = tr_read<v_rd_off2(D0, 1, 1)>(vb);
  const s16x4 l2 = tr_read<v_rd_off2(D0, 2, 0)>(vb), h2 = tr_read<v_rd_off2(D0, 2, 1)>(vb), l3 = tr_read<v_rd_off2(D0, 3, 0)>(vb), h3 = tr_read<v_rd_off2(D0, 3, 1)>(vb);
  asm volatile("s_waitcnt lgkmcnt(0)" ::: "memory"); SBAR();
#define PK(L, H) (bf16x8){L[0], L[1], L[2], L[3], H[0], H[1], H[2], H[3]}
  od = __builtin_amdgcn_mfma_f32_32x32x16_bf16(PK(l0, h0), pa0, od, 0, 0, 0);
  od = __builtin_amdgcn_mfma_f32_32x32x16_bf16(PK(l1, h1), pa1, od, 0, 0, 0);
  od = __builtin_amdgcn_mfma_f32_32x32x16_bf16(PK(l2, h2), pa2, od, 0, 0, 0);
  od = __builtin_amdgcn_mfma_f32_32x32x16_bf16(PK(l3, h3), pa3, od, 0, 0, 0);
#undef PK
}
#define PV_RD2(D0, X) const s16x4 X##l0 = tr_read<v_rd_off2(D0, 0, 0)>(vb), X##h0 = tr_read<v_rd_off2(D0, 0, 1)>(vb), X##l1 = tr_read<v_rd_off2(D0, 1, 0)>(vb), X##h1 = tr_read<v_rd_off2(D0, 1, 1)>(vb), \
                              X##l2 = tr_read<v_rd_off2(D0, 2, 0)>(vb), X##h2 = tr_read<v_rd_off2(D0, 2, 1)>(vb), X##l3 = tr_read<v_rd_off2(D0, 3, 0)>(vb), X##h3 = tr_read<v_rd_off2(D0, 3, 1)>(vb)
#define PV_PK2(L, H) (bf16x8){L[0], L[1], L[2], L[3], H[0], H[1], H[2], H[3]}
#define PV_MM2(OD, X) do { OD = __builtin_amdgcn_mfma_f32_32x32x16_bf16(PV_PK2(X##l0, X##h0), pa0, OD, 0, 0, 0); OD = __builtin_amdgcn_mfma_f32_32x32x16_bf16(PV_PK2(X##l1, X##h1), pa1, OD, 0, 0, 0); \
                           OD = __builtin_amdgcn_mfma_f32_32x32x16_bf16(PV_PK2(X##l2, X##h2), pa2, OD, 0, 0, 0); OD = __builtin_amdgcn_mfma_f32_32x32x16_bf16(PV_PK2(X##l3, X##h3), pa3, OD, 0, 0, 0); } while (0)
__device__ __forceinline__ void pv_d02(f32x16* o, int vb, bf16x8 pa0, bf16x8 pa1, bf16x8 pa2, bf16x8 pa3) {
  PV_RD2(0, a);
  PV_RD2(1, b); asm volatile("s_waitcnt lgkmcnt(8)" ::: "memory"); SBAR(); PV_MM2(o[0], a); SBAR();
  PV_RD2(2, c); asm volatile("s_waitcnt lgkmcnt(8)" ::: "memory"); SBAR(); PV_MM2(o[1], b); SBAR();
  PV_RD2(3, d); asm volatile("s_waitcnt lgkmcnt(8)" ::: "memory"); SBAR(); PV_MM2(o[2], c); SBAR();
  asm volatile("s_waitcnt lgkmcnt(0)" ::: "memory"); SBAR(); PV_MM2(o[3], d);
}
#define EXP4(P, B) do { P[(B) + 0] = __builtin_amdgcn_exp2f(P[(B) + 0]); P[(B) + 1] = __builtin_amdgcn_exp2f(P[(B) + 1]); P[(B) + 2] = __builtin_amdgcn_exp2f(P[(B) + 2]); P[(B) + 3] = __builtin_amdgcn_exp2f(P[(B) + 3]); } while (0)
#define EXP2_(P, B) do { P[(B) + 0] = __builtin_amdgcn_exp2f(P[(B) + 0]); P[(B) + 1] = __builtin_amdgcn_exp2f(P[(B) + 1]); } while (0)
__device__ __forceinline__ void pv_d03(f32x16* o, int vb, bf16x8 pa0, bf16x8 pa1, bf16x8 pa2, bf16x8 pa3, f32x16& pn, f32x16& pm) {
  PV_RD2(0, a);
  PV_RD2(1, b); asm volatile("s_waitcnt lgkmcnt(8)" ::: "memory"); SBAR(); PV_MM2(o[0], a); EXP4(pn, 0); EXP4(pm, 0); SBAR();
  PV_RD2(2, c); asm volatile("s_waitcnt lgkmcnt(8)" ::: "memory"); SBAR(); PV_MM2(o[1], b); EXP4(pn, 4); EXP4(pm, 4); SBAR();
  PV_RD2(3, d); asm volatile("s_waitcnt lgkmcnt(8)" ::: "memory"); SBAR(); PV_MM2(o[2], c); EXP4(pn, 8); EXP4(pm, 8); SBAR();
  asm volatile("s_waitcnt lgkmcnt(0)" ::: "memory"); SBAR(); PV_MM2(o[3], d); EXP4(pn, 12); EXP4(pm, 12);
}
__device__ __forceinline__ void attn_dense_body(const bf16* Qb, const bf16* __restrict__ Kh, const bf16* __restrict__ Vh, const bf16* __restrict__ Zb,
                                                bf16* Ob, int seq, char* lds, const int wid_in, const float kmax, __attribute__((address_space(3))) unsigned char* lds3) {
  using St = Stage<bf16>; using SQ = Stage<bf16>; using TQ = bf16;
  int lane = __builtin_amdgcn_mbcnt_hi(~0u, __builtin_amdgcn_mbcnt_lo(~0u, 0u)); asm volatile("" : "+v"(lane));
  const int wid = wid_in, tid = wid * 64 + lane, r32 = lane & 31, hi = lane >> 5;
  bf16* V_lds = (bf16*)lds; bf16* K_lds = (bf16*)(lds + 3 * SHM_V);
  float l_reg = 0; f32x16 o[4] = {}; bf16x8 qr[8];
  const TQ* Qw = Qb + (long)(wid * QBLK + r32) * LDQ + hi * 8;
#pragma unroll
  for (int d0 = 0; d0 < 8; ++d0) qr[d0] = SQ::tobf(SQ::ld8(Qw + d0 * 16));
  float negBC;
  { float ss = 0.f;
#pragma unroll
    for (int d0 = 0; d0 < 8; ++d0)
#pragma unroll
      for (int e = 0; e < 8; ++e) { const float qv = __uint_as_float((unsigned)(unsigned short)qr[d0][e] << 16); ss = fmaf(qv, qv, ss); }
    auto rr = __builtin_amdgcn_permlane32_swap(__float_as_uint(ss), __float_as_uint(ss), false, false);
    ss = __uint_as_float(rr[0]) + __uint_as_float(rr[1]);
    negBC = -(sqrtf(ss) * kmax * (11.313708498984761f * 1.01f) + 0.07f); }
  f32x16 cinit; for (int r = 0; r < 16; ++r) cinit[r] = negBC;
  const int vb0 = (int)(uintptr_t)V_lds + v_rd_base2(lane);
  int koff0, koff1, voff0, voff1;
  { const int rk0 = 8 * wid + (lane >> 4), rk1 = rk0 + 4; koff0 = rk0 * (LDK * 2) + (((lane & 15) ^ (rk0 & 15)) << 4); koff1 = rk1 * (LDK * 2) + (((lane & 15) ^ (rk1 & 15)) << 4);
    const int st0 = 4 * wid + (lane >> 5), st1 = st0 + 2, q8 = (lane & 31) >> 2;
    const int kk0 = ((st0 >> 2) << 3) | q8, kk1 = ((st1 >> 2) << 3) | q8;
    const int ky0 = (kk0 & ~0xC) | ((kk0 & 4) << 1) | ((kk0 & 8) >> 1), ky1 = (kk1 & ~0xC) | ((kk1 & 4) << 1) | ((kk1 & 8) >> 1);
    voff0 = ky0 * (LDK * 2) + ((st0 & 3) * 32 + (lane & 3) * 8) * 2; voff1 = ky1 * (LDK * 2) + ((st1 & 3) * 32 + (lane & 3) * 8) * 2; }
#define SDMA(s, k0) do { const char* kg_ = (const char*)(Kh + (long)(k0) * LDK); const char* vg_ = (const char*)(Vh + (long)(k0) * LDK); \
    __attribute__((address_space(3))) unsigned char* kd_ = lds3 + 3 * (int)SHM_V + (s) * (int)SHM_K + wid * 2048; __attribute__((address_space(3))) unsigned char* vd_ = lds3 + (s) * (int)SHM_V + wid * 2048; \
    __builtin_amdgcn_global_load_lds((const unsigned*)(kg_ + koff0), (__attribute__((address_space(3))) unsigned*)kd_, 16, 0, 0); \
    __builtin_amdgcn_global_load_lds((const unsigned*)(kg_ + koff1), (__attribute__((address_space(3))) unsigned*)(kd_ + 1024), 16, 0, 0); \
    __builtin_amdgcn_global_load_lds((const unsigned*)(vg_ + voff0), (__attribute__((address_space(3))) unsigned*)vd_, 16, 0, 0); \
    __builtin_amdgcn_global_load_lds((const unsigned*)(vg_ + voff1), (__attribute__((address_space(3))) unsigned*)(vd_ + 1024), 16, 0, 0); } while (0)
#define DWAIT() asm volatile("s_waitcnt vmcnt(0)" ::: "memory")
  f32x16 pA0, pA1, pB0, pB1; bf16x8 pa0, pa1, pa2, pa3; const int NT = seq / KVBLK;
  SDMA(0, 0); DWAIT(); __syncthreads();
  SDMA(1, KVBLK);
  qkt3(pA0, pA1, K_lds, qr, r32, hi, cinit); partialSM3(pA0);
  for (int r = 0; r < 16; ++r) pA1[r] = __builtin_amdgcn_exp2f(pA1[r]);
  DWAIT(); __syncthreads();
  int sP = 0, sC = 1, sN = 2;
#define KSLOT(s) ((bf16*)((char*)K_lds + (s) * (int)SHM_K))
#define ROT() do { const int t_ = sP; sP = sC; sC = sN; sN = t_; } while (0)
  for (int j = 1; j + 1 < NT; j += 2) {
    SDMA(sN, (j + 1) * KVBLK);
    SBAR(); qkt3(pB0, pB1, KSLOT(sC), qr, r32, hi, cinit);
    finishSM4<16>(pA0, pA1, l_reg, pa0, pa1, pa2, pa3);
    pv_d03(o, vb0 + sP * (int)SHM_V, pa0, pa1, pa2, pa3, pB0, pB1);
    DWAIT(); __syncthreads(); ROT();
    SDMA(sN, (j + 2) * KVBLK);
    SBAR(); qkt3(pA0, pA1, KSLOT(sC), qr, r32, hi, cinit);
    finishSM4<16>(pB0, pB1, l_reg, pa0, pa1, pa2, pa3);
    pv_d03(o, vb0 + sP * (int)SHM_V, pa0, pa1, pa2, pa3, pA0, pA1);
    DWAIT(); __syncthreads(); ROT();
  }
  SBAR(); qkt3(pB0, pB1, KSLOT(sC), qr, r32, hi, cinit);
  finishSM4<16>(pA0, pA1, l_reg, pa0, pa1, pa2, pa3); SBAR();
  pv_d03(o, vb0 + sP * (int)SHM_V, pa0, pa1, pa2, pa3, pB0, pB1);
  finishSM4<16>(pB0, pB1, l_reg, pa0, pa1, pa2, pa3); SBAR();
  pv_d02(o, vb0 + sC * (int)SHM_V, pa0, pa1, pa2, pa3);
#undef KSLOT
#undef ROT
#undef SDMA
#undef DWAIT
  { auto rr = __builtin_amdgcn_permlane32_swap(__float_as_uint(l_reg), __float_as_uint(l_reg), false, false); l_reg = __uint_as_float(rr[0]) + __uint_as_float(rr[1]); }
  const float rl = __builtin_amdgcn_rcpf(l_reg);
  { int lb = (wid * QBLK + r32) * LDO + 4 * hi; asm volatile("" : "+v"(lb));
    unsigned short* Ow = (unsigned short*)Ob + lb; const unsigned short* Zw = (const unsigned short*)Zb + lb;
#pragma unroll
    for (int d0 = 0; d0 < 4; ++d0)
#pragma unroll
      for (int g = 0; g < 4; ++g) { const int co = d0 * 32 + 8 * g; const unsigned long long zz = *(const unsigned long long*)(Zw + co);
        const float z0 = __uint_as_float((unsigned)(zz << 16)), z1 = __uint_as_float((unsigned)zz & 0xffff0000u), z2 = __uint_as_float((unsigned)(zz >> 32) << 16), z3 = __uint_as_float((unsigned)(zz >> 32) & 0xffff0000u);
        const unsigned w0 = cvtpk(o[d0][4 * g + 0] * rl * z0, o[d0][4 * g + 1] * rl * z1), w1 = cvtpk(o[d0][4 * g + 2] * rl * z2, o[d0][4 * g + 3] * rl * z3);
        *(unsigned long long*)(Ow + co) = (unsigned long long)w0 | ((unsigned long long)w1 << 32); } }
}
}

typedef unsigned short bf16_t;
typedef float f32x4 __attribute__((ext_vector_type(4)));
typedef unsigned u32x4 __attribute__((ext_vector_type(4)));
typedef unsigned u32x2v __attribute__((ext_vector_type(2)));
typedef short bf16x8v __attribute__((ext_vector_type(8)));
typedef float f32x16v __attribute__((ext_vector_type(16)));
#define LAS __attribute__((address_space(3)))
#define XB_TMO      128
#define XB_XCNT(j)  (256  + 64 * (j))
#define XB_XSUB(j)  (1280 + 64 * (j))
#define XB_XGEN(j)  (2304 + 64 * (j))
#define XB_TOP      3328
#define XB_TOPGEN   3392
#define XCD_BAR_WORDS 3456
#define XB_SPIN_CAP (1u << 18)

__device__ __forceinline__ unsigned xb_ld(unsigned* p)              { return __hip_atomic_load(p, __ATOMIC_RELAXED, __HIP_MEMORY_SCOPE_AGENT); }
__device__ __forceinline__ unsigned xb_add(unsigned* p, unsigned v) { return __hip_atomic_fetch_add(p, v, __ATOMIC_RELAXED, __HIP_MEMORY_SCOPE_AGENT); }
__device__ __forceinline__ unsigned xb_xcc_id() { return (unsigned)__builtin_amdgcn_s_getreg((3 << 11) | 20) & 0xFu; }
#define XB_SPIN(cond, bar) do { unsigned _sp = 0; while (cond) { __builtin_amdgcn_s_sleep(1); \
    if ((++_sp & 255u) == 0u) { if (xb_ld(&(bar)[XB_TMO])) break; if (_sp > XB_SPIN_CAP) { atomicAdd(&(bar)[XB_TMO], 1u); break; } } } } while (0)

struct XcdBarrier {
    unsigned* bar; unsigned x;
    volatile LAS unsigned* st;
};

__device__ __forceinline__ XcdBarrier xcd_barrier_post(unsigned* bar, volatile LAS unsigned* st, const bool leader) {
    XcdBarrier b; b.bar = bar; b.x = xb_xcc_id(); b.st = st;
    if (leader) (void)xb_add(&bar[XB_XCNT(b.x)], 1u);
    return b;
}
__device__ __forceinline__ void xcd_barrier_complete(unsigned* bar, unsigned x, unsigned& nloc, unsigned& nx) {
    const unsigned G = gridDim.x * gridDim.y * gridDim.z;
    unsigned sum, cnt, mine, sp = 0u;
    for (;;) {
        sum = 0u; cnt = 0u; mine = 0u;
#pragma unroll
        for (unsigned j = 0; j < 16; ++j) { const unsigned c = xb_ld(&bar[XB_XCNT(j)]); sum += c; cnt += (c > 0u) ? 1u : 0u; mine = (j == x) ? c : mine; }
        if (sum == G) break;
        __builtin_amdgcn_s_sleep(1);
        if ((++sp & 255u) == 0u) { if (xb_ld(&bar[XB_TMO])) break; if (sp > XB_SPIN_CAP) { atomicAdd(&bar[XB_TMO], 1u); break; } }
    }
    nloc = mine > 0u ? mine : 1u; nx = cnt > 0u ? cnt : 1u;
}

__device__ __forceinline__ void xcd_barrier(const XcdBarrier& b, const bool leader) {
    asm volatile("s_waitcnt vmcnt(0)" ::: "memory");
    __syncthreads();
    if (leader) {
        unsigned* bar = b.bar;
        __builtin_amdgcn_s_waitcnt(0);
        unsigned nloc = b.st[0], nx = b.st[1];
        if (nloc == 0u) { xcd_barrier_complete(bar, b.x, nloc, nx); b.st[0] = nloc; b.st[1] = nx; }
        const unsigned old = xb_add(&bar[XB_XSUB(b.x)], 1u);
        const unsigned gen = old / nloc;
        if (old + 1u == (gen + 1u) * nloc) {
            __builtin_amdgcn_fence(__ATOMIC_RELEASE, "agent");
            asm volatile("s_waitcnt vmcnt(0)" ::: "memory");
            const unsigned og = xb_add(&bar[XB_TOP], 1u);
            const unsigned tg = og / nx;
            if (og + 1u == (tg + 1u) * nx) xb_add(&bar[XB_TOPGEN], 1u);
            else XB_SPIN(xb_ld(&bar[XB_TOPGEN]) == tg, bar);
            __builtin_amdgcn_fence(__ATOMIC_ACQUIRE, "agent");
            xb_add(&bar[XB_XGEN(b.x)], 1u);
            asm volatile("s_waitcnt vmcnt(0)" ::: "memory");
        } else {
            XB_SPIN(xb_ld(&bar[XB_XGEN(b.x)]) == gen, bar);
            __builtin_amdgcn_fence(__ATOMIC_ACQUIRE, "agent");
            asm volatile("s_waitcnt vmcnt(0)" ::: "memory");
        }
    }
    __syncthreads();
}

constexpr int RING_BYTES = pg8::STAGE_BYTES;
constexpr int PART_OFF = RING_BYTES;
constexpr int XBST_OFF = RING_BYTES + 8192;
constexpr int LDS_BYTES = RING_BYTES + 8192 + 16;

__device__ __forceinline__ unsigned pk2(float a, float b) { return pg8::cvt_pk_bf16(a, b); }
__device__ __forceinline__ float wave_sum(float v) {
#pragma unroll
    for (int o = 1; o < 64; o <<= 1) v += __shfl_xor(v, o);
    return v;
}
__device__ __forceinline__ const float* xrow_c(const float* lat, const float* cx, int r) {
    const int b = r / TB, rr = r - b * TB;
    return rr < CTXL ? cx + ((size_t)b * CTXL + rr) * DM : lat + ((size_t)b * SEQ + (rr - CTXL)) * DM;
}
__device__ __forceinline__ int qk_src(int c) { const int h = c & ~127, cp = c & 127;
    return h + ((cp >> 6) & 1) * 64 + ((cp >> 2) & 1) * 32 + ((cp >> 5) & 1) * 16 + ((cp >> 3) & 3) * 4 + (cp & 3); }

__device__ __forceinline__ void transpose_item(const float* W, int K, int N, bf16_t* WT, LAS float* scr, int item, int lane, int nperm) {
    const int nblk = N / 32, kb = item / nblk, nb = item % nblk, k0 = 64 * kb, n0 = 32 * nb;
    const int cdst = n0 + (lane & 31), csrc = cdst < nperm ? qk_src(cdst) : cdst;
#pragma unroll 8
    for (int i = 0; i < 32; ++i) { const int kk = 2 * i + (lane >> 5); scr[kk * 33 + (lane & 31)] = W[(size_t)(k0 + kk) * N + csrc]; }
    asm volatile("s_waitcnt lgkmcnt(0)" ::: "memory");
    const int c = lane & 7;
#pragma unroll
    for (int j = 0; j < 4; ++j) { const int n = (lane >> 3) + 8 * j; const LAS float* s = scr + (8 * c) * 33 + n;
        u32x4 o; o.x = pk2(s[0 * 33], s[1 * 33]); o.y = pk2(s[2 * 33], s[3 * 33]); o.z = pk2(s[4 * 33], s[5 * 33]); o.w = pk2(s[6 * 33], s[7 * 33]);
        *(u32x4*)(WT + (size_t)(n0 + n) * K + k0 + 8 * c) = o; }
    asm volatile("s_waitcnt lgkmcnt(0)" ::: "memory");
}

template <int GI> __device__ __forceinline__ void pool_unit_t(const bf16_t* XB, bf16_t* ZB, const bf16_t* WPt, const float* pscale, int R0, int lane) {
    constexpr int g = GI, a = 1 << GI;
    const int pm = R0 >> 8, b = pm / 65, jt = pm % 65;
    const int lo = b * TB + (jt ? CTXL : 0), hiR = jt ? (b + 1) * TB : b * TB + CTXL;
    const int r32 = lane & 31, hh = lane >> 5, t = R0 + r32;
    const int s0 = max(t - a, lo), s1 = min(t + a - 1, hiR - 1); const float inv = 1.0f / (float)(s1 - s0 + 1);
    f32x16v acc0 = {}, acc1 = {}, acc2 = {}, acc3 = {};
    const bf16_t* xb = XB + g * 128 + hh * 8;
    const bf16_t* wp = WPt + (size_t)(g * 128 + r32) * 128 + hh * 8;
    float wq[2 * a]; int rq[2 * a];
#pragma unroll
    for (int q = 0; q < 2 * a; ++q) { const int rr = t - a + q; const bool ok = (rr >= lo) && (rr < hiR); wq[q] = ok ? inv : 0.f; rq[q] = ok ? rr : t; }
#pragma unroll 1
    for (int kk = 0; kk < 8; ++kk) {
        u32x4 wv[2 * a];
#pragma unroll
        for (int q = 0; q < 2 * a; ++q) wv[q] = *(const u32x4*)(xb + (size_t)rq[q] * 512 + kk * 16);
        const u32x4 w = *(const u32x4*)(xb + (size_t)t * 512 + kk * 16);
        const bf16x8v w0 = *(const bf16x8v*)(wp + kk * 16), w1 = *(const bf16x8v*)(wp + 32 * 128 + kk * 16), w2 = *(const bf16x8v*)(wp + 64 * 128 + kk * 16), w3 = *(const bf16x8v*)(wp + 96 * 128 + kk * 16);
        float s[8] = {0.f, 0.f, 0.f, 0.f, 0.f, 0.f, 0.f, 0.f};
#pragma unroll
        for (int q = 0; q < 2 * a; ++q) { const float f = wq[q]; const u32x4 v = wv[q];
            s[0] += f * pg8::bf_lo(v.x); s[1] += f * pg8::bf_hi(v.x); s[2] += f * pg8::bf_lo(v.y); s[3] += f * pg8::bf_hi(v.y); s[4] += f * pg8::bf_lo(v.z); s[5] += f * pg8::bf_hi(v.z); s[6] += f * pg8::bf_lo(v.w); s[7] += f * pg8::bf_hi(v.w); }
        u32x4 mf; mf.x = pk2(s[0] - pg8::bf_lo(w.x), s[1] - pg8::bf_hi(w.x)); mf.y = pk2(s[2] - pg8::bf_lo(w.y), s[3] - pg8::bf_hi(w.y));
        mf.z = pk2(s[4] - pg8::bf_lo(w.z), s[5] - pg8::bf_hi(w.z)); mf.w = pk2(s[6] - pg8::bf_lo(w.w), s[7] - pg8::bf_hi(w.w));
        const bf16x8v mfrag = *reinterpret_cast<bf16x8v*>(&mf);
        acc0 = __builtin_amdgcn_mfma_f32_32x32x16_bf16(w0, mfrag, acc0, 0, 0, 0); acc1 = __builtin_amdgcn_mfma_f32_32x32x16_bf16(w1, mfrag, acc1, 0, 0, 0);
        acc2 = __builtin_amdgcn_mfma_f32_32x32x16_bf16(w2, mfrag, acc2, 0, 0, 0); acc3 = __builtin_amdgcn_mfma_f32_32x32x16_bf16(w3, mfrag, acc3, 0, 0, 0);
    }
    bf16_t* zrow = ZB + (size_t)t * 512 + g * 128; const float* ps = pscale + g * 128;
#define POOL_OUT(ACC, NS) do { _Pragma("unroll") for (int q = 0; q < 4; ++q) { const int n0 = (NS) * 32 + 8 * q + 4 * hh; const u32x2v z = *(const u32x2v*)(zrow + n0); const f32x4 p4 = *(const f32x4*)(ps + n0); \
        u32x2v o; o.x = pk2(ACC[4 * q + 0] * p4[0] * pg8::bf_lo(z.x), ACC[4 * q + 1] * p4[1] * pg8::bf_hi(z.x)); o.y = pk2(ACC[4 * q + 2] * p4[2] * pg8::bf_lo(z.y), ACC[4 * q + 3] * p4[3] * pg8::bf_hi(z.y)); \
        *(u32x2v*)(zrow + n0) = o; } } while (0)
    POOL_OUT(acc0, 0); POOL_OUT(acc1, 1); POOL_OUT(acc2, 2); POOL_OUT(acc3, 3);
#undef POOL_OUT
}
__device__ __forceinline__ void pool_unit(const bf16_t* XB, bf16_t* ZB, const bf16_t* WPt, const float* pscale, int wu, int lane) {
    const int g = wu & 3, R0 = (wu >> 2) * 32;
    if (g == 0) pool_unit_t<0>(XB, ZB, WPt, pscale, R0, lane); else if (g == 1) pool_unit_t<1>(XB, ZB, WPt, pscale, R0, lane);
    else if (g == 2) pool_unit_t<2>(XB, ZB, WPt, pscale, R0, lane); else pool_unit_t<3>(XB, ZB, WPt, pscale, R0, lane);
}

__device__ __forceinline__ void store_u(const f32x4 (&v)[4], const float* mod, bf16_t* urow, int lane) {
#pragma unroll
    for (int j = 0; j < 4; ++j) { const int c = 4 * lane + 256 * j; const f32x4 sh = *(const f32x4*)(mod + c), sc = *(const f32x4*)(mod + 1024 + c);
        const f32x4 u = v[j] * (sc + 1.0f) + sh; u32x2v o; o.x = pk2(u[0], u[1]); o.y = pk2(u[2], u[3]); *(u32x2v*)(urow + c) = o; }
}

__global__ void __launch_bounds__(NTHREADS, 2) mega(Params P) {
    extern __shared__ __attribute__((aligned(16))) unsigned char lds[];
    cg::grid_group grid = cg::this_grid();
    const int wave = __builtin_amdgcn_readfirstlane(threadIdx.x >> 6);
#define LANE_ID() (__builtin_amdgcn_mbcnt_hi(~0u, __builtin_amdgcn_mbcnt_lo(~0u, 0u)))
    const int G = gridDim.x, bid = blockIdx.x, gw = bid * NWAVES + wave, NGW = G * NWAVES;
#define GRID_SYNC() xcd_barrier(xbar, wave == 0 && LANE_ID() == 0)
#define CAS __attribute__((address_space(4)))
#define WSL() const CAS Params* pp = (const CAS Params*)__builtin_amdgcn_kernarg_segment_ptr(); asm volatile("" : "+s"(pp)); unsigned char* wsl = pp->ws; asm volatile("" : "+s"(wsl))
#define U ((bf16_t*)(wsl + WS_U))
#define Q ((bf16_t*)(wsl + WS_Q))
#define Kb ((bf16_t*)(wsl + WS_K))
#define Vb ((bf16_t*)(wsl + WS_V))
#define ZA ((bf16_t*)(wsl + WS_ZA))
#define XB ((bf16_t*)(wsl + WS_XB))
#define ZB ((bf16_t*)(wsl + WS_ZB))
#define MOD ((float*)(wsl + WS_MOD))
#define CX ((float*)(wsl + WS_CX))
#define DELTA ((const bf16_t*)(wsl + WS_GA))
    LAS unsigned char* l3 = (LAS unsigned char*)lds;
    const CAS Params* pp0 = (const CAS Params*)__builtin_amdgcn_kernarg_segment_ptr();
    { volatile LAS unsigned* st = (volatile LAS unsigned*)(l3 + XBST_OFF); if (wave == 0 && LANE_ID() == 0) { st[0] = 0u; st[1] = 0u; st[2] = 0u; st[3] = 0u; } }
    __syncthreads();
    XcdBarrier xbar = xcd_barrier_post((unsigned*)(pp0->ws + WS_BAR), (volatile LAS unsigned*)(l3 + XBST_OFF), wave == 0 && LANE_ID() == 0);
    grid.sync();

    constexpr int NPH = 2 + 5 * DEPTH;
#pragma unroll 1
    for (int ph = 0; ph < NPH; ++ph) {
    const int l = ph < 2 ? 0 : (ph - 2) / 5, sph = ph < 2 ? ph : 2 + (ph - 2) % 5;
    if (sph == 0) {
        WSL(); int lane = LANE_ID(); asm volatile("" : "+v"(lane)); const int tid = wave * 64 + lane; unsigned char* ws = wsl; float* cosT = (float*)(wsl + WS_ROPE); float* sinT = cosT + 256 * 32;
        LAS float* scr = (LAS float*)(l3 + wave * 16384);
        constexpr int I_IN = (DM / 64) * (NIN / 32), I_A = (DM / 64) * (DM / 32), I_B = (512 / 64) * (DM / 32), I_O = I_A, I_P = (128 / 64) * (128 / 32);
        constexpr int PER_L = I_IN + I_A + I_B + I_O + 4 * I_P;
        for (int it = gw; it < DEPTH * PER_L; it += NGW) {
            const int l = it / PER_L; int r = it - l * PER_L;
            if (r < I_IN) { transpose_item(pp->w_in + (size_t)l * DM * NIN, DM, NIN, (bf16_t*)(ws + WS_WIN + l * SZ_WIN), scr, r, lane, 1280); continue; } r -= I_IN;
            if (r < I_A) { transpose_item(pp->w_br_a + (size_t)l * DM * DM, DM, DM, (bf16_t*)(ws + WS_WA + l * SZ_WA), scr, r, lane, 0); continue; } r -= I_A;
            if (r < I_B) { transpose_item(pp->w_br_b + (size_t)l * 512 * DM, 512, DM, (bf16_t*)(ws + WS_WB + l * SZ_WB), scr, r, lane, 0); continue; } r -= I_B;
            if (r < I_O) { transpose_item(pp->w_out + (size_t)l * DM * DM, DM, DM, (bf16_t*)(ws + WS_WO + l * SZ_WO), scr, r, lane, 0); continue; } r -= I_O;
            const int g = r / I_P; r -= g * I_P;
            transpose_item(pp->w_pool + ((size_t)l * 4 + g) * 128 * 128, 128, 128, (bf16_t*)(ws + WS_WP + l * SZ_WP) + (size_t)g * 128 * 128, scr, r, lane, 0);
        }
        for (int i = bid * NTHREADS + tid; i < 256 * 32; i += G * NTHREADS) { const int pos = i >> 5, f = i & 31;
            const float invf = 1.0f / __builtin_amdgcn_exp2f(13.287712379549449f * (float)f * (1.0f / 32.0f)); const float ang = (float)pos * invf;
            double rev = (double)ang * 0.15915494309189535; rev -= floor(rev); const float fr_ = (float)rev;
            cosT[i] = __builtin_amdgcn_cosf(fr_); sinT[i] = __builtin_amdgcn_sinf(fr_); }
        __syncthreads();
        LAS float* sv = (LAS float*)l3;
        LAS float* red = sv + 3 * 1024;
        for (int i = tid; i < 3 * 1024; i += NTHREADS) { const int v = i >> 10, k = i & 1023; const float cv = v < 2 ? pp->c[v * 1024 + k] : pp->c_ctx[k]; sv[i] = cv * pg8::sigm(cv); }
        __syncthreads();
        for (int un = bid; un < DEPTH * 48; un += G) { const int l = un / 48, n = (un % 48) * 64 + lane, ks = wave;
            const float* wm = pp->w_mod + (size_t)l * DM * 3072 + (size_t)(ks * 128) * 3072 + n; float a0 = 0.f, a1 = 0.f, a2 = 0.f;
#pragma unroll 8
            for (int k = 0; k < 128; ++k) { const float w = wm[(size_t)k * 3072]; a0 += sv[ks * 128 + k] * w; a1 += sv[1024 + ks * 128 + k] * w; a2 += sv[2048 + ks * 128 + k] * w; }
            red[(ks * 3 + 0) * 64 + lane] = a0; red[(ks * 3 + 1) * 64 + lane] = a1; red[(ks * 3 + 2) * 64 + lane] = a2;
            __syncthreads();
            if (tid < 192) { const int v = tid >> 6, cl = tid & 63; float s = 0.f;
#pragma unroll
                for (int q = 0; q < 8; ++q) s += red[(q * 3 + v) * 64 + cl];
                const int nn = (un % 48) * 64 + cl; MOD[((size_t)l * 3 + v) * 3072 + nn] = s + pp->b_mod[l * 3072 + nn]; }
            __syncthreads();
        }
    } else if (sph == 1) {
    WSL(); int lane = LANE_ID(); asm volatile("" : "+v"(lane));
    for (int r = gw; r < TROWS; r += NGW) { const float* xr = xrow_c(pp->x, pp->ctx, r); const int b = r / TB, mi = (r - b * TB) < CTXL ? 2 : b;
        f32x4 v[4];
#pragma unroll
        for (int j = 0; j < 4; ++j) v[j] = *(const f32x4*)(xr + 4 * lane + 256 * j);
        store_u(v, MOD + mi * 3072, U + (size_t)r * DM, lane); }
    } else if (sph == 2) {
        {
            WSL(); pg8::Gemm g{U, (const bf16_t*)(wsl + WS_WIN + l * SZ_WIN), TROWS, NIN, DM}; pg8::StaticOrder S; S.init(TROWS, NIN, G, bid);
            pg8::EpiIn E{wsl, pp->q_norm + l * 128, pp->k_norm + l * 128, (LAS float*)(l3 + PART_OFF)};
            pg8::gemm_phase<pg8::EpiIn, pg8::StaticOrder, true, true>(l3, g, S, E, wave);
        }
    } else if (sph == 3) {
        {
            WSL(); int lane = LANE_ID(); asm volatile("" : "+v"(lane)); const bf16_t* WPt = (const bf16_t*)(wsl + WS_WP + l * SZ_WP);
            const int nunits = 1024 + (l < DEPTH - 1 ? 16 : 0);
            float kmax; { const float* kn = pp->k_norm + l * 128; kmax = fmaxf(fabsf(kn[lane]), fabsf(kn[lane + 64]));
#pragma unroll
                for (int o_ = 1; o_ < 64; o_ <<= 1) kmax = fmaxf(kmax, __shfl_xor(kmax, o_)); }
            for (int un = bid; un < nunits; un += G) {
                __syncthreads();
                int b, h, rowq, seq;
                if (un < 1024) { b = un >> 9; h = (un >> 6) & 7; rowq = b * TB + CTXL + (un & 63) * 256; seq = TB; }
                else { const int c = un - 1024; b = c >> 3; h = c & 7; rowq = b * TB; seq = CTXL; }
                const size_t qoff = (size_t)rowq * DM + h * 128, koff = (size_t)b * TB * 256 + (h >> 2) * 128;
                att::attn_dense_body((const att::bf16*)(Q + qoff), (const att::bf16*)(Kb + koff), (const att::bf16*)(Vb + koff), (const att::bf16*)(ZA + qoff), (att::bf16*)(Q + qoff), seq, (char*)lds, wave, kmax, l3);
            }
            { unsigned* qctr = (unsigned*)(wsl + WS_BAR) + 8 + l; const int npool = (l < DEPTH - 1) ? (TROWS / 32) * 4 : (NBATCH * SEQ / 32) * 4;
              for (;;) { unsigned wq = 0u; if (lane == 0) wq = __hip_atomic_fetch_add(qctr, 1u, __ATOMIC_RELAXED, __HIP_MEMORY_SCOPE_AGENT);
                  const int wi = __builtin_amdgcn_readfirstlane((int)wq); if (wi >= npool) break;
                  int wu = wi; if (l == DEPTH - 1) { const int rc = wi >> 2, rcf = rc + (CTXL / 32) * (1 + rc / (SEQ / 32)); wu = (rcf << 2) | (wi & 3); }
                  pool_unit(XB, ZB, WPt, pp->pool_scale + l * 512, wu, lane); } }
        }
    } else if (sph == 4) {
        {
            WSL(); pg8::Gemm g{Q, (const bf16_t*)(wsl + WS_WA + l * SZ_WA), TROWS, DM, DM};
            pg8::EpiGate<0> E{wsl};
            { pg8::StaticOrder S; S.init(l == DEPTH - 1 ? NBATCH * SEQ : TROWS, DM, G, bid); S.skip = (l == DEPTH - 1); pg8::gemm_phase<pg8::EpiGate<0>, pg8::StaticOrder, true, true>(l3, g, S, E, wave); }
        }
        {
            WSL(); pg8::Gemm g{ZB, (const bf16_t*)(wsl + WS_WB + l * SZ_WB), TROWS, DM, 512};
            pg8::EpiGate<1> E{wsl};
            { pg8::StaticOrder S; S.init(l == DEPTH - 1 ? NBATCH * SEQ : TROWS, DM, G, bid); S.skip = (l == DEPTH - 1); pg8::gemm_phase<pg8::EpiGate<1>, pg8::StaticOrder, true, true>(l3, g, S, E, wave); }
        }
    } else if (sph == 5) {
        {
            WSL(); pg8::Gemm g{ZA, (const bf16_t*)(wsl + WS_WO + l * SZ_WO), TROWS, DM, DM};
            pg8::EpiRes E{MOD + (size_t)l * 3 * 3072, wsl};
            { pg8::StaticOrder S; S.init(l == DEPTH - 1 ? NBATCH * SEQ : TROWS, DM, G, bid); S.skip = (l == DEPTH - 1); pg8::gemm_phase<pg8::EpiRes, pg8::StaticOrder, true, true>(l3, g, S, E, wave); }
        }
    } else {
        {
            WSL(); int lane = LANE_ID(); asm volatile("" : "+v"(lane)); const float* modl = MOD + (size_t)l * 3 * 3072; const float* lg = pp->ln_g + l * DM; const float* lb = pp->ln_b + l * DM; const bool last = (l == DEPTH - 1);
            const float* xlat = l == 0 ? pp->x : pp->out; const float* xctx = l == 0 ? pp->ctx : CX;
            auto ln_row = [&](const int r, const f32x4 (&vin)[4]) {
                const int b = r / TB, rr = r - b * TB; const bool isctx = rr < CTXL; f32x4 v[4]; float s = 0.f;
#pragma unroll
                for (int j = 0; j < 4; ++j) { v[j] = vin[j]; s += (v[j][0] + v[j][1]) + (v[j][2] + v[j][3]); }
                const float mean = wave_sum(s) * (1.0f / DM); float s2 = 0.f;
#pragma unroll
                for (int j = 0; j < 4; ++j) { v[j] = v[j] - mean; s2 += (v[j][0] * v[j][0] + v[j][1] * v[j][1]) + (v[j][2] * v[j][2] + v[j][3] * v[j][3]); }
                const float rstd = 1.0f / sqrtf(wave_sum(s2) * (1.0f / DM) + EPSV);
                float* xo = isctx ? CX + ((size_t)b * CTXL + rr) * DM : pp->out + ((size_t)b * SEQ + (rr - CTXL)) * DM;
#pragma unroll
                for (int j = 0; j < 4; ++j) { const int c = 4 * lane + 256 * j; v[j] = v[j] * rstd * *(const f32x4*)(lg + c) + *(const f32x4*)(lb + c); *(f32x4*)(xo + c) = v[j]; }
                if (!last) store_u(v, modl + 3 * 3072 + (isctx ? 2 : b) * 3072, U + (size_t)r * DM, lane);
            };
            const int nrows = last ? NBATCH * SEQ : TROWS;
            for (int i0 = gw; i0 < nrows; i0 += 2 * NGW) {
                const int i1 = i0 + NGW; const bool has1 = i1 < nrows;
                const int r0 = last ? i0 + CTXL * (1 + i0 / SEQ) : i0, r1 = has1 ? (last ? i1 + CTXL * (1 + i1 / SEQ) : i1) : r0;
                f32x4 va[4], vb[4]; const float* xa = xrow_c(xlat, xctx, r0); const float* xb_ = xrow_c(xlat, xctx, r1);
                const bf16_t* da = DELTA + (size_t)r0 * DM; const bf16_t* db = DELTA + (size_t)r1 * DM;
#pragma unroll
                for (int j = 0; j < 4; ++j) { const int c = 4 * lane + 256 * j; const f32x4 x0 = *(const f32x4*)(xa + c), x1 = *(const f32x4*)(xb_ + c);
                    const u32x2v d0 = *(const u32x2v*)(da + c), d1 = *(const u32x2v*)(db + c);
                    va[j] = x0 * ALPHA_RES + (f32x4){pg8::bf_lo(d0.x), pg8::bf_hi(d0.x), pg8::bf_lo(d0.y), pg8::bf_hi(d0.y)};
                    vb[j] = x1 * ALPHA_RES + (f32x4){pg8::bf_lo(d1.x), pg8::bf_hi(d1.x), pg8::bf_lo(d1.y), pg8::bf_hi(d1.y)}; }
                ln_row(r0, va); if (has1) ln_row(r1, vb);
            }
        }
    }
    if (ph + 1 < NPH) GRID_SYNC();
    }
}

extern "C" void kernel_launch(void* const* d_in, const int* in_sizes, int n_in, void* d_out, int out_size, void* d_ws, size_t ws_size, hipStream_t stream) {
    static int grid_blocks = 0;
    if (grid_blocks == 0) {
        if (n_in != 16 || ws_size < WS_END2 || out_size != NBATCH * SEQ * DM) { fprintf(stderr, "kernel_launch: unexpected shapes: n_in %d out %d ws %zu (need %zu)\n", n_in, out_size, ws_size, (size_t)WS_END2); grid_blocks = -1; return; }
        int dev = 0, cus = 0, per_cu = 0;
        hipGetDevice(&dev); hipDeviceGetAttribute(&cus, hipDeviceAttributeMultiprocessorCount, dev);
        if (hipFuncSetAttribute((const void*)mega, hipFuncAttributeMaxDynamicSharedMemorySize, LDS_BYTES) != hipSuccess) { fprintf(stderr, "kernel_launch: hipFuncSetAttribute failed\n"); grid_blocks = -1; return; }
        if (hipOccupancyMaxActiveBlocksPerMultiprocessor(&per_cu, (const void*)mega, NTHREADS, LDS_BYTES) != hipSuccess || per_cu < 1) { fprintf(stderr, "kernel_launch: occupancy query gave %d\n", per_cu); per_cu = 1; }
        (void)hipGetLastError();
        grid_blocks = cus * per_cu;
    }
    if (grid_blocks < 0) return;
    Params p{};
    p.x = (const float*)d_in[0]; p.c = (const float*)d_in[1]; p.ctx = (const float*)d_in[2]; p.c_ctx = (const float*)d_in[3]; p.w_mod = (const float*)d_in[4]; p.b_mod = (const float*)d_in[5];
    p.w_in = (const float*)d_in[6]; p.q_norm = (const float*)d_in[7]; p.k_norm = (const float*)d_in[8]; p.w_pool = (const float*)d_in[9]; p.pool_scale = (const float*)d_in[10];
    p.w_br_a = (const float*)d_in[11]; p.w_br_b = (const float*)d_in[12]; p.w_out = (const float*)d_in[13]; p.ln_g = (const float*)d_in[14]; p.ln_b = (const float*)d_in[15];
    p.out = (float*)d_out; p.ws = (unsigned char*)d_ws;
    void* args[] = {&p};
    if (hipMemsetAsync((char*)d_ws + WS_BAR, 0, XCD_BAR_WORDS * 4, stream) != hipSuccess) { fprintf(stderr, "kernel_launch: memset of the barrier word failed\n"); return; }
    hipError_t e = hipLaunchCooperativeKernel((const void*)mega, dim3(grid_blocks), dim3(NTHREADS), args, LDS_BYTES, stream);
    if (e != hipSuccess) fprintf(stderr, "kernel_launch: cooperative launch failed: %s (grid %d)\n", hipGetErrorString(e), grid_blocks);
}
```
